# Optimizing an MI355X kernel written in HIP

```python
import math
import jax
import jax.numpy as jnp
from jax import lax
import numpy as np


D_MODEL = 1024
BATCH = 8
SEQ = 2048
DEPTH = 4

GRID_W = 64
CTX_LEN = 256
Q_BLOCK = 128
ROPE_THETA = 10000.0
EPS = 1e-6
F32 = jnp.float32

DIFF_HEADS = 4
DIFF_HEAD_DIM = 48
DIFF_V_DIM = 96
GQA_Q_HEADS = 6
GQA_KV_HEADS = 2
GQA_HEAD_DIM = 64
MLSTM_HEADS = 4
MLSTM_HEAD_DIM = 64
MLSTM_CHUNK = 64
MLSTM_CONV = 3

DIFF_WIDTH = 384
GQA_WIDTH = 384
MLSTM_WIDTH = 256
MIX_WIDTH = 1024
IN_SPLITS = (384, 384, 384, 384, 128, 128, 512, 256, 256, 16)
IN_WIDTH = 2832

MOE_GROUPS = 4
MOE_EXPERTS_PER_GROUP = 8
MOE_EXPERTS = 32
MOE_TOP_K = 2
MOE_HIDDEN = 512
MOE_BLOCK = 128

kernel_name = 'hybrid_diffusion_block'


def rms_norm(x, g):
    xf = x.astype(F32)
    y = xf * lax.rsqrt(jnp.mean(xf * xf, axis=-1, keepdims=True) + EPS)
    return (y * g.astype(F32)).astype(x.dtype)


def modulate(h, shift, scale):
    return h * (1.0 + scale) + shift


def rope_1d(x, pos):
    nf = x.shape[-1] // 2
    freqs = ROPE_THETA ** (-jnp.arange(nf, dtype=F32) / nf)
    ang = pos.astype(F32)[:, None] * freqs
    ang = ang.reshape((ang.shape[0],) + (1,) * (x.ndim - 3) + (nf,))
    cos, sin = jnp.cos(ang), jnp.sin(ang)
    xf = x.astype(F32)
    x1, x2 = xf[..., :nf], xf[..., nf:]
    return jnp.concatenate([x1 * cos - x2 * sin, x2 * cos + x1 * sin], axis=-1).astype(x.dtype)


def axial_rope(x, rows, cols):
    half = x.shape[-1] // 2
    return jnp.concatenate([rope_1d(x[..., :half], rows), rope_1d(x[..., half:], cols)], axis=-1)


def to_query_blocks(q):
    nb = q.shape[-2] // Q_BLOCK
    qb = q.reshape(q.shape[:-2] + (nb, Q_BLOCK, q.shape[-1]))
    return jnp.moveaxis(qb, -3, 0)


def from_query_blocks(o):
    o = jnp.moveaxis(o, 0, -3)
    return o.reshape(o.shape[:-3] + (o.shape[-3] * o.shape[-2], o.shape[-1]))


def diff_attention(q1, q2, k1, k2, v, lam):
    scale = q1.shape[-1] ** -0.5

    def block(qs):
        a, b = qs
        p1 = jax.nn.softmax(jnp.einsum('bhqd,bhkd->bhqk', a, k1).astype(F32) * scale, axis=-1)
        p2 = jax.nn.softmax(jnp.einsum('bhqd,bhkd->bhqk', b, k2).astype(F32) * scale, axis=-1)
        return jnp.einsum('bhqk,bhkv->bhqv', (p1 - lam * p2).astype(v.dtype), v)

    return from_query_blocks(lax.map(block, (to_query_blocks(q1), to_query_blocks(q2))))


def gqa_attention(q, k, v):
    scale = q.shape[-1] ** -0.5

    def block(qb):
        p = jax.nn.softmax(jnp.einsum('bhgqd,bhkd->bhgqk', qb, k).astype(F32) * scale, axis=-1)
        return jnp.einsum('bhgqk,bhkd->bhgqd', p.astype(v.dtype), v)

    return from_query_blocks(lax.map(block, to_query_blocks(q)))


def centred_conv(x, w, b):
    pad = w.shape[0] // 2
    y = lax.conv_general_dilated(x, w[:, None, :], window_strides=(1,), padding=[(pad, pad)],
                                 dimension_numbers=('NWC', 'WIO', 'NWC'), feature_group_count=x.shape[-1])
    return y + b


def mlstm_zero_state(batch):
    return (jnp.zeros((batch, MLSTM_HEADS, MLSTM_HEAD_DIM, MLSTM_HEAD_DIM), F32),
            jnp.zeros((batch, MLSTM_HEADS, MLSTM_HEAD_DIM), F32),
            jnp.zeros((batch, MLSTM_HEADS), F32))


def mlstm_scan(q, k, v, log_i, log_f, state):
    B, H, T, _ = q.shape
    dv = v.shape[-1]
    L = MLSTM_CHUNK
    nc = T // L

    def chunks(a):
        return jnp.moveaxis(a.astype(F32).reshape((B, H, nc, L) + a.shape[3:]), 2, 0)

    tril = jnp.tril(jnp.ones((L, L), dtype=bool))

    def step(carry, inp):
        C, n, m = carry
        qc, kc, vc, li, lf = inp
        b = jnp.cumsum(lf, axis=-1)
        d_log = jnp.where(tril, b[..., :, None] - b[..., None, :] + li[..., None, :], -jnp.inf)
        inter = b + m[..., None]
        m_t = jnp.maximum(inter, jnp.max(d_log, axis=-1))
        w = jnp.exp(d_log - m_t[..., None]) * jnp.einsum('bhtd,bhsd->bhts', qc, kc)
        a = jnp.exp(inter - m_t)
        num = jnp.einsum('bhts,bhsv->bhtv', w, vc) + a[..., None] * jnp.einsum('bhvd,bhtd->bhtv', C, qc)
        den = jnp.sum(w, axis=-1) + a * jnp.einsum('bhd,bhtd->bht', n, qc)
        h = num / jnp.maximum(jnp.abs(den), jnp.exp(-m_t))[..., None]
        b_end = b[..., -1]
        g = b_end[..., None] - b + li
        m_new = jnp.maximum(b_end + m, jnp.max(g, axis=-1))
        ws = jnp.exp(g - m_new[..., None])
        a_end = jnp.exp(b_end + m - m_new)
        C_new = a_end[..., None, None] * C + jnp.einsum('bhs,bhsv,bhsd->bhvd', ws, vc, kc)
        n_new = a_end[..., None] * n + jnp.einsum('bhs,bhsd->bhd', ws, kc)
        return (C_new, n_new, m_new), h

    state, hs = lax.scan(step, state, (chunks(q), chunks(k), chunks(v), chunks(log_i), chunks(log_f)))
    h = jnp.moveaxis(hs, 0, 2).reshape(B, H, T, dv)
    return h.astype(v.dtype), state


def hierarchical_moe(xf, wg, bg, we, be, w1, w3, w2):
    N, D = xf.shape
    E = w1.shape[0]
    g_prob = jax.nn.softmax((xf @ wg).astype(F32) + bg.astype(F32), axis=-1)
    g_top, g_idx = lax.top_k(g_prob, 1)
    e_logits = ((xf @ we).astype(F32) + be.astype(F32)).reshape(N, MOE_GROUPS, MOE_EXPERTS_PER_GROUP)
    e_in_group = jnp.take_along_axis(e_logits, g_idx[:, :, None], axis=1)[:, 0]
    e_top, e_sub = lax.top_k(e_in_group, MOE_TOP_K)
    gates = jax.nn.softmax(e_top, axis=-1) * g_top
    expert = (g_idx * MOE_EXPERTS_PER_GROUP + e_sub).astype(jnp.int32)
    NK = N * MOE_TOP_K
    e_flat = expert.reshape(-1)
    g_flat = gates.reshape(-1)
    tok_flat = jnp.repeat(jnp.arange(N, dtype=jnp.int32), MOE_TOP_K)
    order = jnp.argsort(e_flat)
    e_sorted, tok_sorted, g_sorted = e_flat[order], tok_flat[order], g_flat[order]
    counts = jnp.zeros((E,), jnp.int32).at[e_flat].add(1)
    padded = (counts + MOE_BLOCK - 1) // MOE_BLOCK * MOE_BLOCK
    pad_end = jnp.cumsum(padded)
    pad_start = pad_end - padded
    start = jnp.cumsum(counts) - counts
    dest = pad_start[e_sorted] + jnp.arange(NK, dtype=jnp.int32) - start[e_sorted]
    P = -(-(NK + E * MOE_BLOCK) // MOE_BLOCK) * MOE_BLOCK
    row_tok = jnp.full((P,), N, jnp.int32).at[dest].set(tok_sorted)
    row_gate = jnp.zeros((P,), F32).at[dest].set(g_sorted)
    n_blk = P // MOE_BLOCK
    blk_start = jnp.arange(n_blk, dtype=jnp.int32) * MOE_BLOCK
    blk_expert = jnp.minimum(jnp.sum(pad_end[None, :] <= blk_start[:, None], axis=-1), E - 1).astype(jnp.int32)
    x_rows = jnp.concatenate([xf, jnp.zeros((1, D), xf.dtype)], axis=0)[row_tok].reshape(n_blk, MOE_BLOCK, D)

    def expert_block(args):
        xb, e = args
        return (jax.nn.silu(xb @ w1[e]) * (xb @ w3[e])) @ w2[e]

    y = lax.map(expert_block, (x_rows, blk_expert)).reshape(P, D)
    out = jnp.zeros((N + 1, D), y.dtype).at[row_tok].add(y * row_gate[:, None].astype(y.dtype))
    return out[:N]


def hybrid_layer(x, ctx, c, c_ctx, rows, cols, lam_init, update_ctx,
                 norm1_g, norm2_g, w_mod, b_mod, w_in, w_out,
                 diff_q_norm, diff_k_norm, diff_lambda, diff_subln, gqa_q_norm, gqa_k_norm,
                 mlstm_conv_w, mlstm_conv_b, mlstm_gate_b, mlstm_head_norm,
                 moe_wg, moe_bg, moe_we, moe_be, moe_w1, moe_w3, moe_w2):
    B, T, D = x.shape
    C = ctx.shape[1]
    sh1, sc1, g1, sh2, sc2, g2 = jnp.split((jax.nn.silu(c) @ w_mod + b_mod)[:, None, :], 6, axis=-1)
    sh1c, sc1c, g1c, sh2c, sc2c, g2c = jnp.split(jax.nn.silu(c_ctx) @ w_mod + b_mod, 6, axis=-1)
    split_at = [int(i) for i in np.cumsum(IN_SPLITS)[:-1]]
    dq_l, dk_l, dv_l, gq_l, gk_l, gv_l, mqk_l, mv_l, mo_l, mg_l = jnp.split(
        modulate(rms_norm(x, norm1_g), sh1, sc1) @ w_in, split_at, axis=-1)
    dq_c, dk_c, dv_c, gq_c, gk_c, gv_c, mqk_c, mv_c, mo_c, mg_c = jnp.split(
        modulate(rms_norm(ctx, norm1_g), sh1c, sc1c) @ w_in, split_at, axis=-1)

    def heads(p, n, d):
        return p.reshape(p.shape[0], p.shape[1], n, d).transpose(0, 2, 1, 3)

    def qk_heads(p, n, d, g, rope):
        y = rms_norm(p.reshape(p.shape[0], p.shape[1], n, d), g)
        if rope:
            y = axial_rope(y, rows, cols)
        return y.transpose(0, 2, 1, 3)

    def diff_qk(p, g, rope):
        y = rms_norm(p.reshape(p.shape[0], p.shape[1], DIFF_HEADS, 2, DIFF_HEAD_DIM), g)
        if rope:
            y = axial_rope(y, rows, cols)
        y = y.transpose(3, 0, 2, 1, 4)
        return y[0], y[1]

    def cat(a_c, a_l):
        return jnp.concatenate([a_c, a_l], axis=2)

    lam = (jnp.exp(jnp.sum(diff_lambda[0] * diff_lambda[1]).astype(F32))
           - jnp.exp(jnp.sum(diff_lambda[2] * diff_lambda[3]).astype(F32)) + lam_init)
    k1_c, k2_c = diff_qk(dk_c, diff_k_norm, False)
    k1_l, k2_l = diff_qk(dk_l, diff_k_norm, True)
    q1_l, q2_l = diff_qk(dq_l, diff_q_norm, True)
    dv_ch = heads(dv_c, DIFF_HEADS, DIFF_V_DIM)
    dv_lh = heads(dv_l, DIFF_HEADS, DIFF_V_DIM)

    def diff_out(o):
        o = rms_norm(o.transpose(0, 2, 1, 3), diff_subln) * (1.0 - lam_init)
        return o.reshape(o.shape[0], o.shape[1], DIFF_WIDTH)

    diff_lat = diff_out(diff_attention(q1_l, q2_l, cat(k1_c, k1_l), cat(k2_c, k2_l), cat(dv_ch, dv_lh), lam))

    def group_q(q):
        return q.reshape(q.shape[0], GQA_KV_HEADS, GQA_Q_HEADS // GQA_KV_HEADS, q.shape[2], GQA_HEAD_DIM)

    def gqa_out(o):
        o = o.reshape(o.shape[0], GQA_Q_HEADS, o.shape[3], GQA_HEAD_DIM).transpose(0, 2, 1, 3)
        return o.reshape(o.shape[0], o.shape[1], GQA_WIDTH)

    gk_ch = qk_heads(gk_c, GQA_KV_HEADS, GQA_HEAD_DIM, gqa_k_norm, False)
    gk_lh = qk_heads(gk_l, GQA_KV_HEADS, GQA_HEAD_DIM, gqa_k_norm, True)
    gv_ch = heads(gv_c, GQA_KV_HEADS, GQA_HEAD_DIM)
    gv_lh = heads(gv_l, GQA_KV_HEADS, GQA_HEAD_DIM)
    gq_lh = group_q(qk_heads(gq_l, GQA_Q_HEADS, GQA_HEAD_DIM, gqa_q_norm, True))
    gqa_lat = gqa_out(gqa_attention(gq_lh, cat(gk_ch, gk_lh), cat(gv_ch, gv_lh)))

    def mlstm_inputs(qk, v, gates):
        qk = jax.nn.silu(centred_conv(qk, mlstm_conv_w, mlstm_conv_b))
        q, k = jnp.split(qk, 2, axis=-1)
        q = heads(q, MLSTM_HEADS, MLSTM_HEAD_DIM)
        k = heads(k, MLSTM_HEADS, MLSTM_HEAD_DIM) * (MLSTM_HEAD_DIM ** -0.5)
        v = heads(v, MLSTM_HEADS, MLSTM_HEAD_DIM)
        gt = (gates + mlstm_gate_b).astype(F32).reshape(gates.shape[0], gates.shape[1], 4, MLSTM_HEADS)
        gt = gt.transpose(2, 0, 3, 1)
        return q, k, v, gt[0], jax.nn.log_sigmoid(gt[1]), gt[2], jax.nn.log_sigmoid(gt[3])

    def flip(a):
        return jnp.flip(a, axis=2)

    def mlstm_out(h, o):
        h = rms_norm(h.transpose(0, 2, 1, 3), mlstm_head_norm.reshape(MLSTM_HEADS, MLSTM_HEAD_DIM))
        h = h * jax.nn.sigmoid(o).reshape(h.shape)
        return h.reshape(h.shape[0], h.shape[1], MLSTM_WIDTH)

    qc, kc, vc, ifc, ffc, ibc, fbc = mlstm_inputs(mqk_c, mv_c, mg_c)
    ql, kl, vl, ifl, ffl, ibl, fbl = mlstm_inputs(mqk_l, mv_l, mg_l)
    zero = mlstm_zero_state(B)
    hf_c, st_f = mlstm_scan(qc, kc, vc, ifc, ffc, zero)
    hb_c, st_b = mlstm_scan(flip(qc), flip(kc), flip(vc), flip(ibc), flip(fbc), zero)
    hf_l, _ = mlstm_scan(ql, kl, vl, ifl, ffl, st_f)
    hb_l, _ = mlstm_scan(flip(ql), flip(kl), flip(vl), flip(ibl), flip(fbl), st_b)
    mlstm_lat = mlstm_out(hf_l + flip(hb_l), mo_l)

    x = x + g1 * (jnp.concatenate([diff_lat, gqa_lat, mlstm_lat], axis=-1) @ w_out)
    f_l = modulate(rms_norm(x, norm2_g), sh2, sc2)
    moe_args = (moe_wg, moe_bg, moe_we, moe_be, moe_w1, moe_w3, moe_w2)
    if update_ctx:
        q1_c, q2_c = diff_qk(dq_c, diff_q_norm, False)
        diff_ctx = diff_out(diff_attention(q1_c, q2_c, k1_c, k2_c, dv_ch, lam))
        gq_ch = group_q(qk_heads(gq_c, GQA_Q_HEADS, GQA_HEAD_DIM, gqa_q_norm, False))
        gqa_ctx = gqa_out(gqa_attention(gq_ch, gk_ch, gv_ch))
        mlstm_ctx = mlstm_out(hf_c + flip(hb_c), mo_c)
        ctx = ctx + g1c * (jnp.concatenate([diff_ctx, gqa_ctx, mlstm_ctx], axis=-1) @ w_out)
        f_c = modulate(rms_norm(ctx, norm2_g), sh2c, sc2c)
        y = hierarchical_moe(jnp.concatenate([f_l.reshape(-1, D), f_c.reshape(-1, D)], axis=0), *moe_args)
        x = x + g2 * y[:B * T].reshape(B, T, D)
        ctx = ctx + g2c * y[B * T:].reshape(B, C, D)
    else:
        x = x + g2 * hierarchical_moe(f_l.reshape(-1, D), *moe_args).reshape(B, T, D)
    return x, ctx


def setup_inputs(seed: int = 0) -> dict:
    key = jax.random.key(seed)
    ks = jax.random.split(key, 27)
    D = D_MODEL
    L = DEPTH

    def nrm(k, shape, scale):
        return scale * jax.random.normal(k, shape, F32)

    fb = jnp.linspace(3.0, 6.0, MLSTM_HEADS, dtype=F32)
    zb = jnp.zeros((MLSTM_HEADS,), F32)
    gate_base = jnp.concatenate([zb, fb, zb, fb])
    return {
        'x': nrm(ks[0], (BATCH, SEQ, D), 1.0),
        'c': nrm(ks[1], (BATCH, D), 1.0),
        'ctx': nrm(ks[2], (BATCH, CTX_LEN, D), 1.0),
        'c_ctx': nrm(ks[3], (D,), 1.0),
        'norm1_g': 1.0 + nrm(ks[4], (L, D), 0.02),
        'norm2_g': 1.0 + nrm(ks[5], (L, D), 0.02),
        'w_mod': nrm(ks[6], (L, D, 6 * D), 0.5 * D ** -0.5),
        'b_mod': nrm(ks[7], (L, 6 * D), 0.02),
        'w_in': nrm(ks[8], (L, D, IN_WIDTH), D ** -0.5),
        'w_out': nrm(ks[9], (L, MIX_WIDTH, D), MIX_WIDTH ** -0.5),
        'diff_q_norm': 1.0 + nrm(ks[10], (L, DIFF_HEAD_DIM), 0.02),
        'diff_k_norm': 1.0 + nrm(ks[11], (L, DIFF_HEAD_DIM), 0.02),
        'diff_lambda': nrm(ks[12], (L, 4, DIFF_HEAD_DIM), 0.1),
        'diff_subln': 1.0 + nrm(ks[13], (L, DIFF_V_DIM), 0.02),
        'gqa_q_norm': 1.0 + nrm(ks[14], (L, GQA_HEAD_DIM), 0.02),
        'gqa_k_norm': 1.0 + nrm(ks[15], (L, GQA_HEAD_DIM), 0.02),
        'mlstm_conv_w': nrm(ks[16], (L, MLSTM_CONV, 2 * MLSTM_WIDTH), MLSTM_CONV ** -0.5),
        'mlstm_conv_b': nrm(ks[17], (L, 2 * MLSTM_WIDTH), 0.02),
        'mlstm_gate_b': gate_base + nrm(ks[18], (L, 4 * MLSTM_HEADS), 0.1),
        'mlstm_head_norm': 1.0 + nrm(ks[19], (L, MLSTM_WIDTH), 0.02),
        'moe_wg': nrm(ks[20], (L, D, MOE_GROUPS), D ** -0.5),
        'moe_bg': nrm(ks[21], (L, MOE_GROUPS), 0.01),
        'moe_we': nrm(ks[22], (L, D, MOE_EXPERTS), D ** -0.5),
        'moe_be': nrm(ks[23], (L, MOE_EXPERTS), 0.01),
        'moe_w1': nrm(ks[24], (L, MOE_EXPERTS, D, MOE_HIDDEN), D ** -0.5),
        'moe_w3': nrm(ks[25], (L, MOE_EXPERTS, D, MOE_HIDDEN), D ** -0.5),
        'moe_w2': nrm(ks[26], (L, MOE_EXPERTS, MOE_HIDDEN, D), MOE_HIDDEN ** -0.5),
    }


def reference(x, c, ctx, c_ctx, norm1_g, norm2_g, w_mod, b_mod, w_in, w_out,
              diff_q_norm, diff_k_norm, diff_lambda, diff_subln, gqa_q_norm, gqa_k_norm,
              mlstm_conv_w, mlstm_conv_b, mlstm_gate_b, mlstm_head_norm,
              moe_wg, moe_bg, moe_we, moe_be, moe_w1, moe_w3, moe_w2):
    n_rows = x.shape[1] // GRID_W
    rows = jnp.repeat(jnp.arange(n_rows, dtype=jnp.int32), GRID_W)
    cols = jnp.tile(jnp.arange(GRID_W, dtype=jnp.int32), n_rows)
    for l in range(DEPTH):
        lam_init = 0.8 - 0.6 * math.exp(-0.3 * l)
        x, ctx = hybrid_layer(x, ctx, c, c_ctx, rows, cols, lam_init, l < DEPTH - 1,
                              norm1_g[l], norm2_g[l], w_mod[l], b_mod[l], w_in[l], w_out[l],
                              diff_q_norm[l], diff_k_norm[l], diff_lambda[l], diff_subln[l],
                              gqa_q_norm[l], gqa_k_norm[l],
                              mlstm_conv_w[l], mlstm_conv_b[l], mlstm_gate_b[l], mlstm_head_norm[l],
                              moe_wg[l], moe_bg[l], moe_we[l], moe_be[l], moe_w1[l], moe_w3[l], moe_w2[l])
    return x
```

```cpp
#ifndef HOST_TEST
#include <hip/hip_runtime.h>
#include <hip/hip_cooperative_groups.h>
#include <string.h>
namespace cg = cooperative_groups;
#define HD __host__ __device__ __forceinline__
#else
#include <math.h>
#include <string.h>
#define HD inline
#endif
#include <stdint.h>
#include <stddef.h>

#ifndef HOST_TEST
#define ACT_F32 1
#endif
#ifndef CFG_B
#define CFG_B 8
#define CFG_T 2048
#define CFG_C 256
#define CFG_DEPTH 4
#endif
#ifndef MK_LAUNCHES
#define MK_LAUNCHES 1
#endif

constexpr int Bn = CFG_B, Tn = CFG_T, Cn = CFG_C, DEPTH = CFG_DEPTH;
constexpr int Dm = 1024, INW = 2832, MODW = 6144;
constexpr int NL = Bn * Tn, NC = Bn * Cn, NTOK = NL + NC, Sn = Cn + Tn;
constexpr int DQ_OFF = 0, DK_OFF = 384, DV_OFF = 768, GQ_OFF = 1152, GK_OFF = 1536, GV_OFF = 1664, MQK_OFF = 1792, MV_OFF = 2304, MO_OFF = 2560, MG_OFF = 2816;
constexpr float EPSF = 1e-6f;
constexpr float LOG2E = 1.4426950408889634f;

#ifdef ACT_F32
typedef float act_t;
HD act_t f2a(float f) { return f; }
HD float a2f(act_t a) { return a; }
#else
typedef unsigned short act_t;
HD act_t f2a(float f) { unsigned u; memcpy(&u, &f, 4); u += 0x7fffu + ((u >> 16) & 1u); return (act_t)(u >> 16); }
HD float a2f(act_t a) { unsigned u = ((unsigned)a) << 16; float f; memcpy(&f, &u, 4); return f; }
#endif

HD float silu_f(float x) { return x / (1.0f + expf(-x)); }
HD float sigmoid_f(float x) { return 1.0f / (1.0f + expf(-x)); }
HD float logsigmoid_f(float x) { return fminf(x, 0.0f) - log1pf(expf(-fabsf(x))); }
HD float lam_init_of(int l) { return 0.8f - 0.6f * expf(-0.3f * (float)l); }

struct Params {
    const float *x, *c, *ctx, *c_ctx, *norm1_g, *norm2_g, *w_mod, *b_mod, *w_in, *w_out, *diff_q_norm, *diff_k_norm, *diff_lambda, *diff_subln,
        *gqa_q_norm, *gqa_k_norm, *mlstm_conv_w, *mlstm_conv_b, *mlstm_gate_b, *mlstm_head_norm, *moe_wg, *moe_bg, *moe_we, *moe_be, *moe_w1, *moe_w3, *moe_w2;
    float* out;
    float *mod, *X, *PROJ, *MQK, *MGATE, *DO, *GATE, *HN;
    act_t *XN, *DQL, *DQC, *DK, *DVt, *GQL, *GQC, *GK, *GVt, *MIX, *F;
    int* EID;
};

HD bool tok_ctx(int tok) { return tok >= NL; }
HD int tok_b(int tok) { return tok < NL ? tok / Tn : (tok - NL) / Cn; }
HD int tok_i(int tok) { return tok < NL ? tok % Tn : (tok - NL) % Cn; }
HD int tok_s(int tok) { return tok < NL ? Cn + tok % Tn : (tok - NL) % Cn; }
HD int tok_modrow(int tok) { return tok < NL ? tok / Tn : Bn; }
HD int tok_of(int b, int s) { return s < Cn ? NL + b * Cn + s : b * Tn + (s - Cn); }
HD const float* mod_row(const Params& p, int l, int tok) { return p.mod + ((size_t)l * (Bn + 1) + tok_modrow(tok)) * MODW; }

HD void ph_mod(const Params& p, long gtid, long gsize) {
    for (long it = gtid; it < (long)DEPTH * MODW; it += gsize) {
        const int l = (int)(it / MODW), j = (int)(it % MODW);
        float acc[Bn + 1];
#pragma unroll
        for (int r = 0; r <= Bn; ++r) acc[r] = 0.f;
        const float* w = p.w_mod + (size_t)l * Dm * MODW + j;
        for (int k = 0; k < Dm; ++k) {
            const float wv = w[(size_t)k * MODW];
#pragma unroll
            for (int r = 0; r < Bn; ++r) acc[r] += silu_f(p.c[r * Dm + k]) * wv;
            acc[Bn] += silu_f(p.c_ctx[k]) * wv;
        }
        const float bb = p.b_mod[l * MODW + j];
#pragma unroll
        for (int r = 0; r <= Bn; ++r) p.mod[((size_t)l * (Bn + 1) + r) * MODW + j] = acc[r] + bb;
    }
    for (long it = gtid; it < (long)NTOK * Dm; it += gsize) p.X[it] = it < (long)NL * Dm ? p.x[it] : p.ctx[it - (long)NL * Dm];
}

HD void ph_norm1(const Params& p, int l, long gtid, long gsize) {
    for (long row = gtid; row < NTOK; row += gsize) {
        const float* xr = p.X + row * Dm;
        float ss = 0.f;
        for (int k = 0; k < Dm; ++k) ss += xr[k] * xr[k];
        const float rstd = 1.0f / sqrtf(ss / Dm + EPSF);
        const float* mr = mod_row(p, l, (int)row);
        const float* g = p.norm1_g + l * Dm;
        for (int k = 0; k < Dm; ++k) p.XN[row * Dm + k] = f2a(xr[k] * rstd * g[k] * (1.0f + mr[Dm + k]) + mr[k]);
    }
}

HD void ph_gemm_in(const Params& p, int l, long gtid, long gsize) {
    const float* W = p.w_in + (size_t)l * Dm * INW;
    for (long it = gtid; it < (long)NTOK * INW; it += gsize) {
        const long m = it / INW; const int n = (int)(it % INW);
        const act_t* a = p.XN + m * Dm;
        float acc = 0.f;
        for (int k = 0; k < Dm; ++k) acc += a2f(a[k]) * W[(size_t)k * INW + n];
        p.PROJ[it] = acc;
    }
}

template <int DHn>
HD void qk_unit(const float* src, const float* g, bool rope, int t, float oscale, float (&y)[DHn]) {
    float ss = 0.f;
#pragma unroll
    for (int i = 0; i < DHn; ++i) { y[i] = src[i]; ss += y[i] * y[i]; }
    const float rstd = 1.0f / sqrtf(ss / DHn + EPSF);
#pragma unroll
    for (int i = 0; i < DHn; ++i) y[i] = y[i] * rstd * g[i];
    if (rope) {
        constexpr int half = DHn / 2, nf = half / 2;
        const float posr = (float)(t / 64), posc = (float)(t % 64);
#pragma unroll
        for (int hsel = 0; hsel < 2; ++hsel) {
            const float pos = hsel ? posc : posr;
#pragma unroll
            for (int i = 0; i < nf; ++i) {
                const float fr = expf(-(float)i / (float)nf * 9.210340371976184f);
                const float ang = pos * fr;
                const float cs = cosf(ang), sn = sinf(ang);
                const float x1 = y[hsel * half + i], x2 = y[hsel * half + nf + i];
                y[hsel * half + i] = x1 * cs - x2 * sn;
                y[hsel * half + nf + i] = x2 * cs + x1 * sn;
            }
        }
    }
#pragma unroll
    for (int i = 0; i < DHn; ++i) y[i] *= oscale;
}

HD void ph_post(const Params& p, int l, long gtid, long gsize) {
    constexpr int NU = 27;
    for (long it = gtid; it < (long)NTOK * NU; it += gsize) {
        const int tok = (int)(it / NU), u = (int)(it % NU);
        const bool isc = tok_ctx(tok);
        const int b = tok_b(tok), ti = tok_i(tok), s = tok_s(tok);
        const float* pr = p.PROJ + (size_t)tok * INW;
        if (u < 16) {
            const bool isk = u >= 8; const int h = (u & 7) >> 1, w = u & 1;
            float y[48];
            qk_unit<48>(pr + (isk ? DK_OFF : DQ_OFF) + h * 96 + w * 48, (isk ? p.diff_k_norm : p.diff_q_norm) + l * 48, !isc, ti,
                        isk ? 1.0f : 0.14433756729740643f * LOG2E, y);
            act_t* dst = isk ? p.DK + (((size_t)(b * 4 + h) * 2 + w) * Sn + s) * 48
                             : (isc ? p.DQC + (((size_t)(b * 4 + h) * 2 + w) * Cn + ti) * 48 : p.DQL + (((size_t)(b * 4 + h) * 2 + w) * Tn + ti) * 48);
#pragma unroll
            for (int i = 0; i < 48; ++i) dst[i] = f2a(y[i]);
        } else if (u < 24) {
            const bool isk = u >= 22; const int h = isk ? u - 22 : u - 16;
            float y[64];
            qk_unit<64>(pr + (isk ? GK_OFF : GQ_OFF) + h * 64, (isk ? p.gqa_k_norm : p.gqa_q_norm) + l * 64, !isc, ti, isk ? 1.0f : 0.125f * LOG2E, y);
            act_t* dst = isk ? p.GK + ((size_t)(b * 2 + h) * Sn + s) * 64
                             : (isc ? p.GQC + ((size_t)(b * 6 + h) * Cn + ti) * 64 : p.GQL + ((size_t)(b * 6 + h) * Tn + ti) * 64);
#pragma unroll
            for (int i = 0; i < 64; ++i) dst[i] = f2a(y[i]);
        } else if (u == 24) {
            for (int j = 0; j < 384; ++j) p.DVt[((size_t)(b * 4 + j / 96) * 96 + j % 96) * Sn + s] = f2a(pr[DV_OFF + j]);
        } else if (u == 25) {
            for (int j = 0; j < 128; ++j) p.GVt[((size_t)(b * 2 + j / 64) * 64 + j % 64) * Sn + s] = f2a(pr[GV_OFF + j]);
        } else {
            const int seglen = isc ? Cn : Tn;
            const float* cw = p.mlstm_conv_w + (size_t)l * 3 * 512; const float* cb = p.mlstm_conv_b + l * 512;
            for (int ch = 0; ch < 512; ++ch) {
                float a = cb[ch] + pr[MQK_OFF + ch] * cw[512 + ch];
                if (ti > 0) a += pr[MQK_OFF + ch - INW] * cw[ch];
                if (ti < seglen - 1) a += pr[MQK_OFF + ch + INW] * cw[1024 + ch];
                a = silu_f(a);
                p.MQK[(size_t)tok * 512 + ch] = ch >= 256 ? a * 0.125f : a;
            }
            const float* gb = p.mlstm_gate_b + l * 16;
            for (int j = 0; j < 16; ++j) {
                const float gv = pr[MG_OFF + j] + gb[j];
                p.MGATE[(size_t)tok * 16 + j] = ((j >> 2) & 1) ? logsigmoid_f(gv) : gv;
            }
        }
    }
}

HD void ph_attn_diff(const Params& p, int l, bool upd, long gtid, long gsize) {
    const int nq = upd ? Tn + Cn : Tn;
    const float lam_init = lam_init_of(l);
    for (long it = gtid; it < (long)Bn * 4 * nq; it += gsize) {
        const int qi = (int)(it % nq), h = (int)((it / nq) % 4), b = (int)(it / ((long)nq * 4));
        const bool isc = qi >= Tn; const int ti = isc ? qi - Tn : qi;
        const int nk = isc ? Cn : Sn;
        const int tok = isc ? NL + b * Cn + ti : b * Tn + ti;
        float* dob = p.DO + ((size_t)(b * 4 + h) * (Tn + Cn) + qi) * 96;
        const act_t* vt = p.DVt + (size_t)(b * 4 + h) * 96 * Sn;
        float l2 = 1.f;
        float o[96];
        for (int w = 0; w < 2; ++w) {
            const act_t* qp = isc ? p.DQC + (((size_t)(b * 4 + h) * 2 + w) * Cn + ti) * 48 : p.DQL + (((size_t)(b * 4 + h) * 2 + w) * Tn + ti) * 48;
            const act_t* kp = p.DK + ((size_t)(b * 4 + h) * 2 + w) * Sn * 48;
            float q[48];
#pragma unroll
            for (int i = 0; i < 48; ++i) q[i] = a2f(qp[i]);
#pragma unroll
            for (int i = 0; i < 96; ++i) o[i] = 0.f;
            float m = -1e30f, lsum = 0.f;
            for (int s = 0; s < nk; ++s) {
                float sc = 0.f;
#pragma unroll
                for (int i = 0; i < 48; ++i) sc += q[i] * a2f(kp[(size_t)s * 48 + i]);
                const float mn = fmaxf(m, sc), alpha = exp2f(m - mn), pe = exp2f(sc - mn);
                lsum = lsum * alpha + pe;
#pragma unroll
                for (int i = 0; i < 96; ++i) o[i] = o[i] * alpha + pe * a2f(vt[(size_t)i * Sn + s]);
                m = mn;
            }
            if (w == 0) {
#pragma unroll
                for (int i = 0; i < 96; ++i) dob[i] = o[i] / lsum;
            } else l2 = lsum;
        }
        const float* dl = p.diff_lambda + l * 4 * 48;
        float s01 = 0.f, s23 = 0.f;
        for (int i = 0; i < 48; ++i) { s01 += dl[i] * dl[48 + i]; s23 += dl[96 + i] * dl[144 + i]; }
        const float lam = expf(s01) - expf(s23) + lam_init;
        float ss = 0.f;
#pragma unroll
        for (int i = 0; i < 96; ++i) { o[i] = dob[i] - lam * o[i] / l2; ss += o[i] * o[i]; }
        const float rstd = 1.0f / sqrtf(ss / 96 + EPSF);
        const float* sg = p.diff_subln + l * 96;
#pragma unroll
        for (int i = 0; i < 96; ++i) p.MIX[(size_t)tok * Dm + h * 96 + i] = f2a(o[i] * rstd * sg[i] * (1.0f - lam_init));
    }
}

HD void ph_attn_gqa(const Params& p, int l, bool upd, long gtid, long gsize) {
    const int nq = upd ? Tn + Cn : Tn;
    for (long it = gtid; it < (long)Bn * 6 * nq; it += gsize) {
        const int qi = (int)(it % nq), hq = (int)((it / nq) % 6), b = (int)(it / ((long)nq * 6));
        const bool isc = qi >= Tn; const int ti = isc ? qi - Tn : qi;
        const int nk = isc ? Cn : Sn, kv = hq / 3;
        const int tok = isc ? NL + b * Cn + ti : b * Tn + ti;
        const act_t* qp = isc ? p.GQC + ((size_t)(b * 6 + hq) * Cn + ti) * 64 : p.GQL + ((size_t)(b * 6 + hq) * Tn + ti) * 64;
        const act_t* kp = p.GK + (size_t)(b * 2 + kv) * Sn * 64;
        const act_t* vt = p.GVt + (size_t)(b * 2 + kv) * 64 * Sn;
        float q[64], o[64];
#pragma unroll
        for (int i = 0; i < 64; ++i) { q[i] = a2f(qp[i]); o[i] = 0.f; }
        float m = -1e30f, lsum = 0.f;
        for (int s = 0; s < nk; ++s) {
            float sc = 0.f;
#pragma unroll
            for (int i = 0; i < 64; ++i) sc += q[i] * a2f(kp[(size_t)s * 64 + i]);
            const float mn = fmaxf(m, sc), alpha = exp2f(m - mn), pe = exp2f(sc - mn);
            lsum = lsum * alpha + pe;
#pragma unroll
            for (int i = 0; i < 64; ++i) o[i] = o[i] * alpha + pe * a2f(vt[(size_t)i * Sn + s]);
            m = mn;
        }
#pragma unroll
        for (int i = 0; i < 64; ++i) p.MIX[(size_t)tok * Dm + 384 + hq * 64 + i] = f2a(o[i] / lsum);
    }
}

HD void mlstm_dir_naive(const Params& p, int b, int h, bool isc, int ti, int dir, const float (&q)[64], float (&hout)[64]) {
    float num[64];
#pragma unroll
    for (int i = 0; i < 64; ++i) num[i] = 0.f;
    float den = 0.f, m = -1e30f, Dg = 0.f;
    for (int seg = 0; seg < (isc ? 1 : 2); ++seg) {
        const bool sc_ = seg == 1 ? true : isc;
        const int len = sc_ ? Cn : Tn;
        int cnt, start, step;
        if (seg == 0) { start = ti; step = dir == 0 ? -1 : 1; cnt = dir == 0 ? ti + 1 : len - ti; }
        else { start = dir == 0 ? len - 1 : 0; step = dir == 0 ? -1 : 1; cnt = len; }
        for (int c = 0, si = start; c < cnt; ++c, si += step) {
            const int tk = sc_ ? NL + b * Cn + si : b * Tn + si;
            const float li = p.MGATE[(size_t)tk * 16 + dir * 8 + h], lf = p.MGATE[(size_t)tk * 16 + dir * 8 + 4 + h];
            const float lw = Dg + li;
            const float* kr = p.MQK + (size_t)tk * 512 + 256 + h * 64;
            const float* vr = p.PROJ + (size_t)tk * INW + MV_OFF + h * 64;
            float qk = 0.f;
#pragma unroll
            for (int i = 0; i < 64; ++i) qk += q[i] * kr[i];
            const float mn = fmaxf(m, lw), alpha = expf(m - mn), w = expf(lw - mn) * qk;
            den = den * alpha + w;
#pragma unroll
            for (int i = 0; i < 64; ++i) num[i] = num[i] * alpha + w * vr[i];
            m = mn;
            Dg += lf;
        }
    }
    const float dn = fmaxf(fabsf(den), expf(-m));
#pragma unroll
    for (int i = 0; i < 64; ++i) hout[i] += num[i] / dn;
}

HD void ph_mlstm(const Params& p, int l, bool upd, long gtid, long gsize) {
    const int nq = upd ? Tn + Cn : Tn;
    for (long it = gtid; it < (long)Bn * 4 * nq; it += gsize) {
        const int qi = (int)(it % nq), h = (int)((it / nq) % 4), b = (int)(it / ((long)nq * 4));
        const bool isc = qi >= Tn; const int ti = isc ? qi - Tn : qi;
        const int tok = isc ? NL + b * Cn + ti : b * Tn + ti;
        float q[64], hh[64];
#pragma unroll
        for (int i = 0; i < 64; ++i) { q[i] = p.MQK[(size_t)tok * 512 + h * 64 + i]; hh[i] = 0.f; }
        mlstm_dir_naive(p, b, h, isc, ti, 0, q, hh);
        mlstm_dir_naive(p, b, h, isc, ti, 1, q, hh);
        float ss = 0.f;
#pragma unroll
        for (int i = 0; i < 64; ++i) ss += hh[i] * hh[i];
        const float rstd = 1.0f / sqrtf(ss / 64 + EPSF);
        const float* hn = p.mlstm_head_norm + l * 256 + h * 64;
        const float* og = p.PROJ + (size_t)tok * INW + MO_OFF + h * 64;
#pragma unroll
        for (int i = 0; i < 64; ++i) p.MIX[(size_t)tok * Dm + 768 + h * 64 + i] = f2a(hh[i] * rstd * hn[i] * sigmoid_f(og[i]));
    }
}

HD void ph_gemm_out(const Params& p, int l, bool upd, long gtid, long gsize) {
    const float* W = p.w_out + (size_t)l * Dm * Dm;
    const long rows = upd ? NTOK : NL;
    for (long it = gtid; it < rows * Dm; it += gsize) {
        const long m = it / Dm; const int n = (int)(it % Dm);
        const act_t* a = p.MIX + m * Dm;
        float acc = 0.f;
        for (int k = 0; k < Dm; ++k) acc += a2f(a[k]) * W[(size_t)k * Dm + n];
        p.X[it] += mod_row(p, l, (int)m)[2 * Dm + n] * acc;
    }
}

HD void ph_norm2_route(const Params& p, int l, bool upd, long gtid, long gsize) {
    const long rows = upd ? NTOK : NL;
    for (long row = gtid; row < rows; row += gsize) {
        const float* xr = p.X + row * Dm;
        float ss = 0.f;
        for (int k = 0; k < Dm; ++k) ss += xr[k] * xr[k];
        const float rstd = 1.0f / sqrtf(ss / Dm + EPSF);
        const float* mr = mod_row(p, l, (int)row);
        const float* g = p.norm2_g + l * Dm;
        const float* wg = p.moe_wg + (size_t)l * Dm * 4; const float* we = p.moe_we + (size_t)l * Dm * 32;
        float ag[4], ae[32];
#pragma unroll
        for (int j = 0; j < 4; ++j) ag[j] = 0.f;
#pragma unroll
        for (int j = 0; j < 32; ++j) ae[j] = 0.f;
        for (int k = 0; k < Dm; ++k) {
            const float f = xr[k] * rstd * g[k] * (1.0f + mr[4 * Dm + k]) + mr[3 * Dm + k];
            p.F[row * Dm + k] = f2a(f);
#pragma unroll
            for (int j = 0; j < 4; ++j) ag[j] += f * wg[k * 4 + j];
#pragma unroll
            for (int j = 0; j < 32; ++j) ae[j] += f * we[k * 32 + j];
        }
        float gmax = -1e30f; int gi = 0;
#pragma unroll
        for (int j = 0; j < 4; ++j) { ag[j] += p.moe_bg[l * 4 + j]; if (ag[j] > gmax) { gmax = ag[j]; gi = j; } }
        float gsum = 0.f;
#pragma unroll
        for (int j = 0; j < 4; ++j) gsum += expf(ag[j] - gmax);
        const float gtop = 1.0f / gsum;
        float e1 = -1e30f, e2 = -1e30f; int i1 = 0, i2 = 0;
#pragma unroll
        for (int grp = 0; grp < 4; ++grp) {
            if (grp == gi) {
#pragma unroll
                for (int j = 0; j < 8; ++j) {
                    const float v = ae[grp * 8 + j] + p.moe_be[l * 32 + grp * 8 + j];
                    if (v > e1) { e2 = e1; i2 = i1; e1 = v; i1 = j; } else if (v > e2) { e2 = v; i2 = j; }
                }
            }
        }
        const float g0 = 1.0f / (1.0f + expf(e2 - e1));
        p.EID[row * 2] = gi * 8 + i1; p.EID[row * 2 + 1] = gi * 8 + i2;
        p.GATE[row * 2] = g0 * gtop; p.GATE[row * 2 + 1] = (1.0f - g0) * gtop;
    }
}

HD void ph_moe1(const Params& p, int l, bool upd, long gtid, long gsize) {
    const long rows = upd ? NTOK : NL;
    for (long it = gtid; it < rows * 2 * 512; it += gsize) {
        const long rk = it / 512; const int j = (int)(it % 512);
        const long row = rk >> 1;
        const int e = p.EID[rk];
        const float* W1 = p.moe_w1 + ((size_t)l * 32 + e) * Dm * 512 + j; const float* W3 = p.moe_w3 + ((size_t)l * 32 + e) * Dm * 512 + j;
        const act_t* f = p.F + row * Dm;
        float a = 0.f, bb = 0.f;
        for (int k = 0; k < Dm; ++k) { const float fv = a2f(f[k]); a += fv * W1[(size_t)k * 512]; bb += fv * W3[(size_t)k * 512]; }
        p.HN[it] = silu_f(a) * bb;
    }
}

HD void ph_moe2(const Params& p, int l, bool upd, long gtid, long gsize) {
    const long rows = upd ? NTOK : NL;
    for (long it = gtid; it < rows * Dm; it += gsize) {
        const long row = it / Dm; const int d = (int)(it % Dm);
        float y = 0.f;
        for (int kk = 0; kk < 2; ++kk) {
            const int e = p.EID[row * 2 + kk];
            const float* W2 = p.moe_w2 + ((size_t)l * 32 + e) * 512 * Dm + d;
            const float* hn = p.HN + (row * 2 + kk) * 512;
            float acc = 0.f;
            for (int j = 0; j < 512; ++j) acc += hn[j] * W2[(size_t)j * Dm];
            y += p.GATE[row * 2 + kk] * acc;
        }
        const float xn = p.X[it] + mod_row(p, l, (int)row)[5 * Dm + d] * y;
        p.X[it] = xn;
        if (l == DEPTH - 1) p.out[it] = xn;
    }
}

constexpr int PH_PER_LAYER = 8;
constexpr int N_PHASES = 1 + DEPTH * PH_PER_LAYER;
HD void run_phase(const Params& p, int ph, long gtid, long gsize) {
    if (ph == 0) { ph_mod(p, gtid, gsize); return; }
    const int l = (ph - 1) / PH_PER_LAYER, s = (ph - 1) % PH_PER_LAYER;
    const bool upd = l < DEPTH - 1;
    switch (s) {
        case 0: ph_norm1(p, l, gtid, gsize); break;
        case 1: ph_gemm_in(p, l, gtid, gsize); break;
        case 2: ph_post(p, l, gtid, gsize); break;
        case 3: ph_attn_diff(p, l, upd, gtid, gsize); ph_attn_gqa(p, l, upd, gtid, gsize); ph_mlstm(p, l, upd, gtid, gsize); break;
        case 4: ph_gemm_out(p, l, upd, gtid, gsize); break;
        case 5: ph_norm2_route(p, l, upd, gtid, gsize); break;
        case 6: ph_moe1(p, l, upd, gtid, gsize); break;
        default: ph_moe2(p, l, upd, gtid, gsize); break;
    }
}

struct Carver { char* base; size_t off; template <class T> T* take(size_t n) { T* r = (T*)(base + off); off += (n * sizeof(T) + 255) & ~(size_t)255; return r; } };
static inline size_t carve(Params& p, void* ws) {
    Carver c{(char*)ws, 0};
    p.mod = c.take<float>((size_t)DEPTH * (Bn + 1) * MODW);
    p.X = c.take<float>((size_t)NTOK * Dm);
    p.PROJ = c.take<float>((size_t)NTOK * INW);
    p.MQK = c.take<float>((size_t)NTOK * 512);
    p.MGATE = c.take<float>((size_t)NTOK * 16);
    p.DO = c.take<float>((size_t)Bn * 4 * (Tn + Cn) * 96);
    p.GATE = c.take<float>((size_t)NTOK * 2);
    p.HN = c.take<float>((size_t)NTOK * 2 * 512);
    p.XN = c.take<act_t>((size_t)NTOK * Dm);
    p.DQL = c.take<act_t>((size_t)Bn * 4 * 2 * Tn * 48);
    p.DQC = c.take<act_t>((size_t)Bn * 4 * 2 * Cn * 48);
    p.DK = c.take<act_t>((size_t)Bn * 4 * 2 * Sn * 48);
    p.DVt = c.take<act_t>((size_t)Bn * 4 * 96 * Sn);
    p.GQL = c.take<act_t>((size_t)Bn * 6 * Tn * 64);
    p.GQC = c.take<act_t>((size_t)Bn * 6 * Cn * 64);
    p.GK = c.take<act_t>((size_t)Bn * 2 * Sn * 64);
    p.GVt = c.take<act_t>((size_t)Bn * 2 * 64 * Sn);
    p.MIX = c.take<act_t>((size_t)NTOK * Dm);
    p.F = c.take<act_t>((size_t)NTOK * Dm);
    p.EID = c.take<int>((size_t)NTOK * 2);
    return c.off;
}
static inline void fill_inputs(Params& p, void* const* d_in, void* d_out) {
    const float** f = (const float**)&p;
    for (int i = 0; i < 27; ++i) f[i] = (const float*)d_in[i];
    p.out = (float*)d_out;
}

#ifndef HOST_TEST
__global__ void __launch_bounds__(256) k_phases(Params p, int ph_begin, int ph_end) {
    const long gtid = (long)blockIdx.x * blockDim.x + threadIdx.x, gsize = (long)gridDim.x * blockDim.x;
#if MK_LAUNCHES
    cg::grid_group grid = cg::this_grid();
#endif
    for (int ph = ph_begin; ph < ph_end; ++ph) {
        run_phase(p, ph, gtid, gsize);
#if MK_LAUNCHES
        if (ph + 1 < ph_end) grid.sync();
#endif
    }
}

extern "C" void kernel_launch(void* const* d_in, const int* in_sizes, int n_in, void* d_out, int out_size, void* d_ws, size_t ws_size, hipStream_t stream) {
    Params p;
    memset((void*)&p, 0, sizeof(p));
    fill_inputs(p, d_in, d_out);
    carve(p, d_ws);
#if MK_LAUNCHES
    static int grid_blocks = 0;
    if (!grid_blocks) {
        int dev = 0, cus = 0, per_cu = 0;
        (void)hipGetDevice(&dev);
        (void)hipDeviceGetAttribute(&cus, hipDeviceAttributeMultiprocessorCount, dev);
        (void)hipOccupancyMaxActiveBlocksPerMultiprocessor(&per_cu, k_phases, 256, 0);
        if (per_cu > 4) per_cu = 4;
        if (per_cu < 1) per_cu = 1;
        grid_blocks = cus * per_cu;
    }
    int b0 = 0, b1 = N_PHASES;
    void* args[] = {&p, &b0, &b1};
    (void)hipLaunchCooperativeKernel((void*)k_phases, dim3(grid_blocks), dim3(256), args, 0, stream);
#else
    for (int ph = 0; ph < N_PHASES; ++ph) k_phases<<<2048, 256, 0, stream>>>(p, ph, ph + 1);
#endif
}
#endif
```

```cpp
#ifndef HOST_TEST
#include <hip/hip_runtime.h>
#include <hip/hip_cooperative_groups.h>
#include <string.h>
namespace cg = cooperative_groups;
#define HD __host__ __device__ __forceinline__
#else
#include <math.h>
#include <string.h>
#define HD inline
#endif
#include <stdint.h>
#include <stddef.h>

#ifndef CFG_B
#define CFG_B 8
#define CFG_T 2048
#define CFG_C 256
#define CFG_DEPTH 4
#endif
#ifndef MK_LAUNCHES
#define MK_LAUNCHES 1
#endif

constexpr int Bn = CFG_B, Tn = CFG_T, Cn = CFG_C, DEPTH = CFG_DEPTH;
constexpr int Dm = 1024, INW = 2832, MODW = 6144;
constexpr int NL = Bn * Tn, NC = Bn * Cn, NTOK = NL + NC, Sn = Cn + Tn;
constexpr int DQ_OFF = 0, DK_OFF = 384, DV_OFF = 768, GQ_OFF = 1152, GK_OFF = 1536, GV_OFF = 1664, MQK_OFF = 1792, MV_OFF = 2304, MO_OFF = 2560, MG_OFF = 2816;
constexpr int NCH = Sn / 64, NCC = Cn / 64;
constexpr int PMAX = 2 * NTOK + 32 * 128;
constexpr float EPSF = 1e-6f;
constexpr float LOG2E = 1.4426950408889634f;

#ifdef ACT_F32
typedef float act_t;
HD act_t f2a(float f) { return f; }
HD float a2f(act_t a) { return a; }
#else
typedef unsigned short act_t;
HD act_t f2a(float f) { unsigned u; memcpy(&u, &f, 4); u += 0x7fffu + ((u >> 16) & 1u); return (act_t)(u >> 16); }
HD float a2f(act_t a) { unsigned u = ((unsigned)a) << 16; float f; memcpy(&f, &u, 4); return f; }
#endif

HD float silu_f(float x) { return x / (1.0f + expf(-x)); }
HD float sigmoid_f(float x) { return 1.0f / (1.0f + expf(-x)); }
HD float logsigmoid_f(float x) { return fminf(x, 0.0f) - log1pf(expf(-fabsf(x))); }
HD float lam_init_of(int l) { return 0.8f - 0.6f * expf(-0.3f * (float)l); }

struct Params {
    const float *x, *c, *ctx, *c_ctx, *norm1_g, *norm2_g, *w_mod, *b_mod, *w_in, *w_out, *diff_q_norm, *diff_k_norm, *diff_lambda, *diff_subln,
        *gqa_q_norm, *gqa_k_norm, *mlstm_conv_w, *mlstm_conv_b, *mlstm_gate_b, *mlstm_head_norm, *moe_wg, *moe_bg, *moe_we, *moe_be, *moe_w1, *moe_w3, *moe_w2;
    float* out;
    float *mod, *X, *PROJ, *MQK, *MGATE, *DO, *GATE, *HN;
    act_t *XN, *DQL, *DQC, *DK, *DVt, *GQL, *GQC, *GK, *GVt, *MIX, *F;
    int* EID;
    int *CNT, *LIST, *POS;
    act_t *H, *Y;
    float *ROPE, *KV, *NLC, *CHS, *MG4;
    act_t* MQKB;
};

HD bool tok_ctx(int tok) { return tok >= NL; }
HD int tok_b(int tok) { return tok < NL ? tok / Tn : (tok - NL) / Cn; }
HD int tok_i(int tok) { return tok < NL ? tok % Tn : (tok - NL) % Cn; }
HD int tok_s(int tok) { return tok < NL ? Cn + tok % Tn : (tok - NL) % Cn; }
HD int tok_modrow(int tok) { return tok < NL ? tok / Tn : Bn; }
HD int tok_of(int b, int s) { return s < Cn ? NL + b * Cn + s : b * Tn + (s - Cn); }
HD const float* mod_row(const Params& p, int l, int tok) { return p.mod + ((size_t)l * (Bn + 1) + tok_modrow(tok)) * MODW; }

HD void ph_mod(const Params& p, long gtid, long gsize) {
    for (long it = gtid; it < (long)DEPTH * MODW; it += gsize) {
        const int l = (int)(it / MODW), j = (int)(it % MODW);
        float acc[Bn + 1];
#pragma unroll
        for (int r = 0; r <= Bn; ++r) acc[r] = 0.f;
        const float* w = p.w_mod + (size_t)l * Dm * MODW + j;
        for (int k = 0; k < Dm; ++k) {
            const float wv = w[(size_t)k * MODW];
#pragma unroll
            for (int r = 0; r < Bn; ++r) acc[r] += silu_f(p.c[r * Dm + k]) * wv;
            acc[Bn] += silu_f(p.c_ctx[k]) * wv;
        }
        const float bb = p.b_mod[l * MODW + j];
#pragma unroll
        for (int r = 0; r <= Bn; ++r) p.mod[((size_t)l * (Bn + 1) + r) * MODW + j] = acc[r] + bb;
    }
    for (long it = gtid; it < (long)NTOK * Dm; it += gsize) p.X[it] = it < (long)NL * Dm ? p.x[it] : p.ctx[it - (long)NL * Dm];
}

HD void ph_norm1(const Params& p, int l, long gtid, long gsize) {
    for (long row = gtid; row < NTOK; row += gsize) {
        const float* xr = p.X + row * Dm;
        float ss = 0.f;
        for (int k = 0; k < Dm; ++k) ss += xr[k] * xr[k];
        const float rstd = 1.0f / sqrtf(ss / Dm + EPSF);
        const float* mr = mod_row(p, l, (int)row);
        const float* g = p.norm1_g + l * Dm;
        for (int k = 0; k < Dm; ++k) p.XN[row * Dm + k] = f2a(xr[k] * rstd * g[k] * (1.0f + mr[Dm + k]) + mr[k]);
    }
}

HD void ph_gemm_in(const Params& p, int l, long gtid, long gsize) {
    const float* W = p.w_in + (size_t)l * Dm * INW;
    for (long it = gtid; it < (long)NTOK * INW; it += gsize) {
        const long m = it / INW; const int n = (int)(it % INW);
        const act_t* a = p.XN + m * Dm;
        float acc = 0.f;
        for (int k = 0; k < Dm; ++k) acc += a2f(a[k]) * W[(size_t)k * INW + n];
        p.PROJ[it] = acc;
    }
}

template <int DHn>
HD void qk_unit(const float* src, const float* g, bool rope, int t, float oscale, float (&y)[DHn]) {
    float ss = 0.f;
#pragma unroll
    for (int i = 0; i < DHn; ++i) { y[i] = src[i]; ss += y[i] * y[i]; }
    const float rstd = 1.0f / sqrtf(ss / DHn + EPSF);
#pragma unroll
    for (int i = 0; i < DHn; ++i) y[i] = y[i] * rstd * g[i];
    if (rope) {
        constexpr int half = DHn / 2, nf = half / 2;
        const float posr = (float)(t / 64), posc = (float)(t % 64);
#pragma unroll
        for (int hsel = 0; hsel < 2; ++hsel) {
            const float pos = hsel ? posc : posr;
#pragma unroll
            for (int i = 0; i < nf; ++i) {
                const float fr = expf(-(float)i / (float)nf * 9.210340371976184f);
                const float ang = pos * fr;
                const float cs = cosf(ang), sn = sinf(ang);
                const float x1 = y[hsel * half + i], x2 = y[hsel * half + nf + i];
                y[hsel * half + i] = x1 * cs - x2 * sn;
                y[hsel * half + nf + i] = x2 * cs + x1 * sn;
            }
        }
    }
#pragma unroll
    for (int i = 0; i < DHn; ++i) y[i] *= oscale;
}

HD void ph_post(const Params& p, int l, long gtid, long gsize) {
    constexpr int NU = 27;
    for (long it = gtid; it < (long)NTOK * NU; it += gsize) {
        const int tok = (int)(it / NU), u = (int)(it % NU);
        const bool isc = tok_ctx(tok);
        const int b = tok_b(tok), ti = tok_i(tok), s = tok_s(tok);
        const float* pr = p.PROJ + (size_t)tok * INW;
        if (u < 16) {
            const bool isk = u >= 8; const int h = (u & 7) >> 1, w = u & 1;
            float y[48];
            qk_unit<48>(pr + (isk ? DK_OFF : DQ_OFF) + h * 96 + w * 48, (isk ? p.diff_k_norm : p.diff_q_norm) + l * 48, !isc, ti,
                        isk ? 1.0f : 0.14433756729740643f * LOG2E, y);
            act_t* dst = isk ? p.DK + (((size_t)(b * 4 + h) * 2 + w) * Sn + s) * 48
                             : (isc ? p.DQC + (((size_t)(b * 4 + h) * 2 + w) * Cn + ti) * 48 : p.DQL + (((size_t)(b * 4 + h) * 2 + w) * Tn + ti) * 48);
#pragma unroll
            for (int i = 0; i < 48; ++i) dst[i] = f2a(y[i]);
        } else if (u < 24) {
            const bool isk = u >= 22; const int h = isk ? u - 22 : u - 16;
            float y[64];
            qk_unit<64>(pr + (isk ? GK_OFF : GQ_OFF) + h * 64, (isk ? p.gqa_k_norm : p.gqa_q_norm) + l * 64, !isc, ti, isk ? 1.0f : 0.125f * LOG2E, y);
            act_t* dst = isk ? p.GK + ((size_t)(b * 2 + h) * Sn + s) * 64
                             : (isc ? p.GQC + ((size_t)(b * 6 + h) * Cn + ti) * 64 : p.GQL + ((size_t)(b * 6 + h) * Tn + ti) * 64);
#pragma unroll
            for (int i = 0; i < 64; ++i) dst[i] = f2a(y[i]);
        } else if (u == 24) {
            for (int j = 0; j < 384; ++j) p.DVt[((size_t)(b * 4 + j / 96) * 96 + j % 96) * Sn + s] = f2a(pr[DV_OFF + j]);
        } else if (u == 25) {
            for (int j = 0; j < 128; ++j) p.GVt[((size_t)(b * 2 + j / 64) * 64 + j % 64) * Sn + s] = f2a(pr[GV_OFF + j]);
        } else {
            const int seglen = isc ? Cn : Tn;
            const float* cw = p.mlstm_conv_w + (size_t)l * 3 * 512; const float* cb = p.mlstm_conv_b + l * 512;
            for (int ch = 0; ch < 512; ++ch) {
                float a = cb[ch] + pr[MQK_OFF + ch] * cw[512 + ch];
                if (ti > 0) a += pr[MQK_OFF + ch - INW] * cw[ch];
                if (ti < seglen - 1) a += pr[MQK_OFF + ch + INW] * cw[1024 + ch];
                a = silu_f(a);
                p.MQK[(size_t)tok * 512 + ch] = ch >= 256 ? a * 0.125f : a;
            }
            const float* gb = p.mlstm_gate_b + l * 16;
            for (int j = 0; j < 16; ++j) {
                const float gv = pr[MG_OFF + j] + gb[j];
                p.MGATE[(size_t)tok * 16 + j] = ((j >> 2) & 1) ? logsigmoid_f(gv) : gv;
            }
        }
    }
}

HD void ph_attn_diff(const Params& p, int l, bool upd, long gtid, long gsize) {
    const int nq = upd ? Tn + Cn : Tn;
    const float lam_init = lam_init_of(l);
    for (long it = gtid; it < (long)Bn * 4 * nq; it += gsize) {
        const int qi = (int)(it % nq), h = (int)((it / nq) % 4), b = (int)(it / ((long)nq * 4));
        const bool isc = qi >= Tn; const int ti = isc ? qi - Tn : qi;
        const int nk = isc ? Cn : Sn;
        const int tok = isc ? NL + b * Cn + ti : b * Tn + ti;
        float* dob = p.DO + ((size_t)(b * 4 + h) * (Tn + Cn) + qi) * 96;
        const act_t* vt = p.DVt + (size_t)(b * 4 + h) * 96 * Sn;
        float l2 = 1.f;
        float o[96];
        for (int w = 0; w < 2; ++w) {
            const act_t* qp = isc ? p.DQC + (((size_t)(b * 4 + h) * 2 + w) * Cn + ti) * 48 : p.DQL + (((size_t)(b * 4 + h) * 2 + w) * Tn + ti) * 48;
            const act_t* kp = p.DK + ((size_t)(b * 4 + h) * 2 + w) * Sn * 48;
            float q[48];
#pragma unroll
            for (int i = 0; i < 48; ++i) q[i] = a2f(qp[i]);
#pragma unroll
            for (int i = 0; i < 96; ++i) o[i] = 0.f;
            float m = -1e30f, lsum = 0.f;
            for (int s = 0; s < nk; ++s) {
                float sc = 0.f;
#pragma unroll
                for (int i = 0; i < 48; ++i) sc += q[i] * a2f(kp[(size_t)s * 48 + i]);
                const float mn = fmaxf(m, sc), alpha = exp2f(m - mn), pe = exp2f(sc - mn);
                lsum = lsum * alpha + pe;
#pragma unroll
                for (int i = 0; i < 96; ++i) o[i] = o[i] * alpha + pe * a2f(vt[(size_t)i * Sn + s]);
                m = mn;
            }
            if (w == 0) {
#pragma unroll
                for (int i = 0; i < 96; ++i) dob[i] = o[i] / lsum;
            } else l2 = lsum;
        }
        const float* dl = p.diff_lambda + l * 4 * 48;
        float s01 = 0.f, s23 = 0.f;
        for (int i = 0; i < 48; ++i) { s01 += dl[i] * dl[48 + i]; s23 += dl[96 + i] * dl[144 + i]; }
        const float lam = expf(s01) - expf(s23) + lam_init;
        float ss = 0.f;
#pragma unroll
        for (int i = 0; i < 96; ++i) { o[i] = dob[i] - lam * o[i] / l2; ss += o[i] * o[i]; }
        const float rstd = 1.0f / sqrtf(ss / 96 + EPSF);
        const float* sg = p.diff_subln + l * 96;
#pragma unroll
        for (int i = 0; i < 96; ++i) p.MIX[(size_t)tok * Dm + h * 96 + i] = f2a(o[i] * rstd * sg[i] * (1.0f - lam_init));
    }
}

HD void ph_attn_gqa(const Params& p, int l, bool upd, long gtid, long gsize) {
    const int nq = upd ? Tn + Cn : Tn;
    for (long it = gtid; it < (long)Bn * 6 * nq; it += gsize) {
        const int qi = (int)(it % nq), hq = (int)((it / nq) % 6), b = (int)(it / ((long)nq * 6));
        const bool isc = qi >= Tn; const int ti = isc ? qi - Tn : qi;
        const int nk = isc ? Cn : Sn, kv = hq / 3;
        const int tok = isc ? NL + b * Cn + ti : b * Tn + ti;
        const act_t* qp = isc ? p.GQC + ((size_t)(b * 6 + hq) * Cn + ti) * 64 : p.GQL + ((size_t)(b * 6 + hq) * Tn + ti) * 64;
        const act_t* kp = p.GK + (size_t)(b * 2 + kv) * Sn * 64;
        const act_t* vt = p.GVt + (size_t)(b * 2 + kv) * 64 * Sn;
        float q[64], o[64];
#pragma unroll
        for (int i = 0; i < 64; ++i) { q[i] = a2f(qp[i]); o[i] = 0.f; }
        float m = -1e30f, lsum = 0.f;
        for (int s = 0; s < nk; ++s) {
            float sc = 0.f;
#pragma unroll
            for (int i = 0; i < 64; ++i) sc += q[i] * a2f(kp[(size_t)s * 64 + i]);
            const float mn = fmaxf(m, sc), alpha = exp2f(m - mn), pe = exp2f(sc - mn);
            lsum = lsum * alpha + pe;
#pragma unroll
            for (int i = 0; i < 64; ++i) o[i] = o[i] * alpha + pe * a2f(vt[(size_t)i * Sn + s]);
            m = mn;
        }
#pragma unroll
        for (int i = 0; i < 64; ++i) p.MIX[(size_t)tok * Dm + 384 + hq * 64 + i] = f2a(o[i] / lsum);
    }
}

HD void mlstm_dir_naive(const Params& p, int b, int h, bool isc, int ti, int dir, const float (&q)[64], float (&hout)[64]) {
    float num[64];
#pragma unroll
    for (int i = 0; i < 64; ++i) num[i] = 0.f;
    float den = 0.f, m = -1e30f, Dg = 0.f;
    for (int seg = 0; seg < (isc ? 1 : 2); ++seg) {
        const bool sc_ = seg == 1 ? true : isc;
        const int len = sc_ ? Cn : Tn;
        int cnt, start, step;
        if (seg == 0) { start = ti; step = dir == 0 ? -1 : 1; cnt = dir == 0 ? ti + 1 : len - ti; }
        else { start = dir == 0 ? len - 1 : 0; step = dir == 0 ? -1 : 1; cnt = len; }
        for (int c = 0, si = start; c < cnt; ++c, si += step) {
            const int tk = sc_ ? NL + b * Cn + si : b * Tn + si;
            const float li = p.MGATE[(size_t)tk * 16 + dir * 8 + h], lf = p.MGATE[(size_t)tk * 16 + dir * 8 + 4 + h];
            const float lw = Dg + li;
            const float* kr = p.MQK + (size_t)tk * 512 + 256 + h * 64;
            const float* vr = p.PROJ + (size_t)tk * INW + MV_OFF + h * 64;
            float qk = 0.f;
#pragma unroll
            for (int i = 0; i < 64; ++i) qk += q[i] * kr[i];
            const float mn = fmaxf(m, lw), alpha = expf(m - mn), w = expf(lw - mn) * qk;
            den = den * alpha + w;
#pragma unroll
            for (int i = 0; i < 64; ++i) num[i] = num[i] * alpha + w * vr[i];
            m = mn;
            Dg += lf;
        }
    }
    const float dn = fmaxf(fabsf(den), expf(-m));
#pragma unroll
    for (int i = 0; i < 64; ++i) hout[i] += num[i] / dn;
}

HD void ph_mlstm(const Params& p, int l, bool upd, long gtid, long gsize) {
    const int nq = upd ? Tn + Cn : Tn;
    for (long it = gtid; it < (long)Bn * 4 * nq; it += gsize) {
        const int qi = (int)(it % nq), h = (int)((it / nq) % 4), b = (int)(it / ((long)nq * 4));
        const bool isc = qi >= Tn; const int ti = isc ? qi - Tn : qi;
        const int tok = isc ? NL + b * Cn + ti : b * Tn + ti;
        float q[64], hh[64];
#pragma unroll
        for (int i = 0; i < 64; ++i) { q[i] = p.MQK[(size_t)tok * 512 + h * 64 + i]; hh[i] = 0.f; }
        mlstm_dir_naive(p, b, h, isc, ti, 0, q, hh);
        mlstm_dir_naive(p, b, h, isc, ti, 1, q, hh);
        float ss = 0.f;
#pragma unroll
        for (int i = 0; i < 64; ++i) ss += hh[i] * hh[i];
        const float rstd = 1.0f / sqrtf(ss / 64 + EPSF);
        const float* hn = p.mlstm_head_norm + l * 256 + h * 64;
        const float* og = p.PROJ + (size_t)tok * INW + MO_OFF + h * 64;
#pragma unroll
        for (int i = 0; i < 64; ++i) p.MIX[(size_t)tok * Dm + 768 + h * 64 + i] = f2a(hh[i] * rstd * hn[i] * sigmoid_f(og[i]));
    }
}

HD void ph_gemm_out(const Params& p, int l, bool upd, long gtid, long gsize) {
    const float* W = p.w_out + (size_t)l * Dm * Dm;
    const long rows = upd ? NTOK : NL;
    for (long it = gtid; it < rows * Dm; it += gsize) {
        const long m = it / Dm; const int n = (int)(it % Dm);
        const act_t* a = p.MIX + m * Dm;
        float acc = 0.f;
        for (int k = 0; k < Dm; ++k) acc += a2f(a[k]) * W[(size_t)k * Dm + n];
        p.X[it] += mod_row(p, l, (int)m)[2 * Dm + n] * acc;
    }
}

HD void ph_norm2_route(const Params& p, int l, bool upd, long gtid, long gsize) {
    const long rows = upd ? NTOK : NL;
    for (long row = gtid; row < rows; row += gsize) {
        const float* xr = p.X + row * Dm;
        float ss = 0.f;
        for (int k = 0; k < Dm; ++k) ss += xr[k] * xr[k];
        const float rstd = 1.0f / sqrtf(ss / Dm + EPSF);
        const float* mr = mod_row(p, l, (int)row);
        const float* g = p.norm2_g + l * Dm;
        const float* wg = p.moe_wg + (size_t)l * Dm * 4; const float* we = p.moe_we + (size_t)l * Dm * 32;
        float ag[4], ae[32];
#pragma unroll
        for (int j = 0; j < 4; ++j) ag[j] = 0.f;
#pragma unroll
        for (int j = 0; j < 32; ++j) ae[j] = 0.f;
        for (int k = 0; k < Dm; ++k) {
            const float f = xr[k] * rstd * g[k] * (1.0f + mr[4 * Dm + k]) + mr[3 * Dm + k];
            p.F[row * Dm + k] = f2a(f);
#pragma unroll
            for (int j = 0; j < 4; ++j) ag[j] += f * wg[k * 4 + j];
#pragma unroll
            for (int j = 0; j < 32; ++j) ae[j] += f * we[k * 32 + j];
        }
        float gmax = -1e30f; int gi = 0;
#pragma unroll
        for (int j = 0; j < 4; ++j) { ag[j] += p.moe_bg[l * 4 + j]; if (ag[j] > gmax) { gmax = ag[j]; gi = j; } }
        float gsum = 0.f;
#pragma unroll
        for (int j = 0; j < 4; ++j) gsum += expf(ag[j] - gmax);
        const float gtop = 1.0f / gsum;
        float e1 = -1e30f, e2 = -1e30f; int i1 = 0, i2 = 0;
#pragma unroll
        for (int grp = 0; grp < 4; ++grp) {
            if (grp == gi) {
#pragma unroll
                for (int j = 0; j < 8; ++j) {
                    const float v = ae[grp * 8 + j] + p.moe_be[l * 32 + grp * 8 + j];
                    if (v > e1) { e2 = e1; i2 = i1; e1 = v; i1 = j; } else if (v > e2) { e2 = v; i2 = j; }
                }
            }
        }
        const float g0 = 1.0f / (1.0f + expf(e2 - e1));
        p.EID[row * 2] = gi * 8 + i1; p.EID[row * 2 + 1] = gi * 8 + i2;
        p.GATE[row * 2] = g0 * gtop; p.GATE[row * 2 + 1] = (1.0f - g0) * gtop;
    }
}

HD void ph_moe1(const Params& p, int l, bool upd, long gtid, long gsize) {
    const long rows = upd ? NTOK : NL;
    for (long it = gtid; it < rows * 2 * 512; it += gsize) {
        const long rk = it / 512; const int j = (int)(it % 512);
        const long row = rk >> 1;
        const int e = p.EID[rk];
        const float* W1 = p.moe_w1 + ((size_t)l * 32 + e) * Dm * 512 + j; const float* W3 = p.moe_w3 + ((size_t)l * 32 + e) * Dm * 512 + j;
        const act_t* f = p.F + row * Dm;
        float a = 0.f, bb = 0.f;
        for (int k = 0; k < Dm; ++k) { const float fv = a2f(f[k]); a += fv * W1[(size_t)k * 512]; bb += fv * W3[(size_t)k * 512]; }
        p.HN[it] = silu_f(a) * bb;
    }
}

HD void ph_moe2(const Params& p, int l, bool upd, long gtid, long gsize) {
    const long rows = upd ? NTOK : NL;
    for (long it = gtid; it < rows * Dm; it += gsize) {
        const long row = it / Dm; const int d = (int)(it % Dm);
        float y = 0.f;
        for (int kk = 0; kk < 2; ++kk) {
            const int e = p.EID[row * 2 + kk];
            const float* W2 = p.moe_w2 + ((size_t)l * 32 + e) * 512 * Dm + d;
            const float* hn = p.HN + (row * 2 + kk) * 512;
            float acc = 0.f;
            for (int j = 0; j < 512; ++j) acc += hn[j] * W2[(size_t)j * Dm];
            y += p.GATE[row * 2 + kk] * acc;
        }
        const float xn = p.X[it] + mod_row(p, l, (int)row)[5 * Dm + d] * y;
        p.X[it] = xn;
        if (l == DEPTH - 1) p.out[it] = xn;
    }
}

constexpr int PH_PER_LAYER = 8;
constexpr int N_PHASES = 1 + DEPTH * PH_PER_LAYER;
HD void run_phase(const Params& p, int ph, long gtid, long gsize) {
    if (ph == 0) { ph_mod(p, gtid, gsize); return; }
    const int l = (ph - 1) / PH_PER_LAYER, s = (ph - 1) % PH_PER_LAYER;
    const bool upd = l < DEPTH - 1;
    switch (s) {
        case 0: ph_norm1(p, l, gtid, gsize); break;
        case 1: ph_gemm_in(p, l, gtid, gsize); break;
        case 2: ph_post(p, l, gtid, gsize); break;
        case 3: ph_attn_diff(p, l, upd, gtid, gsize); ph_attn_gqa(p, l, upd, gtid, gsize); ph_mlstm(p, l, upd, gtid, gsize); break;
        case 4: ph_gemm_out(p, l, upd, gtid, gsize); break;
        case 5: ph_norm2_route(p, l, upd, gtid, gsize); break;
        case 6: ph_moe1(p, l, upd, gtid, gsize); break;
        default: ph_moe2(p, l, upd, gtid, gsize); break;
    }
}

struct Carver { char* base; size_t off; template <class T> T* take(size_t n) { T* r = (T*)(base + off); off += (n * sizeof(T) + 255) & ~(size_t)255; return r; } };
static inline size_t carve(Params& p, void* ws) {
    Carver c{(char*)ws, 0};
    p.mod = c.take<float>((size_t)DEPTH * (Bn + 1) * MODW);
    p.X = c.take<float>((size_t)NTOK * Dm);
    p.PROJ = c.take<float>((size_t)NTOK * INW);
    p.MQK = c.take<float>((size_t)NTOK * 512);
    p.MGATE = c.take<float>((size_t)NTOK * 16);
    p.DO = c.take<float>((size_t)Bn * 4 * (Tn + Cn) * 96);
    p.GATE = c.take<float>((size_t)NTOK * 2);
    p.HN = c.take<float>((size_t)NTOK * 2 * 512);
    p.XN = c.take<act_t>((size_t)NTOK * Dm);
    p.DQL = c.take<act_t>((size_t)Bn * 4 * 2 * Tn * 48);
    p.DQC = c.take<act_t>((size_t)Bn * 4 * 2 * Cn * 48);
    p.DK = c.take<act_t>((size_t)Bn * 4 * 2 * Sn * 48);
    p.DVt = c.take<act_t>((size_t)Bn * 4 * 96 * Sn);
    p.GQL = c.take<act_t>((size_t)Bn * 6 * Tn * 64);
    p.GQC = c.take<act_t>((size_t)Bn * 6 * Cn * 64);
    p.GK = c.take<act_t>((size_t)Bn * 2 * Sn * 64);
    p.GVt = c.take<act_t>((size_t)Bn * 2 * 64 * Sn);
    p.MIX = c.take<act_t>((size_t)NTOK * Dm);
    p.F = c.take<act_t>((size_t)NTOK * Dm);
    p.EID = c.take<int>((size_t)NTOK * 2);
    p.CNT = c.take<int>((size_t)DEPTH * 32);
    p.LIST = c.take<int>((size_t)32 * NTOK);
    p.POS = c.take<int>((size_t)NTOK * 2);
    p.H = c.take<act_t>((size_t)PMAX * 512);
    p.Y = c.take<act_t>((size_t)PMAX * Dm);
    p.ROPE = c.take<float>((size_t)64 * 28 * 2);
    p.KV = c.take<float>((size_t)Bn * 4 * 2 * NCH * 4096);
    p.NLC = c.take<float>((size_t)Bn * 4 * 2 * NCH * 64);
    p.CHS = c.take<float>((size_t)Bn * 4 * 2 * NCH * 2);
    p.MG4 = c.take<float>((size_t)NTOK * 16);
    p.MQKB = c.take<act_t>((size_t)NTOK * 512);
    return c.off;
}
static inline void fill_inputs(Params& p, void* const* d_in, void* d_out) {
    const float** f = (const float**)&p;
    for (int i = 0; i < 27; ++i) f[i] = (const float*)d_in[i];
    p.out = (float*)d_out;
}


#ifndef HOST_TEST
typedef short bf16x8 __attribute__((ext_vector_type(8)));
typedef float f32x2 __attribute__((ext_vector_type(2)));
typedef float f32x4 __attribute__((ext_vector_type(4)));
typedef float f32x16 __attribute__((ext_vector_type(16)));
typedef unsigned u32x2 __attribute__((ext_vector_type(2)));
typedef unsigned u32x4 __attribute__((ext_vector_type(4)));
typedef __bf16 bf16x2_t __attribute__((ext_vector_type(2)));
#define DI __device__ __forceinline__
DI unsigned pk2(float a, float b) { f32x2 v = {a, b}; return __builtin_bit_cast(unsigned, __builtin_convertvector(v, bf16x2_t)); }
DI float bflo(unsigned u) { return __uint_as_float(u << 16); }
DI float bfhi(unsigned u) { return __uint_as_float(u & 0xffff0000u); }
DI float shfl_i(float v, int src) { return __int_as_float(__builtin_amdgcn_ds_bpermute(src << 2, __float_as_int(v))); }
DI float shfl_x(float v, int o, int lane) { return shfl_i(v, lane ^ o); }
DI float wave_sum(float v, int lane) {
#pragma unroll
    for (int o = 32; o > 0; o >>= 1) v += shfl_x(v, o, lane);
    return v;
}

constexpr int NTHR = 256;
DI int opaque_tid() { int t = threadIdx.x; asm volatile("" : "+v"(t)); return t; }
constexpr int GT_LD = 144;
constexpr int GT_AS = 0, GT_BS = 128 * GT_LD, GT_END = 256 * GT_LD;
constexpr int SM_AUX = GT_END;
constexpr int SMEM_BYTES = 56 * 1024;

#ifndef IMPL_POST
#define IMPL_POST 1
#endif
#ifndef IMPL_ATTN
#define IMPL_ATTN 1
#endif
#ifndef IMPL_MLSTM
#define IMPL_MLSTM 1
#endif
#ifndef IMPL_ROUTE
#define IMPL_ROUTE 1
#endif
DI void gemm_mainloop(unsigned char* smem, const act_t* const (&arow)[4], const float* bptr, const bool bvalid, const int ldb, const int K, f32x4 (&acc)[4][4]) {
    const int tid = opaque_tid(), lane = tid & 63, w = tid >> 6, wm = w >> 1, wn = w & 1;
    const int a_r = tid >> 3, a_c = tid & 7, kg = lane & 7, c4 = (w * 8 + (lane >> 3)) * 4;
#pragma unroll
    for (int mi = 0; mi < 4; ++mi)
#pragma unroll
        for (int ni = 0; ni < 4; ++ni) acc[mi][ni] = (f32x4){0.f, 0.f, 0.f, 0.f};
    u32x4 ra[4]; f32x4 rb[8];
#pragma unroll
    for (int i = 0; i < 4; ++i) ra[i] = arow[i] ? *(const u32x4*)(arow[i] + a_c * 8) : (u32x4){0u, 0u, 0u, 0u};
#pragma unroll
    for (int r = 0; r < 8; ++r) rb[r] = bvalid ? *(const f32x4*)(bptr + (size_t)(kg * 8 + r) * ldb) : (f32x4){0.f, 0.f, 0.f, 0.f};
    for (int k0 = 0; k0 < K; k0 += 64) {
        __syncthreads();
#pragma unroll
        for (int i = 0; i < 4; ++i) *(u32x4*)(smem + GT_AS + (a_r + 32 * i) * GT_LD + a_c * 16) = ra[i];
#pragma unroll
        for (int i = 0; i < 4; ++i) {
            const u32x4 q = {pk2(rb[0][i], rb[1][i]), pk2(rb[2][i], rb[3][i]), pk2(rb[4][i], rb[5][i]), pk2(rb[6][i], rb[7][i])};
            *(u32x4*)(smem + GT_BS + (c4 + i) * GT_LD + kg * 16) = q;
        }
        __syncthreads();
        if (k0 + 64 < K) {
#pragma unroll
            for (int i = 0; i < 4; ++i) ra[i] = arow[i] ? *(const u32x4*)(arow[i] + k0 + 64 + a_c * 8) : (u32x4){0u, 0u, 0u, 0u};
#pragma unroll
            for (int r = 0; r < 8; ++r) rb[r] = bvalid ? *(const f32x4*)(bptr + (size_t)(k0 + 64 + kg * 8 + r) * ldb) : (f32x4){0.f, 0.f, 0.f, 0.f};
        }
#pragma unroll
        for (int kk = 0; kk < 2; ++kk) {
            bf16x8 af[4], bfr[4];
#pragma unroll
            for (int mi = 0; mi < 4; ++mi) af[mi] = *(const bf16x8*)(smem + GT_AS + (wm * 64 + mi * 16 + (lane & 15)) * GT_LD + kk * 64 + (lane >> 4) * 16);
#pragma unroll
            for (int ni = 0; ni < 4; ++ni) bfr[ni] = *(const bf16x8*)(smem + GT_BS + (wn * 64 + ni * 16 + (lane & 15)) * GT_LD + kk * 64 + (lane >> 4) * 16);
#pragma unroll
            for (int mi = 0; mi < 4; ++mi)
#pragma unroll
                for (int ni = 0; ni < 4; ++ni) acc[mi][ni] = __builtin_amdgcn_mfma_f32_16x16x32_bf16(bfr[ni], af[mi], acc[mi][ni], 0, 0, 0);
        }
    }
}

DI int xcd_remap(int b, int G) { return (G & 7) == 0 ? (b & 7) * (G >> 3) + (b >> 3) : b; }

DI void bp_gemm_in(const Params& p, int l, unsigned char* smem, int vb, int G) {
    constexpr int MT = NTOK / 128, NT = (INW + 127) / 128;
    const float* W = p.w_in + (size_t)l * Dm * INW;
    const int tid = opaque_tid(), lane = tid & 63, w = tid >> 6, wm = w >> 1, wn = w & 1, a_r = tid >> 3, c4 = (w * 8 + (lane >> 3)) * 4;
    for (int t = vb; t < MT * NT; t += G) {
        const int mt = t / NT, nt = t % NT, m0 = mt * 128, n0 = nt * 128;
        const act_t* arow[4];
#pragma unroll
        for (int i = 0; i < 4; ++i) arow[i] = p.XN + (size_t)(m0 + a_r + 32 * i) * Dm;
        f32x4 acc[4][4];
        gemm_mainloop(smem, arow, W + n0 + c4, n0 + c4 < INW, INW, Dm, acc);
#pragma unroll
        for (int mi = 0; mi < 4; ++mi)
#pragma unroll
            for (int ni = 0; ni < 4; ++ni) {
                const int m = m0 + wm * 64 + mi * 16 + (lane & 15), n = n0 + wn * 64 + ni * 16 + (lane >> 4) * 4;
                if (n < INW) *(f32x4*)(p.PROJ + (size_t)m * INW + n) = acc[mi][ni];
            }
    }
}

DI void bp_gemm_out(const Params& p, int l, bool upd, unsigned char* smem, int vb, int G) {
    const int MT = (upd ? NTOK : NL) / 128; constexpr int NT = Dm / 128;
    const float* W = p.w_out + (size_t)l * Dm * Dm;
    const int tid = opaque_tid(), lane = tid & 63, w = tid >> 6, wm = w >> 1, wn = w & 1, a_r = tid >> 3, c4 = (w * 8 + (lane >> 3)) * 4;
    for (int t = vb; t < MT * NT; t += G) {
        const int mt = t / NT, nt = t % NT, m0 = mt * 128, n0 = nt * 128;
        const act_t* arow[4];
#pragma unroll
        for (int i = 0; i < 4; ++i) arow[i] = p.MIX + (size_t)(m0 + a_r + 32 * i) * Dm;
        f32x4 acc[4][4];
        gemm_mainloop(smem, arow, W + n0 + c4, true, Dm, Dm, acc);
#pragma unroll
        for (int mi = 0; mi < 4; ++mi) {
            const int m = m0 + wm * 64 + mi * 16 + (lane & 15);
            const float* g1 = mod_row(p, l, m) + 2 * Dm;
#pragma unroll
            for (int ni = 0; ni < 4; ++ni) {
                const int n = n0 + wn * 64 + ni * 16 + (lane >> 4) * 4;
                f32x4* xp = (f32x4*)(p.X + (size_t)m * Dm + n);
                *xp = *xp + *(const f32x4*)(g1 + n) * acc[mi][ni];
            }
        }
    }
}

DI int* moe_prep(const Params& p, int l, unsigned char* smem) {
    int* s_moff = (int*)(smem + SM_AUX);
    __syncthreads();
    if (threadIdx.x == 0) { int o = 0; for (int e = 0; e < 32; ++e) { s_moff[e] = o; o += (p.CNT[l * 32 + e] + 127) >> 7; } s_moff[32] = o; }
    __syncthreads();
    return s_moff;
}

DI void bp_moe1(const Params& p, int l, unsigned char* smem, int vb, int G) {
    const int* s_moff = moe_prep(p, l, smem);
    const int total = s_moff[32] * 8;
    const int tid = opaque_tid(), lane = tid & 63, w = tid >> 6, wm = w >> 1, wn = w & 1, a_r = tid >> 3, c4 = (w * 8 + (lane >> 3)) * 4;
    for (int t = vb; t < total; t += G) {
        const int mtg = t >> 3, nt = t & 7;
        int e = 0; while (s_moff[e + 1] <= mtg) ++e;
        const int cnt = p.CNT[l * 32 + e], lbase = (mtg - s_moff[e]) * 128;
        const act_t* arow[4];
#pragma unroll
        for (int i = 0; i < 4; ++i) { const int li = lbase + a_r + 32 * i; arow[i] = li < cnt ? p.F + (size_t)p.LIST[(size_t)e * NTOK + li] * Dm : nullptr; }
        const int sel = (c4 & 63) >> 5, j = nt * 64 + (c4 >> 6) * 32 + (c4 & 31);
        const float* bptr = (sel ? p.moe_w3 : p.moe_w1) + ((size_t)l * 32 + e) * Dm * 512 + j;
        f32x4 acc[4][4];
        gemm_mainloop(smem, arow, bptr, true, 512, Dm, acc);
#pragma unroll
        for (int mi = 0; mi < 4; ++mi)
#pragma unroll
            for (int ni = 0; ni < 2; ++ni) {
                const f32x4 a = acc[mi][ni], b = acc[mi][ni + 2];
                float h[4];
#pragma unroll
                for (int r = 0; r < 4; ++r) h[r] = a[r] / (1.0f + __expf(-a[r])) * b[r];
                const int prow = mtg * 128 + wm * 64 + mi * 16 + (lane & 15), jj = nt * 64 + wn * 32 + ni * 16 + (lane >> 4) * 4;
                *(u32x2*)(p.H + (size_t)prow * 512 + jj) = (u32x2){pk2(h[0], h[1]), pk2(h[2], h[3])};
            }
    }
}

DI void bp_moe2(const Params& p, int l, unsigned char* smem, int vb, int G) {
    const int* s_moff = moe_prep(p, l, smem);
    const int total = s_moff[32] * 8;
    const int tid = opaque_tid(), lane = tid & 63, w = tid >> 6, wm = w >> 1, wn = w & 1, a_r = tid >> 3, c4 = (w * 8 + (lane >> 3)) * 4;
    for (int t = vb; t < total; t += G) {
        const int mtg = t >> 3, nt = t & 7, n0 = nt * 128;
        int e = 0; while (s_moff[e + 1] <= mtg) ++e;
        const act_t* arow[4];
#pragma unroll
        for (int i = 0; i < 4; ++i) arow[i] = p.H + (size_t)(mtg * 128 + a_r + 32 * i) * 512;
        f32x4 acc[4][4];
        gemm_mainloop(smem, arow, p.moe_w2 + ((size_t)l * 32 + e) * 512 * Dm + n0 + c4, true, Dm, 512, acc);
#pragma unroll
        for (int mi = 0; mi < 4; ++mi)
#pragma unroll
            for (int ni = 0; ni < 4; ++ni) {
                const int prow = mtg * 128 + wm * 64 + mi * 16 + (lane & 15), n = n0 + wn * 64 + ni * 16 + (lane >> 4) * 4;
                const f32x4 v = acc[mi][ni];
                *(u32x2*)(p.Y + (size_t)prow * Dm + n) = (u32x2){pk2(v[0], v[1]), pk2(v[2], v[3])};
            }
    }
}

DI void bp_route(const Params& p, int l, bool upd, long gtid, long gsize) {
    ph_norm2_route(p, l, upd, gtid, gsize);
    const long rows = upd ? NTOK : NL;
    for (long row = gtid; row < rows; row += gsize)
#pragma unroll
        for (int kk = 0; kk < 2; ++kk) {
            const int e = p.EID[row * 2 + kk];
            const int pos = atomicAdd(&p.CNT[l * 32 + e], 1);
            p.LIST[(size_t)e * NTOK + pos] = (int)row;
            p.POS[row * 2 + kk] = pos;
        }
}

DI void norm1_row(const Params& p, int l, long row, const f32x4 (&x)[4], int lane) {
    float ss = 0.f;
#pragma unroll
    for (int i = 0; i < 4; ++i) ss += x[i][0] * x[i][0] + x[i][1] * x[i][1] + x[i][2] * x[i][2] + x[i][3] * x[i][3];
    ss = wave_sum(ss, lane);
    const float rstd = 1.0f / sqrtf(ss / Dm + EPSF);
    const float* mr = mod_row(p, l, (int)row);
    const float* g = p.norm1_g + l * Dm;
#pragma unroll
    for (int i = 0; i < 4; ++i) {
        const int k = 256 * i + 4 * lane;
        const f32x4 gv = *(const f32x4*)(g + k), sh = *(const f32x4*)(mr + k), sc = *(const f32x4*)(mr + Dm + k);
        const f32x4 y = x[i] * rstd * gv * (1.0f + sc) + sh;
        *(u32x2*)(p.XN + row * Dm + k) = (u32x2){pk2(y[0], y[1]), pk2(y[2], y[3])};
    }
}
DI void bp_norm1(const Params& p, int l, int gwave, int nwaves, int lane) {
    for (long row = gwave; row < NTOK; row += nwaves) {
        f32x4 x[4];
#pragma unroll
        for (int i = 0; i < 4; ++i) x[i] = *(const f32x4*)(p.X + row * Dm + 256 * i + 4 * lane);
        norm1_row(p, l, row, x, lane);
    }
}
DI void bp_combine(const Params& p, int l, bool upd, unsigned char* smem, int gwave, int nwaves, int lane) {
    const int* s_moff = moe_prep(p, l, smem);
    const long rows = upd ? NTOK : NL;
    for (long row = gwave; row < rows; row += nwaves) {
        const int e0 = p.EID[row * 2], e1 = p.EID[row * 2 + 1];
        const size_t p0 = (size_t)s_moff[e0] * 128 + p.POS[row * 2], p1 = (size_t)s_moff[e1] * 128 + p.POS[row * 2 + 1];
        const float g0 = p.GATE[row * 2], g1 = p.GATE[row * 2 + 1];
        const float* g2 = mod_row(p, l, (int)row) + 5 * Dm;
        f32x4 x[4];
#pragma unroll
        for (int i = 0; i < 4; ++i) {
            const int k = 256 * i + 4 * lane;
            const u32x2 ya = *(const u32x2*)(p.Y + p0 * Dm + k), yb = *(const u32x2*)(p.Y + p1 * Dm + k);
            const f32x4 y = {g0 * bflo(ya[0]) + g1 * bflo(yb[0]), g0 * bfhi(ya[0]) + g1 * bfhi(yb[0]), g0 * bflo(ya[1]) + g1 * bflo(yb[1]), g0 * bfhi(ya[1]) + g1 * bfhi(yb[1])};
            x[i] = *(const f32x4*)(p.X + row * Dm + k) + *(const f32x4*)(g2 + k) * y;
            if (l == DEPTH - 1) *(f32x4*)(p.out + row * Dm + k) = x[i]; else *(f32x4*)(p.X + row * Dm + k) = x[i];
        }
        if (l < DEPTH - 1) norm1_row(p, l + 1, row, x, lane);
    }
}

template <int DQK, int DV>
struct AttnCfg {
    static constexpr int KP = DQK * 2 + 16, VP = 144;
    static constexpr int KCH = DQK / 8;
    static constexpr int NK = 64 * KCH, NV = DV * 8, NCH = NK + NV, NLD = (NCH + NTHR - 1) / NTHR;
    static constexpr int LDS_K = 0, LDS_V = 64 * KP, LDS_END = LDS_V + DV * VP;
    static_assert(LDS_END <= GT_END, "attention tile exceeds the LDS budget");
};

template <int DQK, int DV>
DI void attn_block(unsigned char* smem, const act_t* Qb, const act_t* Kb, const act_t* Vt, const int nk, const int q0, f32x16 (&ot)[DV / 32], float& lsum) {
    typedef AttnCfg<DQK, DV> C;
    const int tid = opaque_tid(), lane = tid & 63, w = tid >> 6, h = lane >> 5, qr = lane & 31;
    const int pi = (qr & ~12) | ((qr & 4) << 1) | ((qr & 8) >> 1);
    bf16x8 qf[DQK / 16];
#pragma unroll
    for (int st = 0; st < DQK / 16; ++st) qf[st] = *(const bf16x8*)(Qb + (size_t)(q0 + w * 32 + qr) * DQK + st * 16 + h * 8);
    float m = -1e30f; lsum = 0.f;
#pragma unroll
    for (int db = 0; db < DV / 32; ++db)
#pragma unroll
        for (int r = 0; r < 16; ++r) ot[db][r] = 0.f;
    const act_t* gsrc[C::NLD]; int ldst[C::NLD];
#pragma unroll
    for (int i = 0; i < C::NLD; ++i) {
        const int c = tid + NTHR * i;
        if (c < C::NK) { const int row = c / C::KCH, part = c % C::KCH; gsrc[i] = Kb + (size_t)row * DQK + part * 8; ldst[i] = C::LDS_K + row * C::KP + part * 16; }
        else { const int cc = (c - C::NK) < C::NV ? c - C::NK : 0, row = cc >> 3, part = cc & 7; gsrc[i] = Vt + (size_t)row * Sn + part * 8; ldst[i] = C::LDS_V + row * C::VP + part * 16; }
    }
    u32x4 rg[C::NLD];
#pragma unroll
    for (int i = 0; i < C::NLD; ++i) rg[i] = *(const u32x4*)gsrc[i];
    const int ntiles = nk >> 6;
    for (int kt = 0; kt < ntiles; ++kt) {
        __syncthreads();
#pragma unroll
        for (int i = 0; i < C::NLD; ++i) if (tid + NTHR * i < C::NCH) *(u32x4*)(smem + ldst[i]) = rg[i];
        __syncthreads();
        if (kt + 1 < ntiles) {
#pragma unroll
            for (int i = 0; i < C::NLD; ++i) rg[i] = *(const u32x4*)(gsrc[i] + (size_t)(kt + 1) * ((tid + NTHR * i < C::NK) ? 64 * DQK : 64));
        }
        f32x16 sc[2];
#pragma unroll
        for (int kb = 0; kb < 2; ++kb) {
#pragma unroll
            for (int r = 0; r < 16; ++r) sc[kb][r] = 0.f;
#pragma unroll
            for (int st = 0; st < DQK / 16; ++st) {
                const bf16x8 a = *(const bf16x8*)(smem + C::LDS_K + (kb * 32 + pi) * C::KP + st * 32 + h * 16);
                sc[kb] = __builtin_amdgcn_mfma_f32_32x32x16_bf16(a, qf[st], sc[kb], 0, 0, 0);
            }
        }
        float mx = sc[0][0];
#pragma unroll
        for (int kb = 0; kb < 2; ++kb)
#pragma unroll
            for (int r = 0; r < 16; ++r) mx = fmaxf(mx, sc[kb][r]);
        mx = fmaxf(mx, shfl_x(mx, 32, lane));
        const float mn = fmaxf(m, mx), alpha = __builtin_amdgcn_exp2f(m - mn);
        m = mn;
        float ps = 0.f;
#pragma unroll
        for (int kb = 0; kb < 2; ++kb)
#pragma unroll
            for (int r = 0; r < 16; ++r) { sc[kb][r] = __builtin_amdgcn_exp2f(sc[kb][r] - mn); ps += sc[kb][r]; }
        lsum = lsum * alpha + ps;
#pragma unroll
        for (int db = 0; db < DV / 32; ++db)
#pragma unroll
            for (int r = 0; r < 16; ++r) ot[db][r] *= alpha;
#pragma unroll
        for (int kb = 0; kb < 2; ++kb)
#pragma unroll
            for (int s2 = 0; s2 < 2; ++s2) {
                const u32x4 pw = {pk2(sc[kb][8 * s2], sc[kb][8 * s2 + 1]), pk2(sc[kb][8 * s2 + 2], sc[kb][8 * s2 + 3]), pk2(sc[kb][8 * s2 + 4], sc[kb][8 * s2 + 5]), pk2(sc[kb][8 * s2 + 6], sc[kb][8 * s2 + 7])};
                const bf16x8 pf = __builtin_bit_cast(bf16x8, pw);
#pragma unroll
                for (int db = 0; db < DV / 32; ++db) {
                    const bf16x8 a = *(const bf16x8*)(smem + C::LDS_V + (db * 32 + qr) * C::VP + (kb * 32 + 16 * s2 + 8 * h) * 2);
                    ot[db] = __builtin_amdgcn_mfma_f32_32x32x16_bf16(a, pf, ot[db], 0, 0, 0);
                }
            }
    }
    lsum += shfl_x(lsum, 32, lane);
}

DI void bp_attn(const Params& p, int l, bool upd, unsigned char* smem, int bid, int G) {
    constexpr int QTL = Tn / 128, QTC = Cn / 128;
    const int n_dl = Bn * 4 * QTL, n_gl = Bn * 6 * QTL, n_dc = upd ? Bn * 4 * QTC : 0, n_gc = upd ? Bn * 6 * QTC : 0;
    const int tid = opaque_tid(), lane = tid & 63, w = tid >> 6, hh = lane >> 5, qr = lane & 31;
    const float lam_init = lam_init_of(l);
    for (int it = bid; it < n_dl + n_gl + n_dc + n_gc; it += G) {
        int x = it; bool isdiff, isc;
        if (x < n_dl) { isdiff = true; isc = false; }
        else if ((x -= n_dl) < n_gl) { isdiff = false; isc = false; }
        else if ((x -= n_gl) < n_dc) { isdiff = true; isc = true; }
        else { x -= n_dc; isdiff = false; isc = true; }
        const int qt_n = isc ? QTC : QTL, qlen = isc ? Cn : Tn, nk = isc ? Cn : Sn;
        const int qt = x % qt_n, hb = x / qt_n;
        const int q0 = qt * 128;
        if (isdiff) {
            const int h = hb % 4, b = hb / 4;
            const act_t* Vt = p.DVt + (size_t)(b * 4 + h) * 96 * Sn;
            f32x16 ot[3]; float ls;
            f32x4* stash = (f32x4*)(p.DO + ((size_t)blockIdx.x * NTHR + tid) * 48);
            attn_block<48, 96>(smem, (isc ? p.DQC : p.DQL) + ((size_t)(b * 4 + h) * 2) * qlen * 48, p.DK + ((size_t)(b * 4 + h) * 2) * Sn * 48, Vt, nk, q0, ot, ls);
            {
                const float i1 = 1.0f / ls;
#pragma unroll
                for (int db = 0; db < 3; ++db)
#pragma unroll
                    for (int g = 0; g < 4; ++g) stash[db * 4 + g] = (f32x4){ot[db][4 * g] * i1, ot[db][4 * g + 1] * i1, ot[db][4 * g + 2] * i1, ot[db][4 * g + 3] * i1};
            }
            attn_block<48, 96>(smem, (isc ? p.DQC : p.DQL) + ((size_t)(b * 4 + h) * 2 + 1) * qlen * 48, p.DK + ((size_t)(b * 4 + h) * 2 + 1) * Sn * 48, Vt, nk, q0, ot, ls);
            const float* dl = p.diff_lambda + l * 4 * 48;
            float s01 = 0.f, s23 = 0.f;
            for (int i = 0; i < 48; ++i) { s01 += dl[i] * dl[48 + i]; s23 += dl[96 + i] * dl[144 + i]; }
            const float lam = expf(s01) - expf(s23) + lam_init;
            const float i2 = lam / ls;
            float ss = 0.f;
#pragma unroll
            for (int db = 0; db < 3; ++db)
#pragma unroll
                for (int g = 0; g < 4; ++g) {
                    const f32x4 o1 = stash[db * 4 + g];
#pragma unroll
                    for (int r = 0; r < 4; ++r) { const float v = o1[r] - ot[db][4 * g + r] * i2; ot[db][4 * g + r] = v; ss += v * v; }
                }
            ss += shfl_x(ss, 32, lane);
            const float rstd = 1.0f / sqrtf(ss / 96 + EPSF) * (1.0f - lam_init);
            const float* sg = p.diff_subln + l * 96;
            const size_t tok = isc ? (size_t)NL + b * Cn + q0 + w * 32 + qr : (size_t)b * Tn + q0 + w * 32 + qr;
#pragma unroll
            for (int db = 0; db < 3; ++db)
#pragma unroll
                for (int g = 0; g < 4; ++g) {
                    const int dv = db * 32 + 8 * g + 4 * hh;
                    const f32x4 sv = *(const f32x4*)(sg + dv);
                    *(u32x2*)(p.MIX + tok * Dm + h * 96 + dv) = (u32x2){pk2(ot[db][4 * g] * rstd * sv[0], ot[db][4 * g + 1] * rstd * sv[1]),
                                                                      pk2(ot[db][4 * g + 2] * rstd * sv[2], ot[db][4 * g + 3] * rstd * sv[3])};
                }
        } else {
            const int hq = hb % 6, b = hb / 6, kv = hq / 3;
            f32x16 ot[2]; float ls;
            attn_block<64, 64>(smem, (isc ? p.GQC : p.GQL) + (size_t)(b * 6 + hq) * qlen * 64, p.GK + (size_t)(b * 2 + kv) * Sn * 64, p.GVt + (size_t)(b * 2 + kv) * 64 * Sn, nk, q0, ot, ls);
            const float il = 1.0f / ls;
            const size_t tok = isc ? (size_t)NL + b * Cn + q0 + w * 32 + qr : (size_t)b * Tn + q0 + w * 32 + qr;
#pragma unroll
            for (int db = 0; db < 2; ++db)
#pragma unroll
                for (int g = 0; g < 4; ++g) {
                    const int dv = db * 32 + 8 * g + 4 * hh;
                    *(u32x2*)(p.MIX + tok * Dm + 384 + hq * 64 + dv) = (u32x2){pk2(ot[db][4 * g] * il, ot[db][4 * g + 1] * il), pk2(ot[db][4 * g + 2] * il, ot[db][4 * g + 3] * il)};
                }
        }
    }
}

DI size_t chunk_slot(int b, int h, int dir, int cid) { return (size_t)((b * 4 + h) * 2 + dir) * NCH + cid; }
DI float wave_incl_scan_add(float v, int lane, bool rev) {
#pragma unroll
    for (int o = 1; o < 64; o <<= 1) { const float t = shfl_i(v, (rev ? lane + o : lane - o) & 63); const bool ok = rev ? (lane + o < 64) : (lane >= o); if (ok) v += t; }
    return v;
}
DI float wave_incl_scan_max(float v, int lane, bool rev) {
#pragma unroll
    for (int o = 1; o < 64; o <<= 1) { const float t = shfl_i(v, (rev ? lane + o : lane - o) & 63); const bool ok = rev ? (lane + o < 64) : (lane >= o); if (ok) v = fmaxf(v, t); }
    return v;
}
DI void bp_post(const Params& p, int l, unsigned char* smem, int bid, int G) {
    const int tid = opaque_tid(), lane = tid & 63, w = tid >> 6;
    for (int g = bid; g < NTOK / 64; g += G) {
        const int tok0 = g * 64; const bool isc = tok0 >= NL;
        const int b = tok_b(tok0), ti0 = tok_i(tok0), s0 = tok_s(tok0);
        {
            const int j = lane & 15, ug = lane >> 4;
            for (int tt = w; tt < 64; tt += 4) {
                const int tok = tok0 + tt, ti = ti0 + tt;
                const float* pr = p.PROJ + (size_t)tok * INW;
#pragma unroll
                for (int st = 0; st < 6; ++st) {
                    const int u = st * 4 + ug;
                    const bool d64 = st >= 4;
                    int soff; const float* gw; act_t* dst; float osc;
                    if (!d64) {
                        const bool isk = u >= 8; const int hh = (u & 7) >> 1, ww = u & 1;
                        soff = (isk ? DK_OFF : DQ_OFF) + hh * 96 + ww * 48; gw = (isk ? p.diff_k_norm : p.diff_q_norm) + l * 48; osc = isk ? 1.0f : 0.14433756729740643f * LOG2E;
                        dst = isk ? p.DK + (((size_t)(b * 4 + hh) * 2 + ww) * Sn + s0 + tt) * 48
                                  : (isc ? p.DQC + (((size_t)(b * 4 + hh) * 2 + ww) * Cn + ti) * 48 : p.DQL + (((size_t)(b * 4 + hh) * 2 + ww) * Tn + ti) * 48);
                    } else {
                        const bool isk = u >= 22; const int hh = isk ? u - 22 : u - 16;
                        soff = (isk ? GK_OFF : GQ_OFF) + hh * 64; gw = (isk ? p.gqa_k_norm : p.gqa_q_norm) + l * 64; osc = isk ? 1.0f : 0.125f * LOG2E;
                        dst = isk ? p.GK + ((size_t)(b * 2 + hh) * Sn + s0 + tt) * 64 : (isc ? p.GQC + ((size_t)(b * 6 + hh) * Cn + ti) * 64 : p.GQL + ((size_t)(b * 6 + hh) * Tn + ti) * 64);
                    }
                    const bool act = d64 || j < 12;
                    const f32x4 x = act ? *(const f32x4*)(pr + soff + 4 * j) : (f32x4){0.f, 0.f, 0.f, 0.f};
                    float ss = x[0] * x[0] + x[1] * x[1] + x[2] * x[2] + x[3] * x[3];
                    ss += shfl_x(ss, 1, lane); ss += shfl_x(ss, 2, lane); ss += shfl_x(ss, 4, lane); ss += shfl_x(ss, 8, lane);
                    const float rstd = 1.0f / sqrtf(ss / (d64 ? 64.f : 48.f) + EPSF);
                    const f32x4 gv = act ? *(const f32x4*)(gw + 4 * j) : (f32x4){0.f, 0.f, 0.f, 0.f};
                    f32x4 y = x * rstd * gv;
                    if (!isc) {
                        const int third = j / 3;
                        const int plane = d64 ? (lane ^ 4) : ((third & 1) ? lane - 3 : lane + 3);
                        f32x4 py;
#pragma unroll
                        for (int r = 0; r < 4; ++r) py[r] = shfl_i(y[r], plane);
                        const bool second = d64 ? (j >= 8) : (j >= 6);
                        const bool isx2 = d64 ? ((j & 4) != 0) : ((third & 1) != 0);
                        const int pos = second ? (ti & 63) : (ti >> 6);
                        const int fi0 = d64 ? 12 + (j & 3) * 4 : (j - third * 3) * 4;
                        const float* rt = p.ROPE + ((size_t)pos * 28 + (act ? fi0 : 0)) * 2;
                        const f32x4 t0 = *(const f32x4*)rt, t1 = *(const f32x4*)(rt + 4);
                        const f32x4 cs = {t0[0], t0[2], t1[0], t1[2]}, sn = {t0[1], t0[3], t1[1], t1[3]};
                        y = isx2 ? y * cs + py * sn : y * cs - py * sn;
                    }
                    y = y * osc;
                    if (act) *(u32x2*)(dst + 4 * j) = (u32x2){pk2(y[0], y[1]), pk2(y[2], y[3])};
                }
            }
        }
#pragma unroll 1
        for (int qd = 0; qd < 4; ++qd) {
            __syncthreads();
#pragma unroll
            for (int i = 0; i < 8; ++i) {
                const int c = tid + NTHR * i, tt = c >> 5, d4 = c & 31, vd = qd * 128 + d4 * 4;
                const f32x4 v = *(const f32x4*)(p.PROJ + (size_t)(tok0 + tt) * INW + (vd < 384 ? DV_OFF + vd : GV_OFF + vd - 384));
                *(u32x2*)(smem + tt * 264 + d4 * 8) = (u32x2){pk2(v[0], v[1]), pk2(v[2], v[3])};
            }
            __syncthreads();
#pragma unroll
            for (int i = 0; i < 4; ++i) {
                const int o = tid + NTHR * i, dloc = o >> 3, t8 = o & 7, vd = qd * 128 + dloc;
                unsigned e[8];
#pragma unroll
                for (int r = 0; r < 8; ++r) e[r] = *(const unsigned short*)(smem + (t8 * 8 + r) * 264 + dloc * 2);
                act_t* dst = vd < 384 ? p.DVt + ((size_t)(b * 4 + vd / 96) * 96 + vd % 96) * Sn : p.GVt + ((size_t)(b * 2 + (vd - 384) / 64) * 64 + (vd - 384) % 64) * Sn;
                *(u32x4*)(dst + s0 + t8 * 8) = (u32x4){e[0] | (e[1] << 16), e[2] | (e[3] << 16), e[4] | (e[5] << 16), e[6] | (e[7] << 16)};
            }
        }
        float* kf = (float*)smem; float* vf = kf + 64 * 68; float* gl = vf + 64 * 68;
        const int cid = isc ? ti0 / 64 : NCC + ti0 / 64;
#pragma unroll 1
        for (int h = 0; h < 4; ++h) {
            __syncthreads();
            {
                const int tt = tid >> 2, c16 = tid & 3, ti = ti0 + tt, seglen = isc ? Cn : Tn;
                const float* pr = p.PROJ + (size_t)(tok0 + tt) * INW;
                const bool hasp = ti > 0, hasn = ti < seglen - 1;
                const float* cw = p.mlstm_conv_w + (size_t)l * 1536; const float* cb = p.mlstm_conv_b + l * 512;
#pragma unroll
                for (int part = 0; part < 2; ++part)
#pragma unroll
                    for (int i4 = 0; i4 < 4; ++i4) {
                        const int ch = part * 256 + h * 64 + c16 * 16 + i4 * 4;
                        f32x4 a = *(const f32x4*)(cb + ch) + *(const f32x4*)(pr + MQK_OFF + ch) * *(const f32x4*)(cw + 512 + ch);
                        if (hasp) a = a + *(const f32x4*)(pr - INW + MQK_OFF + ch) * *(const f32x4*)(cw + ch);
                        if (hasn) a = a + *(const f32x4*)(pr + INW + MQK_OFF + ch) * *(const f32x4*)(cw + 1024 + ch);
#pragma unroll
                        for (int r = 0; r < 4; ++r) a[r] = a[r] / (1.0f + __expf(-a[r]));
                        if (part) { a = a * 0.125f; *(f32x4*)(kf + tt * 68 + c16 * 16 + i4 * 4) = a; }
                        *(u32x2*)(p.MQKB + (size_t)(tok0 + tt) * 512 + ch) = (u32x2){pk2(a[0], a[1]), pk2(a[2], a[3])};
#if !IMPL_MLSTM
                        *(f32x4*)(p.MQK + (size_t)(tok0 + tt) * 512 + ch) = a;
#endif
                    }
#pragma unroll
                for (int i4 = 0; i4 < 4; ++i4) *(f32x4*)(vf + tt * 68 + c16 * 16 + i4 * 4) = *(const f32x4*)(pr + MV_OFF + h * 64 + c16 * 16 + i4 * 4);
            }
            if (tid < 64) {
                const float* pr = p.PROJ + (size_t)(tok0 + tid) * INW + MG_OFF; const float* gb = p.mlstm_gate_b + l * 16;
                const f32x4 gt = {pr[h] + gb[h], logsigmoid_f(pr[4 + h] + gb[4 + h]), pr[8 + h] + gb[8 + h], logsigmoid_f(pr[12 + h] + gb[12 + h])};
                gl[tid] = gt[0]; gl[128 + tid] = gt[1]; gl[64 + tid] = gt[2]; gl[192 + tid] = gt[3];
                *(f32x4*)(p.MG4 + ((size_t)(tok0 + tid) * 4 + h) * 4) = gt;
#if !IMPL_MLSTM
                { float* mg = p.MGATE + (size_t)(tok0 + tid) * 16; mg[h] = gt[0]; mg[4 + h] = gt[1]; mg[8 + h] = gt[2]; mg[12 + h] = gt[3]; }
#endif
            }
            __syncthreads();
            if (w < 2) {
                const int dir = w;
                const float lf = gl[128 + dir * 64 + lane], li = gl[dir * 64 + lane];
                const float inc = wave_incl_scan_add(lf, lane, dir == 0);
                const float gg = inc - lf + li;
                float mloc = gg;
#pragma unroll
                for (int o = 32; o > 0; o >>= 1) mloc = fmaxf(mloc, shfl_x(mloc, o, lane));
                gl[256 + dir * 64 + lane] = __expf(gg - mloc);
                const float E = wave_sum(lf, lane);
                if (lane == 0) { float* cs = p.CHS + chunk_slot(b, h, dir, cid) * 2; cs[0] = mloc; cs[1] = E; }
            }
            __syncthreads();
            {
                const int v0 = (tid >> 4) * 4, d0 = (tid & 15) * 4;
                f32x4 a0[4], a1[4];
#pragma unroll
                for (int i = 0; i < 4; ++i) { a0[i] = (f32x4){0.f, 0.f, 0.f, 0.f}; a1[i] = (f32x4){0.f, 0.f, 0.f, 0.f}; }
                for (int sx = 0; sx < 64; ++sx) {
                    const f32x4 vv = *(const f32x4*)(vf + sx * 68 + v0), kk = *(const f32x4*)(kf + sx * 68 + d0);
                    const float w0 = gl[256 + sx], w1 = gl[320 + sx];
#pragma unroll
                    for (int i = 0; i < 4; ++i) { a0[i] = a0[i] + (w0 * vv[i]) * kk; a1[i] = a1[i] + (w1 * vv[i]) * kk; }
                }
                float* kv0 = p.KV + chunk_slot(b, h, 0, cid) * 4096; float* kv1 = p.KV + chunk_slot(b, h, 1, cid) * 4096;
#pragma unroll
                for (int i = 0; i < 4; ++i) { *(f32x4*)(kv0 + (v0 + i) * 64 + d0) = a0[i]; *(f32x4*)(kv1 + (v0 + i) * 64 + d0) = a1[i]; }
                if (tid < 128) {
                    const int dir = tid >> 6, d = tid & 63;
                    float acc = 0.f;
                    for (int sx = 0; sx < 64; ++sx) acc += gl[256 + dir * 64 + sx] * kf[sx * 68 + d];
                    p.NLC[chunk_slot(b, h, dir, cid) * 64 + d] = acc;
                }
            }
        }
    }
}

constexpr int ML_Q = 0, ML_K = 9216, ML_VT = 18432, ML_C = 29952, ML_QA = 41472, ML_SC = 50688;
constexpr int SC_LI = 0, SC_LF = 128, SC_BB = 256, SC_MT = 384, SC_AA = 512, SC_UU = 640, SC_WCH = 768;
static_assert(ML_SC + (SC_WCH + 80) * 4 <= SMEM_BYTES, "mLSTM LDS layout exceeds the budget");
DI int ml_scanpos(int dir, int cid) { return dir == 0 ? cid : (cid < NCC ? NCC - 1 - cid : NCC + (NCH - 1 - cid)); }
DI int ml_cid_at(int dir, int i) { return dir == 0 ? i : (i < NCC ? NCC - 1 - i : NCH - 1 - (i - NCC)); }
DI void bp_mlstm(const Params& p, int l, bool upd, unsigned char* smem, int bid, int G) {
    const int tid = opaque_tid(), lane = tid & 63, w = tid >> 6;
    float* sc = (float*)(smem + ML_SC);
    constexpr int CPL = Tn / 64;
    const int nlat = Bn * 4 * CPL, nctx = upd ? Bn * 4 * NCC : 0;
    for (int it = bid; it < nlat + nctx; it += G) {
        int b, h, cid;
        if (it < nlat) { cid = NCC + it % CPL; h = (it / CPL) % 4; b = it / (CPL * 4); }
        else { const int x = it - nlat; cid = x % NCC; h = (x / NCC) % 4; b = x / (NCC * 4); }
        const int tok0 = cid < NCC ? NL + b * Cn + cid * 64 : b * Tn + (cid - NCC) * 64;
        __syncthreads();
#pragma unroll
        for (int i = 0; i < 4; ++i) {
            const int c = tid + NTHR * i, isk = c >> 9, cc = c & 511, row = cc >> 3, part = cc & 7;
            *(u32x4*)(smem + (isk ? ML_K : ML_Q) + row * 144 + part * 16) = *(const u32x4*)(p.MQKB + (size_t)(tok0 + row) * 512 + isk * 256 + h * 64 + part * 8);
        }
#pragma unroll
        for (int i = 0; i < 2; ++i) {
            const int c = tid + NTHR * i, tt = c >> 3, v8 = c & 7;
            const float* src = p.PROJ + (size_t)(tok0 + tt) * INW + MV_OFF + h * 64 + v8 * 8;
            const f32x4 va = *(const f32x4*)src, vb = *(const f32x4*)(src + 4);
            const unsigned pa = pk2(va[0], va[1]), pb = pk2(va[2], va[3]), pc = pk2(vb[0], vb[1]), pd = pk2(vb[2], vb[3]);
            unsigned char* d0 = smem + ML_VT + (v8 * 8) * 144 + tt * 2;
            *(unsigned short*)(d0) = (unsigned short)pa; *(unsigned short*)(d0 + 144) = (unsigned short)(pa >> 16);
            *(unsigned short*)(d0 + 288) = (unsigned short)pb; *(unsigned short*)(d0 + 432) = (unsigned short)(pb >> 16);
            *(unsigned short*)(d0 + 576) = (unsigned short)pc; *(unsigned short*)(d0 + 720) = (unsigned short)(pc >> 16);
            *(unsigned short*)(d0 + 864) = (unsigned short)pd; *(unsigned short*)(d0 + 1008) = (unsigned short)(pd >> 16);
        }
        if (tid < 144) {
            const unsigned one2 = 0x3F803F80u;
            *(u32x4*)(smem + ML_VT + 64 * 144 + tid * 16) = tid < 9 ? (u32x4){one2, one2, one2, one2} : (u32x4){0u, 0u, 0u, 0u};
            *(u32x4*)(smem + ML_C + 64 * 144 + tid * 16) = (u32x4){0u, 0u, 0u, 0u};
        }
        if (tid < 64) {
            const f32x4 gt = *(const f32x4*)(p.MG4 + ((size_t)(tok0 + tid) * 4 + h) * 4);
            sc[SC_LI + tid] = gt[0]; sc[SC_LF + tid] = gt[1]; sc[SC_LI + 64 + tid] = gt[2]; sc[SC_LF + 64 + tid] = gt[3];
        }
        __syncthreads();
        if (w < 2) {
            const int dir = w, pj = ml_scanpos(dir, cid);
            const float lf = sc[SC_LF + dir * 64 + lane], li = sc[SC_LI + dir * 64 + lane];
            const float bsum = wave_incl_scan_add(lf, lane, dir == 1);
            const float u = li - bsum;
            const float cm = wave_incl_scan_max(u, lane, dir == 1);
            float m = 0.f;
            for (int i = 0; i < pj; ++i) { const float* cs = p.CHS + chunk_slot(b, h, dir, ml_cid_at(dir, i)) * 2; m = fmaxf(cs[1] + m, cs[0]); }
            float F = 0.f;
            for (int i = pj - 1; i >= 0; --i) { const float* cs = p.CHS + chunk_slot(b, h, dir, ml_cid_at(dir, i)) * 2; if (lane == 0) sc[SC_WCH + dir * 40 + i] = __expf(cs[0] + F - m); F += cs[1]; }
            const float mt = bsum + fmaxf(m, cm);
            sc[SC_BB + dir * 64 + lane] = bsum; sc[SC_UU + dir * 64 + lane] = u; sc[SC_MT + dir * 64 + lane] = mt; sc[SC_AA + dir * 64 + lane] = __expf(bsum + m - mt);
        }
        f32x4 sacc[4];
#pragma unroll
        for (int si = 0; si < 4; ++si) sacc[si] = (f32x4){0.f, 0.f, 0.f, 0.f};
#pragma unroll
        for (int ks = 0; ks < 2; ++ks) {
            const bf16x8 bq = *(const bf16x8*)(smem + ML_Q + (16 * w + (lane & 15)) * 144 + ks * 64 + (lane >> 4) * 16);
#pragma unroll
            for (int si = 0; si < 4; ++si) {
                const bf16x8 ak = *(const bf16x8*)(smem + ML_K + (si * 16 + (lane & 15)) * 144 + ks * 64 + (lane >> 4) * 16);
                sacc[si] = __builtin_amdgcn_mfma_f32_16x16x32_bf16(ak, bq, sacc[si], 0, 0, 0);
            }
        }
        __syncthreads();
        f32x4 hs[4];
#pragma unroll
        for (int vt = 0; vt < 4; ++vt) hs[vt] = (f32x4){0.f, 0.f, 0.f, 0.f};
        const int pcol = 16 * w + (lane & 15);
#pragma unroll 1
        for (int dir = 0; dir < 2; ++dir) {
            {
                const int pj = ml_scanpos(dir, cid);
                f32x4 ca[4]; float na = 0.f;
#pragma unroll
                for (int q4 = 0; q4 < 4; ++q4) ca[q4] = (f32x4){0.f, 0.f, 0.f, 0.f};
                for (int i = 0; i < pj; ++i) {
                    const float wg = sc[SC_WCH + dir * 40 + i];
                    const size_t slot = chunk_slot(b, h, dir, ml_cid_at(dir, i));
                    const float* kv = p.KV + slot * 4096;
#pragma unroll
                    for (int q4 = 0; q4 < 4; ++q4) ca[q4] = ca[q4] + wg * *(const f32x4*)(kv + (tid + NTHR * q4) * 4);
                    if (tid < 64) na += wg * p.NLC[slot * 64 + tid];
                }
#pragma unroll
                for (int q4 = 0; q4 < 4; ++q4) { const int idx = (tid + NTHR * q4) * 4; *(u32x2*)(smem + ML_C + (idx >> 6) * 144 + (idx & 63) * 2) = (u32x2){pk2(ca[q4][0], ca[q4][1]), pk2(ca[q4][2], ca[q4][3])}; }
                if (tid < 64) *(unsigned short*)(smem + ML_C + 64 * 144 + tid * 2) = (unsigned short)pk2(na, 0.f);
            }
            {
                const float mtp = sc[SC_MT + dir * 64 + pcol], bp = sc[SC_BB + dir * 64 + pcol];
#pragma unroll
                for (int si = 0; si < 4; ++si) {
                    const int sb = si * 16 + (lane >> 4) * 4;
                    const f32x4 uu = *(const f32x4*)(sc + SC_UU + dir * 64 + sb);
                    float wv[4];
#pragma unroll
                    for (int r = 0; r < 4; ++r) { const int sx = sb + r; const bool valid = dir == 0 ? (sx <= pcol) : (sx >= pcol); wv[r] = valid ? __expf(bp + uu[r] - mtp) * sacc[si][r] : 0.f; }
                    *(u32x2*)(smem + ML_K + pcol * 144 + sb * 2) = (u32x2){pk2(wv[0], wv[1]), pk2(wv[2], wv[3])};
                }
                const int row = tid >> 2, c16 = tid & 3;
                const float ar = sc[SC_AA + dir * 64 + row];
#pragma unroll
                for (int i2 = 0; i2 < 2; ++i2) {
                    const u32x4 qv = *(const u32x4*)(smem + ML_Q + row * 144 + c16 * 32 + i2 * 16);
                    u32x4 o;
#pragma unroll
                    for (int r = 0; r < 4; ++r) o[r] = pk2(bflo(qv[r]) * ar, bfhi(qv[r]) * ar);
                    *(u32x4*)(smem + ML_QA + row * 144 + c16 * 32 + i2 * 16) = o;
                }
            }
            __syncthreads();
            f32x4 na5[5];
#pragma unroll
            for (int vt = 0; vt < 5; ++vt) na5[vt] = (f32x4){0.f, 0.f, 0.f, 0.f};
#pragma unroll
            for (int ks = 0; ks < 4; ++ks) {
                const bf16x8 bfrag = *(const bf16x8*)(smem + (ks < 2 ? ML_K : ML_QA) + pcol * 144 + (ks & 1) * 64 + (lane >> 4) * 16);
#pragma unroll
                for (int vt = 0; vt < 5; ++vt) {
                    const bf16x8 afrag = *(const bf16x8*)(smem + (ks < 2 ? ML_VT : ML_C) + (vt * 16 + (lane & 15)) * 144 + (ks & 1) * 64 + (lane >> 4) * 16);
                    na5[vt] = __builtin_amdgcn_mfma_f32_16x16x32_bf16(afrag, bfrag, na5[vt], 0, 0, 0);
                }
            }
            const float den = shfl_i(na5[4][0], lane & 15);
            const float dn = 1.0f / fmaxf(fabsf(den), __expf(-sc[SC_MT + dir * 64 + pcol]));
#pragma unroll
            for (int vt = 0; vt < 4; ++vt) hs[vt] = hs[vt] + na5[vt] * dn;
            __syncthreads();
        }
        float ss = 0.f;
#pragma unroll
        for (int vt = 0; vt < 4; ++vt) ss += hs[vt][0] * hs[vt][0] + hs[vt][1] * hs[vt][1] + hs[vt][2] * hs[vt][2] + hs[vt][3] * hs[vt][3];
        ss += shfl_x(ss, 16, lane); ss += shfl_x(ss, 32, lane);
        const float rstd = 1.0f / sqrtf(ss / 64 + EPSF);
        const size_t tok = (size_t)tok0 + pcol;
#pragma unroll
        for (int vt = 0; vt < 4; ++vt) {
            const int v = vt * 16 + (lane >> 4) * 4;
            const f32x4 hn = *(const f32x4*)(p.mlstm_head_norm + l * 256 + h * 64 + v), og = *(const f32x4*)(p.PROJ + tok * INW + MO_OFF + h * 64 + v);
            float o[4];
#pragma unroll
            for (int r = 0; r < 4; ++r) o[r] = hs[vt][r] * rstd * hn[r] / (1.0f + __expf(-og[r]));
            *(u32x2*)(p.MIX + tok * Dm + 768 + h * 64 + v) = (u32x2){pk2(o[0], o[1]), pk2(o[2], o[3])};
        }
    }
}

DI void bp_route_fast(const Params& p, int l, bool upd, unsigned char* smem, int bid, int G) {
    const int tid = opaque_tid(), lane = tid & 63, w = tid >> 6;
    const int rows = upd ? NTOK : NL;
    float* Wl = (float*)smem;
    const float* g = p.norm2_g + l * Dm;
    const float* wgp = p.moe_wg + (size_t)l * Dm * 4; const float* wep = p.moe_we + (size_t)l * Dm * 32;
    for (int item = bid; item < rows / 4; item += G) {
        const int r0 = item * 4 + w;
        float rstd[1], pacc[1][36];
#pragma unroll
        for (int rr = 0; rr < 1; ++rr) {
            const float* xr = p.X + (size_t)(r0 + rr) * Dm;
            float ss = 0.f;
#pragma unroll
            for (int j = 0; j < 16; ++j) { const float xv = xr[64 * j + lane]; ss += xv * xv; }
            ss = wave_sum(ss, lane);
            rstd[rr] = 1.0f / sqrtf(ss / Dm + EPSF);
#pragma unroll
            for (int c = 0; c < 36; ++c) pacc[rr][c] = 0.f;
        }
#pragma unroll 1
        for (int ch = 0; ch < 4; ++ch) {
            __syncthreads();
            {
                const int k = ch * 256 + tid;
                *(f32x4*)(Wl + tid * 36) = *(const f32x4*)(wgp + (size_t)k * 4);
#pragma unroll
                for (int q = 0; q < 8; ++q) *(f32x4*)(Wl + tid * 36 + 4 + q * 4) = *(const f32x4*)(wep + (size_t)k * 32 + q * 4);
            }
            __syncthreads();
#pragma unroll
            for (int j = 0; j < 4; ++j) {
                const int k = ch * 256 + 64 * j + lane;
                float f[1];
#pragma unroll
                for (int rr = 0; rr < 1; ++rr) {
                    const float* mr = mod_row(p, l, r0 + rr);
                    f[rr] = p.X[(size_t)(r0 + rr) * Dm + k] * rstd[rr] * g[k] * (1.0f + mr[4 * Dm + k]) + mr[3 * Dm + k];
                    p.F[(size_t)(r0 + rr) * Dm + k] = f2a(f[rr]);
                }
                const float* wr = Wl + (64 * j + lane) * 36;
#pragma unroll
                for (int q = 0; q < 9; ++q) {
                    const f32x4 wq = *(const f32x4*)(wr + q * 4);
#pragma unroll
                    for (int rr = 0; rr < 1; ++rr)
#pragma unroll
                        for (int r = 0; r < 4; ++r) pacc[rr][q * 4 + r] += f[rr] * wq[r];
                }
            }
        }
        __syncthreads();
        float* red = (float*)smem + w * (64 * 37);
#pragma unroll 1
        for (int rr = 0; rr < 1; ++rr) {
#pragma unroll
            for (int c = 0; c < 36; ++c) red[lane * 37 + c] = pacc[0][c];
            __syncthreads();
            float tot = 0.f;
            if (lane < 36) for (int q = 0; q < 64; ++q) tot += red[q * 37 + lane];
            __syncthreads();
            if (lane < 36) red[lane] = tot + (lane < 4 ? p.moe_bg[l * 4 + lane] : p.moe_be[l * 32 + lane - 4]);
            __syncthreads();
            float gmax = red[0]; int gi = 0;
#pragma unroll
            for (int j = 1; j < 4; ++j) { const float v = red[j]; if (v > gmax) { gmax = v; gi = j; } }
            float gsum = 0.f;
#pragma unroll
            for (int j = 0; j < 4; ++j) gsum += expf(red[j] - gmax);
            const float gtop = 1.0f / gsum;
            float e1 = -1e30f, e2 = -1e30f; int i1 = 0, i2 = 0;
#pragma unroll
            for (int j = 0; j < 8; ++j) { const float v = red[4 + gi * 8 + j]; if (v > e1) { e2 = e1; i2 = i1; e1 = v; i1 = j; } else if (v > e2) { e2 = v; i2 = j; } }
            const float g0 = 1.0f / (1.0f + expf(e2 - e1));
            if (lane == 0) {
                const int row = r0 + rr, ea = gi * 8 + i1, eb = gi * 8 + i2;
                p.EID[row * 2] = ea; p.EID[row * 2 + 1] = eb;
                p.GATE[row * 2] = g0 * gtop; p.GATE[row * 2 + 1] = (1.0f - g0) * gtop;
                const int pa = atomicAdd(&p.CNT[l * 32 + ea], 1), pb = atomicAdd(&p.CNT[l * 32 + eb], 1);
                p.LIST[(size_t)ea * NTOK + pa] = row; p.LIST[(size_t)eb * NTOK + pb] = row;
                p.POS[row * 2] = pa; p.POS[row * 2 + 1] = pb;
            }
            __syncthreads();
        }
    }
}

constexpr int PPL = 9;
constexpr int NPH = 2 + PPL * DEPTH;
static inline bool phase_in_mega(int ph) {
    if (ph < 2) return true;
    const int s = (ph - 2) % PPL;
    return s == 1 ? IMPL_POST : s == 2 ? IMPL_ATTN : s == 3 ? IMPL_MLSTM : s == 5 ? IMPL_ROUTE : true;
}

__global__ void __launch_bounds__(NTHR) k_naive(Params p, int ph) {
    const long gtid = (long)blockIdx.x * NTHR + threadIdx.x, gsize = (long)gridDim.x * NTHR;
    const int l = (ph - 2) / PPL, s = (ph - 2) % PPL;
    const bool upd = l < DEPTH - 1;
    (void)gtid; (void)gsize; (void)l; (void)s; (void)upd;
#if !IMPL_POST
    if (s == 1) ph_post(p, l, gtid, gsize);
#endif
#if !IMPL_ATTN
    if (s == 2) { ph_attn_diff(p, l, upd, gtid, gsize); ph_attn_gqa(p, l, upd, gtid, gsize); }
#endif
#if !IMPL_MLSTM
    if (s == 3) ph_mlstm(p, l, upd, gtid, gsize);
#endif
#if !IMPL_ROUTE
    if (s == 5) bp_route(p, l, upd, gtid, gsize);
#endif
}

__global__ void __launch_bounds__(NTHR, 2) k_mega(Params p, int ph_begin, int ph_end) {
    extern __shared__ __attribute__((aligned(16))) unsigned char smem[];
    cg::grid_group grid = cg::this_grid();
    const int G = gridDim.x, vb = xcd_remap(blockIdx.x, G);
    for (int ph = ph_begin; ph < ph_end; ++ph) {
        const int tid = opaque_tid(), lane = tid & 63;
        const long gtid = (long)blockIdx.x * NTHR + tid, gsize = (long)G * NTHR;
        const int gwave = (int)(gtid >> 6), nwaves = (int)(gsize >> 6);
        if (ph == 0) {
            ph_mod(p, gtid, gsize);
            if (gtid < DEPTH * 32) p.CNT[gtid] = 0;
            if (gtid < 64 * 28) {
                const int pos = (int)gtid / 28, fi = (int)gtid % 28, nf = fi < 12 ? 12 : 16, i = fi < 12 ? fi : fi - 12;
                const float ang = (float)pos * expf(-(float)i / (float)nf * 9.210340371976184f);
                p.ROPE[gtid * 2] = cosf(ang); p.ROPE[gtid * 2 + 1] = sinf(ang);
            }
        } else if (ph == 1) {
            bp_norm1(p, 0, gwave, nwaves, lane);
        } else {
            const int l = (ph - 2) / PPL, s = (ph - 2) % PPL;
            const bool upd = l < DEPTH - 1;
            switch (s) {
                case 0: bp_gemm_in(p, l, smem, vb, G); break;
#if IMPL_POST
                case 1: bp_post(p, l, smem, blockIdx.x, G); break;
#endif
#if IMPL_ATTN
                case 2: bp_attn(p, l, upd, smem, blockIdx.x, G); break;
#endif
#if IMPL_MLSTM
                case 3: bp_mlstm(p, l, upd, smem, blockIdx.x, G); break;
#endif
#if IMPL_ROUTE
                case 5: bp_route_fast(p, l, upd, smem, blockIdx.x, G); break;
#endif
                case 4: bp_gemm_out(p, l, upd, smem, vb, G); break;
                case 6: bp_moe1(p, l, smem, vb, G); break;
                case 7: bp_moe2(p, l, smem, vb, G); break;
                case 8: bp_combine(p, l, upd, smem, gwave, nwaves, lane); break;
                default: break;
            }
        }
        if (ph + 1 < ph_end) grid.sync();
    }
}

extern "C" void kernel_launch(void* const* d_in, const int* in_sizes, int n_in, void* d_out, int out_size, void* d_ws, size_t ws_size, hipStream_t stream) {
    Params p;
    memset((void*)&p, 0, sizeof(p));
    fill_inputs(p, d_in, d_out);
    carve(p, d_ws);
    static int grid_blocks = 0;
    if (!grid_blocks) {
        int dev = 0, cus = 0, per_cu = 0;
        (void)hipGetDevice(&dev);
        (void)hipDeviceGetAttribute(&cus, hipDeviceAttributeMultiprocessorCount, dev);
        (void)hipFuncSetAttribute((const void*)k_mega, hipFuncAttributeMaxDynamicSharedMemorySize, SMEM_BYTES);
        (void)hipOccupancyMaxActiveBlocksPerMultiprocessor(&per_cu, k_mega, NTHR, SMEM_BYTES);
        if (per_cu > 2) per_cu = 2;
        if (per_cu < 1) per_cu = 1;
        grid_blocks = cus * per_cu;
    }
    int ph = 0;
    while (ph < NPH) {
        if (phase_in_mega(ph)) {
            int b = ph, e = ph;
            while (e < NPH && phase_in_mega(e)) ++e;
            void* args[] = {&p, &b, &e};
            (void)hipLaunchCooperativeKernel((void*)k_mega, dim3(grid_blocks), dim3(NTHR), args, SMEM_BYTES, stream);
            ph = e;
        } else {
            k_naive<<<2048, NTHR, 0, stream>>>(p, ph);
            ++ph;
        }
    }
}
#endif
```

```cpp
#ifndef HOST_TEST
#include <hip/hip_runtime.h>
#include <hip/hip_cooperative_groups.h>
#include <string.h>
namespace cg = cooperative_groups;
#define HD __host__ __device__ __forceinline__
#else
#include <math.h>
#include <string.h>
#define HD inline
#endif
#include <stdint.h>
#include <stddef.h>

#ifndef CFG_B
#define CFG_B 8
#define CFG_T 2048
#define CFG_C 256
#define CFG_DEPTH 4
#endif
#ifndef MK_LAUNCHES
#define MK_LAUNCHES 1
#endif

constexpr int Bn = CFG_B, Tn = CFG_T, Cn = CFG_C, DEPTH = CFG_DEPTH;
constexpr int Dm = 1024, INW = 2832, MODW = 6144;
constexpr int NL = Bn * Tn, NC = Bn * Cn, NTOK = NL + NC, Sn = Cn + Tn;
constexpr int DQ_OFF = 0, DK_OFF = 384, DV_OFF = 768, GQ_OFF = 1152, GK_OFF = 1536, GV_OFF = 1664, MQK_OFF = 1792, MV_OFF = 2304, MO_OFF = 2560, MG_OFF = 2816;
constexpr int NCH = Sn / 64, NCC = Cn / 64;
constexpr int PMAX = 2 * NTOK + 32 * 128;
constexpr float EPSF = 1e-6f;
constexpr float LOG2E = 1.4426950408889634f;

#ifdef ACT_F32
typedef float act_t;
HD act_t f2a(float f) { return f; }
HD float a2f(act_t a) { return a; }
#else
typedef unsigned short act_t;
HD act_t f2a(float f) { unsigned u; memcpy(&u, &f, 4); u += 0x7fffu + ((u >> 16) & 1u); return (act_t)(u >> 16); }
HD float a2f(act_t a) { unsigned u = ((unsigned)a) << 16; float f; memcpy(&f, &u, 4); return f; }
#endif

HD float silu_f(float x) { return x / (1.0f + expf(-x)); }
HD float sigmoid_f(float x) { return 1.0f / (1.0f + expf(-x)); }
HD float logsigmoid_f(float x) { return fminf(x, 0.0f) - log1pf(expf(-fabsf(x))); }
HD float lam_init_of(int l) { return 0.8f - 0.6f * expf(-0.3f * (float)l); }

struct Params {
    const float *x, *c, *ctx, *c_ctx, *norm1_g, *norm2_g, *w_mod, *b_mod, *w_in, *w_out, *diff_q_norm, *diff_k_norm, *diff_lambda, *diff_subln,
        *gqa_q_norm, *gqa_k_norm, *mlstm_conv_w, *mlstm_conv_b, *mlstm_gate_b, *mlstm_head_norm, *moe_wg, *moe_bg, *moe_we, *moe_be, *moe_w1, *moe_w3, *moe_w2;
    float* out;
    float *mod, *X, *PROJ, *MQK, *MGATE, *DO, *GATE, *HN;
    act_t *XN, *DQL, *DQC, *DK, *DVt, *GQL, *GQC, *GK, *GVt, *MIX, *F;
    int* EID;
    int *CNT, *LIST, *POS;
    act_t *H, *Y;
    float *ROPE, *KV, *NLC, *CHS, *MG4;
    act_t* MQKB;
    unsigned* BAR;
    act_t *WIN_T, *WOUT_T;
    unsigned long long* TS;
    act_t *FLO, *WRHI, *WRLO, *ZROW;
    act_t *W13T, *W2T;
    act_t* PROJB; float* PG;
};

HD bool tok_ctx(int tok) { return tok >= NL; }
HD int tok_b(int tok) { return tok < NL ? tok / Tn : (tok - NL) / Cn; }
HD int tok_i(int tok) { return tok < NL ? tok % Tn : (tok - NL) % Cn; }
HD int tok_s(int tok) { return tok < NL ? Cn + tok % Tn : (tok - NL) % Cn; }
HD int tok_modrow(int tok) { return tok < NL ? tok / Tn : Bn; }
HD int tok_of(int b, int s) { return s < Cn ? NL + b * Cn + s : b * Tn + (s - Cn); }
HD const float* mod_row(const Params& p, int l, int tok) { return p.mod + ((size_t)l * (Bn + 1) + tok_modrow(tok)) * MODW; }

HD void ph_mod(const Params& p, long gtid, long gsize) {
    for (long it = gtid; it < (long)DEPTH * MODW; it += gsize) {
        const int l = (int)(it / MODW), j = (int)(it % MODW);
        float acc[Bn + 1];
#pragma unroll
        for (int r = 0; r <= Bn; ++r) acc[r] = 0.f;
        const float* w = p.w_mod + (size_t)l * Dm * MODW + j;
        for (int k = 0; k < Dm; ++k) {
            const float wv = w[(size_t)k * MODW];
#pragma unroll
            for (int r = 0; r < Bn; ++r) acc[r] += silu_f(p.c[r * Dm + k]) * wv;
            acc[Bn] += silu_f(p.c_ctx[k]) * wv;
        }
        const float bb = p.b_mod[l * MODW + j];
#pragma unroll
        for (int r = 0; r <= Bn; ++r) p.mod[((size_t)l * (Bn + 1) + r) * MODW + j] = acc[r] + bb;
    }
    for (long it = gtid; it < (long)NTOK * Dm; it += gsize) p.X[it] = it < (long)NL * Dm ? p.x[it] : p.ctx[it - (long)NL * Dm];
}

HD void ph_norm1(const Params& p, int l, long gtid, long gsize) {
    for (long row = gtid; row < NTOK; row += gsize) {
        const float* xr = p.X + row * Dm;
        float ss = 0.f;
        for (int k = 0; k < Dm; ++k) ss += xr[k] * xr[k];
        const float rstd = 1.0f / sqrtf(ss / Dm + EPSF);
        const float* mr = mod_row(p, l, (int)row);
        const float* g = p.norm1_g + l * Dm;
        for (int k = 0; k < Dm; ++k) p.XN[row * Dm + k] = f2a(xr[k] * rstd * g[k] * (1.0f + mr[Dm + k]) + mr[k]);
    }
}

HD void ph_gemm_in(const Params& p, int l, long gtid, long gsize) {
    const float* W = p.w_in + (size_t)l * Dm * INW;
    for (long it = gtid; it < (long)NTOK * INW; it += gsize) {
        const long m = it / INW; const int n = (int)(it % INW);
        const act_t* a = p.XN + m * Dm;
        float acc = 0.f;
        for (int k = 0; k < Dm; ++k) acc += a2f(a[k]) * W[(size_t)k * INW + n];
        p.PROJ[it] = acc;
    }
}

template <int DHn>
HD void qk_unit(const float* src, const float* g, bool rope, int t, float oscale, float (&y)[DHn]) {
    float ss = 0.f;
#pragma unroll
    for (int i = 0; i < DHn; ++i) { y[i] = src[i]; ss += y[i] * y[i]; }
    const float rstd = 1.0f / sqrtf(ss / DHn + EPSF);
#pragma unroll
    for (int i = 0; i < DHn; ++i) y[i] = y[i] * rstd * g[i];
    if (rope) {
        constexpr int half = DHn / 2, nf = half / 2;
        const float posr = (float)(t / 64), posc = (float)(t % 64);
#pragma unroll
        for (int hsel = 0; hsel < 2; ++hsel) {
            const float pos = hsel ? posc : posr;
#pragma unroll
            for (int i = 0; i < nf; ++i) {
                const float fr = expf(-(float)i / (float)nf * 9.210340371976184f);
                const float ang = pos * fr;
                const float cs = cosf(ang), sn = sinf(ang);
                const float x1 = y[hsel * half + i], x2 = y[hsel * half + nf + i];
                y[hsel * half + i] = x1 * cs - x2 * sn;
                y[hsel * half + nf + i] = x2 * cs + x1 * sn;
            }
        }
    }
#pragma unroll
    for (int i = 0; i < DHn; ++i) y[i] *= oscale;
}

HD void ph_post(const Params& p, int l, long gtid, long gsize) {
    constexpr int NU = 27;
    for (long it = gtid; it < (long)NTOK * NU; it += gsize) {
        const int tok = (int)(it / NU), u = (int)(it % NU);
        const bool isc = tok_ctx(tok);
        const int b = tok_b(tok), ti = tok_i(tok), s = tok_s(tok);
        const float* pr = p.PROJ + (size_t)tok * INW;
        if (u < 16) {
            const bool isk = u >= 8; const int h = (u & 7) >> 1, w = u & 1;
            float y[48];
            qk_unit<48>(pr + (isk ? DK_OFF : DQ_OFF) + h * 96 + w * 48, (isk ? p.diff_k_norm : p.diff_q_norm) + l * 48, !isc, ti,
                        isk ? 1.0f : 0.14433756729740643f * LOG2E, y);
            act_t* dst = isk ? p.DK + (((size_t)(b * 4 + h) * 2 + w) * Sn + s) * 48
                             : (isc ? p.DQC + (((size_t)(b * 4 + h) * 2 + w) * Cn + ti) * 48 : p.DQL + (((size_t)(b * 4 + h) * 2 + w) * Tn + ti) * 48);
#pragma unroll
            for (int i = 0; i < 48; ++i) dst[i] = f2a(y[i]);
        } else if (u < 24) {
            const bool isk = u >= 22; const int h = isk ? u - 22 : u - 16;
            float y[64];
            qk_unit<64>(pr + (isk ? GK_OFF : GQ_OFF) + h * 64, (isk ? p.gqa_k_norm : p.gqa_q_norm) + l * 64, !isc, ti, isk ? 1.0f : 0.125f * LOG2E, y);
            act_t* dst = isk ? p.GK + ((size_t)(b * 2 + h) * Sn + s) * 64
                             : (isc ? p.GQC + ((size_t)(b * 6 + h) * Cn + ti) * 64 : p.GQL + ((size_t)(b * 6 + h) * Tn + ti) * 64);
#pragma unroll
            for (int i = 0; i < 64; ++i) dst[i] = f2a(y[i]);
        } else if (u == 24) {
            for (int j = 0; j < 384; ++j) p.DVt[((size_t)(b * 4 + j / 96) * 96 + j % 96) * Sn + s] = f2a(pr[DV_OFF + j]);
        } else if (u == 25) {
            for (int j = 0; j < 128; ++j) p.GVt[((size_t)(b * 2 + j / 64) * 64 + j % 64) * Sn + s] = f2a(pr[GV_OFF + j]);
        } else {
            const int seglen = isc ? Cn : Tn;
            const float* cw = p.mlstm_conv_w + (size_t)l * 3 * 512; const float* cb = p.mlstm_conv_b + l * 512;
            for (int ch = 0; ch < 512; ++ch) {
                float a = cb[ch] + pr[MQK_OFF + ch] * cw[512 + ch];
                if (ti > 0) a += pr[MQK_OFF + ch - INW] * cw[ch];
                if (ti < seglen - 1) a += pr[MQK_OFF + ch + INW] * cw[1024 + ch];
                a = silu_f(a);
                p.MQK[(size_t)tok * 512 + ch] = ch >= 256 ? a * 0.125f : a;
            }
            const float* gb = p.mlstm_gate_b + l * 16;
            for (int j = 0; j < 16; ++j) {
                const float gv = pr[MG_OFF + j] + gb[j];
                p.MGATE[(size_t)tok * 16 + j] = ((j >> 2) & 1) ? logsigmoid_f(gv) : gv;
            }
        }
    }
}

HD void ph_attn_diff(const Params& p, int l, bool upd, long gtid, long gsize) {
    const int nq = upd ? Tn + Cn : Tn;
    const float lam_init = lam_init_of(l);
    for (long it = gtid; it < (long)Bn * 4 * nq; it += gsize) {
        const int qi = (int)(it % nq), h = (int)((it / nq) % 4), b = (int)(it / ((long)nq * 4));
        const bool isc = qi >= Tn; const int ti = isc ? qi - Tn : qi;
        const int nk = isc ? Cn : Sn;
        const int tok = isc ? NL + b * Cn + ti : b * Tn + ti;
        float* dob = p.DO + ((size_t)(b * 4 + h) * (Tn + Cn) + qi) * 96;
        const act_t* vt = p.DVt + (size_t)(b * 4 + h) * 96 * Sn;
        float l2 = 1.f;
        float o[96];
        for (int w = 0; w < 2; ++w) {
            const act_t* qp = isc ? p.DQC + (((size_t)(b * 4 + h) * 2 + w) * Cn + ti) * 48 : p.DQL + (((size_t)(b * 4 + h) * 2 + w) * Tn + ti) * 48;
            const act_t* kp = p.DK + ((size_t)(b * 4 + h) * 2 + w) * Sn * 48;
            float q[48];
#pragma unroll
            for (int i = 0; i < 48; ++i) q[i] = a2f(qp[i]);
#pragma unroll
            for (int i = 0; i < 96; ++i) o[i] = 0.f;
            float m = -1e30f, lsum = 0.f;
            for (int s = 0; s < nk; ++s) {
                float sc = 0.f;
#pragma unroll
                for (int i = 0; i < 48; ++i) sc += q[i] * a2f(kp[(size_t)s * 48 + i]);
                const float mn = fmaxf(m, sc), alpha = exp2f(m - mn), pe = exp2f(sc - mn);
                lsum = lsum * alpha + pe;
#pragma unroll
                for (int i = 0; i < 96; ++i) o[i] = o[i] * alpha + pe * a2f(vt[(size_t)i * Sn + s]);
                m = mn;
            }
            if (w == 0) {
#pragma unroll
                for (int i = 0; i < 96; ++i) dob[i] = o[i] / lsum;
            } else l2 = lsum;
        }
        const float* dl = p.diff_lambda + l * 4 * 48;
        float s01 = 0.f, s23 = 0.f;
        for (int i = 0; i < 48; ++i) { s01 += dl[i] * dl[48 + i]; s23 += dl[96 + i] * dl[144 + i]; }
        const float lam = expf(s01) - expf(s23) + lam_init;
        float ss = 0.f;
#pragma unroll
        for (int i = 0; i < 96; ++i) { o[i] = dob[i] - lam * o[i] / l2; ss += o[i] * o[i]; }
        const float rstd = 1.0f / sqrtf(ss / 96 + EPSF);
        const float* sg = p.diff_subln + l * 96;
#pragma unroll
        for (int i = 0; i < 96; ++i) p.MIX[(size_t)tok * Dm + h * 96 + i] = f2a(o[i] * rstd * sg[i] * (1.0f - lam_init));
    }
}

HD void ph_attn_gqa(const Params& p, int l, bool upd, long gtid, long gsize) {
    const int nq = upd ? Tn + Cn : Tn;
    for (long it = gtid; it < (long)Bn * 6 * nq; it += gsize) {
        const int qi = (int)(it % nq), hq = (int)((it / nq) % 6), b = (int)(it / ((long)nq * 6));
        const bool isc = qi >= Tn; const int ti = isc ? qi - Tn : qi;
        const int nk = isc ? Cn : Sn, kv = hq / 3;
        const int tok = isc ? NL + b * Cn + ti : b * Tn + ti;
        const act_t* qp = isc ? p.GQC + ((size_t)(b * 6 + hq) * Cn + ti) * 64 : p.GQL + ((size_t)(b * 6 + hq) * Tn + ti) * 64;
        const act_t* kp = p.GK + (size_t)(b * 2 + kv) * Sn * 64;
        const act_t* vt = p.GVt + (size_t)(b * 2 + kv) * 64 * Sn;
        float q[64], o[64];
#pragma unroll
        for (int i = 0; i < 64; ++i) { q[i] = a2f(qp[i]); o[i] = 0.f; }
        float m = -1e30f, lsum = 0.f;
        for (int s = 0; s < nk; ++s) {
            float sc = 0.f;
#pragma unroll
            for (int i = 0; i < 64; ++i) sc += q[i] * a2f(kp[(size_t)s * 64 + i]);
            const float mn = fmaxf(m, sc), alpha = exp2f(m - mn), pe = exp2f(sc - mn);
            lsum = lsum * alpha + pe;
#pragma unroll
            for (int i = 0; i < 64; ++i) o[i] = o[i] * alpha + pe * a2f(vt[(size_t)i * Sn + s]);
            m = mn;
        }
#pragma unroll
        for (int i = 0; i < 64; ++i) p.MIX[(size_t)tok * Dm + 384 + hq * 64 + i] = f2a(o[i] / lsum);
    }
}

HD void mlstm_dir_naive(const Params& p, int b, int h, bool isc, int ti, int dir, const float (&q)[64], float (&hout)[64]) {
    float num[64];
#pragma unroll
    for (int i = 0; i < 64; ++i) num[i] = 0.f;
    float den = 0.f, m = -1e30f, Dg = 0.f;
    for (int seg = 0; seg < (isc ? 1 : 2); ++seg) {
        const bool sc_ = seg == 1 ? true : isc;
        const int len = sc_ ? Cn : Tn;
        int cnt, start, step;
        if (seg == 0) { start = ti; step = dir == 0 ? -1 : 1; cnt = dir == 0 ? ti + 1 : len - ti; }
        else { start = dir == 0 ? len - 1 : 0; step = dir == 0 ? -1 : 1; cnt = len; }
        for (int c = 0, si = start; c < cnt; ++c, si += step) {
            const int tk = sc_ ? NL + b * Cn + si : b * Tn + si;
            const float li = p.MGATE[(size_t)tk * 16 + dir * 8 + h], lf = p.MGATE[(size_t)tk * 16 + dir * 8 + 4 + h];
            const float lw = Dg + li;
            const float* kr = p.MQK + (size_t)tk * 512 + 256 + h * 64;
            const float* vr = p.PROJ + (size_t)tk * INW + MV_OFF + h * 64;
            float qk = 0.f;
#pragma unroll
            for (int i = 0; i < 64; ++i) qk += q[i] * kr[i];
            const float mn = fmaxf(m, lw), alpha = expf(m - mn), w = expf(lw - mn) * qk;
            den = den * alpha + w;
#pragma unroll
            for (int i = 0; i < 64; ++i) num[i] = num[i] * alpha + w * vr[i];
            m = mn;
            Dg += lf;
        }
    }
    const float dn = fmaxf(fabsf(den), expf(-m));
#pragma unroll
    for (int i = 0; i < 64; ++i) hout[i] += num[i] / dn;
}

HD void ph_mlstm(const Params& p, int l, bool upd, long gtid, long gsize) {
    const int nq = upd ? Tn + Cn : Tn;
    for (long it = gtid; it < (long)Bn * 4 * nq; it += gsize) {
        const int qi = (int)(it % nq), h = (int)((it / nq) % 4), b = (int)(it / ((long)nq * 4));
        const bool isc = qi >= Tn; const int ti = isc ? qi - Tn : qi;
        const int tok = isc ? NL + b * Cn + ti : b * Tn + ti;
        float q[64], hh[64];
#pragma unroll
        for (int i = 0; i < 64; ++i) { q[i] = p.MQK[(size_t)tok * 512 + h * 64 + i]; hh[i] = 0.f; }
        mlstm_dir_naive(p, b, h, isc, ti, 0, q, hh);
        mlstm_dir_naive(p, b, h, isc, ti, 1, q, hh);
        float ss = 0.f;
#pragma unroll
        for (int i = 0; i < 64; ++i) ss += hh[i] * hh[i];
        const float rstd = 1.0f / sqrtf(ss / 64 + EPSF);
        const float* hn = p.mlstm_head_norm + l * 256 + h * 64;
        const float* og = p.PROJ + (size_t)tok * INW + MO_OFF + h * 64;
#pragma unroll
        for (int i = 0; i < 64; ++i) p.MIX[(size_t)tok * Dm + 768 + h * 64 + i] = f2a(hh[i] * rstd * hn[i] * sigmoid_f(og[i]));
    }
}

HD void ph_gemm_out(const Params& p, int l, bool upd, long gtid, long gsize) {
    const float* W = p.w_out + (size_t)l * Dm * Dm;
    const long rows = upd ? NTOK : NL;
    for (long it = gtid; it < rows * Dm; it += gsize) {
        const long m = it / Dm; const int n = (int)(it % Dm);
        const act_t* a = p.MIX + m * Dm;
        float acc = 0.f;
        for (int k = 0; k < Dm; ++k) acc += a2f(a[k]) * W[(size_t)k * Dm + n];
        p.X[it] += mod_row(p, l, (int)m)[2 * Dm + n] * acc;
    }
}

HD void ph_norm2_route(const Params& p, int l, bool upd, long gtid, long gsize) {
    const long rows = upd ? NTOK : NL;
    for (long row = gtid; row < rows; row += gsize) {
        const float* xr = p.X + row * Dm;
        float ss = 0.f;
        for (int k = 0; k < Dm; ++k) ss += xr[k] * xr[k];
        const float rstd = 1.0f / sqrtf(ss / Dm + EPSF);
        const float* mr = mod_row(p, l, (int)row);
        const float* g = p.norm2_g + l * Dm;
        const float* wg = p.moe_wg + (size_t)l * Dm * 4; const float* we = p.moe_we + (size_t)l * Dm * 32;
        float ag[4], ae[32];
#pragma unroll
        for (int j = 0; j < 4; ++j) ag[j] = 0.f;
#pragma unroll
        for (int j = 0; j < 32; ++j) ae[j] = 0.f;
        for (int k = 0; k < Dm; ++k) {
            const float f = xr[k] * rstd * g[k] * (1.0f + mr[4 * Dm + k]) + mr[3 * Dm + k];
            p.F[row * Dm + k] = f2a(f);
#pragma unroll
            for (int j = 0; j < 4; ++j) ag[j] += f * wg[k * 4 + j];
#pragma unroll
            for (int j = 0; j < 32; ++j) ae[j] += f * we[k * 32 + j];
        }
        float gmax = -1e30f; int gi = 0;
#pragma unroll
        for (int j = 0; j < 4; ++j) { ag[j] += p.moe_bg[l * 4 + j]; if (ag[j] > gmax) { gmax = ag[j]; gi = j; } }
        float gsum = 0.f;
#pragma unroll
        for (int j = 0; j < 4; ++j) gsum += expf(ag[j] - gmax);
        const float gtop = 1.0f / gsum;
        float e1 = -1e30f, e2 = -1e30f; int i1 = 0, i2 = 0;
#pragma unroll
        for (int grp = 0; grp < 4; ++grp) {
            if (grp == gi) {
#pragma unroll
                for (int j = 0; j < 8; ++j) {
                    const float v = ae[grp * 8 + j] + p.moe_be[l * 32 + grp * 8 + j];
                    if (v > e1) { e2 = e1; i2 = i1; e1 = v; i1 = j; } else if (v > e2) { e2 = v; i2 = j; }
                }
            }
        }
        const float g0 = 1.0f / (1.0f + expf(e2 - e1));
        p.EID[row * 2] = gi * 8 + i1; p.EID[row * 2 + 1] = gi * 8 + i2;
        p.GATE[row * 2] = g0 * gtop; p.GATE[row * 2 + 1] = (1.0f - g0) * gtop;
    }
}

HD void ph_moe1(const Params& p, int l, bool upd, long gtid, long gsize) {
    const long rows = upd ? NTOK : NL;
    for (long it = gtid; it < rows * 2 * 512; it += gsize) {
        const long rk = it / 512; const int j = (int)(it % 512);
        const long row = rk >> 1;
        const int e = p.EID[rk];
        const float* W1 = p.moe_w1 + ((size_t)l * 32 + e) * Dm * 512 + j; const float* W3 = p.moe_w3 + ((size_t)l * 32 + e) * Dm * 512 + j;
        const act_t* f = p.F + row * Dm;
        float a = 0.f, bb = 0.f;
        for (int k = 0; k < Dm; ++k) { const float fv = a2f(f[k]); a += fv * W1[(size_t)k * 512]; bb += fv * W3[(size_t)k * 512]; }
        p.HN[it] = silu_f(a) * bb;
    }
}

HD void ph_moe2(const Params& p, int l, bool upd, long gtid, long gsize) {
    const long rows = upd ? NTOK : NL;
    for (long it = gtid; it < rows * Dm; it += gsize) {
        const long row = it / Dm; const int d = (int)(it % Dm);
        float y = 0.f;
        for (int kk = 0; kk < 2; ++kk) {
            const int e = p.EID[row * 2 + kk];
            const float* W2 = p.moe_w2 + ((size_t)l * 32 + e) * 512 * Dm + d;
            const float* hn = p.HN + (row * 2 + kk) * 512;
            float acc = 0.f;
            for (int j = 0; j < 512; ++j) acc += hn[j] * W2[(size_t)j * Dm];
            y += p.GATE[row * 2 + kk] * acc;
        }
        const float xn = p.X[it] + mod_row(p, l, (int)row)[5 * Dm + d] * y;
        p.X[it] = xn;
        if (l == DEPTH - 1) p.out[it] = xn;
    }
}

constexpr int PH_PER_LAYER = 8;
constexpr int N_PHASES = 1 + DEPTH * PH_PER_LAYER;
HD void run_phase(const Params& p, int ph, long gtid, long gsize) {
    if (ph == 0) { ph_mod(p, gtid, gsize); return; }
    const int l = (ph - 1) / PH_PER_LAYER, s = (ph - 1) % PH_PER_LAYER;
    const bool upd = l < DEPTH - 1;
    switch (s) {
        case 0: ph_norm1(p, l, gtid, gsize); break;
        case 1: ph_gemm_in(p, l, gtid, gsize); break;
        case 2: ph_post(p, l, gtid, gsize); break;
        case 3: ph_attn_diff(p, l, upd, gtid, gsize); ph_attn_gqa(p, l, upd, gtid, gsize); ph_mlstm(p, l, upd, gtid, gsize); break;
        case 4: ph_gemm_out(p, l, upd, gtid, gsize); break;
        case 5: ph_norm2_route(p, l, upd, gtid, gsize); break;
        case 6: ph_moe1(p, l, upd, gtid, gsize); break;
        default: ph_moe2(p, l, upd, gtid, gsize); break;
    }
}

struct Carver { char* base; size_t off; template <class T> T* take(size_t n) { T* r = (T*)(base + off); off += (n * sizeof(T) + 255) & ~(size_t)255; return r; } };
static inline size_t carve(Params& p, void* ws) {
    Carver c{(char*)ws, 0};
    p.mod = c.take<float>((size_t)DEPTH * (Bn + 1) * MODW);
    p.X = c.take<float>((size_t)NTOK * Dm);
#ifdef HOST_TEST
    p.PROJ = c.take<float>((size_t)NTOK * INW);
#endif
#ifdef HOST_TEST
    p.MQK = c.take<float>((size_t)NTOK * 512);
    p.MGATE = c.take<float>((size_t)NTOK * 16);
#endif
    p.DO = c.take<float>((size_t)Bn * 4 * (Tn + Cn) * 96);
    p.GATE = c.take<float>((size_t)NTOK * 2);
#ifdef HOST_TEST
    p.HN = c.take<float>((size_t)NTOK * 2 * 512);
#endif
    p.XN = c.take<act_t>((size_t)NTOK * Dm);
    p.DQL = c.take<act_t>((size_t)Bn * 4 * 2 * Tn * 48);
    p.DQC = c.take<act_t>((size_t)Bn * 4 * 2 * Cn * 48);
    p.DK = c.take<act_t>((size_t)Bn * 4 * 2 * Sn * 48);
    p.DVt = c.take<act_t>((size_t)Bn * 4 * 96 * Sn);
    p.GQL = c.take<act_t>((size_t)Bn * 6 * Tn * 64);
    p.GQC = c.take<act_t>((size_t)Bn * 6 * Cn * 64);
    p.GK = c.take<act_t>((size_t)Bn * 2 * Sn * 64);
    p.GVt = c.take<act_t>((size_t)Bn * 2 * 64 * Sn);
    p.MIX = c.take<act_t>((size_t)NTOK * Dm);
    p.F = c.take<act_t>((size_t)NTOK * Dm);
    p.EID = c.take<int>((size_t)NTOK * 2);
    p.CNT = c.take<int>((size_t)DEPTH * 32 * 64);
    p.LIST = c.take<int>((size_t)32 * NTOK);
    p.POS = c.take<int>((size_t)NTOK * 2);
    p.H = c.take<act_t>((size_t)PMAX * 512);
    p.Y = c.take<act_t>((size_t)PMAX * Dm);
    p.ROPE = c.take<float>((size_t)64 * 28 * 2);
    p.KV = c.take<float>((size_t)Bn * 4 * 2 * NCH * 4096);
    p.NLC = c.take<float>((size_t)Bn * 4 * 2 * NCH * 64);
    p.CHS = c.take<float>((size_t)Bn * 4 * 2 * NCH * 2);
    p.MG4 = c.take<float>((size_t)NTOK * 16);
    p.MQKB = c.take<act_t>((size_t)NTOK * 512);
    p.BAR = c.take<unsigned>(4096);
    p.WIN_T = c.take<act_t>((size_t)DEPTH * INW * Dm);
    p.WOUT_T = c.take<act_t>((size_t)DEPTH * Dm * Dm);
    p.TS = c.take<unsigned long long>(256);
    p.FLO = c.take<act_t>((size_t)NTOK * Dm);
    p.WRHI = c.take<act_t>((size_t)DEPTH * 36 * Dm);
    p.WRLO = c.take<act_t>((size_t)DEPTH * 36 * Dm);
    p.ZROW = c.take<act_t>(2048);
    p.W13T = c.take<act_t>((size_t)2 * 32 * 1024 * Dm);
    p.W2T = c.take<act_t>((size_t)2 * 32 * Dm * 512);
    p.PROJB = c.take<act_t>((size_t)NTOK * INW);
    p.PG = c.take<float>((size_t)NTOK * 16);
    return c.off;
}
static inline void fill_inputs(Params& p, void* const* d_in, void* d_out) {
    const float** f = (const float**)&p;
    for (int i = 0; i < 27; ++i) f[i] = (const float*)d_in[i];
    p.out = (float*)d_out;
}


#ifndef HOST_TEST
typedef short bf16x8 __attribute__((ext_vector_type(8)));
typedef float f32x2 __attribute__((ext_vector_type(2)));
typedef float f32x4 __attribute__((ext_vector_type(4)));
typedef float f32x16 __attribute__((ext_vector_type(16)));
typedef unsigned u32x2 __attribute__((ext_vector_type(2)));
typedef unsigned u32x4 __attribute__((ext_vector_type(4)));
typedef __bf16 bf16x2_t __attribute__((ext_vector_type(2)));
#define DI __device__ __forceinline__
DI unsigned pk2(float a, float b) { f32x2 v = {a, b}; return __builtin_bit_cast(unsigned, __builtin_convertvector(v, bf16x2_t)); }
DI float bflo(unsigned u) { return __uint_as_float(u << 16); }
DI float bfhi(unsigned u) { return __uint_as_float(u & 0xffff0000u); }
DI f32x4 ld4bf(const act_t* q) { const u32x2 v = *(const u32x2*)q; return (f32x4){bflo(v[0]), bfhi(v[0]), bflo(v[1]), bfhi(v[1])}; }
DI float shfl_i(float v, int src) { return __int_as_float(__builtin_amdgcn_ds_bpermute(src << 2, __float_as_int(v))); }
DI float shfl_x(float v, int o, int lane) { return shfl_i(v, lane ^ o); }
DI float row16_sum(float v) {
#define ROR_(x, n) __int_as_float(__builtin_amdgcn_update_dpp(0, __float_as_int(x), 0x120 + (n), 0xF, 0xF, false))
    v += ROR_(v, 8); v += ROR_(v, 4); v += ROR_(v, 2); v += ROR_(v, 1);
#undef ROR_
    return v;
}
DI float wave_sum(float v, int lane) {
#pragma unroll
    for (int o = 32; o > 0; o >>= 1) v += shfl_x(v, o, lane);
    return v;
}

constexpr int NTHR = 256;
DI void lds_barrier() { asm volatile("s_waitcnt lgkmcnt(0)" ::: "memory"); __builtin_amdgcn_s_barrier(); asm volatile("" ::: "memory"); }
DI int opaque_tid() { int t = threadIdx.x; asm volatile("" : "+v"(t)); return t; }
constexpr int GT_LD = 144;
constexpr int GT_AS = 0, GT_BS = 128 * GT_LD, GT_END = 256 * GT_LD;
constexpr int SM_AUX = 65536;
constexpr int SMEM_BYTES = 66 * 1024;

#ifndef IMPL_POST
#define IMPL_POST 1
#endif
#ifndef IMPL_ATTN
#define IMPL_ATTN 1
#endif
#ifndef IMPL_MLSTM
#define IMPL_MLSTM 1
#endif
#ifndef IMPL_ROUTE
#define IMPL_ROUTE 1
#endif
DI int gt_off(int r, int c) { return r * 128 + ((c ^ ((r >> 1) & 7)) << 4); }
constexpr int GT_STAGE = 32768, GT_B = 16384;
#define GT_COMPUTE(BUF) \
    _Pragma("unroll") for (int kk = 0; kk < 2; ++kk) { \
        bf16x8 af[4], bfr[4]; \
        _Pragma("unroll") for (int mi = 0; mi < 4; ++mi) af[mi] = *(const bf16x8*)(smem + (BUF) * GT_STAGE + gt_off(wm * 64 + mi * 16 + (lane & 15), kk * 4 + (lane >> 4))); \
        _Pragma("unroll") for (int ni = 0; ni < 4; ++ni) bfr[ni] = *(const bf16x8*)(smem + (BUF) * GT_STAGE + GT_B + gt_off(wn * 64 + ni * 16 + (lane & 15), kk * 4 + (lane >> 4))); \
        _Pragma("unroll") for (int mi = 0; mi < 4; ++mi) \
            _Pragma("unroll") for (int ni = 0; ni < 4; ++ni) acc[mi][ni] = __builtin_amdgcn_mfma_f32_16x16x32_bf16(bfr[ni], af[mi], acc[mi][ni], 0, 0, 0); }

DI void gemm_mainloop(unsigned char* smem, const act_t* const (&arow)[4], const float* bptr, const int ldb, const int K, f32x4 (&acc)[4][4]) {
    const int tid = opaque_tid(), lane = tid & 63, w = tid >> 6, wm = w >> 1, wn = w & 1;
    const int a_r = tid >> 3, a_c = tid & 7, kg = lane & 7, c4 = (w * 8 + (lane >> 3)) * 4;
#pragma unroll
    for (int mi = 0; mi < 4; ++mi)
#pragma unroll
        for (int ni = 0; ni < 4; ++ni) acc[mi][ni] = (f32x4){0.f, 0.f, 0.f, 0.f};
    u32x4 ra[4]; f32x4 rb[8];
#define GT_LOAD(KOFF) { \
    _Pragma("unroll") for (int i = 0; i < 4; ++i) ra[i] = *(const u32x4*)(arow[i] + (KOFF) + a_c * 8); \
    _Pragma("unroll") for (int r = 0; r < 8; ++r) rb[r] = *(const f32x4*)(bptr + (size_t)((KOFF) + kg * 8 + r) * ldb); }
#define GT_WRITE(BUF) { \
    _Pragma("unroll") for (int i = 0; i < 4; ++i) *(u32x4*)(smem + (BUF) * GT_STAGE + gt_off(a_r + 32 * i, a_c)) = ra[i]; \
    _Pragma("unroll") for (int i = 0; i < 4; ++i) { \
        const u32x4 q = {pk2(rb[0][i], rb[1][i]), pk2(rb[2][i], rb[3][i]), pk2(rb[4][i], rb[5][i]), pk2(rb[6][i], rb[7][i])}; \
        *(u32x4*)(smem + (BUF) * GT_STAGE + GT_B + gt_off(c4 + i, kg)) = q; } }
    const int nt = K >> 6;
    __syncthreads();
    GT_LOAD(0)
    GT_WRITE(0)
    __syncthreads();
    if (nt > 1) GT_LOAD(64)
    for (int t = 0; t < nt; ++t) {
        const int buf = t & 1;
        GT_COMPUTE(buf)
        if (t + 1 < nt) GT_WRITE(buf ^ 1)
        __syncthreads();
        if (t + 2 < nt) GT_LOAD((t + 2) * 64)
    }
#undef GT_LOAD
#undef GT_WRITE
}

#define LDSP __attribute__((address_space(3)))
template <int MODE = 0>
DI void gemm_mainloop_bb(unsigned char* smem, const act_t* const (&arow)[4], const act_t* const (&brow)[4], const int K, f32x4 (&acc)[4][4]) {
    const int tid = opaque_tid(), lane = tid & 63, w = tid >> 6, wm = w >> 1, wn = w & 1;
    const int wu = __builtin_amdgcn_readfirstlane(w);
#pragma unroll
    for (int mi = 0; mi < 4; ++mi)
#pragma unroll
        for (int ni = 0; ni < 4; ++ni) acc[mi][ni] = (f32x4){0.f, 0.f, 0.f, 0.f};
    const int csrc = ((lane & 7) ^ ((4 * w + (lane >> 4)) & 7)) * 8;
#define GB_DMA(KOFF, BUF) { \
    _Pragma("unroll") for (int i = 0; i < 4; ++i) { \
        __builtin_amdgcn_global_load_lds((const unsigned*)(arow[i] + (KOFF) + csrc), (LDSP unsigned*)(smem + (BUF) * GT_STAGE + (4 * i + wu) * 1024), 16, 0, 0); \
        __builtin_amdgcn_global_load_lds((const unsigned*)(brow[i] + (KOFF) + csrc), (LDSP unsigned*)(smem + (BUF) * GT_STAGE + GT_B + (4 * i + wu) * 1024), 16, 0, 0); } }
    const int nt = K >> 6;
    __syncthreads();
    GB_DMA(0, 0)
    asm volatile("s_waitcnt vmcnt(0)" ::: "memory");
    __syncthreads();
    for (int t = 0; t < nt; ++t) {
        const int buf = t & 1;
        if (t + 1 < nt) GB_DMA((t + 1) * 64, buf ^ 1)
        GT_COMPUTE(buf)
        asm volatile("s_waitcnt vmcnt(0)" ::: "memory");
        __syncthreads();
    }
#undef GB_DMA
}

DI void bp_wconv(const Params& p, unsigned char* smem, int bid, int G) {
    const int tid = opaque_tid();
    float* T = (float*)smem;
    constexpr int NT_IN = (INW + 63) / 64, NT_OUT = Dm / 64, KT = Dm / 64;
    constexpr int PER_L = (NT_IN + NT_OUT) * KT;
    const int k = tid >> 2, n16 = (tid & 3) * 16;
    const int n = tid >> 2, k16 = (tid & 3) * 16;
    f32x4 v[4];
#define WC_DECODE(ITEM) const int l_ = (ITEM) / PER_L, r_ = (ITEM) % PER_L; const bool isout_ = r_ >= NT_IN * KT; \
        const int rr_ = isout_ ? r_ - NT_IN * KT : r_, nt_ = rr_ / KT, kt_ = rr_ % KT, N_ = isout_ ? Dm : INW; \
        const float* W_ = isout_ ? p.w_out + (size_t)l_ * Dm * Dm : p.w_in + (size_t)l_ * Dm * INW;
#define WC_LOAD(ITEM) { WC_DECODE(ITEM) \
        _Pragma("unroll") for (int i = 0; i < 4; ++i) { const int nn = nt_ * 64 + n16 + i * 4; v[i] = nn < N_ ? *(const f32x4*)(W_ + (size_t)(kt_ * 64 + k) * N_ + nn) : (f32x4){0.f, 0.f, 0.f, 0.f}; } }
    if (bid < DEPTH * PER_L) WC_LOAD(bid)
    for (int item = bid; item < DEPTH * PER_L; item += G) {
        __syncthreads();
#pragma unroll
        for (int i = 0; i < 4; ++i) { T[k * 65 + n16 + i * 4] = v[i][0]; T[k * 65 + n16 + i * 4 + 1] = v[i][1]; T[k * 65 + n16 + i * 4 + 2] = v[i][2]; T[k * 65 + n16 + i * 4 + 3] = v[i][3]; }
        __syncthreads();
        if (item + G < DEPTH * PER_L) WC_LOAD(item + G)
        WC_DECODE(item)
        (void)W_;
        act_t* WT = isout_ ? p.WOUT_T + (size_t)l_ * Dm * Dm : p.WIN_T + (size_t)l_ * INW * Dm;
        if (nt_ * 64 + n < N_) {
            unsigned o[8];
#pragma unroll
            for (int i = 0; i < 8; ++i) o[i] = pk2(T[(k16 + 2 * i) * 65 + n], T[(k16 + 2 * i + 1) * 65 + n]);
            act_t* dst = WT + (size_t)(nt_ * 64 + n) * Dm + kt_ * 64 + k16;
            *(u32x4*)dst = (u32x4){o[0], o[1], o[2], o[3]}; *(u32x4*)(dst + 8) = (u32x4){o[4], o[5], o[6], o[7]};
        }
    }
#undef WC_LOAD
#undef WC_DECODE
}

DI int xcd_remap(int b, int G) { return (G & 7) == 0 ? (b & 7) * (G >> 3) + (b >> 3) : b; }

template <int MODE = 0>
DI void bp_gemm_in(const Params& p, int l, unsigned char* smem, int vb, int G) {
    constexpr int MT = NTOK / 128, NT = (INW + 127) / 128;
    const float* W = p.w_in + (size_t)l * Dm * INW;
    const int tid = opaque_tid(), lane = tid & 63, w = tid >> 6, wm = w >> 1, wn = w & 1, a_r = tid >> 3, c4 = (w * 8 + (lane >> 3)) * 4;
    for (int t = vb; t < MT * NT; t += G) {
        const int mt = t / NT, nt = t % NT, m0 = mt * 128, n0 = nt * 128;
        const act_t* arow[4];
#pragma unroll
        for (int i = 0; i < 4; ++i) arow[i] = p.XN + (size_t)(m0 + a_r + 32 * i) * Dm;
        const act_t* brow[4];
#pragma unroll
        for (int i = 0; i < 4; ++i) brow[i] = n0 + a_r + 32 * i < INW ? p.WIN_T + ((size_t)l * INW + n0 + a_r + 32 * i) * Dm : p.ZROW;
        f32x4 acc[4][4];
        gemm_mainloop_bb<MODE>(smem, arow, brow, Dm, acc);
#pragma unroll
        for (int mi = 0; mi < 4; ++mi)
#pragma unroll
            for (int ni = 0; ni < 4; ++ni) {
                const int m = m0 + wm * 64 + mi * 16 + (lane & 15), n = n0 + wn * 64 + ni * 16 + (lane >> 4) * 4;
                if (n < INW) {
                    const f32x4 v = acc[mi][ni];
                    *(u32x2*)(p.PROJB + (size_t)m * INW + n) = (u32x2){pk2(v[0], v[1]), pk2(v[2], v[3])};
                    if (n >= MG_OFF) *(f32x4*)(p.PG + (size_t)m * 16 + n - MG_OFF) = v;
                }
            }
    }
}

DI void mconv_drain(const Params& p, int l, unsigned char* smem, int max_items);
template <bool DRY>
DI void bp_gemm_out(const Params& p, int l, bool upd, unsigned char* smem, int vb, int G) {
    const int MT = (upd ? NTOK : NL) / 128; constexpr int NT = Dm / 128;
    const float* W = p.w_out + (size_t)l * Dm * Dm;
    const int tid = opaque_tid(), lane = tid & 63, w = tid >> 6, wm = w >> 1, wn = w & 1, a_r = tid >> 3, c4 = (w * 8 + (lane >> 3)) * 4;
    for (int t = vb; t < MT * NT; t += G) {
        const int mt = t / NT, nt = t % NT, m0 = mt * 128, n0 = nt * 128;
        const act_t* arow[4];
#pragma unroll
        for (int i = 0; i < 4; ++i) arow[i] = p.MIX + (size_t)(m0 + a_r + 32 * i) * Dm;
        const act_t* brow[4];
#pragma unroll
        for (int i = 0; i < 4; ++i) brow[i] = p.WOUT_T + ((size_t)l * Dm + n0 + a_r + 32 * i) * Dm;
        f32x4 acc[4][4];
        gemm_mainloop_bb(smem, arow, brow, Dm, acc);
#pragma unroll
        for (int mi = 0; mi < 4; ++mi) {
            const int m = m0 + wm * 64 + mi * 16 + (lane & 15);
            const float* g1 = mod_row(p, l, m) + 2 * Dm;
#pragma unroll
            for (int ni = 0; ni < 4; ++ni) {
                const int n = n0 + wn * 64 + ni * 16 + (lane >> 4) * 4;
                f32x4* xp = (f32x4*)(p.X + (size_t)m * Dm + n);
                const f32x4 xo = l == 0 ? *(const f32x4*)((m < NL ? p.x + (size_t)m * Dm : p.ctx + (size_t)(m - NL) * Dm) + n) : *xp;
                if (DRY) *(f32x4*)((float*)p.PROJB + (size_t)m * Dm + n) = xo + *(const f32x4*)(g1 + n) * acc[mi][ni];
                else *xp = xo + *(const f32x4*)(g1 + n) * acc[mi][ni];
            }
        }
    }
    if (!DRY && vb >= (MT * NT) % G) mconv_drain(p, l, smem, 1);
}

DI int* moe_prep(const Params& p, int l, unsigned char* smem) {
    int* s_moff = (int*)(smem + SM_AUX);
    __syncthreads();
    if (threadIdx.x == 0) { int o = 0; for (int e = 0; e < 32; ++e) { s_moff[e] = o; o += (p.CNT[(l * 32 + e) * 64] + 127) >> 7; } s_moff[32] = o; }
    __syncthreads();
    return s_moff;
}

DI void bp_moe1(const Params& p, int l, unsigned char* smem, int vb, int G) {
    const int* s_moff = moe_prep(p, l, smem);
    const int total = s_moff[32] * 8;
    const int tid = opaque_tid(), lane = tid & 63, w = tid >> 6, wm = w >> 1, wn = w & 1, a_r = tid >> 3, c4 = (w * 8 + (lane >> 3)) * 4;
    for (int t = vb; t < total; t += G) {
        const int mtg = t >> 3, nt = t & 7;
        int e = 0; while (s_moff[e + 1] <= mtg) ++e;
        const int cnt = p.CNT[(l * 32 + e) * 64], lbase = (mtg - s_moff[e]) * 128;
        const act_t* arow[4];
#pragma unroll
        for (int i = 0; i < 4; ++i) { const int li = lbase + a_r + 32 * i; arow[i] = li < cnt ? p.F + (size_t)p.LIST[(size_t)e * NTOK + li] * Dm : p.ZROW; }
        const act_t* brow[4];
#pragma unroll
        for (int i = 0; i < 4; ++i) { const int r = a_r + 32 * i, sel = (r & 63) >> 5, j = nt * 64 + (r >> 6) * 32 + (r & 31); brow[i] = p.W13T + ((size_t)(l & 1) * 32 * 1024 + (size_t)e * 1024 + sel * 512 + j) * Dm; }
        f32x4 acc[4][4];
        gemm_mainloop_bb(smem, arow, brow, Dm, acc);
#pragma unroll
        for (int mi = 0; mi < 4; ++mi)
#pragma unroll
            for (int ni = 0; ni < 2; ++ni) {
                const f32x4 a = acc[mi][ni], b = acc[mi][ni + 2];
                float h[4];
#pragma unroll
                for (int r = 0; r < 4; ++r) h[r] = a[r] / (1.0f + __expf(-a[r])) * b[r];
                const int prow = mtg * 128 + wm * 64 + mi * 16 + (lane & 15), jj = nt * 64 + wn * 32 + ni * 16 + (lane >> 4) * 4;
                *(u32x2*)(p.H + (size_t)prow * 512 + jj) = (u32x2){pk2(h[0], h[1]), pk2(h[2], h[3])};
            }
    }
}

DI void bp_moe2(const Params& p, int l, unsigned char* smem, int vb, int G) {
    const int* s_moff = moe_prep(p, l, smem);
    const int total = s_moff[32] * 8;
    const int tid = opaque_tid(), lane = tid & 63, w = tid >> 6, wm = w >> 1, wn = w & 1, a_r = tid >> 3, c4 = (w * 8 + (lane >> 3)) * 4;
    for (int t = vb; t < total; t += G) {
        const int mtg = t >> 3, nt = t & 7, n0 = nt * 128;
        int e = 0; while (s_moff[e + 1] <= mtg) ++e;
        const act_t* arow[4];
#pragma unroll
        for (int i = 0; i < 4; ++i) arow[i] = p.H + (size_t)(mtg * 128 + a_r + 32 * i) * 512;
        const act_t* brow[4];
#pragma unroll
        for (int i = 0; i < 4; ++i) brow[i] = p.W2T + (((size_t)(l & 1) * 32 + e) * Dm + n0 + a_r + 32 * i) * 512;
        f32x4 acc[4][4];
        gemm_mainloop_bb(smem, arow, brow, 512, acc);
#pragma unroll
        for (int mi = 0; mi < 4; ++mi)
#pragma unroll
            for (int ni = 0; ni < 4; ++ni) {
                const int prow = mtg * 128 + wm * 64 + mi * 16 + (lane & 15), n = n0 + wn * 64 + ni * 16 + (lane >> 4) * 4;
                const f32x4 v = acc[mi][ni];
                *(u32x2*)(p.Y + (size_t)prow * Dm + n) = (u32x2){pk2(v[0], v[1]), pk2(v[2], v[3])};
            }
    }
}

DI void bp_route(const Params& p, int l, bool upd, long gtid, long gsize) {
    ph_norm2_route(p, l, upd, gtid, gsize);
    const long rows = upd ? NTOK : NL;
    for (long row = gtid; row < rows; row += gsize)
#pragma unroll
        for (int kk = 0; kk < 2; ++kk) {
            const int e = p.EID[row * 2 + kk];
            const int pos = atomicAdd(&p.CNT[(l * 32 + e) * 64], 1);
            p.LIST[(size_t)e * NTOK + pos] = (int)row;
            p.POS[row * 2 + kk] = pos;
        }
}

DI void norm1_row(const Params& p, int l, long row, const f32x4 (&x)[4], int lane) {
    float ss = 0.f;
#pragma unroll
    for (int i = 0; i < 4; ++i) ss += x[i][0] * x[i][0] + x[i][1] * x[i][1] + x[i][2] * x[i][2] + x[i][3] * x[i][3];
    ss = wave_sum(ss, lane);
    const float rstd = 1.0f / sqrtf(ss / Dm + EPSF);
    const float* mr = mod_row(p, l, (int)row);
    const float* g = p.norm1_g + l * Dm;
#pragma unroll
    for (int i = 0; i < 4; ++i) {
        const int k = 256 * i + 4 * lane;
        const f32x4 gv = *(const f32x4*)(g + k), sh = *(const f32x4*)(mr + k), sc = *(const f32x4*)(mr + Dm + k);
        const f32x4 y = x[i] * rstd * gv * (1.0f + sc) + sh;
        *(u32x2*)(p.XN + row * Dm + k) = (u32x2){pk2(y[0], y[1]), pk2(y[2], y[3])};
    }
}
DI void bp_norm1(const Params& p, int l, int gwave, int nwaves, int lane) {
    for (long row0 = gwave; row0 < NTOK; row0 += 3 * (long)nwaves) {
        f32x4 x[3][4]; long rw[3];
#pragma unroll
        for (int u = 0; u < 3; ++u) {
            rw[u] = row0 + (long)u * nwaves < NTOK ? row0 + (long)u * nwaves : row0;
            const float* src = rw[u] < NL ? p.x + rw[u] * Dm : p.ctx + (rw[u] - NL) * Dm;
#pragma unroll
            for (int i = 0; i < 4; ++i) x[u][i] = *(const f32x4*)(src + 256 * i + 4 * lane);
        }
#pragma unroll
        for (int u = 0; u < 3; ++u) if (u == 0 || row0 + (long)u * nwaves < NTOK) norm1_row(p, l, rw[u], x[u], lane);
    }
}
template <bool DRY>
DI void bp_combine(const Params& p, int l, bool upd, unsigned char* smem, int gwave, int nwaves, int lane) {
    const int* s_moff = moe_prep(p, l, smem);
    const long rows = upd ? NTOK : NL;
    const long rpw = (rows + nwaves - 1) / nwaves, rbeg = (long)gwave * rpw, rend = rbeg + rpw < rows ? rbeg + rpw : rows;
    constexpr int CU_ = 3;
    int mb_loaded = -1;
    f32x4 g2v[4], mulv[4], addv[4];
    for (long row0 = rbeg; row0 < rend; row0 += CU_) {
        long rw[CU_]; bool ok[CU_]; size_t pa[CU_], pb[CU_]; float g0[CU_], g1[CU_];
#pragma unroll
        for (int u = 0; u < CU_; ++u) {
            rw[u] = row0 + u; ok[u] = rw[u] < rend; if (!ok[u]) rw[u] = row0;
            const int e0 = p.EID[rw[u] * 2], e1 = p.EID[rw[u] * 2 + 1];
            pa[u] = (size_t)s_moff[e0] * 128 + p.POS[rw[u] * 2]; pb[u] = (size_t)s_moff[e1] * 128 + p.POS[rw[u] * 2 + 1];
            g0[u] = p.GATE[rw[u] * 2]; g1[u] = p.GATE[rw[u] * 2 + 1];
        }
        f32x4 ya[CU_][4], xo[CU_][4];
#pragma unroll
        for (int u = 0; u < CU_; ++u)
#pragma unroll
            for (int i = 0; i < 4; ++i) {
                const int k = 256 * i + 4 * lane;
                const u32x2 a2 = *(const u32x2*)(p.Y + pa[u] * Dm + k), b2 = *(const u32x2*)(p.Y + pb[u] * Dm + k);
                ya[u][i] = (f32x4){g0[u] * bflo(a2[0]) + g1[u] * bflo(b2[0]), g0[u] * bfhi(a2[0]) + g1[u] * bfhi(b2[0]), g0[u] * bflo(a2[1]) + g1[u] * bflo(b2[1]), g0[u] * bfhi(a2[1]) + g1[u] * bfhi(b2[1])};
                xo[u][i] = *(const f32x4*)(p.X + rw[u] * Dm + k);
            }
#pragma unroll
        for (int u = 0; u < CU_; ++u) {
            if (!ok[u]) continue;
            const int mb = tok_modrow((int)rw[u]);
            if (mb != mb_loaded) {
                mb_loaded = mb;
                const float* mr = p.mod + ((size_t)l * (Bn + 1) + mb) * MODW;
                const float* mrn = p.mod + ((size_t)(l + 1 < DEPTH ? l + 1 : l) * (Bn + 1) + mb) * MODW;
                const float* gn = p.norm1_g + (l + 1 < DEPTH ? l + 1 : l) * Dm;
#pragma unroll
                for (int i = 0; i < 4; ++i) {
                    const int k = 256 * i + 4 * lane;
                    g2v[i] = *(const f32x4*)(mr + 5 * Dm + k);
                    mulv[i] = *(const f32x4*)(gn + k) * (1.0f + *(const f32x4*)(mrn + Dm + k)); addv[i] = *(const f32x4*)(mrn + k);
                }
            }
            f32x4 x[4]; float ss = 0.f;
#pragma unroll
            for (int i = 0; i < 4; ++i) { x[i] = xo[u][i] + g2v[i] * ya[u][i]; ss += x[i][0] * x[i][0] + x[i][1] * x[i][1] + x[i][2] * x[i][2] + x[i][3] * x[i][3]; }
            if (!DRY) {
#pragma unroll
                for (int i = 0; i < 4; ++i) { const int k = 256 * i + 4 * lane; if (l == DEPTH - 1) *(f32x4*)(p.out + rw[u] * Dm + k) = x[i]; else *(f32x4*)(p.X + rw[u] * Dm + k) = x[i]; }
            }
            if (l < DEPTH - 1) {
                ss = wave_sum(ss, lane);
                const float rstd = 1.0f / sqrtf(ss / Dm + EPSF);
#pragma unroll
                for (int i = 0; i < 4; ++i) {
                    const f32x4 y = x[i] * rstd * mulv[i] + addv[i];
                    *(u32x2*)(p.XN + rw[u] * Dm + 256 * i + 4 * lane) = (u32x2){pk2(y[0], y[1]), pk2(y[2], y[3])};
                }
            }
        }
    }
}

template <int DQK, int DV>
struct AttnCfg {
    static constexpr int KP = DQK * 2 + 16, VP = 144;
    static constexpr int KCH = DQK / 8;
    static constexpr int NK = 64 * KCH, NV = DV * 8, NCH = NK + NV, NLD = (NCH + NTHR - 1) / NTHR;
    static constexpr int LDS_K = 0, LDS_V = 64 * KP, LDS_END = LDS_V + DV * VP;
    static_assert(LDS_END <= GT_END, "attention tile exceeds the LDS budget");
};

template <int DQK, int DV>
DI void attn_block(unsigned char* smem, const act_t* Qb, const act_t* Kb, const act_t* Vt, const int nk, const int q0, f32x16 (&ot)[DV / 32], float& lsum) {
    typedef AttnCfg<DQK, DV> C;
    const int tid = opaque_tid(), lane = tid & 63, w = tid >> 6, h = lane >> 5, qr = lane & 31;
    const int pi = (qr & ~12) | ((qr & 4) << 1) | ((qr & 8) >> 1);
    bf16x8 qf[DQK / 16];
#pragma unroll
    for (int st = 0; st < DQK / 16; ++st) qf[st] = *(const bf16x8*)(Qb + (size_t)(q0 + w * 32 + qr) * DQK + st * 16 + h * 8);
    float m = -1e30f; lsum = 0.f;
#pragma unroll
    for (int db = 0; db < DV / 32; ++db)
#pragma unroll
        for (int r = 0; r < 16; ++r) ot[db][r] = 0.f;
    int goff[C::NLD], ldst[C::NLD];
#pragma unroll
    for (int i = 0; i < C::NLD; ++i) {
        const int c = tid + NTHR * i;
        if (c < C::NK) { const int row = c / C::KCH, part = c % C::KCH; goff[i] = (row * DQK + part * 8) * 2; ldst[i] = C::LDS_K + row * C::KP + part * 16; }
        else { const int cc = (c - C::NK) < C::NV ? c - C::NK : 0, row = cc >> 3, part = cc & 7; goff[i] = (int)((const char*)Vt - (const char*)Kb) + (row * Sn + part * 8) * 2; ldst[i] = C::LDS_V + row * C::VP + part * 16; }
    }
    u32x4 rg[C::NLD];
#pragma unroll
    for (int i = 0; i < C::NLD; ++i) rg[i] = *(const u32x4*)((const char*)Kb + goff[i]);
    const int ntiles = nk >> 6;
    for (int kt = 0; kt < ntiles; ++kt) {
        __syncthreads();
#pragma unroll
        for (int i = 0; i < C::NLD; ++i) if (tid + NTHR * i < C::NCH) *(u32x4*)(smem + ldst[i]) = rg[i];
        __syncthreads();
        if (kt + 1 < ntiles) {
#pragma unroll
            for (int i = 0; i < C::NLD; ++i) rg[i] = *(const u32x4*)((const char*)Kb + goff[i] + (kt + 1) * ((tid + NTHR * i < C::NK) ? 128 * DQK : 128));
        }
        f32x16 sc[2];
        __builtin_amdgcn_s_setprio(1);
#pragma unroll
        for (int kb = 0; kb < 2; ++kb) {
#pragma unroll
            for (int r = 0; r < 16; ++r) sc[kb][r] = 0.f;
#pragma unroll
            for (int st = 0; st < DQK / 16; ++st) {
                const bf16x8 a = *(const bf16x8*)(smem + C::LDS_K + (kb * 32 + pi) * C::KP + st * 32 + h * 16);
                sc[kb] = __builtin_amdgcn_mfma_f32_32x32x16_bf16(a, qf[st], sc[kb], 0, 0, 0);
            }
        }
        __builtin_amdgcn_s_setprio(0);
        float mx = sc[0][0];
#pragma unroll
        for (int kb = 0; kb < 2; ++kb)
#pragma unroll
            for (int r = 0; r < 16; ++r) mx = fmaxf(mx, sc[kb][r]);
        mx = fmaxf(mx, shfl_x(mx, 32, lane));
        const float mn = fmaxf(m, mx), alpha = __builtin_amdgcn_exp2f(m - mn);
        m = mn;
        float ps = 0.f;
#pragma unroll
        for (int kb = 0; kb < 2; ++kb)
#pragma unroll
            for (int r = 0; r < 16; ++r) { sc[kb][r] = __builtin_amdgcn_exp2f(sc[kb][r] - mn); ps += sc[kb][r]; }
        lsum = lsum * alpha + ps;
#pragma unroll
        for (int db = 0; db < DV / 32; ++db)
#pragma unroll
            for (int r = 0; r < 16; ++r) ot[db][r] *= alpha;
#pragma unroll
        for (int kb = 0; kb < 2; ++kb)
#pragma unroll
            for (int s2 = 0; s2 < 2; ++s2) {
                const u32x4 pw = {pk2(sc[kb][8 * s2], sc[kb][8 * s2 + 1]), pk2(sc[kb][8 * s2 + 2], sc[kb][8 * s2 + 3]), pk2(sc[kb][8 * s2 + 4], sc[kb][8 * s2 + 5]), pk2(sc[kb][8 * s2 + 6], sc[kb][8 * s2 + 7])};
                const bf16x8 pf = __builtin_bit_cast(bf16x8, pw);
#pragma unroll
                for (int db = 0; db < DV / 32; ++db) {
                    const bf16x8 a = *(const bf16x8*)(smem + C::LDS_V + (db * 32 + qr) * C::VP + (kb * 32 + 16 * s2 + 8 * h) * 2);
                    ot[db] = __builtin_amdgcn_mfma_f32_32x32x16_bf16(a, pf, ot[db], 0, 0, 0);
                }
            }
    }
    lsum += shfl_x(lsum, 32, lane);
}

DI void bp_attn(const Params& p, int l, bool upd, unsigned char* smem, int bid, int G) {
    constexpr int QTL = Tn / 128, QTC = Cn / 128;
    const int n_dl = Bn * 4 * QTL, n_gl = Bn * 6 * QTL, n_dc = upd ? Bn * 4 * QTC : 0, n_gc = upd ? Bn * 6 * QTC : 0;
    const int tid = opaque_tid(), lane = tid & 63, w = tid >> 6, hh = lane >> 5, qr = lane & 31;
    const float lam_init = lam_init_of(l);
    for (int it = bid; it < n_dl + n_gl + n_dc + n_gc; it += G) {
        int x = it; bool isdiff, isc;
        if (x < n_dl) { isdiff = true; isc = false; }
        else if ((x -= n_dl) < n_gl) { isdiff = false; isc = false; }
        else if ((x -= n_gl) < n_dc) { isdiff = true; isc = true; }
        else { x -= n_dc; isdiff = false; isc = true; }
        const int qt_n = isc ? QTC : QTL, qlen = isc ? Cn : Tn, nk = isc ? Cn : Sn;
        const int qt = x % qt_n, hb = x / qt_n;
        const int q0 = qt * 128;
        if (isdiff) {
            const int h = hb % 4, b = hb / 4;
            const act_t* Vt = p.DVt + (size_t)(b * 4 + h) * 96 * Sn;
            f32x16 ot[3]; float ls;
            f32x4* stash = (f32x4*)(p.DO + ((size_t)blockIdx.x * NTHR + tid) * 48);
            attn_block<48, 96>(smem, (isc ? p.DQC : p.DQL) + ((size_t)(b * 4 + h) * 2) * qlen * 48, p.DK + ((size_t)(b * 4 + h) * 2) * Sn * 48, Vt, nk, q0, ot, ls);
            {
                const float i1 = 1.0f / ls;
#pragma unroll
                for (int db = 0; db < 3; ++db)
#pragma unroll
                    for (int g = 0; g < 4; ++g) stash[db * 4 + g] = (f32x4){ot[db][4 * g] * i1, ot[db][4 * g + 1] * i1, ot[db][4 * g + 2] * i1, ot[db][4 * g + 3] * i1};
            }
            attn_block<48, 96>(smem, (isc ? p.DQC : p.DQL) + ((size_t)(b * 4 + h) * 2 + 1) * qlen * 48, p.DK + ((size_t)(b * 4 + h) * 2 + 1) * Sn * 48, Vt, nk, q0, ot, ls);
            const float* dl = p.diff_lambda + l * 4 * 48;
            float s01 = 0.f, s23 = 0.f;
            for (int i = 0; i < 48; ++i) { s01 += dl[i] * dl[48 + i]; s23 += dl[96 + i] * dl[144 + i]; }
            const float lam = expf(s01) - expf(s23) + lam_init;
            const float i2 = lam / ls;
            float ss = 0.f;
#pragma unroll
            for (int db = 0; db < 3; ++db)
#pragma unroll
                for (int g = 0; g < 4; ++g) {
                    const f32x4 o1 = stash[db * 4 + g];
#pragma unroll
                    for (int r = 0; r < 4; ++r) { const float v = o1[r] - ot[db][4 * g + r] * i2; ot[db][4 * g + r] = v; ss += v * v; }
                }
            ss += shfl_x(ss, 32, lane);
            const float rstd = 1.0f / sqrtf(ss / 96 + EPSF) * (1.0f - lam_init);
            const float* sg = p.diff_subln + l * 96;
            const size_t tok = isc ? (size_t)NL + b * Cn + q0 + w * 32 + qr : (size_t)b * Tn + q0 + w * 32 + qr;
#pragma unroll
            for (int db = 0; db < 3; ++db)
#pragma unroll
                for (int g = 0; g < 4; ++g) {
                    const int dv = db * 32 + 8 * g + 4 * hh;
                    const f32x4 sv = *(const f32x4*)(sg + dv);
                    *(u32x2*)(p.MIX + tok * Dm + h * 96 + dv) = (u32x2){pk2(ot[db][4 * g] * rstd * sv[0], ot[db][4 * g + 1] * rstd * sv[1]),
                                                                      pk2(ot[db][4 * g + 2] * rstd * sv[2], ot[db][4 * g + 3] * rstd * sv[3])};
                }
        } else {
            const int hq = hb % 6, b = hb / 6, kv = hq / 3;
            f32x16 ot[2]; float ls;
            attn_block<64, 64>(smem, (isc ? p.GQC : p.GQL) + (size_t)(b * 6 + hq) * qlen * 64, p.GK + (size_t)(b * 2 + kv) * Sn * 64, p.GVt + (size_t)(b * 2 + kv) * 64 * Sn, nk, q0, ot, ls);
            const float il = 1.0f / ls;
            const size_t tok = isc ? (size_t)NL + b * Cn + q0 + w * 32 + qr : (size_t)b * Tn + q0 + w * 32 + qr;
#pragma unroll
            for (int db = 0; db < 2; ++db)
#pragma unroll
                for (int g = 0; g < 4; ++g) {
                    const int dv = db * 32 + 8 * g + 4 * hh;
                    *(u32x2*)(p.MIX + tok * Dm + 384 + hq * 64 + dv) = (u32x2){pk2(ot[db][4 * g] * il, ot[db][4 * g + 1] * il), pk2(ot[db][4 * g + 2] * il, ot[db][4 * g + 3] * il)};
                }
        }
    }
}

DI void bp_mod(const Params& p, unsigned char* smem, int bid, int G, long gtid, long gsize) {
    const int tid = opaque_tid(), lane = tid & 63, w = tid >> 6;
    float* sl = (float*)smem;
    float* red = sl + (Bn + 1) * Dm;
    for (int i = tid; i < (Bn + 1) * Dm; i += NTHR) sl[i] = silu_f(i < Bn * Dm ? p.c[i] : p.c_ctx[i - Bn * Dm]);
    __syncthreads();
    const int ks = tid >> 4, j4 = tid & 15;
    for (int item = bid; item < DEPTH * (MODW / 64); item += G) {
        const int l = item / (MODW / 64), col = (item % (MODW / 64)) * 64 + j4 * 4;
        const float* wp = p.w_mod + ((size_t)l * Dm + ks * 64) * MODW + col;
        f32x4 acc[Bn + 1];
#pragma unroll
        for (int r = 0; r <= Bn; ++r) acc[r] = (f32x4){0.f, 0.f, 0.f, 0.f};
#pragma unroll 8
        for (int kk = 0; kk < 64; ++kk) {
            const f32x4 wv = *(const f32x4*)(wp + (size_t)kk * MODW);
#pragma unroll
            for (int r = 0; r <= Bn; ++r) acc[r] = acc[r] + sl[r * Dm + ks * 64 + kk] * wv;
        }
#pragma unroll
        for (int r = 0; r <= Bn; ++r)
#pragma unroll
            for (int e = 0; e < 4; ++e) { float v = acc[r][e]; v += shfl_x(v, 16, lane); v += shfl_x(v, 32, lane); acc[r][e] = v; }
        __syncthreads();
        if (lane < 16)
#pragma unroll
            for (int r = 0; r <= Bn; ++r) *(f32x4*)(red + ((w * 16 + lane) * (Bn + 1) + r) * 4) = acc[r];
        __syncthreads();
        if (tid < 16 * (Bn + 1)) {
            const int jj = tid & 15, r = tid >> 4;
            f32x4 t = *(const f32x4*)(p.b_mod + l * MODW + (item % (MODW / 64)) * 64 + jj * 4);
#pragma unroll
            for (int ww = 0; ww < 4; ++ww) t = t + *(const f32x4*)(red + ((ww * 16 + jj) * (Bn + 1) + r) * 4);
            *(f32x4*)(p.mod + ((size_t)l * (Bn + 1) + r) * MODW + (item % (MODW / 64)) * 64 + jj * 4) = t;
        }
    }
    (void)gtid; (void)gsize;
}

DI size_t chunk_slot(int b, int h, int dir, int cid) { return (size_t)((b * 4 + h) * 2 + dir) * NCH + cid; }
DI float wave_incl_scan_add(float v, int lane, bool rev) {
#pragma unroll
    for (int o = 1; o < 64; o <<= 1) { const float t = shfl_i(v, (rev ? lane + o : lane - o) & 63); const bool ok = rev ? (lane + o < 64) : (lane >= o); if (ok) v += t; }
    return v;
}
DI float wave_incl_scan_max(float v, int lane, bool rev) {
#pragma unroll
    for (int o = 1; o < 64; o <<= 1) { const float t = shfl_i(v, (rev ? lane + o : lane - o) & 63); const bool ok = rev ? (lane + o < 64) : (lane >= o); if (ok) v = fmaxf(v, t); }
    return v;
}
DI void bp_post(const Params& p, int l, unsigned char* smem, int bid, int G) {
    const int tid = opaque_tid(), lane = tid & 63, w = tid >> 6;
    constexpr int NGRP = NTOK / 64, N_M = NGRP * 4, N_V = NGRP * 4, N_Q = NTOK / 16;
    volatile int* s_item = (volatile int*)(smem + SM_AUX + 512);
    unsigned* ctr = p.BAR + 3700 + l;
    (void)bid; (void)G;
    for (;;) {
        __syncthreads();
        if (threadIdx.x == 0) *s_item = (int)atomicAdd(ctr, 1u);
        __syncthreads();
        const int item = *s_item;
        if (item >= N_M + N_V + N_Q) break;
        if (item >= N_M + N_V) {
            const int tokb = (item - N_M - N_V) * 16 + w * 4;
            const int j = lane & 15, ug = lane >> 4, third = j / 3;
            f32x4 gvv[6];
#pragma unroll
            for (int st = 0; st < 6; ++st) {
                const int u = st * 4 + ug; const bool d64 = st >= 4;
                const float* gw = !d64 ? ((u >= 8 ? p.diff_k_norm : p.diff_q_norm) + l * 48) : ((u >= 22 ? p.gqa_k_norm : p.gqa_q_norm) + l * 64);
                gvv[st] = (d64 || j < 12) ? *(const f32x4*)(gw + 4 * j) : (f32x4){0.f, 0.f, 0.f, 0.f};
            }
#pragma unroll 2
            for (int t4 = 0; t4 < 4; ++t4) {
                const int tok = tokb + t4; const bool isc = tok >= NL;
                const int b = tok_b(tok), ti = tok_i(tok), sx = tok_s(tok);
                const act_t* pr = p.PROJB + (size_t)tok * INW;
                f32x4 xs[6], t0s[6], t1s[6];
#pragma unroll
                for (int st = 0; st < 6; ++st) {
                    const int u = st * 4 + ug; const bool d64 = st >= 4;
                    const int soff = !d64 ? ((u >= 8 ? DK_OFF : DQ_OFF) + ((u & 7) >> 1) * 96 + (u & 1) * 48) : (u >= 22 ? GK_OFF + (u - 22) * 64 : GQ_OFF + (u - 16) * 64);
                    const bool act = d64 || j < 12;
                    xs[st] = act ? ld4bf(pr + soff + 4 * j) : (f32x4){0.f, 0.f, 0.f, 0.f};
                    const bool second = d64 ? (j >= 8) : (j >= 6);
                    const int pos = second ? (ti & 63) : (ti >> 6);
                    const int fi0 = d64 ? 12 + (j & 3) * 4 : (j - third * 3) * 4;
                    const float* rt = p.ROPE + ((size_t)pos * 28 + (act ? fi0 : 0)) * 2;
                    t0s[st] = *(const f32x4*)rt; t1s[st] = *(const f32x4*)(rt + 4);
                }
#pragma unroll
                for (int st = 0; st < 6; ++st) {
                    const int u = st * 4 + ug; const bool d64 = st >= 4;
                    act_t* dst; float osc;
                    if (!d64) {
                        const bool isk = u >= 8; const int hh = (u & 7) >> 1, ww = u & 1;
                        osc = isk ? 1.0f : 0.14433756729740643f * LOG2E;
                        dst = isk ? p.DK + (((size_t)(b * 4 + hh) * 2 + ww) * Sn + sx) * 48
                                  : (isc ? p.DQC + (((size_t)(b * 4 + hh) * 2 + ww) * Cn + ti) * 48 : p.DQL + (((size_t)(b * 4 + hh) * 2 + ww) * Tn + ti) * 48);
                    } else {
                        const bool isk = u >= 22; const int hh = isk ? u - 22 : u - 16;
                        osc = isk ? 1.0f : 0.125f * LOG2E;
                        dst = isk ? p.GK + ((size_t)(b * 2 + hh) * Sn + sx) * 64 : (isc ? p.GQC + ((size_t)(b * 6 + hh) * Cn + ti) * 64 : p.GQL + ((size_t)(b * 6 + hh) * Tn + ti) * 64);
                    }
                    const bool act = d64 || j < 12;
                    const f32x4 x = xs[st];
                    const float ss = row16_sum(x[0] * x[0] + x[1] * x[1] + x[2] * x[2] + x[3] * x[3]);
                    const float rstd = 1.0f / sqrtf(ss / (d64 ? 64.f : 48.f) + EPSF);
                    f32x4 y = x * rstd * gvv[st];
                    if (!isc) {
                        const int plane = d64 ? (lane ^ 4) : ((third & 1) ? lane - 3 : lane + 3);
                        f32x4 py;
#pragma unroll
                        for (int r = 0; r < 4; ++r) py[r] = shfl_i(y[r], plane);
                        const bool isx2 = d64 ? ((j & 4) != 0) : ((third & 1) != 0);
                        const f32x4 t0 = t0s[st], t1 = t1s[st];
                        const f32x4 cs = {t0[0], t0[2], t1[0], t1[2]}, sn = {t0[1], t0[3], t1[1], t1[3]};
                        y = isx2 ? y * cs + py * sn : y * cs - py * sn;
                    }
                    y = y * osc;
                    if (act) *(u32x2*)(dst + 4 * j) = (u32x2){pk2(y[0], y[1]), pk2(y[2], y[3])};
                }
            }
        } else if (item >= N_M) {
            const int g = (item - N_M) >> 2, qd = (item - N_M) & 3;
            const int tok0 = g * 64;
            const int b = tok_b(tok0), s0 = tok_s(tok0);
            __syncthreads();
#pragma unroll
            for (int i = 0; i < 8; ++i) {
                const int c = tid + NTHR * i, tt = c >> 5, d4 = c & 31, vd = qd * 128 + d4 * 4;
                *(u32x2*)(smem + tt * 264 + d4 * 8) = *(const u32x2*)(p.PROJB + (size_t)(tok0 + tt) * INW + (vd < 384 ? DV_OFF + vd : GV_OFF + vd - 384));
            }
            __syncthreads();
#pragma unroll
            for (int i = 0; i < 4; ++i) {
                const int o = tid + NTHR * i, dloc = o >> 3, t8 = o & 7, vd = qd * 128 + dloc;
                unsigned e[8];
#pragma unroll
                for (int r = 0; r < 8; ++r) e[r] = *(const unsigned short*)(smem + (t8 * 8 + r) * 264 + dloc * 2);
                act_t* dst = vd < 384 ? p.DVt + ((size_t)(b * 4 + vd / 96) * 96 + vd % 96) * Sn : p.GVt + ((size_t)(b * 2 + (vd - 384) / 64) * 64 + (vd - 384) % 64) * Sn;
                *(u32x4*)(dst + s0 + t8 * 8) = (u32x4){e[0] | (e[1] << 16), e[2] | (e[3] << 16), e[4] | (e[5] << 16), e[6] | (e[7] << 16)};
            }
        } else {
            const int g = item >> 2, h = item & 3;
            const int tok0 = g * 64; const bool isc = tok0 >= NL;
            const int b = tok_b(tok0), ti0 = tok_i(tok0);
        float* kf = (float*)smem; float* vf = kf + 64 * 68; float* gl = vf + 64 * 68;
        const int cid = isc ? ti0 / 64 : NCC + ti0 / 64;
            __syncthreads();
            {
                const int tt = tid >> 2, c16 = tid & 3, ti = ti0 + tt, seglen = isc ? Cn : Tn;
                const act_t* pr = p.PROJB + (size_t)(tok0 + tt) * INW;
                const bool hasp = ti > 0, hasn = ti < seglen - 1;
                const float* cw = p.mlstm_conv_w + (size_t)l * 1536; const float* cb = p.mlstm_conv_b + l * 512;
#pragma unroll
                for (int part = 0; part < 2; ++part)
#pragma unroll
                    for (int i4 = 0; i4 < 4; ++i4) {
                        const int ch = part * 256 + h * 64 + c16 * 16 + i4 * 4;
                        f32x4 a = *(const f32x4*)(cb + ch) + ld4bf(pr + MQK_OFF + ch) * *(const f32x4*)(cw + 512 + ch);
                        if (hasp) a = a + ld4bf(pr - INW + MQK_OFF + ch) * *(const f32x4*)(cw + ch);
                        if (hasn) a = a + ld4bf(pr + INW + MQK_OFF + ch) * *(const f32x4*)(cw + 1024 + ch);
#pragma unroll
                        for (int r = 0; r < 4; ++r) a[r] = a[r] / (1.0f + __expf(-a[r]));
                        if (part) { a = a * 0.125f; *(f32x4*)(kf + tt * 68 + c16 * 16 + i4 * 4) = a; }
                        *(u32x2*)(p.MQKB + (size_t)(tok0 + tt) * 512 + ch) = (u32x2){pk2(a[0], a[1]), pk2(a[2], a[3])};
#if !IMPL_MLSTM
                        *(f32x4*)(p.MQK + (size_t)(tok0 + tt) * 512 + ch) = a;
#endif
                    }
#pragma unroll
                for (int i4 = 0; i4 < 4; ++i4) *(f32x4*)(vf + tt * 68 + c16 * 16 + i4 * 4) = ld4bf(pr + MV_OFF + h * 64 + c16 * 16 + i4 * 4);
            }
            if (tid < 64) {
                const float* pr = p.PG + (size_t)(tok0 + tid) * 16; const float* gb = p.mlstm_gate_b + l * 16;
                const f32x4 gt = {pr[h] + gb[h], logsigmoid_f(pr[4 + h] + gb[4 + h]), pr[8 + h] + gb[8 + h], logsigmoid_f(pr[12 + h] + gb[12 + h])};
                gl[tid] = gt[0]; gl[128 + tid] = gt[1]; gl[64 + tid] = gt[2]; gl[192 + tid] = gt[3];
                *(f32x4*)(p.MG4 + ((size_t)(tok0 + tid) * 4 + h) * 4) = gt;
#if !IMPL_MLSTM
                { float* mg = p.MGATE + (size_t)(tok0 + tid) * 16; mg[h] = gt[0]; mg[4 + h] = gt[1]; mg[8 + h] = gt[2]; mg[12 + h] = gt[3]; }
#endif
            }
            __syncthreads();
            if (w < 2) {
                const int dir = w;
                const float lf = gl[128 + dir * 64 + lane], li = gl[dir * 64 + lane];
                const float inc = wave_incl_scan_add(lf, lane, dir == 0);
                const float gg = inc - lf + li;
                float mloc = gg;
#pragma unroll
                for (int o = 32; o > 0; o >>= 1) mloc = fmaxf(mloc, shfl_x(mloc, o, lane));
                gl[256 + dir * 64 + lane] = __expf(gg - mloc);
                const float E = wave_sum(lf, lane);
                if (lane == 0) { float* cs = p.CHS + chunk_slot(b, h, dir, cid) * 2; cs[0] = mloc; cs[1] = E; }
            }
            __syncthreads();
            {
                const int v0 = (tid >> 4) * 4, d0 = (tid & 15) * 4;
                f32x4 a0[4], a1[4];
#pragma unroll
                for (int i = 0; i < 4; ++i) { a0[i] = (f32x4){0.f, 0.f, 0.f, 0.f}; a1[i] = (f32x4){0.f, 0.f, 0.f, 0.f}; }
                for (int sx = 0; sx < 64; ++sx) {
                    const f32x4 vv = *(const f32x4*)(vf + sx * 68 + v0), kk = *(const f32x4*)(kf + sx * 68 + d0);
                    const float w0 = gl[256 + sx], w1 = gl[320 + sx];
#pragma unroll
                    for (int i = 0; i < 4; ++i) { a0[i] = a0[i] + (w0 * vv[i]) * kk; a1[i] = a1[i] + (w1 * vv[i]) * kk; }
                }
                float* kv0 = p.KV + chunk_slot(b, h, 0, cid) * 4096; float* kv1 = p.KV + chunk_slot(b, h, 1, cid) * 4096;
#pragma unroll
                for (int i = 0; i < 4; ++i) { *(f32x4*)(kv0 + (v0 + i) * 64 + d0) = a0[i]; *(f32x4*)(kv1 + (v0 + i) * 64 + d0) = a1[i]; }
                if (tid < 128) {
                    const int dir = tid >> 6, d = tid & 63;
                    float acc = 0.f;
                    for (int sx = 0; sx < 64; ++sx) acc += gl[256 + dir * 64 + sx] * kf[sx * 68 + d];
                    p.NLC[chunk_slot(b, h, dir, cid) * 64 + d] = acc;
                }
            }
        }
    }
}

constexpr int ML_Q = 0, ML_K = 9216, ML_VT = 18432, ML_C = 29952, ML_QA = 41472, ML_SC = 50688;
constexpr int SC_LI = 0, SC_LF = 128, SC_BB = 256, SC_MT = 384, SC_AA = 512, SC_UU = 640, SC_WCH = 768;
static_assert(ML_SC + (SC_WCH + 80) * 4 <= SMEM_BYTES - 16, "mLSTM LDS layout exceeds the budget");
DI int ml_scanpos(int dir, int cid) { return dir == 0 ? cid : (cid < NCC ? NCC - 1 - cid : NCC + (NCH - 1 - cid)); }
DI int ml_cid_at(int dir, int i) { return dir == 0 ? i : (i < NCC ? NCC - 1 - i : NCH - 1 - (i - NCC)); }
DI void bp_mlstm(const Params& p, int l, bool upd, unsigned char* smem, int bid, int G) {
    const int tid = opaque_tid(), lane = tid & 63, w = tid >> 6;
    float* sc = (float*)(smem + ML_SC);
    constexpr int CPL = Tn / 64;
    const int nlat = Bn * 4 * CPL, nctx = upd ? Bn * 4 * NCC : 0;
    for (int it = bid; it < nlat + nctx; it += G) {
        int b, h, cid;
        if (it < nlat) { cid = NCC + it % CPL; h = (it / CPL) % 4; b = it / (CPL * 4); }
        else { const int x = it - nlat; cid = x % NCC; h = (x / NCC) % 4; b = x / (NCC * 4); }
        const int tok0 = cid < NCC ? NL + b * Cn + cid * 64 : b * Tn + (cid - NCC) * 64;
        __syncthreads();
#pragma unroll
        for (int i = 0; i < 4; ++i) {
            const int c = tid + NTHR * i, isk = c >> 9, cc = c & 511, row = cc >> 3, part = cc & 7;
            *(u32x4*)(smem + (isk ? ML_K : ML_Q) + row * 144 + part * 16) = *(const u32x4*)(p.MQKB + (size_t)(tok0 + row) * 512 + isk * 256 + h * 64 + part * 8);
        }
#pragma unroll
        for (int i = 0; i < 2; ++i) {
            const int c = tid + NTHR * i, tt = c >> 3, v8 = c & 7;
            const u32x4 vv = *(const u32x4*)(p.PROJB + (size_t)(tok0 + tt) * INW + MV_OFF + h * 64 + v8 * 8);
            const unsigned pa = vv[0], pb = vv[1], pc = vv[2], pd = vv[3];
            unsigned char* d0 = smem + ML_VT + (v8 * 8) * 144 + tt * 2;
            *(unsigned short*)(d0) = (unsigned short)pa; *(unsigned short*)(d0 + 144) = (unsigned short)(pa >> 16);
            *(unsigned short*)(d0 + 288) = (unsigned short)pb; *(unsigned short*)(d0 + 432) = (unsigned short)(pb >> 16);
            *(unsigned short*)(d0 + 576) = (unsigned short)pc; *(unsigned short*)(d0 + 720) = (unsigned short)(pc >> 16);
            *(unsigned short*)(d0 + 864) = (unsigned short)pd; *(unsigned short*)(d0 + 1008) = (unsigned short)(pd >> 16);
        }
        if (tid < 144) {
            unsigned zz = 0u; asm volatile("" : "+v"(zz));
            const unsigned one2 = tid < 9 ? 0x3F803F80u : zz;
            *(u32x4*)(smem + ML_VT + 64 * 144 + tid * 16) = (u32x4){one2, one2, one2, one2};
            *(u32x4*)(smem + ML_C + 64 * 144 + tid * 16) = (u32x4){zz, zz, zz, zz};
        }
        if (tid < 64) {
            const f32x4 gt = *(const f32x4*)(p.MG4 + ((size_t)(tok0 + tid) * 4 + h) * 4);
            sc[SC_LI + tid] = gt[0]; sc[SC_LF + tid] = gt[1]; sc[SC_LI + 64 + tid] = gt[2]; sc[SC_LF + 64 + tid] = gt[3];
        }
        __syncthreads();
        if (w < 2) {
            const int dir = w, pj = ml_scanpos(dir, cid);
            const float lf = sc[SC_LF + dir * 64 + lane], li = sc[SC_LI + dir * 64 + lane];
            const float bsum = wave_incl_scan_add(lf, lane, dir == 1);
            const float u = li - bsum;
            const float cm = wave_incl_scan_max(u, lane, dir == 1);
            float m = 0.f;
            for (int i = 0; i < pj; ++i) { const float* cs = p.CHS + chunk_slot(b, h, dir, ml_cid_at(dir, i)) * 2; m = fmaxf(cs[1] + m, cs[0]); }
            float F = 0.f;
            for (int i = pj - 1; i >= 0; --i) { const float* cs = p.CHS + chunk_slot(b, h, dir, ml_cid_at(dir, i)) * 2; if (lane == 0) sc[SC_WCH + dir * 40 + i] = __expf(cs[0] + F - m); F += cs[1]; }
            const float mt = bsum + fmaxf(m, cm);
            sc[SC_BB + dir * 64 + lane] = bsum; sc[SC_UU + dir * 64 + lane] = u; sc[SC_MT + dir * 64 + lane] = mt; sc[SC_AA + dir * 64 + lane] = __expf(bsum + m - mt);
        }
        f32x4 sacc[4];
#pragma unroll
        for (int si = 0; si < 4; ++si) sacc[si] = (f32x4){0.f, 0.f, 0.f, 0.f};
#pragma unroll
        for (int ks = 0; ks < 2; ++ks) {
            const bf16x8 bq = *(const bf16x8*)(smem + ML_Q + (16 * w + (lane & 15)) * 144 + ks * 64 + (lane >> 4) * 16);
#pragma unroll
            for (int si = 0; si < 4; ++si) {
                const bf16x8 ak = *(const bf16x8*)(smem + ML_K + (si * 16 + (lane & 15)) * 144 + ks * 64 + (lane >> 4) * 16);
                sacc[si] = __builtin_amdgcn_mfma_f32_16x16x32_bf16(ak, bq, sacc[si], 0, 0, 0);
            }
        }
        __syncthreads();
        f32x4 hs[4];
#pragma unroll
        for (int vt = 0; vt < 4; ++vt) hs[vt] = (f32x4){0.f, 0.f, 0.f, 0.f};
        const int pcol = 16 * w + (lane & 15);
#pragma unroll 1
        for (int dir = 0; dir < 2; ++dir) {
            {
                const int pj = ml_scanpos(dir, cid);
                f32x4 ca[4]; float na = 0.f;
#pragma unroll
                for (int q4 = 0; q4 < 4; ++q4) ca[q4] = (f32x4){0.f, 0.f, 0.f, 0.f};
                for (int i0 = 0; i0 < pj; i0 += 4) {
                    f32x4 kvv[4][4]; float nv[4], wgs[4];
#pragma unroll
                    for (int u = 0; u < 4; ++u) {
                        const int i = i0 + u < pj ? i0 + u : pj - 1;
                        wgs[u] = i0 + u < pj ? sc[SC_WCH + dir * 40 + i] : 0.f;
                        const size_t slot = chunk_slot(b, h, dir, ml_cid_at(dir, i));
                        const float* kv = p.KV + slot * 4096;
#pragma unroll
                        for (int q4 = 0; q4 < 4; ++q4) kvv[u][q4] = *(const f32x4*)(kv + (tid + NTHR * q4) * 4);
                        nv[u] = tid < 64 ? p.NLC[slot * 64 + tid] : 0.f;
                    }
#pragma unroll
                    for (int u = 0; u < 4; ++u) {
#pragma unroll
                        for (int q4 = 0; q4 < 4; ++q4) ca[q4] = ca[q4] + wgs[u] * kvv[u][q4];
                        na += wgs[u] * nv[u];
                    }
                }
#pragma unroll
                for (int q4 = 0; q4 < 4; ++q4) { const int idx = (tid + NTHR * q4) * 4; *(u32x2*)(smem + ML_C + (idx >> 6) * 144 + (idx & 63) * 2) = (u32x2){pk2(ca[q4][0], ca[q4][1]), pk2(ca[q4][2], ca[q4][3])}; }
                if (tid < 64) *(unsigned short*)(smem + ML_C + 64 * 144 + tid * 2) = (unsigned short)pk2(na, 0.f);
            }
            {
                const float mtp = sc[SC_MT + dir * 64 + pcol], bp = sc[SC_BB + dir * 64 + pcol];
#pragma unroll
                for (int si = 0; si < 4; ++si) {
                    const int sb = si * 16 + (lane >> 4) * 4;
                    const f32x4 uu = *(const f32x4*)(sc + SC_UU + dir * 64 + sb);
                    float wv[4];
#pragma unroll
                    for (int r = 0; r < 4; ++r) { const int sx = sb + r; const bool valid = dir == 0 ? (sx <= pcol) : (sx >= pcol); wv[r] = valid ? __expf(bp + uu[r] - mtp) * sacc[si][r] : 0.f; }
                    *(u32x2*)(smem + ML_K + pcol * 144 + sb * 2) = (u32x2){pk2(wv[0], wv[1]), pk2(wv[2], wv[3])};
                }
                const int row = tid >> 2, c16 = tid & 3;
                const float ar = sc[SC_AA + dir * 64 + row];
#pragma unroll
                for (int i2 = 0; i2 < 2; ++i2) {
                    const u32x4 qv = *(const u32x4*)(smem + ML_Q + row * 144 + c16 * 32 + i2 * 16);
                    u32x4 o;
#pragma unroll
                    for (int r = 0; r < 4; ++r) o[r] = pk2(bflo(qv[r]) * ar, bfhi(qv[r]) * ar);
                    *(u32x4*)(smem + ML_QA + row * 144 + c16 * 32 + i2 * 16) = o;
                }
            }
            __syncthreads();
            f32x4 na5[5];
#pragma unroll
            for (int vt = 0; vt < 5; ++vt) na5[vt] = (f32x4){0.f, 0.f, 0.f, 0.f};
#pragma unroll
            for (int ks = 0; ks < 4; ++ks) {
                const bf16x8 bfrag = *(const bf16x8*)(smem + (ks < 2 ? ML_K : ML_QA) + pcol * 144 + (ks & 1) * 64 + (lane >> 4) * 16);
#pragma unroll
                for (int vt = 0; vt < 5; ++vt) {
                    const bf16x8 afrag = *(const bf16x8*)(smem + (ks < 2 ? ML_VT : ML_C) + (vt * 16 + (lane & 15)) * 144 + (ks & 1) * 64 + (lane >> 4) * 16);
                    na5[vt] = __builtin_amdgcn_mfma_f32_16x16x32_bf16(afrag, bfrag, na5[vt], 0, 0, 0);
                }
            }
            const float den = shfl_i(na5[4][0], lane & 15);
            const float dn = 1.0f / fmaxf(fabsf(den), __expf(-sc[SC_MT + dir * 64 + pcol]));
#pragma unroll
            for (int vt = 0; vt < 4; ++vt) hs[vt] = hs[vt] + na5[vt] * dn;
            __syncthreads();
        }
        float ss = 0.f;
#pragma unroll
        for (int vt = 0; vt < 4; ++vt) ss += hs[vt][0] * hs[vt][0] + hs[vt][1] * hs[vt][1] + hs[vt][2] * hs[vt][2] + hs[vt][3] * hs[vt][3];
        ss += shfl_x(ss, 16, lane); ss += shfl_x(ss, 32, lane);
        const float rstd = 1.0f / sqrtf(ss / 64 + EPSF);
        const size_t tok = (size_t)tok0 + pcol;
#pragma unroll
        for (int vt = 0; vt < 4; ++vt) {
            const int v = vt * 16 + (lane >> 4) * 4;
            const f32x4 hn = *(const f32x4*)(p.mlstm_head_norm + l * 256 + h * 64 + v), og = ld4bf(p.PROJB + tok * INW + MO_OFF + h * 64 + v);
            float o[4];
#pragma unroll
            for (int r = 0; r < 4; ++r) o[r] = hs[vt][r] * rstd * hn[r] / (1.0f + __expf(-og[r]));
            *(u32x2*)(p.MIX + tok * Dm + 768 + h * 64 + v) = (u32x2){pk2(o[0], o[1]), pk2(o[2], o[3])};
        }
    }
}

template <bool DRY>
DI void bp_route_fast(const Params& p, int l, bool upd, unsigned char* smem, int bid, int G) {
    const int tid = opaque_tid(), lane = tid & 63, w = tid >> 6;
    const int rows = upd ? NTOK : NL;
    float* Wl = (float*)smem;
    const float* g = p.norm2_g + l * Dm;
    const float* wgp = p.moe_wg + (size_t)l * Dm * 4; const float* wep = p.moe_we + (size_t)l * Dm * 32;
    for (int item = bid; item < rows / 4; item += G) {
        const int r0 = item * 4 + w;
        float rstd[1], pacc[1][36];
#pragma unroll
        for (int rr = 0; rr < 1; ++rr) {
            const float* xr = p.X + (size_t)(r0 + rr) * Dm;
            float ss = 0.f;
#pragma unroll
            for (int j = 0; j < 16; ++j) { const float xv = xr[64 * j + lane]; ss += xv * xv; }
            ss = wave_sum(ss, lane);
            rstd[rr] = 1.0f / sqrtf(ss / Dm + EPSF);
#pragma unroll
            for (int c = 0; c < 36; ++c) pacc[rr][c] = 0.f;
        }
#pragma unroll 1
        for (int ch = 0; ch < 4; ++ch) {
            __syncthreads();
            {
                const int k = ch * 256 + tid;
                *(f32x4*)(Wl + tid * 36) = *(const f32x4*)(wgp + (size_t)k * 4);
#pragma unroll
                for (int q = 0; q < 8; ++q) *(f32x4*)(Wl + tid * 36 + 4 + q * 4) = *(const f32x4*)(wep + (size_t)k * 32 + q * 4);
            }
            __syncthreads();
#pragma unroll
            for (int j = 0; j < 4; ++j) {
                const int k = ch * 256 + 64 * j + lane;
                float f[1];
#pragma unroll
                for (int rr = 0; rr < 1; ++rr) {
                    const float* mr = mod_row(p, l, r0 + rr);
                    f[rr] = p.X[(size_t)(r0 + rr) * Dm + k] * rstd[rr] * g[k] * (1.0f + mr[4 * Dm + k]) + mr[3 * Dm + k];
                    p.F[(size_t)(r0 + rr) * Dm + k] = f2a(f[rr]);
                }
                const float* wr = Wl + (64 * j + lane) * 36;
#pragma unroll
                for (int q = 0; q < 9; ++q) {
                    const f32x4 wq = *(const f32x4*)(wr + q * 4);
#pragma unroll
                    for (int rr = 0; rr < 1; ++rr)
#pragma unroll
                        for (int r = 0; r < 4; ++r) pacc[rr][q * 4 + r] += f[rr] * wq[r];
                }
            }
        }
        __syncthreads();
        float* red = (float*)smem + w * (64 * 37);
#pragma unroll 1
        for (int rr = 0; rr < 1; ++rr) {
#pragma unroll
            for (int c = 0; c < 36; ++c) red[lane * 37 + c] = pacc[0][c];
            __syncthreads();
            float tot = 0.f;
            if (lane < 36) for (int q = 0; q < 64; ++q) tot += red[q * 37 + lane];
            __syncthreads();
            if (lane < 36) red[lane] = tot + (lane < 4 ? p.moe_bg[l * 4 + lane] : p.moe_be[l * 32 + lane - 4]);
            __syncthreads();
            float gmax = red[0]; int gi = 0;
#pragma unroll
            for (int j = 1; j < 4; ++j) { const float v = red[j]; if (v > gmax) { gmax = v; gi = j; } }
            float gsum = 0.f;
#pragma unroll
            for (int j = 0; j < 4; ++j) gsum += expf(red[j] - gmax);
            const float gtop = 1.0f / gsum;
            float e1 = -1e30f, e2 = -1e30f; int i1 = 0, i2 = 0;
#pragma unroll
            for (int j = 0; j < 8; ++j) { const float v = red[4 + gi * 8 + j]; if (v > e1) { e2 = e1; i2 = i1; e1 = v; i1 = j; } else if (v > e2) { e2 = v; i2 = j; } }
            const float g0 = 1.0f / (1.0f + expf(e2 - e1));
            if (lane == 0 && (!DRY || g0 == 123.456f)) {
                const int row = r0 + rr, ea = gi * 8 + i1, eb = gi * 8 + i2;
                p.EID[row * 2] = ea; p.EID[row * 2 + 1] = eb;
                p.GATE[row * 2] = g0 * gtop; p.GATE[row * 2 + 1] = (1.0f - g0) * gtop;
                const int pa = atomicAdd(&p.CNT[(l * 32 + ea) * 64], 1), pb = atomicAdd(&p.CNT[(l * 32 + eb) * 64], 1);
                p.LIST[(size_t)ea * NTOK + pa] = row; p.LIST[(size_t)eb * NTOK + pb] = row;
                p.POS[row * 2] = pa; p.POS[row * 2 + 1] = pb;
            }
            __syncthreads();
        }
    }
}

DI void mconv_item(const Params& p, int l, unsigned char* smem, int it) {
    const int tid = opaque_tid();
    float* T = (float*)smem;
    const int e = it / 24, r = it % 24, mat = r >> 3, q = r & 7;
    const int K = mat < 2 ? Dm : 512, N = mat < 2 ? 512 : Dm;
    const float *w1p = p.moe_w1, *w3p = p.moe_w3, *w2p = p.moe_w2;
    asm volatile("" : "+s"(w1p), "+s"(w3p), "+s"(w2p));
    const float* W = (mat == 0 ? w1p : mat == 1 ? w3p : w2p) + ((size_t)l * 32 + e) * Dm * 512;
    act_t* WT = mat < 2 ? p.W13T + ((size_t)(l & 1) * 32 * 1024 + (size_t)e * 1024 + mat * 512) * Dm : p.W2T + ((size_t)(l & 1) * 32 + e) * Dm * 512;
    const int ntile0 = mat < 2 ? q : 2 * q, nnt = mat < 2 ? 1 : 2, nkt = K / 64;
    const int k = tid >> 2, n16 = (tid & 3) * 16;
    const int n = tid >> 2, k16 = (tid & 3) * 16;
    f32x4 v[4];
#pragma unroll
    for (int i = 0; i < 4; ++i) v[i] = *(const f32x4*)(W + (size_t)k * N + ntile0 * 64 + n16 + i * 4);
    for (int tix = 0; tix < nnt * nkt; ++tix) {
        const int nt = ntile0 + tix / nkt, kt = tix % nkt;
        __syncthreads();
#pragma unroll
        for (int i = 0; i < 4; ++i) { T[k * 65 + n16 + i * 4] = v[i][0]; T[k * 65 + n16 + i * 4 + 1] = v[i][1]; T[k * 65 + n16 + i * 4 + 2] = v[i][2]; T[k * 65 + n16 + i * 4 + 3] = v[i][3]; }
        __syncthreads();
        if (tix + 1 < nnt * nkt) {
            const int nt2 = ntile0 + (tix + 1) / nkt, kt2 = (tix + 1) % nkt;
#pragma unroll
            for (int i = 0; i < 4; ++i) v[i] = *(const f32x4*)(W + (size_t)(kt2 * 64 + k) * N + nt2 * 64 + n16 + i * 4);
        }
        unsigned o[8];
#pragma unroll
        for (int i = 0; i < 8; ++i) o[i] = pk2(T[(k16 + 2 * i) * 65 + n], T[(k16 + 2 * i + 1) * 65 + n]);
        act_t* dst = WT + (size_t)(nt * 64 + n) * K + kt * 64 + k16;
        *(u32x4*)dst = (u32x4){o[0], o[1], o[2], o[3]}; *(u32x4*)(dst + 8) = (u32x4){o[4], o[5], o[6], o[7]};
    }
}

DI void mconv_drain(const Params& p, int l, unsigned char* smem, int max_items) {
    volatile int* s_item = (volatile int*)(smem + SM_AUX + 512);
    unsigned* ctr = p.BAR + 3600 + l;
    for (int n = 0; n < max_items; ++n) {
        __syncthreads();
        if (threadIdx.x == 0) *s_item = (int)atomicAdd(ctr, 1u);
        __syncthreads();
        const int it = *s_item;
        if (it >= 32 * 24) break;
        mconv_item(p, l, smem, it);
    }
}

DI void bp_mixer(const Params& p, int l, bool upd, unsigned char* smem) {
    constexpr int QTL = Tn / 128, QTC = Cn / 128, CPL = Tn / 64, BIG = 1 << 30;
    const int n_al = Bn * 4 * QTL + Bn * 6 * QTL, n_ac = upd ? Bn * 4 * QTC + Bn * 6 * QTC : 0;
    const int n_ml = Bn * 4 * CPL + (upd ? Bn * 4 * NCC : 0);
    const int total = n_al + n_ml + n_ac;
    volatile int* s_item = (volatile int*)(smem + SM_AUX + 512);
    unsigned* ctr = p.BAR + 3500 + l;
#define NEXT_ITEM() ({ __syncthreads(); if (threadIdx.x == 0) *s_item = (int)atomicAdd(ctr, 1u); __syncthreads(); (int)*s_item; })
    int it = NEXT_ITEM();
    while (it < n_al) { bp_attn(p, l, upd, smem, it, BIG); it = NEXT_ITEM(); }
    while (it < n_al + n_ml) { bp_mlstm(p, l, upd, smem, it - n_al, BIG); it = NEXT_ITEM(); }
    while (it < n_al + n_ml + n_ac) { bp_attn(p, l, upd, smem, it - n_ml, BIG); it = NEXT_ITEM(); }
    (void)total;
#undef NEXT_ITEM

}

constexpr int RT_LD = 272, RT_AH = 0, RT_AL = 64 * RT_LD, RT_BH = 128 * RT_LD, RT_BL = RT_BH + 48 * RT_LD, RT_END = RT_BL + 48 * RT_LD;
static_assert(RT_END <= 65536, "router tiles exceed the LDS budget");
DI void mconv_drain(const Params& p, int l, unsigned char* smem, int max_items);
DI void bp_route2(const Params& p, int l, bool upd, unsigned char* smem, int bid, int G) {
    const int tid = opaque_tid(), lane = tid & 63, w = tid >> 6;
    const int rows = upd ? NTOK : NL;
    const float* gn = p.norm2_g + l * Dm;
    for (int item = bid; item < rows / 64; item += G) {
        const int r0 = item * 64;
        {
            const float* mr = mod_row(p, l, r0);
            f32x4 mul[4], add[4];
#pragma unroll
            for (int i = 0; i < 4; ++i) {
                const int k = 256 * i + 4 * lane;
                mul[i] = *(const f32x4*)(gn + k) * (1.0f + *(const f32x4*)(mr + 4 * Dm + k)); add[i] = *(const f32x4*)(mr + 3 * Dm + k);
            }
#pragma unroll 1
            for (int i0 = 0; i0 < 16; i0 += 4) {
                f32x4 x[4][4];
#pragma unroll
                for (int rr = 0; rr < 4; ++rr)
#pragma unroll
                    for (int i = 0; i < 4; ++i) x[rr][i] = *(const f32x4*)(p.X + (size_t)(r0 + w * 16 + i0 + rr) * Dm + 256 * i + 4 * lane);
#pragma unroll
                for (int rr = 0; rr < 4; ++rr) {
                    const int row = r0 + w * 16 + i0 + rr;
                    float ss = 0.f;
#pragma unroll
                    for (int i = 0; i < 4; ++i) ss += x[rr][i][0] * x[rr][i][0] + x[rr][i][1] * x[rr][i][1] + x[rr][i][2] * x[rr][i][2] + x[rr][i][3] * x[rr][i][3];
                    ss = wave_sum(ss, lane);
                    const float rstd = 1.0f / sqrtf(ss / Dm + EPSF);
#pragma unroll
                    for (int i = 0; i < 4; ++i) {
                        const int k = 256 * i + 4 * lane;
                        const f32x4 y = x[rr][i] * rstd * mul[i] + add[i];
                        const unsigned h01 = pk2(y[0], y[1]), h23 = pk2(y[2], y[3]);
                        *(u32x2*)(p.F + (size_t)row * Dm + k) = (u32x2){h01, h23};
                        *(u32x2*)(p.FLO + (size_t)row * Dm + k) = (u32x2){pk2(y[0] - bflo(h01), y[1] - bfhi(h01)), pk2(y[2] - bflo(h23), y[3] - bfhi(h23))};
                    }
                }
            }
        }
        __threadfence_block();
        __syncthreads();
        f32x4 acc[3];
#pragma unroll
        for (int ni = 0; ni < 3; ++ni) acc[ni] = (f32x4){0.f, 0.f, 0.f, 0.f};
        const int s_r = tid >> 4, s_c = tid & 15;
        {
            const act_t* Ah = p.F + (size_t)(r0 + s_r) * Dm + s_c * 8;
            const act_t* Al = p.FLO + (size_t)(r0 + s_r) * Dm + s_c * 8;
            const act_t* Bh = p.WRHI + ((size_t)l * 36 + s_r) * Dm + s_c * 8;
            const act_t* Bl = p.WRLO + ((size_t)l * 36 + s_r) * Dm + s_c * 8;
            u32x4 rah[4], ral[4], rbh[3], rbl[3];
#define RT_LOAD(KOFF) { \
    _Pragma("unroll") for (int i = 0; i < 4; ++i) { rah[i] = *(const u32x4*)(Ah + (size_t)16 * i * Dm + (KOFF)); ral[i] = *(const u32x4*)(Al + (size_t)16 * i * Dm + (KOFF)); } \
    _Pragma("unroll") for (int i = 0; i < 3; ++i) { const bool ok = s_r + 16 * i < 36; \
        rbh[i] = ok ? *(const u32x4*)(Bh + (size_t)16 * i * Dm + (KOFF)) : (u32x4){0u, 0u, 0u, 0u}; rbl[i] = ok ? *(const u32x4*)(Bl + (size_t)16 * i * Dm + (KOFF)) : (u32x4){0u, 0u, 0u, 0u}; } }
            RT_LOAD(0)
#pragma unroll 1
            for (int k0 = 0; k0 < Dm; k0 += 128) {
                __syncthreads();
#pragma unroll
                for (int i = 0; i < 4; ++i) { *(u32x4*)(smem + RT_AH + (s_r + 16 * i) * RT_LD + s_c * 16) = rah[i]; *(u32x4*)(smem + RT_AL + (s_r + 16 * i) * RT_LD + s_c * 16) = ral[i]; }
#pragma unroll
                for (int i = 0; i < 3; ++i) { *(u32x4*)(smem + RT_BH + (s_r + 16 * i) * RT_LD + s_c * 16) = rbh[i]; *(u32x4*)(smem + RT_BL + (s_r + 16 * i) * RT_LD + s_c * 16) = rbl[i]; }
                __syncthreads();
                if (k0 + 128 < Dm) RT_LOAD(k0 + 128)
#pragma unroll
                for (int kk = 0; kk < 4; ++kk) {
                    const int fo = (lane & 15) * RT_LD + kk * 64 + (lane >> 4) * 16;
                    const bf16x8 ah = *(const bf16x8*)(smem + RT_AH + w * 16 * RT_LD + fo), al = *(const bf16x8*)(smem + RT_AL + w * 16 * RT_LD + fo);
#pragma unroll
                    for (int ni = 0; ni < 3; ++ni) {
                        const bf16x8 bh = *(const bf16x8*)(smem + RT_BH + ni * 16 * RT_LD + fo), bl = *(const bf16x8*)(smem + RT_BL + ni * 16 * RT_LD + fo);
                        acc[ni] = __builtin_amdgcn_mfma_f32_16x16x32_bf16(bh, ah, acc[ni], 0, 0, 0);
                        acc[ni] = __builtin_amdgcn_mfma_f32_16x16x32_bf16(bh, al, acc[ni], 0, 0, 0);
                        acc[ni] = __builtin_amdgcn_mfma_f32_16x16x32_bf16(bl, ah, acc[ni], 0, 0, 0);
                    }
                }
            }
#undef RT_LOAD
        }
        __syncthreads();
        float* lg = (float*)smem;
#pragma unroll
        for (int ni = 0; ni < 3; ++ni)
#pragma unroll
            for (int r = 0; r < 4; ++r) lg[(w * 16 + (lane & 15)) * 49 + ni * 16 + (lane >> 4) * 4 + r] = acc[ni][r];
        __syncthreads();
        if (tid < 64) {
            const float* rl = lg + tid * 49;
            float ag[4];
            float gmax = -1e30f; int gi = 0;
#pragma unroll
            for (int j = 0; j < 4; ++j) { ag[j] = rl[j] + p.moe_bg[l * 4 + j]; if (ag[j] > gmax) { gmax = ag[j]; gi = j; } }
            float gsum = 0.f;
#pragma unroll
            for (int j = 0; j < 4; ++j) gsum += expf(ag[j] - gmax);
            const float gtop = 1.0f / gsum;
            float e1 = -1e30f, e2 = -1e30f; int i1 = 0, i2 = 0;
#pragma unroll
            for (int j = 0; j < 8; ++j) { const float v = rl[4 + gi * 8 + j] + p.moe_be[l * 32 + gi * 8 + j]; if (v > e1) { e2 = e1; i2 = i1; e1 = v; i1 = j; } else if (v > e2) { e2 = v; i2 = j; } }
            const float g0 = 1.0f / (1.0f + expf(e2 - e1));
            const int row = r0 + tid, ea = gi * 8 + i1, eb = gi * 8 + i2;
            p.EID[row * 2] = ea; p.EID[row * 2 + 1] = eb;
            p.GATE[row * 2] = g0 * gtop; p.GATE[row * 2 + 1] = (1.0f - g0) * gtop;
            const int pa = atomicAdd(&p.CNT[(l * 32 + ea) * 64], 1), pb = atomicAdd(&p.CNT[(l * 32 + eb) * 64], 1);
            p.LIST[(size_t)ea * NTOK + pa] = row; p.LIST[(size_t)eb * NTOK + pb] = row;
            p.POS[row * 2] = pa; p.POS[row * 2 + 1] = pb;
        }
        __syncthreads();
    }
    mconv_drain(p, l, smem, 1 << 30);
}

constexpr int PPL = 9;
constexpr int NPH = 2 + PPL * DEPTH;
static inline bool phase_in_mega(int ph) {
    if (ph < 2) return true;
    const int s = (ph - 2) % PPL;
    return s == 1 ? IMPL_POST : s == 2 ? IMPL_ATTN : s == 3 ? IMPL_MLSTM : s == 5 ? IMPL_ROUTE : true;
}

#define XB_TMO      128
#define XB_XCNT(j)  (256  + 64 * (j))
#define XB_XSUB(j)  (1280 + 64 * (j))
#define XB_XGEN(j)  (2304 + 64 * (j))
#define XB_TOP      3328
#define XB_TOPGEN   3392
#define XCD_BAR_WORDS 3456
#define XB_SPIN_CAP (1u << 22)
#define LAS __attribute__((address_space(3)))
DI unsigned xb_ld(unsigned* p) { return __hip_atomic_load(p, __ATOMIC_RELAXED, __HIP_MEMORY_SCOPE_AGENT); }
DI unsigned xb_add(unsigned* p, unsigned v) { return __hip_atomic_fetch_add(p, v, __ATOMIC_RELAXED, __HIP_MEMORY_SCOPE_AGENT); }
DI unsigned xb_xcc_id() { return (unsigned)__builtin_amdgcn_s_getreg((3 << 11) | 20) & 0xFu; }
#define XB_SPIN(cond, bar) do { unsigned _sp = 0; while (cond) { __builtin_amdgcn_s_sleep(1); \
    if ((++_sp & 255u) == 0u) { if (xb_ld(&(bar)[XB_TMO])) break; if (_sp > XB_SPIN_CAP) { atomicAdd(&(bar)[XB_TMO], 1u); break; } } } } while (0)
struct XcdBarrier { unsigned* bar; unsigned x; volatile LAS unsigned* st; };
DI XcdBarrier xcd_barrier_post(unsigned* bar, volatile LAS unsigned* st) {
    XcdBarrier b; b.bar = bar; b.x = xb_xcc_id(); b.st = st;
    if (threadIdx.x == 0) (void)xb_add(&bar[XB_XCNT(b.x)], 1u);
    return b;
}
DI void xcd_barrier_complete(unsigned* bar, unsigned x, unsigned& nloc, unsigned& nx) {
    const unsigned G = gridDim.x * gridDim.y * gridDim.z;
    unsigned sum, cnt, mine, sp = 0u;
    for (;;) {
        sum = 0u; cnt = 0u; mine = 0u;
#pragma unroll
        for (unsigned j = 0; j < 16; ++j) { const unsigned c = xb_ld(&bar[XB_XCNT(j)]); sum += c; cnt += (c > 0u) ? 1u : 0u; mine = (j == x) ? c : mine; }
        if (sum == G) break;
        __builtin_amdgcn_s_sleep(1);
        if ((++sp & 255u) == 0u) { if (xb_ld(&bar[XB_TMO])) break; if (sp > XB_SPIN_CAP) { atomicAdd(&bar[XB_TMO], 1u); break; } }
    }
    nloc = mine > 0u ? mine : 1u; nx = cnt > 0u ? cnt : 1u;
}
DI void xcd_barrier(const XcdBarrier& b) {
    asm volatile("s_waitcnt vmcnt(0)" ::: "memory");
    __syncthreads();
    if (threadIdx.x == 0) {
        unsigned* bar = b.bar;
        __builtin_amdgcn_s_waitcnt(0);
        unsigned nloc = b.st[0], nx = b.st[1];
        if (nloc == 0u) { xcd_barrier_complete(bar, b.x, nloc, nx); b.st[0] = nloc; b.st[1] = nx; }
        const unsigned old = xb_add(&bar[XB_XSUB(b.x)], 1u);
        const unsigned gen = old / nloc;
        if (old + 1u == (gen + 1u) * nloc) {
            __builtin_amdgcn_fence(__ATOMIC_RELEASE, "agent");
            asm volatile("s_waitcnt vmcnt(0)" ::: "memory");
            const unsigned og = xb_add(&bar[XB_TOP], 1u);
            const unsigned tg = og / nx;
            if (og + 1u == (tg + 1u) * nx) xb_add(&bar[XB_TOPGEN], 1u);
            else XB_SPIN(xb_ld(&bar[XB_TOPGEN]) == tg, bar);
            __builtin_amdgcn_fence(__ATOMIC_ACQUIRE, "agent");
            xb_add(&bar[XB_XGEN(b.x)], 1u);
            asm volatile("s_waitcnt vmcnt(0)" ::: "memory");
        } else {
            XB_SPIN(xb_ld(&bar[XB_XGEN(b.x)]) == gen, bar);
            __builtin_amdgcn_fence(__ATOMIC_ACQUIRE, "agent");
            asm volatile("s_waitcnt vmcnt(0)" ::: "memory");
        }
    }
    __syncthreads();
}

__global__ void __launch_bounds__(NTHR) k_naive(Params p, int ph) {
    const long gtid = (long)blockIdx.x * NTHR + threadIdx.x, gsize = (long)gridDim.x * NTHR;
    const int l = (ph - 2) / PPL, s = (ph - 2) % PPL;
    const bool upd = l < DEPTH - 1;
    (void)gtid; (void)gsize; (void)l; (void)s; (void)upd;
#if !IMPL_POST
    if (s == 1) ph_post(p, l, gtid, gsize);
#endif
#if !IMPL_ATTN
    if (s == 2) { ph_attn_diff(p, l, upd, gtid, gsize); ph_attn_gqa(p, l, upd, gtid, gsize); }
#endif
#if !IMPL_MLSTM
    if (s == 3) ph_mlstm(p, l, upd, gtid, gsize);
#endif
#if !IMPL_ROUTE
    if (s == 5) bp_route(p, l, upd, gtid, gsize);
#endif
}

__global__ void __launch_bounds__(NTHR, 2) k_mega(Params p_arg, int ph_begin, int ph_end) {
    extern __shared__ __attribute__((aligned(16))) unsigned char smem[];
    const Params& p0 = p_arg;
    cg::grid_group grid = cg::this_grid();
    const int G = gridDim.x, vb = xcd_remap(blockIdx.x, G);
    volatile LAS unsigned* xb_st = (volatile LAS unsigned*)(smem + SMEM_BYTES - 16);
    if (threadIdx.x == 0) { xb_st[0] = 0u; xb_st[1] = 0u; xb_st[2] = 0u; }
    __syncthreads();
    const XcdBarrier xb = xcd_barrier_post(p0.BAR, xb_st);
    for (int ph = ph_begin; ph < ph_end; ++ph) {
        Params p;
#if defined(__HIP_DEVICE_COMPILE__)
        {
            typedef const __attribute__((address_space(4))) unsigned long long* kp_t;
            kp_t pk = (kp_t)__builtin_amdgcn_kernarg_segment_ptr();
            asm volatile("" : "+s"(pk));
            static_assert(sizeof(Params) % 8 == 0, "Params is a list of pointers");
#pragma unroll
            for (unsigned i = 0; i < sizeof(Params) / 8; ++i) {
                char* gp = (char*)(__attribute__((address_space(1))) char*)pk[i];
                __builtin_memcpy((char*)&p + 8 * i, &gp, 8);
            }
        }
#else
        p = p0;
#endif
#ifdef PROBE_TS
        if (blockIdx.x == 0 && threadIdx.x == 0) { typedef const __attribute__((address_space(4))) unsigned long long* kp_t; kp_t pk = (kp_t)__builtin_amdgcn_kernarg_segment_ptr(); ((unsigned long long*)pk[offsetof(Params, TS) / 8])[ph] = __builtin_amdgcn_s_memrealtime(); }
#endif
        const int tid = opaque_tid(), lane = tid & 63;
        const long gtid = (long)blockIdx.x * NTHR + tid, gsize = (long)G * NTHR;
        const int gwave = (int)(gtid >> 6), nwaves = (int)(gsize >> 6);
        if (ph == 0) {
            bp_mod(p, smem, blockIdx.x, G, gtid, gsize);
            bp_wconv(p, smem, G - 1 - blockIdx.x, G);
            if (gtid < DEPTH * 32 * 64) p.CNT[gtid] = 0;
            for (long it = gtid; it < (long)DEPTH * 36 * Dm; it += gsize) {
                const int k = (int)(it % Dm), n = (int)((it / Dm) % 36), ll = (int)(it / (36 * Dm));
                const float wv = n < 4 ? p.moe_wg[((size_t)ll * Dm + k) * 4 + n] : p.moe_we[((size_t)ll * Dm + k) * 32 + n - 4];
                const act_t hi = f2a(wv);
                p.WRHI[it] = hi; p.WRLO[it] = f2a(wv - a2f(hi));
            }
            if (gtid < 512) ((unsigned long long*)p.ZROW)[gtid] = 0ull;
            if (gtid < 64 * 28) {
                const int pos = (int)gtid / 28, fi = (int)gtid % 28, nf = fi < 12 ? 12 : 16, i = fi < 12 ? fi : fi - 12;
                const float ang = (float)pos * expf(-(float)i / (float)nf * 9.210340371976184f);
                p.ROPE[gtid * 2] = cosf(ang); p.ROPE[gtid * 2 + 1] = sinf(ang);
            }
        } else if (ph == 1) {
            bp_norm1(p, 0, gwave, nwaves, lane);
        } else {
            const int l = (ph - 2) / PPL, s = (ph - 2) % PPL;
            const bool upd = l < DEPTH - 1;
#ifdef PROBE_DUP
            if ((PROBE_DUP >> s) & 1) {
                if (s == 0) bp_gemm_in<PROBE_MODE>(p, l, smem, vb, G);
                if (s == 1) bp_post(p, l, smem, blockIdx.x, G);
                if (s == 6) bp_moe1(p, l, smem, vb, G);
                if (s == 7) bp_moe2(p, l, smem, vb, G);
                if (s == 4) bp_gemm_out<true>(p, l, upd, smem, vb, G);
                if (s == 8 && l < DEPTH - 1) bp_combine<true>(p, l, upd, smem, gwave, nwaves, lane);
            }
#endif
            switch (s) {
                case 0: bp_gemm_in(p, l, smem, vb, G); break;
#if IMPL_POST
                case 1: bp_post(p, l, smem, blockIdx.x, G); break;
#endif
#if IMPL_ATTN
                case 2: bp_mixer(p, l, upd, smem); break;
#endif
#if IMPL_MLSTM
                case 3: break;
#endif
#if IMPL_ROUTE
                case 5: bp_route2(p, l, upd, smem, blockIdx.x, G); break;
#endif
                case 4: bp_gemm_out<false>(p, l, upd, smem, vb, G); break;
                case 6: bp_moe1(p, l, smem, vb, G); break;
                case 7: bp_moe2(p, l, smem, vb, G); break;
                case 8: bp_combine<false>(p, l, upd, smem, gwave, nwaves, lane); break;
                default: break;
            }
        }
        if (ph + 1 < ph_end && !(ph >= 2 && (ph - 2) % PPL == 2 && IMPL_ATTN && IMPL_MLSTM)) {
            if (ph_end < 0) grid.sync();
            xcd_barrier(xb);
#ifdef PROBE_DUP
            if (PROBE_DUP & 1024) xcd_barrier(xb);
#endif
        }
    }
#ifdef PROBE_TS
    if (blockIdx.x == 0 && __builtin_amdgcn_mbcnt_hi(~0u, __builtin_amdgcn_mbcnt_lo(~0u, 0u)) == 0u && atomicAdd((unsigned*)(smem + SMEM_BYTES - 8), 1u) == 0u) {
        struct { unsigned long long* TS; float* out; } p;
        { typedef const __attribute__((address_space(4))) unsigned long long* kp_t; kp_t pk = (kp_t)__builtin_amdgcn_kernarg_segment_ptr(); p.TS = (unsigned long long*)pk[offsetof(Params, TS) / 8]; p.out = (float*)pk[offsetof(Params, out) / 8]; }
        p.TS[NPH] = __builtin_amdgcn_s_memrealtime();
        unsigned long long tot = 0;
        if (PROBE_TS == 9) tot = p.TS[2] - p.TS[0];
        else if (PROBE_TS == 10) tot = p.TS[NPH] - p.TS[0];
        else for (int l = 0; l < DEPTH; ++l) tot += p.TS[2 + l * PPL + PROBE_TS + 1] - p.TS[2 + l * PPL + PROBE_TS];
        p.out[0] += (float)tot * 0.01f / PROBE_SCALE;
    }
#endif
}

extern "C" void kernel_launch(void* const* d_in, const int* in_sizes, int n_in, void* d_out, int out_size, void* d_ws, size_t ws_size, hipStream_t stream) {
    Params p;
    memset((void*)&p, 0, sizeof(p));
    fill_inputs(p, d_in, d_out);
    carve(p, d_ws);
    static int grid_blocks = 0;
    if (!grid_blocks) {
        int dev = 0, cus = 0, per_cu = 0;
        (void)hipGetDevice(&dev);
        (void)hipDeviceGetAttribute(&cus, hipDeviceAttributeMultiprocessorCount, dev);
        (void)hipFuncSetAttribute((const void*)k_mega, hipFuncAttributeMaxDynamicSharedMemorySize, SMEM_BYTES);
        (void)hipOccupancyMaxActiveBlocksPerMultiprocessor(&per_cu, k_mega, NTHR, SMEM_BYTES);
        if (per_cu > 2) per_cu = 2;
        if (per_cu < 1) per_cu = 1;
        grid_blocks = cus * per_cu;
    }
    (void)hipMemsetAsync(p.BAR, 0, 4096 * sizeof(unsigned), stream);
    int ph = 0;
    while (ph < NPH) {
        if (phase_in_mega(ph)) {
            int b = ph, e = ph;
            while (e < NPH && phase_in_mega(e)) ++e;
            void* args[] = {&p, &b, &e};
            (void)hipLaunchCooperativeKernel((void*)k_mega, dim3(grid_blocks), dim3(NTHR), args, SMEM_BYTES, stream);
            ph = e;
        } else {
            k_naive<<<2048, NTHR, 0, stream>>>(p, ph);
            ++ph;
        }
    }
}
#endif
```

```cpp
#ifndef HOST_TEST
#include <hip/hip_runtime.h>
#include <hip/hip_cooperative_groups.h>
#include <string.h>
namespace cg = cooperative_groups;
#define HD __host__ __device__ __forceinline__
#else
#include <math.h>
#include <string.h>
#define HD inline
#endif
#include <stdint.h>
#include <stddef.h>

#ifndef CFG_B
#define CFG_B 8
#define CFG_T 2048
#define CFG_C 256
#define CFG_DEPTH 4
#endif
#ifndef MK_LAUNCHES
#define MK_LAUNCHES 1
#endif

constexpr int Bn = CFG_B, Tn = CFG_T, Cn = CFG_C, DEPTH = CFG_DEPTH;
constexpr int Dm = 1024, INW = 2832, MODW = 6144;
constexpr int NL = Bn * Tn, NC = Bn * Cn, NTOK = NL + NC, Sn = Cn + Tn;
constexpr int DQ_OFF = 0, DK_OFF = 384, DV_OFF = 768, GQ_OFF = 1152, GK_OFF = 1536, GV_OFF = 1664, MQK_OFF = 1792, MV_OFF = 2304, MO_OFF = 2560, MG_OFF = 2816;
constexpr int NCH = Sn / 64, NCC = Cn / 64;
constexpr int PMAX = 2 * NTOK + 32 * 128;
constexpr float EPSF = 1e-6f;
constexpr float LOG2E = 1.4426950408889634f;

#ifdef ACT_F32
typedef float act_t;
HD act_t f2a(float f) { return f; }
HD float a2f(act_t a) { return a; }
#else
typedef unsigned short act_t;
HD act_t f2a(float f) { unsigned u; memcpy(&u, &f, 4); u += 0x7fffu + ((u >> 16) & 1u); return (act_t)(u >> 16); }
HD float a2f(act_t a) { unsigned u = ((unsigned)a) << 16; float f; memcpy(&f, &u, 4); return f; }
#endif

HD float silu_f(float x) { return x / (1.0f + expf(-x)); }
HD float sigmoid_f(float x) { return 1.0f / (1.0f + expf(-x)); }
HD float logsigmoid_f(float x) { return fminf(x, 0.0f) - log1pf(expf(-fabsf(x))); }
HD float lam_init_of(int l) { return 0.8f - 0.6f * expf(-0.3f * (float)l); }

struct Params {
    const float *x, *c, *ctx, *c_ctx, *norm1_g, *norm2_g, *w_mod, *b_mod, *w_in, *w_out, *diff_q_norm, *diff_k_norm, *diff_lambda, *diff_subln,
        *gqa_q_norm, *gqa_k_norm, *mlstm_conv_w, *mlstm_conv_b, *mlstm_gate_b, *mlstm_head_norm, *moe_wg, *moe_bg, *moe_we, *moe_be, *moe_w1, *moe_w3, *moe_w2;
    float* out;
    float *mod, *X, *PROJ, *MQK, *MGATE, *DO, *GATE, *HN;
    act_t *XN, *DQL, *DQC, *DK, *DVt, *GQL, *GQC, *GK, *GVt, *MIX, *F;
    int* EID;
    int *CNT, *LIST, *POS;
    act_t *H, *Y;
    float *ROPE, *KV, *NLC, *CHS, *MG4;
    act_t* MQKB;
    unsigned* BAR;
    act_t *WIN_T, *WOUT_T;
    unsigned long long* TS;
    act_t *FLO, *WRHI, *WRLO, *ZROW;
    act_t *W13T, *W2T;
    act_t* PROJB; float* PG;
};

HD bool tok_ctx(int tok) { return tok >= NL; }
HD int tok_b(int tok) { return tok < NL ? tok / Tn : (tok - NL) / Cn; }
HD int tok_i(int tok) { return tok < NL ? tok % Tn : (tok - NL) % Cn; }
HD int tok_s(int tok) { return tok < NL ? Cn + tok % Tn : (tok - NL) % Cn; }
HD int tok_modrow(int tok) { return tok < NL ? tok / Tn : Bn; }
HD int tok_of(int b, int s) { return s < Cn ? NL + b * Cn + s : b * Tn + (s - Cn); }
HD const float* mod_row(const Params& p, int l, int tok) { return p.mod + ((size_t)l * (Bn + 1) + tok_modrow(tok)) * MODW; }

HD void ph_mod(const Params& p, long gtid, long gsize) {
    for (long it = gtid; it < (long)DEPTH * MODW; it += gsize) {
        const int l = (int)(it / MODW), j = (int)(it % MODW);
        float acc[Bn + 1];
#pragma unroll
        for (int r = 0; r <= Bn; ++r) acc[r] = 0.f;
        const float* w = p.w_mod + (size_t)l * Dm * MODW + j;
        for (int k = 0; k < Dm; ++k) {
            const float wv = w[(size_t)k * MODW];
#pragma unroll
            for (int r = 0; r < Bn; ++r) acc[r] += silu_f(p.c[r * Dm + k]) * wv;
            acc[Bn] += silu_f(p.c_ctx[k]) * wv;
        }
        const float bb = p.b_mod[l * MODW + j];
#pragma unroll
        for (int r = 0; r <= Bn; ++r) p.mod[((size_t)l * (Bn + 1) + r) * MODW + j] = acc[r] + bb;
    }
    for (long it = gtid; it < (long)NTOK * Dm; it += gsize) p.X[it] = it < (long)NL * Dm ? p.x[it] : p.ctx[it - (long)NL * Dm];
}

HD void ph_norm1(const Params& p, int l, long gtid, long gsize) {
    for (long row = gtid; row < NTOK; row += gsize) {
        const float* xr = p.X + row * Dm;
        float ss = 0.f;
        for (int k = 0; k < Dm; ++k) ss += xr[k] * xr[k];
        const float rstd = 1.0f / sqrtf(ss / Dm + EPSF);
        const float* mr = mod_row(p, l, (int)row);
        const float* g = p.norm1_g + l * Dm;
        for (int k = 0; k < Dm; ++k) p.XN[row * Dm + k] = f2a(xr[k] * rstd * g[k] * (1.0f + mr[Dm + k]) + mr[k]);
    }
}

HD void ph_gemm_in(const Params& p, int l, long gtid, long gsize) {
    const float* W = p.w_in + (size_t)l * Dm * INW;
    for (long it = gtid; it < (long)NTOK * INW; it += gsize) {
        const long m = it / INW; const int n = (int)(it % INW);
        const act_t* a = p.XN + m * Dm;
        float acc = 0.f;
        for (int k = 0; k < Dm; ++k) acc += a2f(a[k]) * W[(size_t)k * INW + n];
        p.PROJ[it] = acc;
    }
}

template <int DHn>
HD void qk_unit(const float* src, const float* g, bool rope, int t, float oscale, float (&y)[DHn]) {
    float ss = 0.f;
#pragma unroll
    for (int i = 0; i < DHn; ++i) { y[i] = src[i]; ss += y[i] * y[i]; }
    const float rstd = 1.0f / sqrtf(ss / DHn + EPSF);
#pragma unroll
    for (int i = 0; i < DHn; ++i) y[i] = y[i] * rstd * g[i];
    if (rope) {
        constexpr int half = DHn / 2, nf = half / 2;
        const float posr = (float)(t / 64), posc = (float)(t % 64);
#pragma unroll
        for (int hsel = 0; hsel < 2; ++hsel) {
            const float pos = hsel ? posc : posr;
#pragma unroll
            for (int i = 0; i < nf; ++i) {
                const float fr = expf(-(float)i / (float)nf * 9.210340371976184f);
                const float ang = pos * fr;
                const float cs = cosf(ang), sn = sinf(ang);
                const float x1 = y[hsel * half + i], x2 = y[hsel * half + nf + i];
                y[hsel * half + i] = x1 * cs - x2 * sn;
                y[hsel * half + nf + i] = x2 * cs + x1 * sn;
            }
        }
    }
#pragma unroll
    for (int i = 0; i < DHn; ++i) y[i] *= oscale;
}

HD void ph_post(const Params& p, int l, long gtid, long gsize) {
    constexpr int NU = 27;
    for (long it = gtid; it < (long)NTOK * NU; it += gsize) {
        const int tok = (int)(it / NU), u = (int)(it % NU);
        const bool isc = tok_ctx(tok);
        const int b = tok_b(tok), ti = tok_i(tok), s = tok_s(tok);
        const float* pr = p.PROJ + (size_t)tok * INW;
        if (u < 16) {
            const bool isk = u >= 8; const int h = (u & 7) >> 1, w = u & 1;
            float y[48];
            qk_unit<48>(pr + (isk ? DK_OFF : DQ_OFF) + h * 96 + w * 48, (isk ? p.diff_k_norm : p.diff_q_norm) + l * 48, !isc, ti,
                        isk ? 1.0f : 0.14433756729740643f * LOG2E, y);
            act_t* dst = isk ? p.DK + (((size_t)(b * 4 + h) * 2 + w) * Sn + s) * 48
                             : (isc ? p.DQC + (((size_t)(b * 4 + h) * 2 + w) * Cn + ti) * 48 : p.DQL + (((size_t)(b * 4 + h) * 2 + w) * Tn + ti) * 48);
#pragma unroll
            for (int i = 0; i < 48; ++i) dst[i] = f2a(y[i]);
        } else if (u < 24) {
            const bool isk = u >= 22; const int h = isk ? u - 22 : u - 16;
            float y[64];
            qk_unit<64>(pr + (isk ? GK_OFF : GQ_OFF) + h * 64, (isk ? p.gqa_k_norm : p.gqa_q_norm) + l * 64, !isc, ti, isk ? 1.0f : 0.125f * LOG2E, y);
            act_t* dst = isk ? p.GK + ((size_t)(b * 2 + h) * Sn + s) * 64
                             : (isc ? p.GQC + ((size_t)(b * 6 + h) * Cn + ti) * 64 : p.GQL + ((size_t)(b * 6 + h) * Tn + ti) * 64);
#pragma unroll
            for (int i = 0; i < 64; ++i) dst[i] = f2a(y[i]);
        } else if (u == 24) {
            for (int j = 0; j < 384; ++j) p.DVt[((size_t)(b * 4 + j / 96) * 96 + j % 96) * Sn + s] = f2a(pr[DV_OFF + j]);
        } else if (u == 25) {
            for (int j = 0; j < 128; ++j) p.GVt[((size_t)(b * 2 + j / 64) * 64 + j % 64) * Sn + s] = f2a(pr[GV_OFF + j]);
        } else {
            const int seglen = isc ? Cn : Tn;
            const float* cw = p.mlstm_conv_w + (size_t)l * 3 * 512; const float* cb = p.mlstm_conv_b + l * 512;
            for (int ch = 0; ch < 512; ++ch) {
                float a = cb[ch] + pr[MQK_OFF + ch] * cw[512 + ch];
                if (ti > 0) a += pr[MQK_OFF + ch - INW] * cw[ch];
                if (ti < seglen - 1) a += pr[MQK_OFF + ch + INW] * cw[1024 + ch];
                a = silu_f(a);
                p.MQK[(size_t)tok * 512 + ch] = ch >= 256 ? a * 0.125f : a;
            }
            const float* gb = p.mlstm_gate_b + l * 16;
            for (int j = 0; j < 16; ++j) {
                const float gv = pr[MG_OFF + j] + gb[j];
                p.MGATE[(size_t)tok * 16 + j] = ((j >> 2) & 1) ? logsigmoid_f(gv) : gv;
            }
        }
    }
}

HD void ph_attn_diff(const Params& p, int l, bool upd, long gtid, long gsize) {
    const int nq = upd ? Tn + Cn : Tn;
    const float lam_init = lam_init_of(l);
    for (long it = gtid; it < (long)Bn * 4 * nq; it += gsize) {
        const int qi = (int)(it % nq), h = (int)((it / nq) % 4), b = (int)(it / ((long)nq * 4));
        const bool isc = qi >= Tn; const int ti = isc ? qi - Tn : qi;
        const int nk = isc ? Cn : Sn;
        const int tok = isc ? NL + b * Cn + ti : b * Tn + ti;
        float* dob = p.DO + ((size_t)(b * 4 + h) * (Tn + Cn) + qi) * 96;
        const act_t* vt = p.DVt + (size_t)(b * 4 + h) * 96 * Sn;
        float l2 = 1.f;
        float o[96];
        for (int w = 0; w < 2; ++w) {
            const act_t* qp = isc ? p.DQC + (((size_t)(b * 4 + h) * 2 + w) * Cn + ti) * 48 : p.DQL + (((size_t)(b * 4 + h) * 2 + w) * Tn + ti) * 48;
            const act_t* kp = p.DK + ((size_t)(b * 4 + h) * 2 + w) * Sn * 48;
            float q[48];
#pragma unroll
            for (int i = 0; i < 48; ++i) q[i] = a2f(qp[i]);
#pragma unroll
            for (int i = 0; i < 96; ++i) o[i] = 0.f;
            float m = -1e30f, lsum = 0.f;
            for (int s = 0; s < nk; ++s) {
                float sc = 0.f;
#pragma unroll
                for (int i = 0; i < 48; ++i) sc += q[i] * a2f(kp[(size_t)s * 48 + i]);
                const float mn = fmaxf(m, sc), alpha = exp2f(m - mn), pe = exp2f(sc - mn);
                lsum = lsum * alpha + pe;
#pragma unroll
                for (int i = 0; i < 96; ++i) o[i] = o[i] * alpha + pe * a2f(vt[(size_t)i * Sn + s]);
                m = mn;
            }
            if (w == 0) {
#pragma unroll
                for (int i = 0; i < 96; ++i) dob[i] = o[i] / lsum;
            } else l2 = lsum;
        }
        const float* dl = p.diff_lambda + l * 4 * 48;
        float s01 = 0.f, s23 = 0.f;
        for (int i = 0; i < 48; ++i) { s01 += dl[i] * dl[48 + i]; s23 += dl[96 + i] * dl[144 + i]; }
        const float lam = expf(s01) - expf(s23) + lam_init;
        float ss = 0.f;
#pragma unroll
        for (int i = 0; i < 96; ++i) { o[i] = dob[i] - lam * o[i] / l2; ss += o[i] * o[i]; }
        const float rstd = 1.0f / sqrtf(ss / 96 + EPSF);
        const float* sg = p.diff_subln + l * 96;
#pragma unroll
        for (int i = 0; i < 96; ++i) p.MIX[(size_t)tok * Dm + h * 96 + i] = f2a(o[i] * rstd * sg[i] * (1.0f - lam_init));
    }
}

HD void ph_attn_gqa(const Params& p, int l, bool upd, long gtid, long gsize) {
    const int nq = upd ? Tn + Cn : Tn;
    for (long it = gtid; it < (long)Bn * 6 * nq; it += gsize) {
        const int qi = (int)(it % nq), hq = (int)((it / nq) % 6), b = (int)(it / ((long)nq * 6));
        const bool isc = qi >= Tn; const int ti = isc ? qi - Tn : qi;
        const int nk = isc ? Cn : Sn, kv = hq / 3;
        const int tok = isc ? NL + b * Cn + ti : b * Tn + ti;
        const act_t* qp = isc ? p.GQC + ((size_t)(b * 6 + hq) * Cn + ti) * 64 : p.GQL + ((size_t)(b * 6 + hq) * Tn + ti) * 64;
        const act_t* kp = p.GK + (size_t)(b * 2 + kv) * Sn * 64;
        const act_t* vt = p.GVt + (size_t)(b * 2 + kv) * 64 * Sn;
        float q[64], o[64];
#pragma unroll
        for (int i = 0; i < 64; ++i) { q[i] = a2f(qp[i]); o[i] = 0.f; }
        float m = -1e30f, lsum = 0.f;
        for (int s = 0; s < nk; ++s) {
            float sc = 0.f;
#pragma unroll
            for (int i = 0; i < 64; ++i) sc += q[i] * a2f(kp[(size_t)s * 64 + i]);
            const float mn = fmaxf(m, sc), alpha = exp2f(m - mn), pe = exp2f(sc - mn);
            lsum = lsum * alpha + pe;
#pragma unroll
            for (int i = 0; i < 64; ++i) o[i] = o[i] * alpha + pe * a2f(vt[(size_t)i * Sn + s]);
            m = mn;
        }
#pragma unroll
        for (int i = 0; i < 64; ++i) p.MIX[(size_t)tok * Dm + 384 + hq * 64 + i] = f2a(o[i] / lsum);
    }
}

HD void mlstm_dir_naive(const Params& p, int b, int h, bool isc, int ti, int dir, const float (&q)[64], float (&hout)[64]) {
    float num[64];
#pragma unroll
    for (int i = 0; i < 64; ++i) num[i] = 0.f;
    float den = 0.f, m = -1e30f, Dg = 0.f;
    for (int seg = 0; seg < (isc ? 1 : 2); ++seg) {
        const bool sc_ = seg == 1 ? true : isc;
        const int len = sc_ ? Cn : Tn;
        int cnt, start, step;
        if (seg == 0) { start = ti; step = dir == 0 ? -1 : 1; cnt = dir == 0 ? ti + 1 : len - ti; }
        else { start = dir == 0 ? len - 1 : 0; step = dir == 0 ? -1 : 1; cnt = len; }
        for (int c = 0, si = start; c < cnt; ++c, si += step) {
            const int tk = sc_ ? NL + b * Cn + si : b * Tn + si;
            const float li = p.MGATE[(size_t)tk * 16 + dir * 8 + h], lf = p.MGATE[(size_t)tk * 16 + dir * 8 + 4 + h];
            const float lw = Dg + li;
            const float* kr = p.MQK + (size_t)tk * 512 + 256 + h * 64;
            const float* vr = p.PROJ + (size_t)tk * INW + MV_OFF + h * 64;
            float qk = 0.f;
#pragma unroll
            for (int i = 0; i < 64; ++i) qk += q[i] * kr[i];
            const float mn = fmaxf(m, lw), alpha = expf(m - mn), w = expf(lw - mn) * qk;
            den = den * alpha + w;
#pragma unroll
            for (int i = 0; i < 64; ++i) num[i] = num[i] * alpha + w * vr[i];
            m = mn;
            Dg += lf;
        }
    }
    const float dn = fmaxf(fabsf(den), expf(-m));
#pragma unroll
    for (int i = 0; i < 64; ++i) hout[i] += num[i] / dn;
}

HD void ph_mlstm(const Params& p, int l, bool upd, long gtid, long gsize) {
    const int nq = upd ? Tn + Cn : Tn;
    for (long it = gtid; it < (long)Bn * 4 * nq; it += gsize) {
        const int qi = (int)(it % nq), h = (int)((it / nq) % 4), b = (int)(it / ((long)nq * 4));
        const bool isc = qi >= Tn; const int ti = isc ? qi - Tn : qi;
        const int tok = isc ? NL + b * Cn + ti : b * Tn + ti;
        float q[64], hh[64];
#pragma unroll
        for (int i = 0; i < 64; ++i) { q[i] = p.MQK[(size_t)tok * 512 + h * 64 + i]; hh[i] = 0.f; }
        mlstm_dir_naive(p, b, h, isc, ti, 0, q, hh);
        mlstm_dir_naive(p, b, h, isc, ti, 1, q, hh);
        float ss = 0.f;
#pragma unroll
        for (int i = 0; i < 64; ++i) ss += hh[i] * hh[i];
        const float rstd = 1.0f / sqrtf(ss / 64 + EPSF);
        const float* hn = p.mlstm_head_norm + l * 256 + h * 64;
        const float* og = p.PROJ + (size_t)tok * INW + MO_OFF + h * 64;
#pragma unroll
        for (int i = 0; i < 64; ++i) p.MIX[(size_t)tok * Dm + 768 + h * 64 + i] = f2a(hh[i] * rstd * hn[i] * sigmoid_f(og[i]));
    }
}

HD void ph_gemm_out(const Params& p, int l, bool upd, long gtid, long gsize) {
    const float* W = p.w_out + (size_t)l * Dm * Dm;
    const long rows = upd ? NTOK : NL;
    for (long it = gtid; it < rows * Dm; it += gsize) {
        const long m = it / Dm; const int n = (int)(it % Dm);
        const act_t* a = p.MIX + m * Dm;
        float acc = 0.f;
        for (int k = 0; k < Dm; ++k) acc += a2f(a[k]) * W[(size_t)k * Dm + n];
        p.X[it] += mod_row(p, l, (int)m)[2 * Dm + n] * acc;
    }
}

HD void ph_norm2_route(const Params& p, int l, bool upd, long gtid, long gsize) {
    const long rows = upd ? NTOK : NL;
    for (long row = gtid; row < rows; row += gsize) {
        const float* xr = p.X + row * Dm;
        float ss = 0.f;
        for (int k = 0; k < Dm; ++k) ss += xr[k] * xr[k];
        const float rstd = 1.0f / sqrtf(ss / Dm + EPSF);
        const float* mr = mod_row(p, l, (int)row);
        const float* g = p.norm2_g + l * Dm;
        const float* wg = p.moe_wg + (size_t)l * Dm * 4; const float* we = p.moe_we + (size_t)l * Dm * 32;
        float ag[4], ae[32];
#pragma unroll
        for (int j = 0; j < 4; ++j) ag[j] = 0.f;
#pragma unroll
        for (int j = 0; j < 32; ++j) ae[j] = 0.f;
        for (int k = 0; k < Dm; ++k) {
            const float f = xr[k] * rstd * g[k] * (1.0f + mr[4 * Dm + k]) + mr[3 * Dm + k];
            p.F[row * Dm + k] = f2a(f);
#pragma unroll
            for (int j = 0; j < 4; ++j) ag[j] += f * wg[k * 4 + j];
#pragma unroll
            for (int j = 0; j < 32; ++j) ae[j] += f * we[k * 32 + j];
        }
        float gmax = -1e30f; int gi = 0;
#pragma unroll
        for (int j = 0; j < 4; ++j) { ag[j] += p.moe_bg[l * 4 + j]; if (ag[j] > gmax) { gmax = ag[j]; gi = j; } }
        float gsum = 0.f;
#pragma unroll
        for (int j = 0; j < 4; ++j) gsum += expf(ag[j] - gmax);
        const float gtop = 1.0f / gsum;
        float e1 = -1e30f, e2 = -1e30f; int i1 = 0, i2 = 0;
#pragma unroll
        for (int grp = 0; grp < 4; ++grp) {
            if (grp == gi) {
#pragma unroll
                for (int j = 0; j < 8; ++j) {
                    const float v = ae[grp * 8 + j] + p.moe_be[l * 32 + grp * 8 + j];
                    if (v > e1) { e2 = e1; i2 = i1; e1 = v; i1 = j; } else if (v > e2) { e2 = v; i2 = j; }
                }
            }
        }
        const float g0 = 1.0f / (1.0f + expf(e2 - e1));
        p.EID[row * 2] = gi * 8 + i1; p.EID[row * 2 + 1] = gi * 8 + i2;
        p.GATE[row * 2] = g0 * gtop; p.GATE[row * 2 + 1] = (1.0f - g0) * gtop;
    }
}

HD void ph_moe1(const Params& p, int l, bool upd, long gtid, long gsize) {
    const long rows = upd ? NTOK : NL;
    for (long it = gtid; it < rows * 2 * 512; it += gsize) {
        const long rk = it / 512; const int j = (int)(it % 512);
        const long row = rk >> 1;
        const int e = p.EID[rk];
        const float* W1 = p.moe_w1 + ((size_t)l * 32 + e) * Dm * 512 + j; const float* W3 = p.moe_w3 + ((size_t)l * 32 + e) * Dm * 512 + j;
        const act_t* f = p.F + row * Dm;
        float a = 0.f, bb = 0.f;
        for (int k = 0; k < Dm; ++k) { const float fv = a2f(f[k]); a += fv * W1[(size_t)k * 512]; bb += fv * W3[(size_t)k * 512]; }
        p.HN[it] = silu_f(a) * bb;
    }
}

HD void ph_moe2(const Params& p, int l, bool upd, long gtid, long gsize) {
    const long rows = upd ? NTOK : NL;
    for (long it = gtid; it < rows * Dm; it += gsize) {
        const long row = it / Dm; const int d = (int)(it % Dm);
        float y = 0.f;
        for (int kk = 0; kk < 2; ++kk) {
            const int e = p.EID[row * 2 + kk];
            const float* W2 = p.moe_w2 + ((size_t)l * 32 + e) * 512 * Dm + d;
            const float* hn = p.HN + (row * 2 + kk) * 512;
            float acc = 0.f;
            for (int j = 0; j < 512; ++j) acc += hn[j] * W2[(size_t)j * Dm];
            y += p.GATE[row * 2 + kk] * acc;
        }
        const float xn = p.X[it] + mod_row(p, l, (int)row)[5 * Dm + d] * y;
        p.X[it] = xn;
        if (l == DEPTH - 1) p.out[it] = xn;
    }
}

constexpr int PH_PER_LAYER = 8;
constexpr int N_PHASES = 1 + DEPTH * PH_PER_LAYER;
HD void run_phase(const Params& p, int ph, long gtid, long gsize) {
    if (ph == 0) { ph_mod(p, gtid, gsize); return; }
    const int l = (ph - 1) / PH_PER_LAYER, s = (ph - 1) % PH_PER_LAYER;
    const bool upd = l < DEPTH - 1;
    switch (s) {
        case 0: ph_norm1(p, l, gtid, gsize); break;
        case 1: ph_gemm_in(p, l, gtid, gsize); break;
        case 2: ph_post(p, l, gtid, gsize); break;
        case 3: ph_attn_diff(p, l, upd, gtid, gsize); ph_attn_gqa(p, l, upd, gtid, gsize); ph_mlstm(p, l, upd, gtid, gsize); break;
        case 4: ph_gemm_out(p, l, upd, gtid, gsize); break;
        case 5: ph_norm2_route(p, l, upd, gtid, gsize); break;
        case 6: ph_moe1(p, l, upd, gtid, gsize); break;
        default: ph_moe2(p, l, upd, gtid, gsize); break;
    }
}

struct Carver { char* base; size_t off; template <class T> T* take(size_t n) { T* r = (T*)(base + off); off += (n * sizeof(T) + 255) & ~(size_t)255; return r; } };
static inline size_t carve(Params& p, void* ws) {
    Carver c{(char*)ws, 0};
    p.mod = c.take<float>((size_t)DEPTH * (Bn + 1) * MODW);
    p.X = c.take<float>((size_t)NTOK * Dm);
#ifdef HOST_TEST
    p.PROJ = c.take<float>((size_t)NTOK * INW);
#endif
#ifdef HOST_TEST
    p.MQK = c.take<float>((size_t)NTOK * 512);
    p.MGATE = c.take<float>((size_t)NTOK * 16);
#endif
    p.DO = c.take<float>((size_t)Bn * 4 * (Tn + Cn) * 96);
    p.GATE = c.take<float>((size_t)NTOK * 2);
#ifdef HOST_TEST
    p.HN = c.take<float>((size_t)NTOK * 2 * 512);
#endif
    p.XN = c.take<act_t>((size_t)NTOK * Dm);
    p.DQL = c.take<act_t>((size_t)Bn * 4 * 2 * Tn * 48);
    p.DQC = c.take<act_t>((size_t)Bn * 4 * 2 * Cn * 48);
    p.DK = c.take<act_t>((size_t)Bn * 4 * 2 * Sn * 48);
    p.DVt = c.take<act_t>((size_t)Bn * 4 * 96 * Sn);
    p.GQL = c.take<act_t>((size_t)Bn * 6 * Tn * 64);
    p.GQC = c.take<act_t>((size_t)Bn * 6 * Cn * 64);
    p.GK = c.take<act_t>((size_t)Bn * 2 * Sn * 64);
    p.GVt = c.take<act_t>((size_t)Bn * 2 * 64 * Sn);
    p.MIX = c.take<act_t>((size_t)NTOK * Dm);
    p.F = c.take<act_t>((size_t)NTOK * Dm);
    p.EID = c.take<int>((size_t)NTOK * 2);
    p.CNT = c.take<int>((size_t)DEPTH * 32 * 64);
    p.LIST = c.take<int>((size_t)32 * NTOK);
    p.POS = c.take<int>((size_t)NTOK * 2);
    p.H = c.take<act_t>((size_t)PMAX * 512);
    p.Y = c.take<act_t>((size_t)PMAX * Dm);
    p.ROPE = c.take<float>((size_t)64 * 28 * 2);
    p.KV = c.take<float>((size_t)Bn * 4 * 2 * NCH * 4096);
    p.NLC = c.take<float>((size_t)Bn * 4 * 2 * NCH * 64);
    p.CHS = c.take<float>((size_t)Bn * 4 * 2 * NCH * 2);
    p.MG4 = c.take<float>((size_t)NTOK * 16);
    p.MQKB = c.take<act_t>((size_t)NTOK * 512);
    p.BAR = c.take<unsigned>(4096);
    p.WIN_T = c.take<act_t>((size_t)DEPTH * INW * Dm);
    p.WOUT_T = c.take<act_t>((size_t)DEPTH * Dm * Dm);
    p.TS = c.take<unsigned long long>(256);
    p.FLO = c.take<act_t>((size_t)NTOK * Dm);
    p.WRHI = c.take<act_t>((size_t)DEPTH * 36 * Dm);
    p.WRLO = c.take<act_t>((size_t)DEPTH * 36 * Dm);
    p.ZROW = c.take<act_t>(2048);
    p.W13T = c.take<act_t>((size_t)2 * 32 * 1024 * Dm);
    p.W2T = c.take<act_t>((size_t)2 * 32 * Dm * 512);
    p.PROJB = c.take<act_t>((size_t)NTOK * INW);
    p.PG = c.take<float>((size_t)NTOK * 16);
    return c.off;
}
static inline void fill_inputs(Params& p, void* const* d_in, void* d_out) {
    const float** f = (const float**)&p;
    for (int i = 0; i < 27; ++i) f[i] = (const float*)d_in[i];
    p.out = (float*)d_out;
}


#ifndef HOST_TEST
typedef short bf16x8 __attribute__((ext_vector_type(8)));
typedef float f32x2 __attribute__((ext_vector_type(2)));
typedef float f32x4 __attribute__((ext_vector_type(4)));
typedef float f32x16 __attribute__((ext_vector_type(16)));
typedef unsigned u32x2 __attribute__((ext_vector_type(2)));
typedef unsigned u32x4 __attribute__((ext_vector_type(4)));
typedef __bf16 bf16x2_t __attribute__((ext_vector_type(2)));
#define DI __device__ __forceinline__
DI unsigned pk2(float a, float b) { f32x2 v = {a, b}; return __builtin_bit_cast(unsigned, __builtin_convertvector(v, bf16x2_t)); }
DI float bflo(unsigned u) { return __uint_as_float(u << 16); }
DI float bfhi(unsigned u) { return __uint_as_float(u & 0xffff0000u); }
DI f32x4 ld4bf(const act_t* q) { const u32x2 v = *(const u32x2*)q; return (f32x4){bflo(v[0]), bfhi(v[0]), bflo(v[1]), bfhi(v[1])}; }
DI float shfl_i(float v, int src) { return __int_as_float(__builtin_amdgcn_ds_bpermute(src << 2, __float_as_int(v))); }
DI float shfl_x(float v, int o, int lane) { return shfl_i(v, lane ^ o); }
DI float row16_sum(float v) {
#define ROR_(x, n) __int_as_float(__builtin_amdgcn_update_dpp(0, __float_as_int(x), 0x120 + (n), 0xF, 0xF, false))
    v += ROR_(v, 8); v += ROR_(v, 4); v += ROR_(v, 2); v += ROR_(v, 1);
#undef ROR_
    return v;
}
DI float wave_sum(float v, int lane) {
#pragma unroll
    for (int o = 32; o > 0; o >>= 1) v += shfl_x(v, o, lane);
    return v;
}

constexpr int NTHR = 256;
DI void lds_barrier() { asm volatile("s_waitcnt lgkmcnt(0)" ::: "memory"); __builtin_amdgcn_s_barrier(); asm volatile("" ::: "memory"); }
DI int opaque_tid() { int t = threadIdx.x; asm volatile("" : "+v"(t)); return t; }
constexpr int GT_LD = 144;
constexpr int GT_AS = 0, GT_BS = 128 * GT_LD, GT_END = 256 * GT_LD;
constexpr int SM_AUX = 65536;
constexpr int SMEM_BYTES = 66 * 1024;

#ifndef IMPL_POST
#define IMPL_POST 1
#endif
#ifndef IMPL_ATTN
#define IMPL_ATTN 1
#endif
#ifndef IMPL_MLSTM
#define IMPL_MLSTM 1
#endif
#ifndef IMPL_ROUTE
#define IMPL_ROUTE 1
#endif
DI int gt_off(int r, int c) { return r * 128 + ((c ^ ((r >> 1) & 7)) << 4); }
constexpr int GT_STAGE = 32768, GT_B = 16384;
#define GT_COMPUTE(BUF) \
    _Pragma("unroll") for (int kk = 0; kk < 2; ++kk) { \
        bf16x8 af[4], bfr[4]; \
        _Pragma("unroll") for (int mi = 0; mi < 4; ++mi) af[mi] = *(const bf16x8*)(smem + (BUF) * GT_STAGE + gt_off(wm * 64 + mi * 16 + (lane & 15), kk * 4 + (lane >> 4))); \
        _Pragma("unroll") for (int ni = 0; ni < 4; ++ni) bfr[ni] = *(const bf16x8*)(smem + (BUF) * GT_STAGE + GT_B + gt_off(wn * 64 + ni * 16 + (lane & 15), kk * 4 + (lane >> 4))); \
        _Pragma("unroll") for (int mi = 0; mi < 4; ++mi) \
            _Pragma("unroll") for (int ni = 0; ni < 4; ++ni) acc[mi][ni] = __builtin_amdgcn_mfma_f32_16x16x32_bf16(bfr[ni], af[mi], acc[mi][ni], 0, 0, 0); }

DI void gemm_mainloop(unsigned char* smem, const act_t* const (&arow)[4], const float* bptr, const int ldb, const int K, f32x4 (&acc)[4][4]) {
    const int tid = opaque_tid(), lane = tid & 63, w = tid >> 6, wm = w >> 1, wn = w & 1;
    const int a_r = tid >> 3, a_c = tid & 7, kg = lane & 7, c4 = (w * 8 + (lane >> 3)) * 4;
#pragma unroll
    for (int mi = 0; mi < 4; ++mi)
#pragma unroll
        for (int ni = 0; ni < 4; ++ni) acc[mi][ni] = (f32x4){0.f, 0.f, 0.f, 0.f};
    u32x4 ra[4]; f32x4 rb[8];
#define GT_LOAD(KOFF) { \
    _Pragma("unroll") for (int i = 0; i < 4; ++i) ra[i] = *(const u32x4*)(arow[i] + (KOFF) + a_c * 8); \
    _Pragma("unroll") for (int r = 0; r < 8; ++r) rb[r] = *(const f32x4*)(bptr + (size_t)((KOFF) + kg * 8 + r) * ldb); }
#define GT_WRITE(BUF) { \
    _Pragma("unroll") for (int i = 0; i < 4; ++i) *(u32x4*)(smem + (BUF) * GT_STAGE + gt_off(a_r + 32 * i, a_c)) = ra[i]; \
    _Pragma("unroll") for (int i = 0; i < 4; ++i) { \
        const u32x4 q = {pk2(rb[0][i], rb[1][i]), pk2(rb[2][i], rb[3][i]), pk2(rb[4][i], rb[5][i]), pk2(rb[6][i], rb[7][i])}; \
        *(u32x4*)(smem + (BUF) * GT_STAGE + GT_B + gt_off(c4 + i, kg)) = q; } }
    const int nt = K >> 6;
    __syncthreads();
    GT_LOAD(0)
    GT_WRITE(0)
    __syncthreads();
    if (nt > 1) GT_LOAD(64)
    for (int t = 0; t < nt; ++t) {
        const int buf = t & 1;
        GT_COMPUTE(buf)
        if (t + 1 < nt) GT_WRITE(buf ^ 1)
        __syncthreads();
        if (t + 2 < nt) GT_LOAD((t + 2) * 64)
    }
#undef GT_LOAD
#undef GT_WRITE
}

#define LDSP __attribute__((address_space(3)))
template <int MODE = 0>
DI void gemm_mainloop_bb(unsigned char* smem, const act_t* const (&arow)[4], const act_t* const (&brow)[4], const int K, f32x4 (&acc)[4][4]) {
    const int tid = opaque_tid(), lane = tid & 63, w = tid >> 6, wm = w >> 1, wn = w & 1;
    const int wu = __builtin_amdgcn_readfirstlane(w);
#pragma unroll
    for (int mi = 0; mi < 4; ++mi)
#pragma unroll
        for (int ni = 0; ni < 4; ++ni) acc[mi][ni] = (f32x4){0.f, 0.f, 0.f, 0.f};
    const int csrc = ((lane & 7) ^ ((4 * w + (lane >> 4)) & 7)) * 8;
#define GB_DMA(KOFF, BUF) { \
    _Pragma("unroll") for (int i = 0; i < 4; ++i) { \
        __builtin_amdgcn_global_load_lds((const unsigned*)(arow[i] + (KOFF) + csrc), (LDSP unsigned*)(smem + (BUF) * GT_STAGE + (4 * i + wu) * 1024), 16, 0, 0); \
        __builtin_amdgcn_global_load_lds((const unsigned*)(brow[i] + (KOFF) + csrc), (LDSP unsigned*)(smem + (BUF) * GT_STAGE + GT_B + (4 * i + wu) * 1024), 16, 0, 0); } }
    const int nt = K >> 6;
    __syncthreads();
    GB_DMA(0, 0)
    asm volatile("s_waitcnt vmcnt(0)" ::: "memory");
    __syncthreads();
    for (int t = 0; t < nt; ++t) {
        const int buf = t & 1;
        if (t + 1 < nt) GB_DMA((t + 1) * 64, buf ^ 1)
        GT_COMPUTE(buf)
        asm volatile("s_waitcnt vmcnt(0)" ::: "memory");
        __syncthreads();
    }
#undef GB_DMA
}

DI void bp_wconv(const Params& p, unsigned char* smem, int bid, int G) {
    const int tid = opaque_tid();
    float* T = (float*)smem;
    constexpr int NT_IN = (INW + 63) / 64, NT_OUT = Dm / 64, KT = Dm / 64;
    constexpr int PER_L = (NT_IN + NT_OUT) * KT;
    const int k = tid >> 2, n16 = (tid & 3) * 16;
    const int n = tid >> 2, k16 = (tid & 3) * 16;
    f32x4 v[4];
#define WC_DECODE(ITEM) const int l_ = (ITEM) / PER_L, r_ = (ITEM) % PER_L; const bool isout_ = r_ >= NT_IN * KT; \
        const int rr_ = isout_ ? r_ - NT_IN * KT : r_, nt_ = rr_ / KT, kt_ = rr_ % KT, N_ = isout_ ? Dm : INW; \
        const float* W_ = isout_ ? p.w_out + (size_t)l_ * Dm * Dm : p.w_in + (size_t)l_ * Dm * INW;
#define WC_LOAD(ITEM) { WC_DECODE(ITEM) \
        _Pragma("unroll") for (int i = 0; i < 4; ++i) { const int nn = nt_ * 64 + n16 + i * 4; v[i] = nn < N_ ? *(const f32x4*)(W_ + (size_t)(kt_ * 64 + k) * N_ + nn) : (f32x4){0.f, 0.f, 0.f, 0.f}; } }
    if (bid < DEPTH * PER_L) WC_LOAD(bid)
    for (int item = bid; item < DEPTH * PER_L; item += G) {
        __syncthreads();
#pragma unroll
        for (int i = 0; i < 4; ++i) { T[k * 65 + n16 + i * 4] = v[i][0]; T[k * 65 + n16 + i * 4 + 1] = v[i][1]; T[k * 65 + n16 + i * 4 + 2] = v[i][2]; T[k * 65 + n16 + i * 4 + 3] = v[i][3]; }
        __syncthreads();
        if (item + G < DEPTH * PER_L) WC_LOAD(item + G)
        WC_DECODE(item)
        (void)W_;
        act_t* WT = isout_ ? p.WOUT_T + (size_t)l_ * Dm * Dm : p.WIN_T + (size_t)l_ * INW * Dm;
        if (nt_ * 64 + n < N_) {
            unsigned o[8];
#pragma unroll
            for (int i = 0; i < 8; ++i) o[i] = pk2(T[(k16 + 2 * i) * 65 + n], T[(k16 + 2 * i + 1) * 65 + n]);
            act_t* dst = WT + (size_t)(nt_ * 64 + n) * Dm + kt_ * 64 + k16;
            *(u32x4*)dst = (u32x4){o[0], o[1], o[2], o[3]}; *(u32x4*)(dst + 8) = (u32x4){o[4], o[5], o[6], o[7]};
        }
    }
#undef WC_LOAD
#undef WC_DECODE
}

DI int xcd_remap(int b, int G) { return (G & 7) == 0 ? (b & 7) * (G >> 3) + (b >> 3) : b; }

template <int MODE = 0>
DI void bp_gemm_in(const Params& p, int l, unsigned char* smem, int vb, int G) {
    constexpr int MT = NTOK / 128, NT = (INW + 127) / 128;
    const float* W = p.w_in + (size_t)l * Dm * INW;
    const int tid = opaque_tid(), lane = tid & 63, w = tid >> 6, wm = w >> 1, wn = w & 1, a_r = tid >> 3, c4 = (w * 8 + (lane >> 3)) * 4;
    for (int t = vb; t < MT * NT; t += G) {
        const int mt = t / NT, nt = t % NT, m0 = mt * 128, n0 = nt * 128;
        const act_t* arow[4];
#pragma unroll
        for (int i = 0; i < 4; ++i) arow[i] = p.XN + (size_t)(m0 + a_r + 32 * i) * Dm;
        const act_t* brow[4];
#pragma unroll
        for (int i = 0; i < 4; ++i) brow[i] = n0 + a_r + 32 * i < INW ? p.WIN_T + ((size_t)l * INW + n0 + a_r + 32 * i) * Dm : p.ZROW;
        f32x4 acc[4][4];
        gemm_mainloop_bb<MODE>(smem, arow, brow, Dm, acc);
#pragma unroll
        for (int mi = 0; mi < 4; ++mi)
#pragma unroll
            for (int ni = 0; ni < 4; ++ni) {
                const int m = m0 + wm * 64 + mi * 16 + (lane & 15), n = n0 + wn * 64 + ni * 16 + (lane >> 4) * 4;
                if (n < INW) {
                    const f32x4 v = acc[mi][ni];
                    *(u32x2*)(p.PROJB + (size_t)m * INW + n) = (u32x2){pk2(v[0], v[1]), pk2(v[2], v[3])};
                    if (n >= MG_OFF) *(f32x4*)(p.PG + (size_t)m * 16 + n - MG_OFF) = v;
                }
            }
    }
}

DI void mconv_drain(const Params& p, int l, unsigned char* smem, int max_items);
template <bool DRY>
DI void bp_gemm_out(const Params& p, int l, bool upd, unsigned char* smem, int vb, int G) {
    const int MT = (upd ? NTOK : NL) / 128; constexpr int NT = Dm / 128;
    const float* W = p.w_out + (size_t)l * Dm * Dm;
    const int tid = opaque_tid(), lane = tid & 63, w = tid >> 6, wm = w >> 1, wn = w & 1, a_r = tid >> 3, c4 = (w * 8 + (lane >> 3)) * 4;
    for (int t = vb; t < MT * NT; t += G) {
        const int mt = t / NT, nt = t % NT, m0 = mt * 128, n0 = nt * 128;
        const act_t* arow[4];
#pragma unroll
        for (int i = 0; i < 4; ++i) arow[i] = p.MIX + (size_t)(m0 + a_r + 32 * i) * Dm;
        const act_t* brow[4];
#pragma unroll
        for (int i = 0; i < 4; ++i) brow[i] = p.WOUT_T + ((size_t)l * Dm + n0 + a_r + 32 * i) * Dm;
        f32x4 acc[4][4];
        gemm_mainloop_bb(smem, arow, brow, Dm, acc);
#pragma unroll
        for (int mi = 0; mi < 4; ++mi) {
            const int m = m0 + wm * 64 + mi * 16 + (lane & 15);
            const float* g1 = mod_row(p, l, m) + 2 * Dm;
#pragma unroll
            for (int ni = 0; ni < 4; ++ni) {
                const int n = n0 + wn * 64 + ni * 16 + (lane >> 4) * 4;
                f32x4* xp = (f32x4*)(p.X + (size_t)m * Dm + n);
                const f32x4 xo = l == 0 ? *(const f32x4*)((m < NL ? p.x + (size_t)m * Dm : p.ctx + (size_t)(m - NL) * Dm) + n) : *xp;
                if (DRY) *(f32x4*)((float*)p.PROJB + (size_t)m * Dm + n) = xo + *(const f32x4*)(g1 + n) * acc[mi][ni];
                else *xp = xo + *(const f32x4*)(g1 + n) * acc[mi][ni];
            }
        }
    }
    if (!DRY && vb >= (MT * NT) % G) mconv_drain(p, l, smem, 1);
}

DI int* moe_prep(const Params& p, int l, unsigned char* smem) {
    int* s_moff = (int*)(smem + SM_AUX);
    __syncthreads();
    if (threadIdx.x == 0) { int o = 0; for (int e = 0; e < 32; ++e) { s_moff[e] = o; o += (p.CNT[(l * 32 + e) * 64] + 127) >> 7; } s_moff[32] = o; }
    __syncthreads();
    return s_moff;
}

DI void bp_moe1(const Params& p, int l, unsigned char* smem, int vb, int G) {
    const int* s_moff = moe_prep(p, l, smem);
    const int total = s_moff[32] * 8;
    const int tid = opaque_tid(), lane = tid & 63, w = tid >> 6, wm = w >> 1, wn = w & 1, a_r = tid >> 3, c4 = (w * 8 + (lane >> 3)) * 4;
    for (int t = vb; t < total; t += G) {
        const int mtg = t >> 3, nt = t & 7;
        int e = 0; while (s_moff[e + 1] <= mtg) ++e;
        const int cnt = p.CNT[(l * 32 + e) * 64], lbase = (mtg - s_moff[e]) * 128;
        const act_t* arow[4];
#pragma unroll
        for (int i = 0; i < 4; ++i) { const int li = lbase + a_r + 32 * i; arow[i] = li < cnt ? p.F + (size_t)p.LIST[(size_t)e * NTOK + li] * Dm : p.ZROW; }
        const act_t* brow[4];
#pragma unroll
        for (int i = 0; i < 4; ++i) { const int r = a_r + 32 * i, sel = (r & 63) >> 5, j = nt * 64 + (r >> 6) * 32 + (r & 31); brow[i] = p.W13T + ((size_t)(l & 1) * 32 * 1024 + (size_t)e * 1024 + sel * 512 + j) * Dm; }
        f32x4 acc[4][4];
        gemm_mainloop_bb(smem, arow, brow, Dm, acc);
#pragma unroll
        for (int mi = 0; mi < 4; ++mi)
#pragma unroll
            for (int ni = 0; ni < 2; ++ni) {
                const f32x4 a = acc[mi][ni], b = acc[mi][ni + 2];
                float h[4];
#pragma unroll
                for (int r = 0; r < 4; ++r) h[r] = a[r] / (1.0f + __expf(-a[r])) * b[r];
                const int prow = mtg * 128 + wm * 64 + mi * 16 + (lane & 15), jj = nt * 64 + wn * 32 + ni * 16 + (lane >> 4) * 4;
                *(u32x2*)(p.H + (size_t)prow * 512 + jj) = (u32x2){pk2(h[0], h[1]), pk2(h[2], h[3])};
            }
    }
}

DI void bp_moe2(const Params& p, int l, unsigned char* smem, int vb, int G) {
    const int* s_moff = moe_prep(p, l, smem);
    const int total = s_moff[32] * 8;
    const int tid = opaque_tid(), lane = tid & 63, w = tid >> 6, wm = w >> 1, wn = w & 1, a_r = tid >> 3, c4 = (w * 8 + (lane >> 3)) * 4;
    for (int t = vb; t < total; t += G) {
        const int mtg = t >> 3, nt = t & 7, n0 = nt * 128;
        int e = 0; while (s_moff[e + 1] <= mtg) ++e;
        const act_t* arow[4];
#pragma unroll
        for (int i = 0; i < 4; ++i) arow[i] = p.H + (size_t)(mtg * 128 + a_r + 32 * i) * 512;
        const act_t* brow[4];
#pragma unroll
        for (int i = 0; i < 4; ++i) brow[i] = p.W2T + (((size_t)(l & 1) * 32 + e) * Dm + n0 + a_r + 32 * i) * 512;
        f32x4 acc[4][4];
        gemm_mainloop_bb(smem, arow, brow, 512, acc);
#pragma unroll
        for (int mi = 0; mi < 4; ++mi)
#pragma unroll
            for (int ni = 0; ni < 4; ++ni) {
                const int prow = mtg * 128 + wm * 64 + mi * 16 + (lane & 15), n = n0 + wn * 64 + ni * 16 + (lane >> 4) * 4;
                const f32x4 v = acc[mi][ni];
                *(u32x2*)(p.Y + (size_t)prow * Dm + n) = (u32x2){pk2(v[0], v[1]), pk2(v[2], v[3])};
            }
    }
}

DI void bp_route(const Params& p, int l, bool upd, long gtid, long gsize) {
    ph_norm2_route(p, l, upd, gtid, gsize);
    const long rows = upd ? NTOK : NL;
    for (long row = gtid; row < rows; row += gsize)
#pragma unroll
        for (int kk = 0; kk < 2; ++kk) {
            const int e = p.EID[row * 2 + kk];
            const int pos = atomicAdd(&p.CNT[(l * 32 + e) * 64], 1);
            p.LIST[(size_t)e * NTOK + pos] = (int)row;
            p.POS[row * 2 + kk] = pos;
        }
}

DI void norm1_row(const Params& p, int l, long row, const f32x4 (&x)[4], int lane) {
    float ss = 0.f;
#pragma unroll
    for (int i = 0; i < 4; ++i) ss += x[i][0] * x[i][0] + x[i][1] * x[i][1] + x[i][2] * x[i][2] + x[i][3] * x[i][3];
    ss = wave_sum(ss, lane);
    const float rstd = 1.0f / sqrtf(ss / Dm + EPSF);
    const float* mr = mod_row(p, l, (int)row);
    const float* g = p.norm1_g + l * Dm;
#pragma unroll
    for (int i = 0; i < 4; ++i) {
        const int k = 256 * i + 4 * lane;
        const f32x4 gv = *(const f32x4*)(g + k), sh = *(const f32x4*)(mr + k), sc = *(const f32x4*)(mr + Dm + k);
        const f32x4 y = x[i] * rstd * gv * (1.0f + sc) + sh;
        *(u32x2*)(p.XN + row * Dm + k) = (u32x2){pk2(y[0], y[1]), pk2(y[2], y[3])};
    }
}
DI void bp_norm1(const Params& p, int l, int gwave, int nwaves, int lane) {
    for (long row0 = gwave; row0 < NTOK; row0 += 3 * (long)nwaves) {
        f32x4 x[3][4]; long rw[3];
#pragma unroll
        for (int u = 0; u < 3; ++u) {
            rw[u] = row0 + (long)u * nwaves < NTOK ? row0 + (long)u * nwaves : row0;
            const float* src = rw[u] < NL ? p.x + rw[u] * Dm : p.ctx + (rw[u] - NL) * Dm;
#pragma unroll
            for (int i = 0; i < 4; ++i) x[u][i] = *(const f32x4*)(src + 256 * i + 4 * lane);
        }
#pragma unroll
        for (int u = 0; u < 3; ++u) if (u == 0 || row0 + (long)u * nwaves < NTOK) norm1_row(p, l, rw[u], x[u], lane);
    }
}
template <bool DRY>
DI void bp_combine(const Params& p, int l, bool upd, unsigned char* smem, int gwave, int nwaves, int lane) {
    const int* s_moff = moe_prep(p, l, smem);
    const long rows = upd ? NTOK : NL;
    const long rpw = (rows + nwaves - 1) / nwaves, rbeg = (long)gwave * rpw, rend = rbeg + rpw < rows ? rbeg + rpw : rows;
    constexpr int CU_ = 3;
    int mb_loaded = -1;
    f32x4 g2v[4], mulv[4], addv[4];
    for (long row0 = rbeg; row0 < rend; row0 += CU_) {
        long rw[CU_]; bool ok[CU_]; size_t pa[CU_], pb[CU_]; float g0[CU_], g1[CU_];
#pragma unroll
        for (int u = 0; u < CU_; ++u) {
            rw[u] = row0 + u; ok[u] = rw[u] < rend; if (!ok[u]) rw[u] = row0;
            const int e0 = p.EID[rw[u] * 2], e1 = p.EID[rw[u] * 2 + 1];
            pa[u] = (size_t)s_moff[e0] * 128 + p.POS[rw[u] * 2]; pb[u] = (size_t)s_moff[e1] * 128 + p.POS[rw[u] * 2 + 1];
            g0[u] = p.GATE[rw[u] * 2]; g1[u] = p.GATE[rw[u] * 2 + 1];
        }
        f32x4 ya[CU_][4], xo[CU_][4];
#pragma unroll
        for (int u = 0; u < CU_; ++u)
#pragma unroll
            for (int i = 0; i < 4; ++i) {
                const int k = 256 * i + 4 * lane;
                const u32x2 a2 = *(const u32x2*)(p.Y + pa[u] * Dm + k), b2 = *(const u32x2*)(p.Y + pb[u] * Dm + k);
                ya[u][i] = (f32x4){g0[u] * bflo(a2[0]) + g1[u] * bflo(b2[0]), g0[u] * bfhi(a2[0]) + g1[u] * bfhi(b2[0]), g0[u] * bflo(a2[1]) + g1[u] * bflo(b2[1]), g0[u] * bfhi(a2[1]) + g1[u] * bfhi(b2[1])};
                xo[u][i] = *(const f32x4*)(p.X + rw[u] * Dm + k);
            }
#pragma unroll
        for (int u = 0; u < CU_; ++u) {
            if (!ok[u]) continue;
            const int mb = tok_modrow((int)rw[u]);
            if (mb != mb_loaded) {
                mb_loaded = mb;
                const float* mr = p.mod + ((size_t)l * (Bn + 1) + mb) * MODW;
                const float* mrn = p.mod + ((size_t)(l + 1 < DEPTH ? l + 1 : l) * (Bn + 1) + mb) * MODW;
                const float* gn = p.norm1_g + (l + 1 < DEPTH ? l + 1 : l) * Dm;
#pragma unroll
                for (int i = 0; i < 4; ++i) {
                    const int k = 256 * i + 4 * lane;
                    g2v[i] = *(const f32x4*)(mr + 5 * Dm + k);
                    mulv[i] = *(const f32x4*)(gn + k) * (1.0f + *(const f32x4*)(mrn + Dm + k)); addv[i] = *(const f32x4*)(mrn + k);
                }
            }
            f32x4 x[4]; float ss = 0.f;
#pragma unroll
            for (int i = 0; i < 4; ++i) { x[i] = xo[u][i] + g2v[i] * ya[u][i]; ss += x[i][0] * x[i][0] + x[i][1] * x[i][1] + x[i][2] * x[i][2] + x[i][3] * x[i][3]; }
            if (!DRY) {
#pragma unroll
                for (int i = 0; i < 4; ++i) { const int k = 256 * i + 4 * lane; if (l == DEPTH - 1) *(f32x4*)(p.out + rw[u] * Dm + k) = x[i]; else *(f32x4*)(p.X + rw[u] * Dm + k) = x[i]; }
            }
            if (l < DEPTH - 1) {
                ss = wave_sum(ss, lane);
                const float rstd = 1.0f / sqrtf(ss / Dm + EPSF);
#pragma unroll
                for (int i = 0; i < 4; ++i) {
                    const f32x4 y = x[i] * rstd * mulv[i] + addv[i];
                    *(u32x2*)(p.XN + rw[u] * Dm + 256 * i + 4 * lane) = (u32x2){pk2(y[0], y[1]), pk2(y[2], y[3])};
                }
            }
        }
    }
}

template <int DQK, int DV>
struct AttnCfg {
    static constexpr int KP = DQK * 2 + 16, VP = 144;
    static constexpr int KCH = DQK / 8;
    static constexpr int NK = 64 * KCH, NV = DV * 8, NCH = NK + NV, NLD = (NCH + NTHR - 1) / NTHR;
    static constexpr int LDS_K = 0, LDS_V = 64 * KP, LDS_END = LDS_V + DV * VP;
    static_assert(LDS_END <= GT_END, "attention tile exceeds the LDS budget");
};

template <int DQK, int DV>
DI void attn_block(unsigned char* smem, const act_t* Qb, const act_t* Kb, const act_t* Vt, const int nk, const int q0, f32x16 (&ot)[DV / 32], float& lsum) {
    typedef AttnCfg<DQK, DV> C;
    const int tid = opaque_tid(), lane = tid & 63, w = tid >> 6, h = lane >> 5, qr = lane & 31;
    const int pi = (qr & ~12) | ((qr & 4) << 1) | ((qr & 8) >> 1);
    bf16x8 qf[DQK / 16];
#pragma unroll
    for (int st = 0; st < DQK / 16; ++st) qf[st] = *(const bf16x8*)(Qb + (size_t)(q0 + w * 32 + qr) * DQK + st * 16 + h * 8);
    float m = -1e30f; lsum = 0.f;
#pragma unroll
    for (int db = 0; db < DV / 32; ++db)
#pragma unroll
        for (int r = 0; r < 16; ++r) ot[db][r] = 0.f;
    int goff[C::NLD], ldst[C::NLD];
#pragma unroll
    for (int i = 0; i < C::NLD; ++i) {
        const int c = tid + NTHR * i;
        if (c < C::NK) { const int row = c / C::KCH, part = c % C::KCH; goff[i] = (row * DQK + part * 8) * 2; ldst[i] = C::LDS_K + row * C::KP + part * 16; }
        else { const int cc = (c - C::NK) < C::NV ? c - C::NK : 0, row = cc >> 3, part = cc & 7; goff[i] = (int)((const char*)Vt - (const char*)Kb) + (row * Sn + part * 8) * 2; ldst[i] = C::LDS_V + row * C::VP + part * 16; }
    }
    u32x4 rg[C::NLD];
#pragma unroll
    for (int i = 0; i < C::NLD; ++i) rg[i] = *(const u32x4*)((const char*)Kb + goff[i]);
    const int ntiles = nk >> 6;
    for (int kt = 0; kt < ntiles; ++kt) {
        __syncthreads();
#pragma unroll
        for (int i = 0; i < C::NLD; ++i) if (tid + NTHR * i < C::NCH) *(u32x4*)(smem + ldst[i]) = rg[i];
        __syncthreads();
        if (kt + 1 < ntiles) {
#pragma unroll
            for (int i = 0; i < C::NLD; ++i) rg[i] = *(const u32x4*)((const char*)Kb + goff[i] + (kt + 1) * ((tid + NTHR * i < C::NK) ? 128 * DQK : 128));
        }
        f32x16 sc[2];
        __builtin_amdgcn_s_setprio(1);
#pragma unroll
        for (int kb = 0; kb < 2; ++kb) {
#pragma unroll
            for (int r = 0; r < 16; ++r) sc[kb][r] = 0.f;
#pragma unroll
            for (int st = 0; st < DQK / 16; ++st) {
                const bf16x8 a = *(const bf16x8*)(smem + C::LDS_K + (kb * 32 + pi) * C::KP + st * 32 + h * 16);
                sc[kb] = __builtin_amdgcn_mfma_f32_32x32x16_bf16(a, qf[st], sc[kb], 0, 0, 0);
            }
        }
        __builtin_amdgcn_s_setprio(0);
        float mx = sc[0][0];
#pragma unroll
        for (int kb = 0; kb < 2; ++kb)
#pragma unroll
            for (int r = 0; r < 16; ++r) mx = fmaxf(mx, sc[kb][r]);
        mx = fmaxf(mx, shfl_x(mx, 32, lane));
        const float mn = fmaxf(m, mx), alpha = __builtin_amdgcn_exp2f(m - mn);
        m = mn;
        float ps = 0.f;
#pragma unroll
        for (int kb = 0; kb < 2; ++kb)
#pragma unroll
            for (int r = 0; r < 16; ++r) { sc[kb][r] = __builtin_amdgcn_exp2f(sc[kb][r] - mn); ps += sc[kb][r]; }
        lsum = lsum * alpha + ps;
#pragma unroll
        for (int db = 0; db < DV / 32; ++db)
#pragma unroll
            for (int r = 0; r < 16; ++r) ot[db][r] *= alpha;
#pragma unroll
        for (int kb = 0; kb < 2; ++kb)
#pragma unroll
            for (int s2 = 0; s2 < 2; ++s2) {
                const u32x4 pw = {pk2(sc[kb][8 * s2], sc[kb][8 * s2 + 1]), pk2(sc[kb][8 * s2 + 2], sc[kb][8 * s2 + 3]), pk2(sc[kb][8 * s2 + 4], sc[kb][8 * s2 + 5]), pk2(sc[kb][8 * s2 + 6], sc[kb][8 * s2 + 7])};
                const bf16x8 pf = __builtin_bit_cast(bf16x8, pw);
#pragma unroll
                for (int db = 0; db < DV / 32; ++db) {
                    const bf16x8 a = *(const bf16x8*)(smem + C::LDS_V + (db * 32 + qr) * C::VP + (kb * 32 + 16 * s2 + 8 * h) * 2);
                    ot[db] = __builtin_amdgcn_mfma_f32_32x32x16_bf16(a, pf, ot[db], 0, 0, 0);
                }
            }
    }
    lsum += shfl_x(lsum, 32, lane);
}

DI void bp_attn(const Params& p, int l, bool upd, unsigned char* smem, int bid, int G) {
    constexpr int QTL = Tn / 128, QTC = Cn / 128;
    const int n_dl = Bn * 4 * QTL, n_gl = Bn * 6 * QTL, n_dc = upd ? Bn * 4 * QTC : 0, n_gc = upd ? Bn * 6 * QTC : 0;
    const int tid = opaque_tid(), lane = tid & 63, w = tid >> 6, hh = lane >> 5, qr = lane & 31;
    const float lam_init = lam_init_of(l);
    for (int it = bid; it < n_dl + n_gl + n_dc + n_gc; it += G) {
        int x = it; bool isdiff, isc;
        if (x < n_dl) { isdiff = true; isc = false; }
        else if ((x -= n_dl) < n_gl) { isdiff = false; isc = false; }
        else if ((x -= n_gl) < n_dc) { isdiff = true; isc = true; }
        else { x -= n_dc; isdiff = false; isc = true; }
        const int qt_n = isc ? QTC : QTL, qlen = isc ? Cn : Tn, nk = isc ? Cn : Sn;
        const int qt = x % qt_n, hb = x / qt_n;
        const int q0 = qt * 128;
        if (isdiff) {
            const int h = hb % 4, b = hb / 4;
            const act_t* Vt = p.DVt + (size_t)(b * 4 + h) * 96 * Sn;
            f32x16 ot[3]; float ls;
            f32x4* stash = (f32x4*)(p.DO + ((size_t)blockIdx.x * NTHR + tid) * 48);
            attn_block<48, 96>(smem, (isc ? p.DQC : p.DQL) + ((size_t)(b * 4 + h) * 2) * qlen * 48, p.DK + ((size_t)(b * 4 + h) * 2) * Sn * 48, Vt, nk, q0, ot, ls);
            {
                const float i1 = 1.0f / ls;
#pragma unroll
                for (int db = 0; db < 3; ++db)
#pragma unroll
                    for (int g = 0; g < 4; ++g) stash[db * 4 + g] = (f32x4){ot[db][4 * g] * i1, ot[db][4 * g + 1] * i1, ot[db][4 * g + 2] * i1, ot[db][4 * g + 3] * i1};
            }
            attn_block<48, 96>(smem, (isc ? p.DQC : p.DQL) + ((size_t)(b * 4 + h) * 2 + 1) * qlen * 48, p.DK + ((size_t)(b * 4 + h) * 2 + 1) * Sn * 48, Vt, nk, q0, ot, ls);
            const float* dl = p.diff_lambda + l * 4 * 48;
            float s01 = 0.f, s23 = 0.f;
            for (int i = 0; i < 48; ++i) { s01 += dl[i] * dl[48 + i]; s23 += dl[96 + i] * dl[144 + i]; }
            const float lam = expf(s01) - expf(s23) + lam_init;
            const float i2 = lam / ls;
            float ss = 0.f;
#pragma unroll
            for (int db = 0; db < 3; ++db)
#pragma unroll
                for (int g = 0; g < 4; ++g) {
                    const f32x4 o1 = stash[db * 4 + g];
#pragma unroll
                    for (int r = 0; r < 4; ++r) { const float v = o1[r] - ot[db][4 * g + r] * i2; ot[db][4 * g + r] = v; ss += v * v; }
                }
            ss += shfl_x(ss, 32, lane);
            const float rstd = 1.0f / sqrtf(ss / 96 + EPSF) * (1.0f - lam_init);
            const float* sg = p.diff_subln + l * 96;
            const size_t tok = isc ? (size_t)NL + b * Cn + q0 + w * 32 + qr : (size_t)b * Tn + q0 + w * 32 + qr;
#pragma unroll
            for (int db = 0; db < 3; ++db)
#pragma unroll
                for (int g = 0; g < 4; ++g) {
                    const int dv = db * 32 + 8 * g + 4 * hh;
                    const f32x4 sv = *(const f32x4*)(sg + dv);
                    *(u32x2*)(p.MIX + tok * Dm + h * 96 + dv) = (u32x2){pk2(ot[db][4 * g] * rstd * sv[0], ot[db][4 * g + 1] * rstd * sv[1]),
                                                                      pk2(ot[db][4 * g + 2] * rstd * sv[2], ot[db][4 * g + 3] * rstd * sv[3])};
                }
        } else {
            const int hq = hb % 6, b = hb / 6, kv = hq / 3;
            f32x16 ot[2]; float ls;
            attn_block<64, 64>(smem, (isc ? p.GQC : p.GQL) + (size_t)(b * 6 + hq) * qlen * 64, p.GK + (size_t)(b * 2 + kv) * Sn * 64, p.GVt + (size_t)(b * 2 + kv) * 64 * Sn, nk, q0, ot, ls);
            const float il = 1.0f / ls;
            const size_t tok = isc ? (size_t)NL + b * Cn + q0 + w * 32 + qr : (size_t)b * Tn + q0 + w * 32 + qr;
#pragma unroll
            for (int db = 0; db < 2; ++db)
#pragma unroll
                for (int g = 0; g < 4; ++g) {
                    const int dv = db * 32 + 8 * g + 4 * hh;
                    *(u32x2*)(p.MIX + tok * Dm + 384 + hq * 64 + dv) = (u32x2){pk2(ot[db][4 * g] * il, ot[db][4 * g + 1] * il), pk2(ot[db][4 * g + 2] * il, ot[db][4 * g + 3] * il)};
                }
        }
    }
}

DI void bp_mod(const Params& p, unsigned char* smem, int bid, int G, long gtid, long gsize) {
    const int tid = opaque_tid(), lane = tid & 63, w = tid >> 6;
    float* sl = (float*)smem;
    float* red = sl + (Bn + 1) * Dm;
    for (int i = tid; i < (Bn + 1) * Dm; i += NTHR) sl[i] = silu_f(i < Bn * Dm ? p.c[i] : p.c_ctx[i - Bn * Dm]);
    __syncthreads();
    const int ks = tid >> 4, j4 = tid & 15;
    for (int item = bid; item < DEPTH * (MODW / 64); item += G) {
        const int l = item / (MODW / 64), col = (item % (MODW / 64)) * 64 + j4 * 4;
        const float* wp = p.w_mod + ((size_t)l * Dm + ks * 64) * MODW + col;
        f32x4 acc[Bn + 1];
#pragma unroll
        for (int r = 0; r <= Bn; ++r) acc[r] = (f32x4){0.f, 0.f, 0.f, 0.f};
#pragma unroll 8
        for (int kk = 0; kk < 64; ++kk) {
            const f32x4 wv = *(const f32x4*)(wp + (size_t)kk * MODW);
#pragma unroll
            for (int r = 0; r <= Bn; ++r) acc[r] = acc[r] + sl[r * Dm + ks * 64 + kk] * wv;
        }
#pragma unroll
        for (int r = 0; r <= Bn; ++r)
#pragma unroll
            for (int e = 0; e < 4; ++e) { float v = acc[r][e]; v += shfl_x(v, 16, lane); v += shfl_x(v, 32, lane); acc[r][e] = v; }
        __syncthreads();
        if (lane < 16)
#pragma unroll
            for (int r = 0; r <= Bn; ++r) *(f32x4*)(red + ((w * 16 + lane) * (Bn + 1) + r) * 4) = acc[r];
        __syncthreads();
        if (tid < 16 * (Bn + 1)) {
            const int jj = tid & 15, r = tid >> 4;
            f32x4 t = *(const f32x4*)(p.b_mod + l * MODW + (item % (MODW / 64)) * 64 + jj * 4);
#pragma unroll
            for (int ww = 0; ww < 4; ++ww) t = t + *(const f32x4*)(red + ((ww * 16 + jj) * (Bn + 1) + r) * 4);
            *(f32x4*)(p.mod + ((size_t)l * (Bn + 1) + r) * MODW + (item % (MODW / 64)) * 64 + jj * 4) = t;
        }
    }
    (void)gtid; (void)gsize;
}

DI size_t chunk_slot(int b, int h, int dir, int cid) { return (size_t)((b * 4 + h) * 2 + dir) * NCH + cid; }
DI float wave_incl_scan_add(float v, int lane, bool rev) {
#pragma unroll
    for (int o = 1; o < 64; o <<= 1) { const float t = shfl_i(v, (rev ? lane + o : lane - o) & 63); const bool ok = rev ? (lane + o < 64) : (lane >= o); if (ok) v += t; }
    return v;
}
DI float wave_incl_scan_max(float v, int lane, bool rev) {
#pragma unroll
    for (int o = 1; o < 64; o <<= 1) { const float t = shfl_i(v, (rev ? lane + o : lane - o) & 63); const bool ok = rev ? (lane + o < 64) : (lane >= o); if (ok) v = fmaxf(v, t); }
    return v;
}
DI void bp_post(const Params& p, int l, unsigned char* smem, int bid, int G) {
    const int tid = opaque_tid(), lane = tid & 63, w = tid >> 6;
    constexpr int NGRP = NTOK / 64, N_M = NGRP * 4, N_V = NGRP * 4, N_Q = NTOK / 16;
    volatile int* s_item = (volatile int*)(smem + SM_AUX + 512);
    unsigned* ctr = p.BAR + 3700 + l;
    (void)bid; (void)G;
    for (;;) {
        __syncthreads();
        if (threadIdx.x == 0) *s_item = (int)atomicAdd(ctr, 1u);
        __syncthreads();
        const int item = *s_item;
        if (item >= N_M + N_V + N_Q) break;
        if (item >= N_M + N_V) {
            const int tokb = (item - N_M - N_V) * 16 + w * 4;
            const int j = lane & 15, ug = lane >> 4, third = j / 3;
            f32x4 gvv[6];
#pragma unroll
            for (int st = 0; st < 6; ++st) {
                const int u = st * 4 + ug; const bool d64 = st >= 4;
                const float* gw = !d64 ? ((u >= 8 ? p.diff_k_norm : p.diff_q_norm) + l * 48) : ((u >= 22 ? p.gqa_k_norm : p.gqa_q_norm) + l * 64);
                gvv[st] = (d64 || j < 12) ? *(const f32x4*)(gw + 4 * j) : (f32x4){0.f, 0.f, 0.f, 0.f};
            }
#pragma unroll 2
            for (int t4 = 0; t4 < 4; ++t4) {
                const int tok = tokb + t4; const bool isc = tok >= NL;
                const int b = tok_b(tok), ti = tok_i(tok), sx = tok_s(tok);
                const act_t* pr = p.PROJB + (size_t)tok * INW;
                f32x4 xs[6], t0s[6], t1s[6];
#pragma unroll
                for (int st = 0; st < 6; ++st) {
                    const int u = st * 4 + ug; const bool d64 = st >= 4;
                    const int soff = !d64 ? ((u >= 8 ? DK_OFF : DQ_OFF) + ((u & 7) >> 1) * 96 + (u & 1) * 48) : (u >= 22 ? GK_OFF + (u - 22) * 64 : GQ_OFF + (u - 16) * 64);
                    const bool act = d64 || j < 12;
                    xs[st] = act ? ld4bf(pr + soff + 4 * j) : (f32x4){0.f, 0.f, 0.f, 0.f};
                    const bool second = d64 ? (j >= 8) : (j >= 6);
                    const int pos = second ? (ti & 63) : (ti >> 6);
                    const int fi0 = d64 ? 12 + (j & 3) * 4 : (j - third * 3) * 4;
                    const float* rt = p.ROPE + ((size_t)pos * 28 + (act ? fi0 : 0)) * 2;
                    t0s[st] = *(const f32x4*)rt; t1s[st] = *(const f32x4*)(rt + 4);
                }
#pragma unroll
                for (int st = 0; st < 6; ++st) {
                    const int u = st * 4 + ug; const bool d64 = st >= 4;
                    act_t* dst; float osc;
                    if (!d64) {
                        const bool isk = u >= 8; const int hh = (u & 7) >> 1, ww = u & 1;
                        osc = isk ? 1.0f : 0.14433756729740643f * LOG2E;
                        dst = isk ? p.DK + (((size_t)(b * 4 + hh) * 2 + ww) * Sn + sx) * 48
                                  : (isc ? p.DQC + (((size_t)(b * 4 + hh) * 2 + ww) * Cn + ti) * 48 : p.DQL + (((size_t)(b * 4 + hh) * 2 + ww) * Tn + ti) * 48);
                    } else {
                        const bool isk = u >= 22; const int hh = isk ? u - 22 : u - 16;
                        osc = isk ? 1.0f : 0.125f * LOG2E;
                        dst = isk ? p.GK + ((size_t)(b * 2 + hh) * Sn + sx) * 64 : (isc ? p.GQC + ((size_t)(b * 6 + hh) * Cn + ti) * 64 : p.GQL + ((size_t)(b * 6 + hh) * Tn + ti) * 64);
                    }
                    const bool act = d64 || j < 12;
                    const f32x4 x = xs[st];
                    const float ss = row16_sum(x[0] * x[0] + x[1] * x[1] + x[2] * x[2] + x[3] * x[3]);
                    const float rstd = 1.0f / sqrtf(ss / (d64 ? 64.f : 48.f) + EPSF);
                    f32x4 y = x * rstd * gvv[st];
                    if (!isc) {
                        const int plane = d64 ? (lane ^ 4) : ((third & 1) ? lane - 3 : lane + 3);
                        f32x4 py;
#pragma unroll
                        for (int r = 0; r < 4; ++r) py[r] = shfl_i(y[r], plane);
                        const bool isx2 = d64 ? ((j & 4) != 0) : ((third & 1) != 0);
                        const f32x4 t0 = t0s[st], t1 = t1s[st];
                        const f32x4 cs = {t0[0], t0[2], t1[0], t1[2]}, sn = {t0[1], t0[3], t1[1], t1[3]};
                        y = isx2 ? y * cs + py * sn : y * cs - py * sn;
                    }
                    y = y * osc;
                    if (act) *(u32x2*)(dst + 4 * j) = (u32x2){pk2(y[0], y[1]), pk2(y[2], y[3])};
                }
            }
        } else if (item >= N_M) {
            const int g = (item - N_M) >> 2, qd = (item - N_M) & 3;
            const int tok0 = g * 64;
            const int b = tok_b(tok0), s0 = tok_s(tok0);
            __syncthreads();
#pragma unroll
            for (int i = 0; i < 8; ++i) {
                const int c = tid + NTHR * i, tt = c >> 5, d4 = c & 31, vd = qd * 128 + d4 * 4;
                *(u32x2*)(smem + tt * 264 + d4 * 8) = *(const u32x2*)(p.PROJB + (size_t)(tok0 + tt) * INW + (vd < 384 ? DV_OFF + vd : GV_OFF + vd - 384));
            }
            __syncthreads();
#pragma unroll
            for (int i = 0; i < 4; ++i) {
                const int o = tid + NTHR * i, dloc = o >> 3, t8 = o & 7, vd = qd * 128 + dloc;
                unsigned e[8];
#pragma unroll
                for (int r = 0; r < 8; ++r) e[r] = *(const unsigned short*)(smem + (t8 * 8 + r) * 264 + dloc * 2);
                act_t* dst = vd < 384 ? p.DVt + ((size_t)(b * 4 + vd / 96) * 96 + vd % 96) * Sn : p.GVt + ((size_t)(b * 2 + (vd - 384) / 64) * 64 + (vd - 384) % 64) * Sn;
                *(u32x4*)(dst + s0 + t8 * 8) = (u32x4){e[0] | (e[1] << 16), e[2] | (e[3] << 16), e[4] | (e[5] << 16), e[6] | (e[7] << 16)};
            }
        } else {
            const int g = item >> 2, h = item & 3;
            const int tok0 = g * 64; const bool isc = tok0 >= NL;
            const int b = tok_b(tok0), ti0 = tok_i(tok0);
        float* kf = (float*)smem; float* vf = kf + 64 * 68; float* gl = vf + 64 * 68;
        const int cid = isc ? ti0 / 64 : NCC + ti0 / 64;
            __syncthreads();
            {
                const int tt = tid >> 2, c16 = tid & 3, ti = ti0 + tt, seglen = isc ? Cn : Tn;
                const act_t* pr = p.PROJB + (size_t)(tok0 + tt) * INW;
                const bool hasp = ti > 0, hasn = ti < seglen - 1;
                const float* cw = p.mlstm_conv_w + (size_t)l * 1536; const float* cb = p.mlstm_conv_b + l * 512;
#pragma unroll
                for (int part = 0; part < 2; ++part)
#pragma unroll
                    for (int i4 = 0; i4 < 4; ++i4) {
                        const int ch = part * 256 + h * 64 + c16 * 16 + i4 * 4;
                        f32x4 a = *(const f32x4*)(cb + ch) + ld4bf(pr + MQK_OFF + ch) * *(const f32x4*)(cw + 512 + ch);
                        if (hasp) a = a + ld4bf(pr - INW + MQK_OFF + ch) * *(const f32x4*)(cw + ch);
                        if (hasn) a = a + ld4bf(pr + INW + MQK_OFF + ch) * *(const f32x4*)(cw + 1024 + ch);
#pragma unroll
                        for (int r = 0; r < 4; ++r) a[r] = a[r] / (1.0f + __expf(-a[r]));
                        if (part) { a = a * 0.125f; *(f32x4*)(kf + tt * 68 + c16 * 16 + i4 * 4) = a; }
                        *(u32x2*)(p.MQKB + (size_t)(tok0 + tt) * 512 + ch) = (u32x2){pk2(a[0], a[1]), pk2(a[2], a[3])};
#if !IMPL_MLSTM
                        *(f32x4*)(p.MQK + (size_t)(tok0 + tt) * 512 + ch) = a;
#endif
                    }
#pragma unroll
                for (int i4 = 0; i4 < 4; ++i4) *(f32x4*)(vf + tt * 68 + c16 * 16 + i4 * 4) = ld4bf(pr + MV_OFF + h * 64 + c16 * 16 + i4 * 4);
            }
            if (tid < 64) {
                const float* pr = p.PG + (size_t)(tok0 + tid) * 16; const float* gb = p.mlstm_gate_b + l * 16;
                const f32x4 gt = {pr[h] + gb[h], logsigmoid_f(pr[4 + h] + gb[4 + h]), pr[8 + h] + gb[8 + h], logsigmoid_f(pr[12 + h] + gb[12 + h])};
                gl[tid] = gt[0]; gl[128 + tid] = gt[1]; gl[64 + tid] = gt[2]; gl[192 + tid] = gt[3];
                *(f32x4*)(p.MG4 + ((size_t)(tok0 + tid) * 4 + h) * 4) = gt;
#if !IMPL_MLSTM
                { float* mg = p.MGATE + (size_t)(tok0 + tid) * 16; mg[h] = gt[0]; mg[4 + h] = gt[1]; mg[8 + h] = gt[2]; mg[12 + h] = gt[3]; }
#endif
            }
            __syncthreads();
            if (w < 2) {
                const int dir = w;
                const float lf = gl[128 + dir * 64 + lane], li = gl[dir * 64 + lane];
                const float inc = wave_incl_scan_add(lf, lane, dir == 0);
                const float gg = inc - lf + li;
                float mloc = gg;
#pragma unroll
                for (int o = 32; o > 0; o >>= 1) mloc = fmaxf(mloc, shfl_x(mloc, o, lane));
                gl[256 + dir * 64 + lane] = __expf(gg - mloc);
                const float E = wave_sum(lf, lane);
                if (lane == 0) { float* cs = p.CHS + chunk_slot(b, h, dir, cid) * 2; cs[0] = mloc; cs[1] = E; }
            }
            __syncthreads();
            {
                const int v0 = (tid >> 4) * 4, d0 = (tid & 15) * 4;
                f32x4 a0[4], a1[4];
#pragma unroll
                for (int i = 0; i < 4; ++i) { a0[i] = (f32x4){0.f, 0.f, 0.f, 0.f}; a1[i] = (f32x4){0.f, 0.f, 0.f, 0.f}; }
                for (int sx = 0; sx < 64; ++sx) {
                    const f32x4 vv = *(const f32x4*)(vf + sx * 68 + v0), kk = *(const f32x4*)(kf + sx * 68 + d0);
                    const float w0 = gl[256 + sx], w1 = gl[320 + sx];
#pragma unroll
                    for (int i = 0; i < 4; ++i) { a0[i] = a0[i] + (w0 * vv[i]) * kk; a1[i] = a1[i] + (w1 * vv[i]) * kk; }
                }
                act_t* kv0 = (act_t*)p.KV + chunk_slot(b, h, 0, cid) * 4096; act_t* kv1 = (act_t*)p.KV + chunk_slot(b, h, 1, cid) * 4096;
#pragma unroll
                for (int i = 0; i < 4; ++i) {
                    *(u32x2*)(kv0 + (v0 + i) * 64 + d0) = (u32x2){pk2(a0[i][0], a0[i][1]), pk2(a0[i][2], a0[i][3])};
                    *(u32x2*)(kv1 + (v0 + i) * 64 + d0) = (u32x2){pk2(a1[i][0], a1[i][1]), pk2(a1[i][2], a1[i][3])};
                }
                if (tid < 128) {
                    const int dir = tid >> 6, d = tid & 63;
                    float acc = 0.f;
                    for (int sx = 0; sx < 64; ++sx) acc += gl[256 + dir * 64 + sx] * kf[sx * 68 + d];
                    p.NLC[chunk_slot(b, h, dir, cid) * 64 + d] = acc;
                }
            }
        }
    }
}

constexpr int ML_Q = 0, ML_K = 9216, ML_VT = 18432, ML_C = 29952, ML_QA = 41472, ML_SC = 50688;
constexpr int SC_LI = 0, SC_LF = 128, SC_BB = 256, SC_MT = 384, SC_AA = 512, SC_UU = 640, SC_WCH = 768;
static_assert(ML_SC + (SC_WCH + 80) * 4 <= SMEM_BYTES - 16, "mLSTM LDS layout exceeds the budget");
DI int ml_scanpos(int dir, int cid) { return dir == 0 ? cid : (cid < NCC ? NCC - 1 - cid : NCC + (NCH - 1 - cid)); }
DI int ml_cid_at(int dir, int i) { return dir == 0 ? i : (i < NCC ? NCC - 1 - i : NCH - 1 - (i - NCC)); }
DI void bp_mlstm(const Params& p, int l, bool upd, unsigned char* smem, int bid, int G) {
    const int tid = opaque_tid(), lane = tid & 63, w = tid >> 6;
    float* sc = (float*)(smem + ML_SC);
    constexpr int CPL = Tn / 64;
    const int nlat = Bn * 4 * CPL, nctx = upd ? Bn * 4 * NCC : 0;
    for (int it = bid; it < nlat + nctx; it += G) {
        int b, h, cid;
        if (it < nlat) { cid = NCC + it % CPL; h = (it / CPL) % 4; b = it / (CPL * 4); }
        else { const int x = it - nlat; cid = x % NCC; h = (x / NCC) % 4; b = x / (NCC * 4); }
        const int tok0 = cid < NCC ? NL + b * Cn + cid * 64 : b * Tn + (cid - NCC) * 64;
        __syncthreads();
#pragma unroll
        for (int i = 0; i < 4; ++i) {
            const int c = tid + NTHR * i, isk = c >> 9, cc = c & 511, row = cc >> 3, part = cc & 7;
            *(u32x4*)(smem + (isk ? ML_K : ML_Q) + row * 144 + part * 16) = *(const u32x4*)(p.MQKB + (size_t)(tok0 + row) * 512 + isk * 256 + h * 64 + part * 8);
        }
#pragma unroll
        for (int i = 0; i < 2; ++i) {
            const int c = tid + NTHR * i, tt = c >> 3, v8 = c & 7;
            const u32x4 vv = *(const u32x4*)(p.PROJB + (size_t)(tok0 + tt) * INW + MV_OFF + h * 64 + v8 * 8);
            const unsigned pa = vv[0], pb = vv[1], pc = vv[2], pd = vv[3];
            unsigned char* d0 = smem + ML_VT + (v8 * 8) * 144 + tt * 2;
            *(unsigned short*)(d0) = (unsigned short)pa; *(unsigned short*)(d0 + 144) = (unsigned short)(pa >> 16);
            *(unsigned short*)(d0 + 288) = (unsigned short)pb; *(unsigned short*)(d0 + 432) = (unsigned short)(pb >> 16);
            *(unsigned short*)(d0 + 576) = (unsigned short)pc; *(unsigned short*)(d0 + 720) = (unsigned short)(pc >> 16);
            *(unsigned short*)(d0 + 864) = (unsigned short)pd; *(unsigned short*)(d0 + 1008) = (unsigned short)(pd >> 16);
        }
        if (tid < 144) {
            unsigned zz = 0u; asm volatile("" : "+v"(zz));
            const unsigned one2 = tid < 9 ? 0x3F803F80u : zz;
            *(u32x4*)(smem + ML_VT + 64 * 144 + tid * 16) = (u32x4){one2, one2, one2, one2};
            *(u32x4*)(smem + ML_C + 64 * 144 + tid * 16) = (u32x4){zz, zz, zz, zz};
        }
        if (tid < 64) {
            const f32x4 gt = *(const f32x4*)(p.MG4 + ((size_t)(tok0 + tid) * 4 + h) * 4);
            sc[SC_LI + tid] = gt[0]; sc[SC_LF + tid] = gt[1]; sc[SC_LI + 64 + tid] = gt[2]; sc[SC_LF + 64 + tid] = gt[3];
        }
        __syncthreads();
        if (w < 2) {
            const int dir = w, pj = ml_scanpos(dir, cid);
            const float lf = sc[SC_LF + dir * 64 + lane], li = sc[SC_LI + dir * 64 + lane];
            const float bsum = wave_incl_scan_add(lf, lane, dir == 1);
            const float u = li - bsum;
            const float cm = wave_incl_scan_max(u, lane, dir == 1);
            float m = 0.f;
            for (int i = 0; i < pj; ++i) { const float* cs = p.CHS + chunk_slot(b, h, dir, ml_cid_at(dir, i)) * 2; m = fmaxf(cs[1] + m, cs[0]); }
            float F = 0.f;
            for (int i = pj - 1; i >= 0; --i) { const float* cs = p.CHS + chunk_slot(b, h, dir, ml_cid_at(dir, i)) * 2; if (lane == 0) sc[SC_WCH + dir * 40 + i] = __expf(cs[0] + F - m); F += cs[1]; }
            const float mt = bsum + fmaxf(m, cm);
            sc[SC_BB + dir * 64 + lane] = bsum; sc[SC_UU + dir * 64 + lane] = u; sc[SC_MT + dir * 64 + lane] = mt; sc[SC_AA + dir * 64 + lane] = __expf(bsum + m - mt);
        }
        f32x4 sacc[4];
#pragma unroll
        for (int si = 0; si < 4; ++si) sacc[si] = (f32x4){0.f, 0.f, 0.f, 0.f};
#pragma unroll
        for (int ks = 0; ks < 2; ++ks) {
            const bf16x8 bq = *(const bf16x8*)(smem + ML_Q + (16 * w + (lane & 15)) * 144 + ks * 64 + (lane >> 4) * 16);
#pragma unroll
            for (int si = 0; si < 4; ++si) {
                const bf16x8 ak = *(const bf16x8*)(smem + ML_K + (si * 16 + (lane & 15)) * 144 + ks * 64 + (lane >> 4) * 16);
                sacc[si] = __builtin_amdgcn_mfma_f32_16x16x32_bf16(ak, bq, sacc[si], 0, 0, 0);
            }
        }
        __syncthreads();
        f32x4 hs[4];
#pragma unroll
        for (int vt = 0; vt < 4; ++vt) hs[vt] = (f32x4){0.f, 0.f, 0.f, 0.f};
        const int pcol = 16 * w + (lane & 15);
#pragma unroll 1
        for (int dir = 0; dir < 2; ++dir) {
            {
                const int pj = ml_scanpos(dir, cid);
                f32x4 ca[4]; float na = 0.f;
#pragma unroll
                for (int q4 = 0; q4 < 4; ++q4) ca[q4] = (f32x4){0.f, 0.f, 0.f, 0.f};
                for (int i0 = 0; i0 < pj; i0 += 4) {
                    f32x4 kvv[4][4]; float nv[4], wgs[4];
#pragma unroll
                    for (int u = 0; u < 4; ++u) {
                        const int i = i0 + u < pj ? i0 + u : pj - 1;
                        wgs[u] = i0 + u < pj ? sc[SC_WCH + dir * 40 + i] : 0.f;
                        const size_t slot = chunk_slot(b, h, dir, ml_cid_at(dir, i));
                        const act_t* kv = (const act_t*)p.KV + slot * 4096;
#pragma unroll
                        for (int q4 = 0; q4 < 4; ++q4) kvv[u][q4] = ld4bf(kv + (tid + NTHR * q4) * 4);
                        nv[u] = tid < 64 ? p.NLC[slot * 64 + tid] : 0.f;
                    }
#pragma unroll
                    for (int u = 0; u < 4; ++u) {
#pragma unroll
                        for (int q4 = 0; q4 < 4; ++q4) ca[q4] = ca[q4] + wgs[u] * kvv[u][q4];
                        na += wgs[u] * nv[u];
                    }
                }
#pragma unroll
                for (int q4 = 0; q4 < 4; ++q4) { const int idx = (tid + NTHR * q4) * 4; *(u32x2*)(smem + ML_C + (idx >> 6) * 144 + (idx & 63) * 2) = (u32x2){pk2(ca[q4][0], ca[q4][1]), pk2(ca[q4][2], ca[q4][3])}; }
                if (tid < 64) *(unsigned short*)(smem + ML_C + 64 * 144 + tid * 2) = (unsigned short)pk2(na, 0.f);
            }
            {
                const float mtp = sc[SC_MT + dir * 64 + pcol], bp = sc[SC_BB + dir * 64 + pcol];
#pragma unroll
                for (int si = 0; si < 4; ++si) {
                    const int sb = si * 16 + (lane >> 4) * 4;
                    const f32x4 uu = *(const f32x4*)(sc + SC_UU + dir * 64 + sb);
                    float wv[4];
#pragma unroll
                    for (int r = 0; r < 4; ++r) { const int sx = sb + r; const bool valid = dir == 0 ? (sx <= pcol) : (sx >= pcol); wv[r] = valid ? __expf(bp + uu[r] - mtp) * sacc[si][r] : 0.f; }
                    *(u32x2*)(smem + ML_K + pcol * 144 + sb * 2) = (u32x2){pk2(wv[0], wv[1]), pk2(wv[2], wv[3])};
                }
                const int row = tid >> 2, c16 = tid & 3;
                const float ar = sc[SC_AA + dir * 64 + row];
#pragma unroll
                for (int i2 = 0; i2 < 2; ++i2) {
                    const u32x4 qv = *(const u32x4*)(smem + ML_Q + row * 144 + c16 * 32 + i2 * 16);
                    u32x4 o;
#pragma unroll
                    for (int r = 0; r < 4; ++r) o[r] = pk2(bflo(qv[r]) * ar, bfhi(qv[r]) * ar);
                    *(u32x4*)(smem + ML_QA + row * 144 + c16 * 32 + i2 * 16) = o;
                }
            }
            __syncthreads();
            f32x4 na5[5];
#pragma unroll
            for (int vt = 0; vt < 5; ++vt) na5[vt] = (f32x4){0.f, 0.f, 0.f, 0.f};
#pragma unroll
            for (int ks = 0; ks < 4; ++ks) {
                const bf16x8 bfrag = *(const bf16x8*)(smem + (ks < 2 ? ML_K : ML_QA) + pcol * 144 + (ks & 1) * 64 + (lane >> 4) * 16);
#pragma unroll
                for (int vt = 0; vt < 5; ++vt) {
                    const bf16x8 afrag = *(const bf16x8*)(smem + (ks < 2 ? ML_VT : ML_C) + (vt * 16 + (lane & 15)) * 144 + (ks & 1) * 64 + (lane >> 4) * 16);
                    na5[vt] = __builtin_amdgcn_mfma_f32_16x16x32_bf16(afrag, bfrag, na5[vt], 0, 0, 0);
                }
            }
            const float den = shfl_i(na5[4][0], lane & 15);
            const float dn = 1.0f / fmaxf(fabsf(den), __expf(-sc[SC_MT + dir * 64 + pcol]));
#pragma unroll
            for (int vt = 0; vt < 4; ++vt) hs[vt] = hs[vt] + na5[vt] * dn;
            __syncthreads();
        }
        float ss = 0.f;
#pragma unroll
        for (int vt = 0; vt < 4; ++vt) ss += hs[vt][0] * hs[vt][0] + hs[vt][1] * hs[vt][1] + hs[vt][2] * hs[vt][2] + hs[vt][3] * hs[vt][3];
        ss += shfl_x(ss, 16, lane); ss += shfl_x(ss, 32, lane);
        const float rstd = 1.0f / sqrtf(ss / 64 + EPSF);
        const size_t tok = (size_t)tok0 + pcol;
#pragma unroll
        for (int vt = 0; vt < 4; ++vt) {
            const int v = vt * 16 + (lane >> 4) * 4;
            const f32x4 hn = *(const f32x4*)(p.mlstm_head_norm + l * 256 + h * 64 + v), og = ld4bf(p.PROJB + tok * INW + MO_OFF + h * 64 + v);
            float o[4];
#pragma unroll
            for (int r = 0; r < 4; ++r) o[r] = hs[vt][r] * rstd * hn[r] / (1.0f + __expf(-og[r]));
            *(u32x2*)(p.MIX + tok * Dm + 768 + h * 64 + v) = (u32x2){pk2(o[0], o[1]), pk2(o[2], o[3])};
        }
    }
}

template <bool DRY>
DI void bp_route_fast(const Params& p, int l, bool upd, unsigned char* smem, int bid, int G) {
    const int tid = opaque_tid(), lane = tid & 63, w = tid >> 6;
    const int rows = upd ? NTOK : NL;
    float* Wl = (float*)smem;
    const float* g = p.norm2_g + l * Dm;
    const float* wgp = p.moe_wg + (size_t)l * Dm * 4; const float* wep = p.moe_we + (size_t)l * Dm * 32;
    for (int item = bid; item < rows / 4; item += G) {
        const int r0 = item * 4 + w;
        float rstd[1], pacc[1][36];
#pragma unroll
        for (int rr = 0; rr < 1; ++rr) {
            const float* xr = p.X + (size_t)(r0 + rr) * Dm;
            float ss = 0.f;
#pragma unroll
            for (int j = 0; j < 16; ++j) { const float xv = xr[64 * j + lane]; ss += xv * xv; }
            ss = wave_sum(ss, lane);
            rstd[rr] = 1.0f / sqrtf(ss / Dm + EPSF);
#pragma unroll
            for (int c = 0; c < 36; ++c) pacc[rr][c] = 0.f;
        }
#pragma unroll 1
        for (int ch = 0; ch < 4; ++ch) {
            __syncthreads();
            {
                const int k = ch * 256 + tid;
                *(f32x4*)(Wl + tid * 36) = *(const f32x4*)(wgp + (size_t)k * 4);
#pragma unroll
                for (int q = 0; q < 8; ++q) *(f32x4*)(Wl + tid * 36 + 4 + q * 4) = *(const f32x4*)(wep + (size_t)k * 32 + q * 4);
            }
            __syncthreads();
#pragma unroll
            for (int j = 0; j < 4; ++j) {
                const int k = ch * 256 + 64 * j + lane;
                float f[1];
#pragma unroll
                for (int rr = 0; rr < 1; ++rr) {
                    const float* mr = mod_row(p, l, r0 + rr);
                    f[rr] = p.X[(size_t)(r0 + rr) * Dm + k] * rstd[rr] * g[k] * (1.0f + mr[4 * Dm + k]) + mr[3 * Dm + k];
                    p.F[(size_t)(r0 + rr) * Dm + k] = f2a(f[rr]);
                }
                const float* wr = Wl + (64 * j + lane) * 36;
#pragma unroll
                for (int q = 0; q < 9; ++q) {
                    const f32x4 wq = *(const f32x4*)(wr + q * 4);
#pragma unroll
                    for (int rr = 0; rr < 1; ++rr)
#pragma unroll
                        for (int r = 0; r < 4; ++r) pacc[rr][q * 4 + r] += f[rr] * wq[r];
                }
            }
        }
        __syncthreads();
        float* red = (float*)smem + w * (64 * 37);
#pragma unroll 1
        for (int rr = 0; rr < 1; ++rr) {
#pragma unroll
            for (int c = 0; c < 36; ++c) red[lane * 37 + c] = pacc[0][c];
            __syncthreads();
            float tot = 0.f;
            if (lane < 36) for (int q = 0; q < 64; ++q) tot += red[q * 37 + lane];
            __syncthreads();
            if (lane < 36) red[lane] = tot + (lane < 4 ? p.moe_bg[l * 4 + lane] : p.moe_be[l * 32 + lane - 4]);
            __syncthreads();
            float gmax = red[0]; int gi = 0;
#pragma unroll
            for (int j = 1; j < 4; ++j) { const float v = red[j]; if (v > gmax) { gmax = v; gi = j; } }
            float gsum = 0.f;
#pragma unroll
            for (int j = 0; j < 4; ++j) gsum += expf(red[j] - gmax);
            const float gtop = 1.0f / gsum;
            float e1 = -1e30f, e2 = -1e30f; int i1 = 0, i2 = 0;
#pragma unroll
            for (int j = 0; j < 8; ++j) { const float v = red[4 + gi * 8 + j]; if (v > e1) { e2 = e1; i2 = i1; e1 = v; i1 = j; } else if (v > e2) { e2 = v; i2 = j; } }
            const float g0 = 1.0f / (1.0f + expf(e2 - e1));
            if (lane == 0 && (!DRY || g0 == 123.456f)) {
                const int row = r0 + rr, ea = gi * 8 + i1, eb = gi * 8 + i2;
                p.EID[row * 2] = ea; p.EID[row * 2 + 1] = eb;
                p.GATE[row * 2] = g0 * gtop; p.GATE[row * 2 + 1] = (1.0f - g0) * gtop;
                const int pa = atomicAdd(&p.CNT[(l * 32 + ea) * 64], 1), pb = atomicAdd(&p.CNT[(l * 32 + eb) * 64], 1);
                p.LIST[(size_t)ea * NTOK + pa] = row; p.LIST[(size_t)eb * NTOK + pb] = row;
                p.POS[row * 2] = pa; p.POS[row * 2 + 1] = pb;
            }
            __syncthreads();
        }
    }
}

DI void mconv_item(const Params& p, int l, unsigned char* smem, int it) {
    const int tid = opaque_tid();
    float* T = (float*)smem;
    const int e = it / 24, r = it % 24, mat = r >> 3, q = r & 7;
    const int K = mat < 2 ? Dm : 512, N = mat < 2 ? 512 : Dm;
    const float *w1p = p.moe_w1, *w3p = p.moe_w3, *w2p = p.moe_w2;
    asm volatile("" : "+s"(w1p), "+s"(w3p), "+s"(w2p));
    const float* W = (mat == 0 ? w1p : mat == 1 ? w3p : w2p) + ((size_t)l * 32 + e) * Dm * 512;
    act_t* WT = mat < 2 ? p.W13T + ((size_t)(l & 1) * 32 * 1024 + (size_t)e * 1024 + mat * 512) * Dm : p.W2T + ((size_t)(l & 1) * 32 + e) * Dm * 512;
    const int ntile0 = mat < 2 ? q : 2 * q, nnt = mat < 2 ? 1 : 2, nkt = K / 64;
    const int k = tid >> 2, n16 = (tid & 3) * 16;
    const int n = tid >> 2, k16 = (tid & 3) * 16;
    f32x4 v[4];
#pragma unroll
    for (int i = 0; i < 4; ++i) v[i] = *(const f32x4*)(W + (size_t)k * N + ntile0 * 64 + n16 + i * 4);
    for (int tix = 0; tix < nnt * nkt; ++tix) {
        const int nt = ntile0 + tix / nkt, kt = tix % nkt;
        __syncthreads();
#pragma unroll
        for (int i = 0; i < 4; ++i) { T[k * 65 + n16 + i * 4] = v[i][0]; T[k * 65 + n16 + i * 4 + 1] = v[i][1]; T[k * 65 + n16 + i * 4 + 2] = v[i][2]; T[k * 65 + n16 + i * 4 + 3] = v[i][3]; }
        __syncthreads();
        if (tix + 1 < nnt * nkt) {
            const int nt2 = ntile0 + (tix + 1) / nkt, kt2 = (tix + 1) % nkt;
#pragma unroll
            for (int i = 0; i < 4; ++i) v[i] = *(const f32x4*)(W + (size_t)(kt2 * 64 + k) * N + nt2 * 64 + n16 + i * 4);
        }
        unsigned o[8];
#pragma unroll
        for (int i = 0; i < 8; ++i) o[i] = pk2(T[(k16 + 2 * i) * 65 + n], T[(k16 + 2 * i + 1) * 65 + n]);
        act_t* dst = WT + (size_t)(nt * 64 + n) * K + kt * 64 + k16;
        *(u32x4*)dst = (u32x4){o[0], o[1], o[2], o[3]}; *(u32x4*)(dst + 8) = (u32x4){o[4], o[5], o[6], o[7]};
    }
}

DI void mconv_drain(const Params& p, int l, unsigned char* smem, int max_items) {
    volatile int* s_item = (volatile int*)(smem + SM_AUX + 512);
    unsigned* ctr = p.BAR + 3600 + l;
    for (int n = 0; n < max_items; ++n) {
        __syncthreads();
        if (threadIdx.x == 0) *s_item = (int)atomicAdd(ctr, 1u);
        __syncthreads();
        const int it = *s_item;
        if (it >= 32 * 24) break;
        mconv_item(p, l, smem, it);
    }
}

DI void bp_mixer(const Params& p, int l, bool upd, unsigned char* smem) {
    constexpr int QTL = Tn / 128, QTC = Cn / 128, CPL = Tn / 64, BIG = 1 << 30;
    const int n_al = Bn * 4 * QTL + Bn * 6 * QTL, n_ac = upd ? Bn * 4 * QTC + Bn * 6 * QTC : 0;
    const int n_ml = Bn * 4 * CPL + (upd ? Bn * 4 * NCC : 0);
    const int total = n_al + n_ml + n_ac;
    volatile int* s_item = (volatile int*)(smem + SM_AUX + 512);
    unsigned* ctr = p.BAR + 3500 + l;
#define NEXT_ITEM() ({ __syncthreads(); if (threadIdx.x == 0) *s_item = (int)atomicAdd(ctr, 1u); __syncthreads(); (int)*s_item; })
    int it = NEXT_ITEM();
    while (it < n_al) { bp_attn(p, l, upd, smem, it, BIG); it = NEXT_ITEM(); }
    while (it < n_al + n_ml) { bp_mlstm(p, l, upd, smem, it - n_al, BIG); it = NEXT_ITEM(); }
    while (it < n_al + n_ml + n_ac) { bp_attn(p, l, upd, smem, it - n_ml, BIG); it = NEXT_ITEM(); }
    (void)total;
#undef NEXT_ITEM

}

constexpr int RT_LD = 272, RT_AH = 0, RT_AL = 64 * RT_LD, RT_BH = 128 * RT_LD, RT_BL = RT_BH + 48 * RT_LD, RT_END = RT_BL + 48 * RT_LD;
static_assert(RT_END <= 65536, "router tiles exceed the LDS budget");
DI void mconv_drain(const Params& p, int l, unsigned char* smem, int max_items);
DI void bp_route2(const Params& p, int l, bool upd, unsigned char* smem, int bid, int G) {
    const int tid = opaque_tid(), lane = tid & 63, w = tid >> 6;
    const int rows = upd ? NTOK : NL;
    const float* gn = p.norm2_g + l * Dm;
    for (int item = bid; item < rows / 64; item += G) {
        const int r0 = item * 64;
        {
            const float* mr = mod_row(p, l, r0);
            f32x4 mul[4], add[4];
#pragma unroll
            for (int i = 0; i < 4; ++i) {
                const int k = 256 * i + 4 * lane;
                mul[i] = *(const f32x4*)(gn + k) * (1.0f + *(const f32x4*)(mr + 4 * Dm + k)); add[i] = *(const f32x4*)(mr + 3 * Dm + k);
            }
#pragma unroll 1
            for (int i0 = 0; i0 < 16; i0 += 4) {
                f32x4 x[4][4];
#pragma unroll
                for (int rr = 0; rr < 4; ++rr)
#pragma unroll
                    for (int i = 0; i < 4; ++i) x[rr][i] = *(const f32x4*)(p.X + (size_t)(r0 + w * 16 + i0 + rr) * Dm + 256 * i + 4 * lane);
#pragma unroll
                for (int rr = 0; rr < 4; ++rr) {
                    const int row = r0 + w * 16 + i0 + rr;
                    float ss = 0.f;
#pragma unroll
                    for (int i = 0; i < 4; ++i) ss += x[rr][i][0] * x[rr][i][0] + x[rr][i][1] * x[rr][i][1] + x[rr][i][2] * x[rr][i][2] + x[rr][i][3] * x[rr][i][3];
                    ss = wave_sum(ss, lane);
                    const float rstd = 1.0f / sqrtf(ss / Dm + EPSF);
#pragma unroll
                    for (int i = 0; i < 4; ++i) {
                        const int k = 256 * i + 4 * lane;
                        const f32x4 y = x[rr][i] * rstd * mul[i] + add[i];
                        const unsigned h01 = pk2(y[0], y[1]), h23 = pk2(y[2], y[3]);
                        *(u32x2*)(p.F + (size_t)row * Dm + k) = (u32x2){h01, h23};
                        *(u32x2*)(p.FLO + (size_t)row * Dm + k) = (u32x2){pk2(y[0] - bflo(h01), y[1] - bfhi(h01)), pk2(y[2] - bflo(h23), y[3] - bfhi(h23))};
                    }
                }
            }
        }
        __threadfence_block();
        __syncthreads();
        f32x4 acc[3];
#pragma unroll
        for (int ni = 0; ni < 3; ++ni) acc[ni] = (f32x4){0.f, 0.f, 0.f, 0.f};
        const int s_r = tid >> 4, s_c = tid & 15;
        {
            const act_t* Ah = p.F + (size_t)(r0 + s_r) * Dm + s_c * 8;
            const act_t* Al = p.FLO + (size_t)(r0 + s_r) * Dm + s_c * 8;
            const act_t* Bh = p.WRHI + ((size_t)l * 36 + s_r) * Dm + s_c * 8;
            const act_t* Bl = p.WRLO + ((size_t)l * 36 + s_r) * Dm + s_c * 8;
            u32x4 rah[4], ral[4], rbh[3], rbl[3];
#define RT_LOAD(KOFF) { \
    _Pragma("unroll") for (int i = 0; i < 4; ++i) { rah[i] = *(const u32x4*)(Ah + (size_t)16 * i * Dm + (KOFF)); ral[i] = *(const u32x4*)(Al + (size_t)16 * i * Dm + (KOFF)); } \
    _Pragma("unroll") for (int i = 0; i < 3; ++i) { const bool ok = s_r + 16 * i < 36; \
        rbh[i] = ok ? *(const u32x4*)(Bh + (size_t)16 * i * Dm + (KOFF)) : (u32x4){0u, 0u, 0u, 0u}; rbl[i] = ok ? *(const u32x4*)(Bl + (size_t)16 * i * Dm + (KOFF)) : (u32x4){0u, 0u, 0u, 0u}; } }
            RT_LOAD(0)
#pragma unroll 1
            for (int k0 = 0; k0 < Dm; k0 += 128) {
                __syncthreads();
#pragma unroll
                for (int i = 0; i < 4; ++i) { *(u32x4*)(smem + RT_AH + (s_r + 16 * i) * RT_LD + s_c * 16) = rah[i]; *(u32x4*)(smem + RT_AL + (s_r + 16 * i) * RT_LD + s_c * 16) = ral[i]; }
#pragma unroll
                for (int i = 0; i < 3; ++i) { *(u32x4*)(smem + RT_BH + (s_r + 16 * i) * RT_LD + s_c * 16) = rbh[i]; *(u32x4*)(smem + RT_BL + (s_r + 16 * i) * RT_LD + s_c * 16) = rbl[i]; }
                __syncthreads();
                if (k0 + 128 < Dm) RT_LOAD(k0 + 128)
#pragma unroll
                for (int kk = 0; kk < 4; ++kk) {
                    const int fo = (lane & 15) * RT_LD + kk * 64 + (lane >> 4) * 16;
                    const bf16x8 ah = *(const bf16x8*)(smem + RT_AH + w * 16 * RT_LD + fo), al = *(const bf16x8*)(smem + RT_AL + w * 16 * RT_LD + fo);
#pragma unroll
                    for (int ni = 0; ni < 3; ++ni) {
                        const bf16x8 bh = *(const bf16x8*)(smem + RT_BH + ni * 16 * RT_LD + fo), bl = *(const bf16x8*)(smem + RT_BL + ni * 16 * RT_LD + fo);
                        acc[ni] = __builtin_amdgcn_mfma_f32_16x16x32_bf16(bh, ah, acc[ni], 0, 0, 0);
                        acc[ni] = __builtin_amdgcn_mfma_f32_16x16x32_bf16(bh, al, acc[ni], 0, 0, 0);
                        acc[ni] = __builtin_amdgcn_mfma_f32_16x16x32_bf16(bl, ah, acc[ni], 0, 0, 0);
                    }
                }
            }
#undef RT_LOAD
        }
        __syncthreads();
        float* lg = (float*)smem;
#pragma unroll
        for (int ni = 0; ni < 3; ++ni)
#pragma unroll
            for (int r = 0; r < 4; ++r) lg[(w * 16 + (lane & 15)) * 49 + ni * 16 + (lane >> 4) * 4 + r] = acc[ni][r];
        __syncthreads();
        if (tid < 64) {
            const float* rl = lg + tid * 49;
            float ag[4];
            float gmax = -1e30f; int gi = 0;
#pragma unroll
            for (int j = 0; j < 4; ++j) { ag[j] = rl[j] + p.moe_bg[l * 4 + j]; if (ag[j] > gmax) { gmax = ag[j]; gi = j; } }
            float gsum = 0.f;
#pragma unroll
            for (int j = 0; j < 4; ++j) gsum += expf(ag[j] - gmax);
            const float gtop = 1.0f / gsum;
            float e1 = -1e30f, e2 = -1e30f; int i1 = 0, i2 = 0;
#pragma unroll
            for (int j = 0; j < 8; ++j) { const float v = rl[4 + gi * 8 + j] + p.moe_be[l * 32 + gi * 8 + j]; if (v > e1) { e2 = e1; i2 = i1; e1 = v; i1 = j; } else if (v > e2) { e2 = v; i2 = j; } }
            const float g0 = 1.0f / (1.0f + expf(e2 - e1));
            const int row = r0 + tid, ea = gi * 8 + i1, eb = gi * 8 + i2;
            p.EID[row * 2] = ea; p.EID[row * 2 + 1] = eb;
            p.GATE[row * 2] = g0 * gtop; p.GATE[row * 2 + 1] = (1.0f - g0) * gtop;
            const int pa = atomicAdd(&p.CNT[(l * 32 + ea) * 64], 1), pb = atomicAdd(&p.CNT[(l * 32 + eb) * 64], 1);
            p.LIST[(size_t)ea * NTOK + pa] = row; p.LIST[(size_t)eb * NTOK + pb] = row;
            p.POS[row * 2] = pa; p.POS[row * 2 + 1] = pb;
        }
        __syncthreads();
    }
    mconv_drain(p, l, smem, 1 << 30);
}

constexpr int PPL = 9;
constexpr int NPH = 2 + PPL * DEPTH;
static inline bool phase_in_mega(int ph) {
    if (ph < 2) return true;
    const int s = (ph - 2) % PPL;
    return s == 1 ? IMPL_POST : s == 2 ? IMPL_ATTN : s == 3 ? IMPL_MLSTM : s == 5 ? IMPL_ROUTE : true;
}

#define XB_TMO      128
#define XB_XCNT(j)  (256  + 64 * (j))
#define XB_XSUB(j)  (1280 + 64 * (j))
#define XB_XGEN(j)  (2304 + 64 * (j))
#define XB_TOP      3328
#define XB_TOPGEN   3392
#define XCD_BAR_WORDS 3456
#define XB_SPIN_CAP (1u << 22)
#define LAS __attribute__((address_space(3)))
DI unsigned xb_ld(unsigned* p) { return __hip_atomic_load(p, __ATOMIC_RELAXED, __HIP_MEMORY_SCOPE_AGENT); }
DI unsigned xb_add(unsigned* p, unsigned v) { return __hip_atomic_fetch_add(p, v, __ATOMIC_RELAXED, __HIP_MEMORY_SCOPE_AGENT); }
DI unsigned xb_xcc_id() { return (unsigned)__builtin_amdgcn_s_getreg((3 << 11) | 20) & 0xFu; }
#define XB_SPIN(cond, bar) do { unsigned _sp = 0; while (cond) { __builtin_amdgcn_s_sleep(1); \
    if ((++_sp & 255u) == 0u) { if (xb_ld(&(bar)[XB_TMO])) break; if (_sp > XB_SPIN_CAP) { atomicAdd(&(bar)[XB_TMO], 1u); break; } } } } while (0)
struct XcdBarrier { unsigned* bar; unsigned x; volatile LAS unsigned* st; };
DI XcdBarrier xcd_barrier_post(unsigned* bar, volatile LAS unsigned* st) {
    XcdBarrier b; b.bar = bar; b.x = xb_xcc_id(); b.st = st;
    if (threadIdx.x == 0) (void)xb_add(&bar[XB_XCNT(b.x)], 1u);
    return b;
}
DI void xcd_barrier_complete(unsigned* bar, unsigned x, unsigned& nloc, unsigned& nx) {
    const unsigned G = gridDim.x * gridDim.y * gridDim.z;
    unsigned sum, cnt, mine, sp = 0u;
    for (;;) {
        sum = 0u; cnt = 0u; mine = 0u;
#pragma unroll
        for (unsigned j = 0; j < 16; ++j) { const unsigned c = xb_ld(&bar[XB_XCNT(j)]); sum += c; cnt += (c > 0u) ? 1u : 0u; mine = (j == x) ? c : mine; }
        if (sum == G) break;
        __builtin_amdgcn_s_sleep(1);
        if ((++sp & 255u) == 0u) { if (xb_ld(&bar[XB_TMO])) break; if (sp > XB_SPIN_CAP) { atomicAdd(&bar[XB_TMO], 1u); break; } }
    }
    nloc = mine > 0u ? mine : 1u; nx = cnt > 0u ? cnt : 1u;
}
DI void xcd_barrier(const XcdBarrier& b) {
    asm volatile("s_waitcnt vmcnt(0)" ::: "memory");
    __syncthreads();
    if (threadIdx.x == 0) {
        unsigned* bar = b.bar;
        __builtin_amdgcn_s_waitcnt(0);
        unsigned nloc = b.st[0], nx = b.st[1];
        if (nloc == 0u) { xcd_barrier_complete(bar, b.x, nloc, nx); b.st[0] = nloc; b.st[1] = nx; }
        const unsigned old = xb_add(&bar[XB_XSUB(b.x)], 1u);
        const unsigned gen = old / nloc;
        if (old + 1u == (gen + 1u) * nloc) {
            __builtin_amdgcn_fence(__ATOMIC_RELEASE, "agent");
            asm volatile("s_waitcnt vmcnt(0)" ::: "memory");
            const unsigned og = xb_add(&bar[XB_TOP], 1u);
            const unsigned tg = og / nx;
            if (og + 1u == (tg + 1u) * nx) xb_add(&bar[XB_TOPGEN], 1u);
            else XB_SPIN(xb_ld(&bar[XB_TOPGEN]) == tg, bar);
            __builtin_amdgcn_fence(__ATOMIC_ACQUIRE, "agent");
            xb_add(&bar[XB_XGEN(b.x)], 1u);
            asm volatile("s_waitcnt vmcnt(0)" ::: "memory");
        } else {
            XB_SPIN(xb_ld(&bar[XB_XGEN(b.x)]) == gen, bar);
            __builtin_amdgcn_fence(__ATOMIC_ACQUIRE, "agent");
            asm volatile("s_waitcnt vmcnt(0)" ::: "memory");
        }
    }
    __syncthreads();
}

__global__ void __launch_bounds__(NTHR) k_naive(Params p, int ph) {
    const long gtid = (long)blockIdx.x * NTHR + threadIdx.x, gsize = (long)gridDim.x * NTHR;
    const int l = (ph - 2) / PPL, s = (ph - 2) % PPL;
    const bool upd = l < DEPTH - 1;
    (void)gtid; (void)gsize; (void)l; (void)s; (void)upd;
#if !IMPL_POST
    if (s == 1) ph_post(p, l, gtid, gsize);
#endif
#if !IMPL_ATTN
    if (s == 2) { ph_attn_diff(p, l, upd, gtid, gsize); ph_attn_gqa(p, l, upd, gtid, gsize); }
#endif
#if !IMPL_MLSTM
    if (s == 3) ph_mlstm(p, l, upd, gtid, gsize);
#endif
#if !IMPL_ROUTE
    if (s == 5) bp_route(p, l, upd, gtid, gsize);
#endif
}

__global__ void __launch_bounds__(NTHR, 2) k_mega(Params p_arg, int ph_begin, int ph_end) {
    extern __shared__ __attribute__((aligned(16))) unsigned char smem[];
    const Params& p0 = p_arg;
    cg::grid_group grid = cg::this_grid();
    const int G = gridDim.x, vb = xcd_remap(blockIdx.x, G);
    volatile LAS unsigned* xb_st = (volatile LAS unsigned*)(smem + SMEM_BYTES - 16);
    if (threadIdx.x == 0) { xb_st[0] = 0u; xb_st[1] = 0u; xb_st[2] = 0u; }
    __syncthreads();
    const XcdBarrier xb = xcd_barrier_post(p0.BAR, xb_st);
    for (int ph = ph_begin; ph < ph_end; ++ph) {
        Params p;
#if defined(__HIP_DEVICE_COMPILE__)
        {
            typedef const __attribute__((address_space(4))) unsigned long long* kp_t;
            kp_t pk = (kp_t)__builtin_amdgcn_kernarg_segment_ptr();
            asm volatile("" : "+s"(pk));
            static_assert(sizeof(Params) % 8 == 0, "Params is a list of pointers");
#pragma unroll
            for (unsigned i = 0; i < sizeof(Params) / 8; ++i) {
                char* gp = (char*)(__attribute__((address_space(1))) char*)pk[i];
                __builtin_memcpy((char*)&p + 8 * i, &gp, 8);
            }
        }
#else
        p = p0;
#endif
#ifdef PROBE_TS
        if (blockIdx.x == 0 && threadIdx.x == 0) { typedef const __attribute__((address_space(4))) unsigned long long* kp_t; kp_t pk = (kp_t)__builtin_amdgcn_kernarg_segment_ptr(); ((unsigned long long*)pk[offsetof(Params, TS) / 8])[ph] = __builtin_amdgcn_s_memrealtime(); }
#endif
        const int tid = opaque_tid(), lane = tid & 63;
        const long gtid = (long)blockIdx.x * NTHR + tid, gsize = (long)G * NTHR;
        const int gwave = (int)(gtid >> 6), nwaves = (int)(gsize >> 6);
        if (ph == 0) {
            bp_mod(p, smem, blockIdx.x, G, gtid, gsize);
            bp_wconv(p, smem, G - 1 - blockIdx.x, G);
            if (gtid < DEPTH * 32 * 64) p.CNT[gtid] = 0;
            for (long it = gtid; it < (long)DEPTH * 36 * Dm; it += gsize) {
                const int k = (int)(it % Dm), n = (int)((it / Dm) % 36), ll = (int)(it / (36 * Dm));
                const float wv = n < 4 ? p.moe_wg[((size_t)ll * Dm + k) * 4 + n] : p.moe_we[((size_t)ll * Dm + k) * 32 + n - 4];
                const act_t hi = f2a(wv);
                p.WRHI[it] = hi; p.WRLO[it] = f2a(wv - a2f(hi));
            }
            if (gtid < 512) ((unsigned long long*)p.ZROW)[gtid] = 0ull;
            if (gtid < 64 * 28) {
                const int pos = (int)gtid / 28, fi = (int)gtid % 28, nf = fi < 12 ? 12 : 16, i = fi < 12 ? fi : fi - 12;
                const float ang = (float)pos * expf(-(float)i / (float)nf * 9.210340371976184f);
                p.ROPE[gtid * 2] = cosf(ang); p.ROPE[gtid * 2 + 1] = sinf(ang);
            }
        } else if (ph == 1) {
            bp_norm1(p, 0, gwave, nwaves, lane);
        } else {
            const int l = (ph - 2) / PPL, s = (ph - 2) % PPL;
            const bool upd = l < DEPTH - 1;
#ifdef PROBE_DUP
            if ((PROBE_DUP >> s) & 1) {
                if (s == 0) bp_gemm_in<PROBE_MODE>(p, l, smem, vb, G);
                if (s == 1) bp_post(p, l, smem, blockIdx.x, G);
                if (s == 6) bp_moe1(p, l, smem, vb, G);
                if (s == 7) bp_moe2(p, l, smem, vb, G);
                if (s == 4) bp_gemm_out<true>(p, l, upd, smem, vb, G);
                if (s == 8 && l < DEPTH - 1) bp_combine<true>(p, l, upd, smem, gwave, nwaves, lane);
            }
#endif
            switch (s) {
                case 0: bp_gemm_in(p, l, smem, vb, G); break;
#if IMPL_POST
                case 1: bp_post(p, l, smem, blockIdx.x, G); break;
#endif
#if IMPL_ATTN
                case 2: bp_mixer(p, l, upd, smem); break;
#endif
#if IMPL_MLSTM
                case 3: break;
#endif
#if IMPL_ROUTE
                case 5: bp_route2(p, l, upd, smem, blockIdx.x, G); break;
#endif
                case 4: bp_gemm_out<false>(p, l, upd, smem, vb, G); break;
                case 6: bp_moe1(p, l, smem, vb, G); break;
                case 7: bp_moe2(p, l, smem, vb, G); break;
                case 8: bp_combine<false>(p, l, upd, smem, gwave, nwaves, lane); break;
                default: break;
            }
        }
        if (ph + 1 < ph_end && !(ph >= 2 && (ph - 2) % PPL == 2 && IMPL_ATTN && IMPL_MLSTM)) {
            if (ph_end < 0) grid.sync();
            xcd_barrier(xb);
#ifdef PROBE_DUP
            if (PROBE_DUP & 1024) xcd_barrier(xb);
#endif
        }
    }
#ifdef PROBE_TS
    if (blockIdx.x == 0 && __builtin_amdgcn_mbcnt_hi(~0u, __builtin_amdgcn_mbcnt_lo(~0u, 0u)) == 0u && atomicAdd((unsigned*)(smem + SMEM_BYTES - 8), 1u) == 0u) {
        struct { unsigned long long* TS; float* out; } p;
        { typedef const __attribute__((address_space(4))) unsigned long long* kp_t; kp_t pk = (kp_t)__builtin_amdgcn_kernarg_segment_ptr(); p.TS = (unsigned long long*)pk[offsetof(Params, TS) / 8]; p.out = (float*)pk[offsetof(Params, out) / 8]; }
        p.TS[NPH] = __builtin_amdgcn_s_memrealtime();
        unsigned long long tot = 0;
        if (PROBE_TS == 9) tot = p.TS[2] - p.TS[0];
        else if (PROBE_TS == 10) tot = p.TS[NPH] - p.TS[0];
        else for (int l = 0; l < DEPTH; ++l) tot += p.TS[2 + l * PPL + PROBE_TS + 1] - p.TS[2 + l * PPL + PROBE_TS];
        p.out[0] += (float)tot * 0.01f / PROBE_SCALE;
    }
#endif
}

extern "C" void kernel_launch(void* const* d_in, const int* in_sizes, int n_in, void* d_out, int out_size, void* d_ws, size_t ws_size, hipStream_t stream) {
    Params p;
    memset((void*)&p, 0, sizeof(p));
    fill_inputs(p, d_in, d_out);
    carve(p, d_ws);
    static int grid_blocks = 0;
    if (!grid_blocks) {
        int dev = 0, cus = 0, per_cu = 0;
        (void)hipGetDevice(&dev);
        (void)hipDeviceGetAttribute(&cus, hipDeviceAttributeMultiprocessorCount, dev);
        (void)hipFuncSetAttribute((const void*)k_mega, hipFuncAttributeMaxDynamicSharedMemorySize, SMEM_BYTES);
        (void)hipOccupancyMaxActiveBlocksPerMultiprocessor(&per_cu, k_mega, NTHR, SMEM_BYTES);
        if (per_cu > 2) per_cu = 2;
        if (per_cu < 1) per_cu = 1;
        grid_blocks = cus * per_cu;
    }
    (void)hipMemsetAsync(p.BAR, 0, 4096 * sizeof(unsigned), stream);
    int ph = 0;
    while (ph < NPH) {
        if (phase_in_mega(ph)) {
            int b = ph, e = ph;
            while (e < NPH && phase_in_mega(e)) ++e;
            void* args[] = {&p, &b, &e};
            (void)hipLaunchCooperativeKernel((void*)k_mega, dim3(grid_blocks), dim3(NTHR), args, SMEM_BYTES, stream);
            ph = e;
        } else {
            k_naive<<<2048, NTHR, 0, stream>>>(p, ph);
            ++ph;
        }
    }
}
#endif
```

```cpp
#ifndef HOST_TEST
#include <hip/hip_runtime.h>
#include <hip/hip_cooperative_groups.h>
#include <string.h>
namespace cg = cooperative_groups;
#define HD __host__ __device__ __forceinline__
#else
#include <math.h>
#include <string.h>
#define HD inline
#endif
#include <stdint.h>
#include <stddef.h>

#ifndef CFG_B
#define CFG_B 8
#define CFG_T 2048
#define CFG_C 256
#define CFG_DEPTH 4
#endif
#ifndef MK_LAUNCHES
#define MK_LAUNCHES 1
#endif

constexpr int Bn = CFG_B, Tn = CFG_T, Cn = CFG_C, DEPTH = CFG_DEPTH;
constexpr int Dm = 1024, INW = 2832, MODW = 6144;
constexpr int NL = Bn * Tn, NC = Bn * Cn, NTOK = NL + NC, Sn = Cn + Tn;
constexpr int DQ_OFF = 0, DK_OFF = 384, DV_OFF = 768, GQ_OFF = 1152, GK_OFF = 1536, GV_OFF = 1664, MQK_OFF = 1792, MV_OFF = 2304, MO_OFF = 2560, MG_OFF = 2816;
constexpr int NCH = Sn / 64, NCC = Cn / 64;
constexpr int PMAX = 2 * NTOK + 32 * 128;
constexpr float EPSF = 1e-6f;
constexpr float LOG2E = 1.4426950408889634f;

#ifdef ACT_F32
typedef float act_t;
HD act_t f2a(float f) { return f; }
HD float a2f(act_t a) { return a; }
#else
typedef unsigned short act_t;
HD act_t f2a(float f) { unsigned u; memcpy(&u, &f, 4); u += 0x7fffu + ((u >> 16) & 1u); return (act_t)(u >> 16); }
HD float a2f(act_t a) { unsigned u = ((unsigned)a) << 16; float f; memcpy(&f, &u, 4); return f; }
#endif

HD float silu_f(float x) { return x / (1.0f + expf(-x)); }
HD float sigmoid_f(float x) { return 1.0f / (1.0f + expf(-x)); }
HD float logsigmoid_f(float x) { return fminf(x, 0.0f) - log1pf(expf(-fabsf(x))); }
HD float lam_init_of(int l) { return 0.8f - 0.6f * expf(-0.3f * (float)l); }

struct Params {
    const float *x, *c, *ctx, *c_ctx, *norm1_g, *norm2_g, *w_mod, *b_mod, *w_in, *w_out, *diff_q_norm, *diff_k_norm, *diff_lambda, *diff_subln,
        *gqa_q_norm, *gqa_k_norm, *mlstm_conv_w, *mlstm_conv_b, *mlstm_gate_b, *mlstm_head_norm, *moe_wg, *moe_bg, *moe_we, *moe_be, *moe_w1, *moe_w3, *moe_w2;
    float* out;
    float *mod, *X, *PROJ, *MQK, *MGATE, *DO, *GATE, *HN;
    act_t *XN, *DQL, *DQC, *DK, *DVt, *GQL, *GQC, *GK, *GVt, *MIX, *F;
    int* EID;
    int *CNT, *LIST, *POS;
    act_t *H, *Y;
    float *ROPE, *KV, *NLC, *CHS, *MG4;
    act_t* MQKB;
    unsigned* BAR;
    act_t *WIN_T, *WOUT_T;
    unsigned long long* TS;
    act_t *FLO, *WRHI, *WRLO, *ZROW;
    act_t *W13T, *W2T;
    act_t* PROJB; float* PG;
};

HD bool tok_ctx(int tok) { return tok >= NL; }
HD int tok_b(int tok) { return tok < NL ? tok / Tn : (tok - NL) / Cn; }
HD int tok_i(int tok) { return tok < NL ? tok % Tn : (tok - NL) % Cn; }
HD int tok_s(int tok) { return tok < NL ? Cn + tok % Tn : (tok - NL) % Cn; }
HD int tok_modrow(int tok) { return tok < NL ? tok / Tn : Bn; }
HD int tok_of(int b, int s) { return s < Cn ? NL + b * Cn + s : b * Tn + (s - Cn); }
HD const float* mod_row(const Params& p, int l, int tok) { return p.mod + ((size_t)l * (Bn + 1) + tok_modrow(tok)) * MODW; }

HD void ph_mod(const Params& p, long gtid, long gsize) {
    for (long it = gtid; it < (long)DEPTH * MODW; it += gsize) {
        const int l = (int)(it / MODW), j = (int)(it % MODW);
        float acc[Bn + 1];
#pragma unroll
        for (int r = 0; r <= Bn; ++r) acc[r] = 0.f;
        const float* w = p.w_mod + (size_t)l * Dm * MODW + j;
        for (int k = 0; k < Dm; ++k) {
            const float wv = w[(size_t)k * MODW];
#pragma unroll
            for (int r = 0; r < Bn; ++r) acc[r] += silu_f(p.c[r * Dm + k]) * wv;
            acc[Bn] += silu_f(p.c_ctx[k]) * wv;
        }
        const float bb = p.b_mod[l * MODW + j];
#pragma unroll
        for (int r = 0; r <= Bn; ++r) p.mod[((size_t)l * (Bn + 1) + r) * MODW + j] = acc[r] + bb;
    }
    for (long it = gtid; it < (long)NTOK * Dm; it += gsize) p.X[it] = it < (long)NL * Dm ? p.x[it] : p.ctx[it - (long)NL * Dm];
}

HD void ph_norm1(const Params& p, int l, long gtid, long gsize) {
    for (long row = gtid; row < NTOK; row += gsize) {
        const float* xr = p.X + row * Dm;
        float ss = 0.f;
        for (int k = 0; k < Dm; ++k) ss += xr[k] * xr[k];
        const float rstd = 1.0f / sqrtf(ss / Dm + EPSF);
        const float* mr = mod_row(p, l, (int)row);
        const float* g = p.norm1_g + l * Dm;
        for (int k = 0; k < Dm; ++k) p.XN[row * Dm + k] = f2a(xr[k] * rstd * g[k] * (1.0f + mr[Dm + k]) + mr[k]);
    }
}

HD void ph_gemm_in(const Params& p, int l, long gtid, long gsize) {
    const float* W = p.w_in + (size_t)l * Dm * INW;
    for (long it = gtid; it < (long)NTOK * INW; it += gsize) {
        const long m = it / INW; const int n = (int)(it % INW);
        const act_t* a = p.XN + m * Dm;
        float acc = 0.f;
        for (int k = 0; k < Dm; ++k) acc += a2f(a[k]) * W[(size_t)k * INW + n];
        p.PROJ[it] = acc;
    }
}

template <int DHn>
HD void qk_unit(const float* src, const float* g, bool rope, int t, float oscale, float (&y)[DHn]) {
    float ss = 0.f;
#pragma unroll
    for (int i = 0; i < DHn; ++i) { y[i] = src[i]; ss += y[i] * y[i]; }
    const float rstd = 1.0f / sqrtf(ss / DHn + EPSF);
#pragma unroll
    for (int i = 0; i < DHn; ++i) y[i] = y[i] * rstd * g[i];
    if (rope) {
        constexpr int half = DHn / 2, nf = half / 2;
        const float posr = (float)(t / 64), posc = (float)(t % 64);
#pragma unroll
        for (int hsel = 0; hsel < 2; ++hsel) {
            const float pos = hsel ? posc : posr;
#pragma unroll
            for (int i = 0; i < nf; ++i) {
                const float fr = expf(-(float)i / (float)nf * 9.210340371976184f);
                const float ang = pos * fr;
                const float cs = cosf(ang), sn = sinf(ang);
                const float x1 = y[hsel * half + i], x2 = y[hsel * half + nf + i];
                y[hsel * half + i] = x1 * cs - x2 * sn;
                y[hsel * half + nf + i] = x2 * cs + x1 * sn;
            }
        }
    }
#pragma unroll
    for (int i = 0; i < DHn; ++i) y[i] *= oscale;
}

HD void ph_post(const Params& p, int l, long gtid, long gsize) {
    constexpr int NU = 27;
    for (long it = gtid; it < (long)NTOK * NU; it += gsize) {
        const int tok = (int)(it / NU), u = (int)(it % NU);
        const bool isc = tok_ctx(tok);
        const int b = tok_b(tok), ti = tok_i(tok), s = tok_s(tok);
        const float* pr = p.PROJ + (size_t)tok * INW;
        if (u < 16) {
            const bool isk = u >= 8; const int h = (u & 7) >> 1, w = u & 1;
            float y[48];
            qk_unit<48>(pr + (isk ? DK_OFF : DQ_OFF) + h * 96 + w * 48, (isk ? p.diff_k_norm : p.diff_q_norm) + l * 48, !isc, ti,
                        isk ? 1.0f : 0.14433756729740643f * LOG2E, y);
            act_t* dst = isk ? p.DK + (((size_t)(b * 4 + h) * 2 + w) * Sn + s) * 48
                             : (isc ? p.DQC + (((size_t)(b * 4 + h) * 2 + w) * Cn + ti) * 48 : p.DQL + (((size_t)(b * 4 + h) * 2 + w) * Tn + ti) * 48);
#pragma unroll
            for (int i = 0; i < 48; ++i) dst[i] = f2a(y[i]);
        } else if (u < 24) {
            const bool isk = u >= 22; const int h = isk ? u - 22 : u - 16;
            float y[64];
            qk_unit<64>(pr + (isk ? GK_OFF : GQ_OFF) + h * 64, (isk ? p.gqa_k_norm : p.gqa_q_norm) + l * 64, !isc, ti, isk ? 1.0f : 0.125f * LOG2E, y);
            act_t* dst = isk ? p.GK + ((size_t)(b * 2 + h) * Sn + s) * 64
                             : (isc ? p.GQC + ((size_t)(b * 6 + h) * Cn + ti) * 64 : p.GQL + ((size_t)(b * 6 + h) * Tn + ti) * 64);
#pragma unroll
            for (int i = 0; i < 64; ++i) dst[i] = f2a(y[i]);
        } else if (u == 24) {
            for (int j = 0; j < 384; ++j) p.DVt[((size_t)(b * 4 + j / 96) * 96 + j % 96) * Sn + s] = f2a(pr[DV_OFF + j]);
        } else if (u == 25) {
            for (int j = 0; j < 128; ++j) p.GVt[((size_t)(b * 2 + j / 64) * 64 + j % 64) * Sn + s] = f2a(pr[GV_OFF + j]);
        } else {
            const int seglen = isc ? Cn : Tn;
            const float* cw = p.mlstm_conv_w + (size_t)l * 3 * 512; const float* cb = p.mlstm_conv_b + l * 512;
            for (int ch = 0; ch < 512; ++ch) {
                float a = cb[ch] + pr[MQK_OFF + ch] * cw[512 + ch];
                if (ti > 0) a += pr[MQK_OFF + ch - INW] * cw[ch];
                if (ti < seglen - 1) a += pr[MQK_OFF + ch + INW] * cw[1024 + ch];
                a = silu_f(a);
                p.MQK[(size_t)tok * 512 + ch] = ch >= 256 ? a * 0.125f : a;
            }
            const float* gb = p.mlstm_gate_b + l * 16;
            for (int j = 0; j < 16; ++j) {
                const float gv = pr[MG_OFF + j] + gb[j];
                p.MGATE[(size_t)tok * 16 + j] = ((j >> 2) & 1) ? logsigmoid_f(gv) : gv;
            }
        }
    }
}

HD void ph_attn_diff(const Params& p, int l, bool upd, long gtid, long gsize) {
    const int nq = upd ? Tn + Cn : Tn;
    const float lam_init = lam_init_of(l);
    for (long it = gtid; it < (long)Bn * 4 * nq; it += gsize) {
        const int qi = (int)(it % nq), h = (int)((it / nq) % 4), b = (int)(it / ((long)nq * 4));
        const bool isc = qi >= Tn; const int ti = isc ? qi - Tn : qi;
        const int nk = isc ? Cn : Sn;
        const int tok = isc ? NL + b * Cn + ti : b * Tn + ti;
        float* dob = p.DO + ((size_t)(b * 4 + h) * (Tn + Cn) + qi) * 96;
        const act_t* vt = p.DVt + (size_t)(b * 4 + h) * 96 * Sn;
        float l2 = 1.f;
        float o[96];
        for (int w = 0; w < 2; ++w) {
            const act_t* qp = isc ? p.DQC + (((size_t)(b * 4 + h) * 2 + w) * Cn + ti) * 48 : p.DQL + (((size_t)(b * 4 + h) * 2 + w) * Tn + ti) * 48;
            const act_t* kp = p.DK + ((size_t)(b * 4 + h) * 2 + w) * Sn * 48;
            float q[48];
#pragma unroll
            for (int i = 0; i < 48; ++i) q[i] = a2f(qp[i]);
#pragma unroll
            for (int i = 0; i < 96; ++i) o[i] = 0.f;
            float m = -1e30f, lsum = 0.f;
            for (int s = 0; s < nk; ++s) {
                float sc = 0.f;
#pragma unroll
                for (int i = 0; i < 48; ++i) sc += q[i] * a2f(kp[(size_t)s * 48 + i]);
                const float mn = fmaxf(m, sc), alpha = exp2f(m - mn), pe = exp2f(sc - mn);
                lsum = lsum * alpha + pe;
#pragma unroll
                for (int i = 0; i < 96; ++i) o[i] = o[i] * alpha + pe * a2f(vt[(size_t)i * Sn + s]);
                m = mn;
            }
            if (w == 0) {
#pragma unroll
                for (int i = 0; i < 96; ++i) dob[i] = o[i] / lsum;
            } else l2 = lsum;
        }
        const float* dl = p.diff_lambda + l * 4 * 48;
        float s01 = 0.f, s23 = 0.f;
        for (int i = 0; i < 48; ++i) { s01 += dl[i] * dl[48 + i]; s23 += dl[96 + i] * dl[144 + i]; }
        const float lam = expf(s01) - expf(s23) + lam_init;
        float ss = 0.f;
#pragma unroll
        for (int i = 0; i < 96; ++i) { o[i] = dob[i] - lam * o[i] / l2; ss += o[i] * o[i]; }
        const float rstd = 1.0f / sqrtf(ss / 96 + EPSF);
        const float* sg = p.diff_subln + l * 96;
#pragma unroll
        for (int i = 0; i < 96; ++i) p.MIX[(size_t)tok * Dm + h * 96 + i] = f2a(o[i] * rstd * sg[i] * (1.0f - lam_init));
    }
}

HD void ph_attn_gqa(const Params& p, int l, bool upd, long gtid, long gsize) {
    const int nq = upd ? Tn + Cn : Tn;
    for (long it = gtid; it < (long)Bn * 6 * nq; it += gsize) {
        const int qi = (int)(it % nq), hq = (int)((it / nq) % 6), b = (int)(it / ((long)nq * 6));
        const bool isc = qi >= Tn; const int ti = isc ? qi - Tn : qi;
        const int nk = isc ? Cn : Sn, kv = hq / 3;
        const int tok = isc ? NL + b * Cn + ti : b * Tn + ti;
        const act_t* qp = isc ? p.GQC + ((size_t)(b * 6 + hq) * Cn + ti) * 64 : p.GQL + ((size_t)(b * 6 + hq) * Tn + ti) * 64;
        const act_t* kp = p.GK + (size_t)(b * 2 + kv) * Sn * 64;
        const act_t* vt = p.GVt + (size_t)(b * 2 + kv) * 64 * Sn;
        float q[64], o[64];
#pragma unroll
        for (int i = 0; i < 64; ++i) { q[i] = a2f(qp[i]); o[i] = 0.f; }
        float m = -1e30f, lsum = 0.f;
        for (int s = 0; s < nk; ++s) {
            float sc = 0.f;
#pragma unroll
            for (int i = 0; i < 64; ++i) sc += q[i] * a2f(kp[(size_t)s * 64 + i]);
            const float mn = fmaxf(m, sc), alpha = exp2f(m - mn), pe = exp2f(sc - mn);
            lsum = lsum * alpha + pe;
#pragma unroll
            for (int i = 0; i < 64; ++i) o[i] = o[i] * alpha + pe * a2f(vt[(size_t)i * Sn + s]);
            m = mn;
        }
#pragma unroll
        for (int i = 0; i < 64; ++i) p.MIX[(size_t)tok * Dm + 384 + hq * 64 + i] = f2a(o[i] / lsum);
    }
}

HD void mlstm_dir_naive(const Params& p, int b, int h, bool isc, int ti, int dir, const float (&q)[64], float (&hout)[64]) {
    float num[64];
#pragma unroll
    for (int i = 0; i < 64; ++i) num[i] = 0.f;
    float den = 0.f, m = -1e30f, Dg = 0.f;
    for (int seg = 0; seg < (isc ? 1 : 2); ++seg) {
        const bool sc_ = seg == 1 ? true : isc;
        const int len = sc_ ? Cn : Tn;
        int cnt, start, step;
        if (seg == 0) { start = ti; step = dir == 0 ? -1 : 1; cnt = dir == 0 ? ti + 1 : len - ti; }
        else { start = dir == 0 ? len - 1 : 0; step = dir == 0 ? -1 : 1; cnt = len; }
        for (int c = 0, si = start; c < cnt; ++c, si += step) {
            const int tk = sc_ ? NL + b * Cn + si : b * Tn + si;
            const float li = p.MGATE[(size_t)tk * 16 + dir * 8 + h], lf = p.MGATE[(size_t)tk * 16 + dir * 8 + 4 + h];
            const float lw = Dg + li;
            const float* kr = p.MQK + (size_t)tk * 512 + 256 + h * 64;
            const float* vr = p.PROJ + (size_t)tk * INW + MV_OFF + h * 64;
            float qk = 0.f;
#pragma unroll
            for (int i = 0; i < 64; ++i) qk += q[i] * kr[i];
            const float mn = fmaxf(m, lw), alpha = expf(m - mn), w = expf(lw - mn) * qk;
            den = den * alpha + w;
#pragma unroll
            for (int i = 0; i < 64; ++i) num[i] = num[i] * alpha + w * vr[i];
            m = mn;
            Dg += lf;
        }
    }
    const float dn = fmaxf(fabsf(den), expf(-m));
#pragma unroll
    for (int i = 0; i < 64; ++i) hout[i] += num[i] / dn;
}

HD void ph_mlstm(const Params& p, int l, bool upd, long gtid, long gsize) {
    const int nq = upd ? Tn + Cn : Tn;
    for (long it = gtid; it < (long)Bn * 4 * nq; it += gsize) {
        const int qi = (int)(it % nq), h = (int)((it / nq) % 4), b = (int)(it / ((long)nq * 4));
        const bool isc = qi >= Tn; const int ti = isc ? qi - Tn : qi;
        const int tok = isc ? NL + b * Cn + ti : b * Tn + ti;
        float q[64], hh[64];
#pragma unroll
        for (int i = 0; i < 64; ++i) { q[i] = p.MQK[(size_t)tok * 512 + h * 64 + i]; hh[i] = 0.f; }
        mlstm_dir_naive(p, b, h, isc, ti, 0, q, hh);
        mlstm_dir_naive(p, b, h, isc, ti, 1, q, hh);
        float ss = 0.f;
#pragma unroll
        for (int i = 0; i < 64; ++i) ss += hh[i] * hh[i];
        const float rstd = 1.0f / sqrtf(ss / 64 + EPSF);
        const float* hn = p.mlstm_head_norm + l * 256 + h * 64;
        const float* og = p.PROJ + (size_t)tok * INW + MO_OFF + h * 64;
#pragma unroll
        for (int i = 0; i < 64; ++i) p.MIX[(size_t)tok * Dm + 768 + h * 64 + i] = f2a(hh[i] * rstd * hn[i] * sigmoid_f(og[i]));
    }
}

HD void ph_gemm_out(const Params& p, int l, bool upd, long gtid, long gsize) {
    const float* W = p.w_out + (size_t)l * Dm * Dm;
    const long rows = upd ? NTOK : NL;
    for (long it = gtid; it < rows * Dm; it += gsize) {
        const long m = it / Dm; const int n = (int)(it % Dm);
        const act_t* a = p.MIX + m * Dm;
        float acc = 0.f;
        for (int k = 0; k < Dm; ++k) acc += a2f(a[k]) * W[(size_t)k * Dm + n];
        p.X[it] += mod_row(p, l, (int)m)[2 * Dm + n] * acc;
    }
}

HD void ph_norm2_route(const Params& p, int l, bool upd, long gtid, long gsize) {
    const long rows = upd ? NTOK : NL;
    for (long row = gtid; row < rows; row += gsize) {
        const float* xr = p.X + row * Dm;
        float ss = 0.f;
        for (int k = 0; k < Dm; ++k) ss += xr[k] * xr[k];
        const float rstd = 1.0f / sqrtf(ss / Dm + EPSF);
        const float* mr = mod_row(p, l, (int)row);
        const float* g = p.norm2_g + l * Dm;
        const float* wg = p.moe_wg + (size_t)l * Dm * 4; const float* we = p.moe_we + (size_t)l * Dm * 32;
        float ag[4], ae[32];
#pragma unroll
        for (int j = 0; j < 4; ++j) ag[j] = 0.f;
#pragma unroll
        for (int j = 0; j < 32; ++j) ae[j] = 0.f;
        for (int k = 0; k < Dm; ++k) {
            const float f = xr[k] * rstd * g[k] * (1.0f + mr[4 * Dm + k]) + mr[3 * Dm + k];
            p.F[row * Dm + k] = f2a(f);
#pragma unroll
            for (int j = 0; j < 4; ++j) ag[j] += f * wg[k * 4 + j];
#pragma unroll
            for (int j = 0; j < 32; ++j) ae[j] += f * we[k * 32 + j];
        }
        float gmax = -1e30f; int gi = 0;
#pragma unroll
        for (int j = 0; j < 4; ++j) { ag[j] += p.moe_bg[l * 4 + j]; if (ag[j] > gmax) { gmax = ag[j]; gi = j; } }
        float gsum = 0.f;
#pragma unroll
        for (int j = 0; j < 4; ++j) gsum += expf(ag[j] - gmax);
        const float gtop = 1.0f / gsum;
        float e1 = -1e30f, e2 = -1e30f; int i1 = 0, i2 = 0;
#pragma unroll
        for (int grp = 0; grp < 4; ++grp) {
            if (grp == gi) {
#pragma unroll
                for (int j = 0; j < 8; ++j) {
                    const float v = ae[grp * 8 + j] + p.moe_be[l * 32 + grp * 8 + j];
                    if (v > e1) { e2 = e1; i2 = i1; e1 = v; i1 = j; } else if (v > e2) { e2 = v; i2 = j; }
                }
            }
        }
        const float g0 = 1.0f / (1.0f + expf(e2 - e1));
        p.EID[row * 2] = gi * 8 + i1; p.EID[row * 2 + 1] = gi * 8 + i2;
        p.GATE[row * 2] = g0 * gtop; p.GATE[row * 2 + 1] = (1.0f - g0) * gtop;
    }
}

HD void ph_moe1(const Params& p, int l, bool upd, long gtid, long gsize) {
    const long rows = upd ? NTOK : NL;
    for (long it = gtid; it < rows * 2 * 512; it += gsize) {
        const long rk = it / 512; const int j = (int)(it % 512);
        const long row = rk >> 1;
        const int e = p.EID[rk];
        const float* W1 = p.moe_w1 + ((size_t)l * 32 + e) * Dm * 512 + j; const float* W3 = p.moe_w3 + ((size_t)l * 32 + e) * Dm * 512 + j;
        const act_t* f = p.F + row * Dm;
        float a = 0.f, bb = 0.f;
        for (int k = 0; k < Dm; ++k) { const float fv = a2f(f[k]); a += fv * W1[(size_t)k * 512]; bb += fv * W3[(size_t)k * 512]; }
        p.HN[it] = silu_f(a) * bb;
    }
}

HD void ph_moe2(const Params& p, int l, bool upd, long gtid, long gsize) {
    const long rows = upd ? NTOK : NL;
    for (long it = gtid; it < rows * Dm; it += gsize) {
        const long row = it / Dm; const int d = (int)(it % Dm);
        float y = 0.f;
        for (int kk = 0; kk < 2; ++kk) {
            const int e = p.EID[row * 2 + kk];
            const float* W2 = p.moe_w2 + ((size_t)l * 32 + e) * 512 * Dm + d;
            const float* hn = p.HN + (row * 2 + kk) * 512;
            float acc = 0.f;
            for (int j = 0; j < 512; ++j) acc += hn[j] * W2[(size_t)j * Dm];
            y += p.GATE[row * 2 + kk] * acc;
        }
        const float xn = p.X[it] + mod_row(p, l, (int)row)[5 * Dm + d] * y;
        p.X[it] = xn;
        if (l == DEPTH - 1) p.out[it] = xn;
    }
}

constexpr int PH_PER_LAYER = 8;
constexpr int N_PHASES = 1 + DEPTH * PH_PER_LAYER;
HD void run_phase(const Params& p, int ph, long gtid, long gsize) {
    if (ph == 0) { ph_mod(p, gtid, gsize); return; }
    const int l = (ph - 1) / PH_PER_LAYER, s = (ph - 1) % PH_PER_LAYER;
    const bool upd = l < DEPTH - 1;
    switch (s) {
        case 0: ph_norm1(p, l, gtid, gsize); break;
        case 1: ph_gemm_in(p, l, gtid, gsize); break;
        case 2: ph_post(p, l, gtid, gsize); break;
        case 3: ph_attn_diff(p, l, upd, gtid, gsize); ph_attn_gqa(p, l, upd, gtid, gsize); ph_mlstm(p, l, upd, gtid, gsize); break;
        case 4: ph_gemm_out(p, l, upd, gtid, gsize); break;
        case 5: ph_norm2_route(p, l, upd, gtid, gsize); break;
        case 6: ph_moe1(p, l, upd, gtid, gsize); break;
        default: ph_moe2(p, l, upd, gtid, gsize); break;
    }
}

struct Carver { char* base; size_t off; template <class T> T* take(size_t n) { T* r = (T*)(base + off); off += (n * sizeof(T) + 255) & ~(size_t)255; return r; } };
static inline size_t carve(Params& p, void* ws) {
    Carver c{(char*)ws, 0};
    p.mod = c.take<float>((size_t)DEPTH * (Bn + 1) * MODW);
    p.X = c.take<float>((size_t)NTOK * Dm);
#ifdef HOST_TEST
    p.PROJ = c.take<float>((size_t)NTOK * INW);
#endif
#ifdef HOST_TEST
    p.MQK = c.take<float>((size_t)NTOK * 512);
    p.MGATE = c.take<float>((size_t)NTOK * 16);
#endif
    p.DO = c.take<float>((size_t)Bn * 4 * (Tn + Cn) * 96);
    p.GATE = c.take<float>((size_t)NTOK * 2);
#ifdef HOST_TEST
    p.HN = c.take<float>((size_t)NTOK * 2 * 512);
#endif
    p.XN = c.take<act_t>((size_t)NTOK * Dm);
    p.DQL = c.take<act_t>((size_t)Bn * 4 * 2 * Tn * 48);
    p.DQC = c.take<act_t>((size_t)Bn * 4 * 2 * Cn * 48);
    p.DK = c.take<act_t>((size_t)Bn * 4 * 2 * Sn * 48);
    p.DVt = c.take<act_t>((size_t)Bn * 4 * 96 * Sn);
    p.GQL = c.take<act_t>((size_t)Bn * 6 * Tn * 64);
    p.GQC = c.take<act_t>((size_t)Bn * 6 * Cn * 64);
    p.GK = c.take<act_t>((size_t)Bn * 2 * Sn * 64);
    p.GVt = c.take<act_t>((size_t)Bn * 2 * 64 * Sn);
    p.MIX = c.take<act_t>((size_t)NTOK * Dm);
    p.F = c.take<act_t>((size_t)NTOK * Dm);
    p.EID = c.take<int>((size_t)NTOK * 2);
    p.CNT = c.take<int>((size_t)DEPTH * 32 * 64);
    p.LIST = c.take<int>((size_t)32 * NTOK);
    p.POS = c.take<int>((size_t)NTOK * 2);
    p.H = c.take<act_t>((size_t)PMAX * 512);
    p.Y = c.take<act_t>((size_t)PMAX * Dm);
    p.ROPE = c.take<float>((size_t)64 * 28 * 2);
    p.KV = c.take<float>((size_t)Bn * 4 * 2 * NCH * 4096);
    p.NLC = c.take<float>((size_t)Bn * 4 * 2 * NCH * 64);
    p.CHS = c.take<float>((size_t)Bn * 4 * 2 * NCH * 2);
    p.MG4 = c.take<float>((size_t)NTOK * 16);
    p.MQKB = c.take<act_t>((size_t)NTOK * 512);
    p.BAR = c.take<unsigned>(4096);
    p.WIN_T = c.take<act_t>((size_t)DEPTH * INW * Dm);
    p.WOUT_T = c.take<act_t>((size_t)DEPTH * Dm * Dm);
    p.TS = c.take<unsigned long long>(256);
    p.FLO = c.take<act_t>((size_t)NTOK * Dm);
    p.WRHI = c.take<act_t>((size_t)DEPTH * 36 * Dm);
    p.WRLO = c.take<act_t>((size_t)DEPTH * 36 * Dm);
    p.ZROW = c.take<act_t>(2048);
    p.W13T = c.take<act_t>((size_t)2 * 32 * 1024 * Dm);
    p.W2T = c.take<act_t>((size_t)2 * 32 * Dm * 512);
    p.PROJB = c.take<act_t>((size_t)NTOK * INW);
    p.PG = c.take<float>((size_t)NTOK * 16);
    return c.off;
}
static inline void fill_inputs(Params& p, void* const* d_in, void* d_out) {
    const float** f = (const float**)&p;
    for (int i = 0; i < 27; ++i) f[i] = (const float*)d_in[i];
    p.out = (float*)d_out;
}


#ifndef HOST_TEST
typedef short bf16x8 __attribute__((ext_vector_type(8)));
typedef float f32x2 __attribute__((ext_vector_type(2)));
typedef float f32x4 __attribute__((ext_vector_type(4)));
typedef float f32x16 __attribute__((ext_vector_type(16)));
typedef unsigned u32x2 __attribute__((ext_vector_type(2)));
typedef unsigned u32x4 __attribute__((ext_vector_type(4)));
typedef __bf16 bf16x2_t __attribute__((ext_vector_type(2)));
#define DI __device__ __forceinline__
DI unsigned pk2(float a, float b) { f32x2 v = {a, b}; return __builtin_bit_cast(unsigned, __builtin_convertvector(v, bf16x2_t)); }
DI float bflo(unsigned u) { return __uint_as_float(u << 16); }
DI float bfhi(unsigned u) { return __uint_as_float(u & 0xffff0000u); }
DI f32x4 ld4bf(const act_t* q) { const u32x2 v = *(const u32x2*)q; return (f32x4){bflo(v[0]), bfhi(v[0]), bflo(v[1]), bfhi(v[1])}; }
DI float shfl_i(float v, int src) { return __int_as_float(__builtin_amdgcn_ds_bpermute(src << 2, __float_as_int(v))); }
DI float shfl_x(float v, int o, int lane) { return shfl_i(v, lane ^ o); }
DI float row16_sum(float v) {
#define ROR_(x, n) __int_as_float(__builtin_amdgcn_update_dpp(0, __float_as_int(x), 0x120 + (n), 0xF, 0xF, false))
    v += ROR_(v, 8); v += ROR_(v, 4); v += ROR_(v, 2); v += ROR_(v, 1);
#undef ROR_
    return v;
}
DI float wave_sum(float v, int lane) {
#pragma unroll
    for (int o = 32; o > 0; o >>= 1) v += shfl_x(v, o, lane);
    return v;
}

constexpr int NTHR = 256;
DI void lds_barrier() { asm volatile("s_waitcnt lgkmcnt(0)" ::: "memory"); __builtin_amdgcn_s_barrier(); asm volatile("" ::: "memory"); }
DI int opaque_tid() { int t = threadIdx.x; asm volatile("" : "+v"(t)); return t; }
constexpr int GT_LD = 144;
constexpr int GT_AS = 0, GT_BS = 128 * GT_LD, GT_END = 256 * GT_LD;
constexpr int SM_AUX = 65536;
constexpr int SMEM_BYTES = 66 * 1024;

#ifndef IMPL_POST
#define IMPL_POST 1
#endif
#ifndef IMPL_ATTN
#define IMPL_ATTN 1
#endif
#ifndef IMPL_MLSTM
#define IMPL_MLSTM 1
#endif
#ifndef IMPL_ROUTE
#define IMPL_ROUTE 1
#endif
DI int gt_off(int r, int c) { return r * 128 + ((c ^ ((r >> 1) & 7)) << 4); }
constexpr int GT_STAGE = 32768, GT_B = 16384;
#define GT_COMPUTE(BUF) \
    _Pragma("unroll") for (int kk = 0; kk < 2; ++kk) { \
        bf16x8 af[4], bfr[4]; \
        _Pragma("unroll") for (int mi = 0; mi < 4; ++mi) af[mi] = *(const bf16x8*)(smem + (BUF) * GT_STAGE + gt_off(wm * 64 + mi * 16 + (lane & 15), kk * 4 + (lane >> 4))); \
        _Pragma("unroll") for (int ni = 0; ni < 4; ++ni) bfr[ni] = *(const bf16x8*)(smem + (BUF) * GT_STAGE + GT_B + gt_off(wn * 64 + ni * 16 + (lane & 15), kk * 4 + (lane >> 4))); \
        _Pragma("unroll") for (int mi = 0; mi < 4; ++mi) \
            _Pragma("unroll") for (int ni = 0; ni < 4; ++ni) acc[mi][ni] = __builtin_amdgcn_mfma_f32_16x16x32_bf16(bfr[ni], af[mi], acc[mi][ni], 0, 0, 0); }

DI void gemm_mainloop(unsigned char* smem, const act_t* const (&arow)[4], const float* bptr, const int ldb, const int K, f32x4 (&acc)[4][4]) {
    const int tid = opaque_tid(), lane = tid & 63, w = tid >> 6, wm = w >> 1, wn = w & 1;
    const int a_r = tid >> 3, a_c = tid & 7, kg = lane & 7, c4 = (w * 8 + (lane >> 3)) * 4;
#pragma unroll
    for (int mi = 0; mi < 4; ++mi)
#pragma unroll
        for (int ni = 0; ni < 4; ++ni) acc[mi][ni] = (f32x4){0.f, 0.f, 0.f, 0.f};
    u32x4 ra[4]; f32x4 rb[8];
#define GT_LOAD(KOFF) { \
    _Pragma("unroll") for (int i = 0; i < 4; ++i) ra[i] = *(const u32x4*)(arow[i] + (KOFF) + a_c * 8); \
    _Pragma("unroll") for (int r = 0; r < 8; ++r) rb[r] = *(const f32x4*)(bptr + (size_t)((KOFF) + kg * 8 + r) * ldb); }
#define GT_WRITE(BUF) { \
    _Pragma("unroll") for (int i = 0; i < 4; ++i) *(u32x4*)(smem + (BUF) * GT_STAGE + gt_off(a_r + 32 * i, a_c)) = ra[i]; \
    _Pragma("unroll") for (int i = 0; i < 4; ++i) { \
        const u32x4 q = {pk2(rb[0][i], rb[1][i]), pk2(rb[2][i], rb[3][i]), pk2(rb[4][i], rb[5][i]), pk2(rb[6][i], rb[7][i])}; \
        *(u32x4*)(smem + (BUF) * GT_STAGE + GT_B + gt_off(c4 + i, kg)) = q; } }
    const int nt = K >> 6;
    __syncthreads();
    GT_LOAD(0)
    GT_WRITE(0)
    __syncthreads();
    if (nt > 1) GT_LOAD(64)
    for (int t = 0; t < nt; ++t) {
        const int buf = t & 1;
        GT_COMPUTE(buf)
        if (t + 1 < nt) GT_WRITE(buf ^ 1)
        __syncthreads();
        if (t + 2 < nt) GT_LOAD((t + 2) * 64)
    }
#undef GT_LOAD
#undef GT_WRITE
}

#define LDSP __attribute__((address_space(3)))
template <int MODE = 0>
DI void gemm_mainloop_bb(unsigned char* smem, const act_t* const (&arow)[4], const act_t* const (&brow)[4], const int K, f32x4 (&acc)[4][4]) {
    const int tid = opaque_tid(), lane = tid & 63, w = tid >> 6, wm = w >> 1, wn = w & 1;
    const int wu = __builtin_amdgcn_readfirstlane(w);
#pragma unroll
    for (int mi = 0; mi < 4; ++mi)
#pragma unroll
        for (int ni = 0; ni < 4; ++ni) acc[mi][ni] = (f32x4){0.f, 0.f, 0.f, 0.f};
    const int csrc = ((lane & 7) ^ ((4 * w + (lane >> 4)) & 7)) * 8;
#define GB_DMA(KOFF, BUF) { \
    _Pragma("unroll") for (int i = 0; i < 4; ++i) { \
        __builtin_amdgcn_global_load_lds((const unsigned*)(arow[i] + (KOFF) + csrc), (LDSP unsigned*)(smem + (BUF) * GT_STAGE + (4 * i + wu) * 1024), 16, 0, 0); \
        __builtin_amdgcn_global_load_lds((const unsigned*)(brow[i] + (KOFF) + csrc), (LDSP unsigned*)(smem + (BUF) * GT_STAGE + GT_B + (4 * i + wu) * 1024), 16, 0, 0); } }
    const int nt = K >> 6;
    __syncthreads();
    GB_DMA(0, 0)
    asm volatile("s_waitcnt vmcnt(0)" ::: "memory");
    __syncthreads();
    for (int t = 0; t < nt; ++t) {
        const int buf = t & 1;
        if (t + 1 < nt) GB_DMA((t + 1) * 64, buf ^ 1)
        GT_COMPUTE(buf)
        asm volatile("s_waitcnt vmcnt(0)" ::: "memory");
        __syncthreads();
    }
#undef GB_DMA
}

DI int g32_off(int r, int c) { return r * 64 + ((c ^ (((r >> 2) & 1) * 3)) << 4); }
DI void gemm_mainloop_big(unsigned char* smem, const act_t* const (&arow)[4], const act_t* const (&brow)[2], const int K, f32x4 (&acc)[8][4]) {
    const int tid = opaque_tid(), lane = tid & 63, w = tid >> 6, wm = w >> 1, wn = w & 1;
    const int wu = __builtin_amdgcn_readfirstlane(w);
#pragma unroll
    for (int mi = 0; mi < 8; ++mi)
#pragma unroll
        for (int ni = 0; ni < 4; ++ni) acc[mi][ni] = (f32x4){0.f, 0.f, 0.f, 0.f};
    const int csrc = ((lane & 3) ^ (((lane >> 4) & 1) * 3)) * 8;
    constexpr int STG = 24576, BOFF = 16384;
#define GB_DMA(T, BUF) { const int ko_ = (T) * 32 + csrc; unsigned char* st_ = smem + (BUF) * STG; \
    _Pragma("unroll") for (int j = 0; j < 4; ++j) __builtin_amdgcn_global_load_lds((const unsigned*)(arow[j] + ko_), (LDSP unsigned*)(st_ + (4 * wu + j) * 1024), 16, 0, 0); \
    _Pragma("unroll") for (int j = 0; j < 2; ++j) __builtin_amdgcn_global_load_lds((const unsigned*)(brow[j] + ko_), (LDSP unsigned*)(st_ + BOFF + (2 * wu + j) * 1024), 16, 0, 0); }
    const int nt = K >> 5;
    __syncthreads();
    GB_DMA(0, 0)
    asm volatile("s_waitcnt vmcnt(0)" ::: "memory");
    __syncthreads();
    for (int t = 0; t < nt; ++t) {
        const int buf = t & 1;
        if (t + 1 < nt) GB_DMA(t + 1, buf ^ 1)
        const unsigned char* st = smem + buf * STG;
        bf16x8 bfr[4];
#pragma unroll
        for (int ni = 0; ni < 4; ++ni) bfr[ni] = *(const bf16x8*)(st + BOFF + g32_off(wn * 64 + ni * 16 + (lane & 15), lane >> 4));
#pragma unroll
        for (int mi = 0; mi < 8; ++mi) {
            const bf16x8 af = *(const bf16x8*)(st + g32_off(wm * 128 + mi * 16 + (lane & 15), lane >> 4));
#pragma unroll
            for (int ni = 0; ni < 4; ++ni) acc[mi][ni] = __builtin_amdgcn_mfma_f32_16x16x32_bf16(bfr[ni], af, acc[mi][ni], 0, 0, 0);
        }
        asm volatile("s_waitcnt vmcnt(0)" ::: "memory");
        __syncthreads();
    }
#undef GB_DMA
}

DI void bp_wconv(const Params& p, unsigned char* smem, int bid, int G) {
    const int tid = opaque_tid();
    float* T = (float*)smem;
    constexpr int NT_IN = (INW + 63) / 64, NT_OUT = Dm / 64, KT = Dm / 64;
    constexpr int PER_L = (NT_IN + NT_OUT) * KT;
    const int k = tid >> 2, n16 = (tid & 3) * 16;
    const int n = tid >> 2, k16 = (tid & 3) * 16;
    f32x4 v[4];
#define WC_DECODE(ITEM) const int l_ = (ITEM) / PER_L, r_ = (ITEM) % PER_L; const bool isout_ = r_ >= NT_IN * KT; \
        const int rr_ = isout_ ? r_ - NT_IN * KT : r_, nt_ = rr_ / KT, kt_ = rr_ % KT, N_ = isout_ ? Dm : INW; \
        const float* W_ = isout_ ? p.w_out + (size_t)l_ * Dm * Dm : p.w_in + (size_t)l_ * Dm * INW;
#define WC_LOAD(ITEM) { WC_DECODE(ITEM) \
        _Pragma("unroll") for (int i = 0; i < 4; ++i) { const int nn = nt_ * 64 + n16 + i * 4; v[i] = nn < N_ ? *(const f32x4*)(W_ + (size_t)(kt_ * 64 + k) * N_ + nn) : (f32x4){0.f, 0.f, 0.f, 0.f}; } }
    if (bid < DEPTH * PER_L) WC_LOAD(bid)
    for (int item = bid; item < DEPTH * PER_L; item += G) {
        __syncthreads();
#pragma unroll
        for (int i = 0; i < 4; ++i) { T[k * 65 + n16 + i * 4] = v[i][0]; T[k * 65 + n16 + i * 4 + 1] = v[i][1]; T[k * 65 + n16 + i * 4 + 2] = v[i][2]; T[k * 65 + n16 + i * 4 + 3] = v[i][3]; }
        __syncthreads();
        if (item + G < DEPTH * PER_L) WC_LOAD(item + G)
        WC_DECODE(item)
        (void)W_;
        act_t* WT = isout_ ? p.WOUT_T + (size_t)l_ * Dm * Dm : p.WIN_T + (size_t)l_ * INW * Dm;
        if (nt_ * 64 + n < N_) {
            unsigned o[8];
#pragma unroll
            for (int i = 0; i < 8; ++i) o[i] = pk2(T[(k16 + 2 * i) * 65 + n], T[(k16 + 2 * i + 1) * 65 + n]);
            act_t* dst = WT + (size_t)(nt_ * 64 + n) * Dm + kt_ * 64 + k16;
            *(u32x4*)dst = (u32x4){o[0], o[1], o[2], o[3]}; *(u32x4*)(dst + 8) = (u32x4){o[4], o[5], o[6], o[7]};
        }
    }
#undef WC_LOAD
#undef WC_DECODE
}

DI int xcd_remap(int b, int G) { return (G & 7) == 0 ? (b & 7) * (G >> 3) + (b >> 3) : b; }

template <int MODE = 0>
DI void bp_gemm_in(const Params& p, int l, unsigned char* smem, int vb, int G) {
    constexpr int MTB = NTOK / 256, NT = (INW + 127) / 128;
    const int tid = opaque_tid(), lane = tid & 63, w = tid >> 6, wm = w >> 1, wn = w & 1;
    const int nbig_all = MTB * NT, nbig = (nbig_all / G) * G;
    for (int t = vb; t < nbig; t += G) {
        const int mt = t / NT, nt = t % NT, m0 = mt * 256, n0 = nt * 128;
        const act_t* arow[4]; const act_t* brow[2];
#pragma unroll
        for (int j = 0; j < 4; ++j) arow[j] = p.XN + (size_t)(m0 + 64 * w + 16 * j + (lane >> 2)) * Dm;
#pragma unroll
        for (int j = 0; j < 2; ++j) { const int r = 32 * w + 16 * j + (lane >> 2); brow[j] = n0 + r < INW ? p.WIN_T + ((size_t)l * INW + n0 + r) * Dm : p.ZROW; }
        f32x4 acc[8][4];
        gemm_mainloop_big(smem, arow, brow, Dm, acc);
#pragma unroll
        for (int mi = 0; mi < 8; ++mi)
#pragma unroll
            for (int ni = 0; ni < 4; ++ni) {
                const int m = m0 + wm * 128 + mi * 16 + (lane & 15), n = n0 + wn * 64 + ni * 16 + (lane >> 4) * 4;
                if (n < INW) {
                    const f32x4 v = acc[mi][ni];
                    *(u32x2*)(p.PROJB + (size_t)m * INW + n) = (u32x2){pk2(v[0], v[1]), pk2(v[2], v[3])};
                    if (n >= MG_OFF) *(f32x4*)(p.PG + (size_t)m * 16 + n - MG_OFF) = v;
                }
            }
    }
    const int a_r = tid >> 3;
    for (int t = vb; t < 2 * (nbig_all - nbig); t += G) {
        const int tb = nbig + (t >> 1), mt = tb / NT, nt = tb % NT, m0 = mt * 256 + (t & 1) * 128, n0 = nt * 128;
        const act_t* arow[4]; const act_t* brow[4];
#pragma unroll
        for (int i = 0; i < 4; ++i) { arow[i] = p.XN + (size_t)(m0 + a_r + 32 * i) * Dm; brow[i] = n0 + a_r + 32 * i < INW ? p.WIN_T + ((size_t)l * INW + n0 + a_r + 32 * i) * Dm : p.ZROW; }
        f32x4 acc[4][4];
        gemm_mainloop_bb<MODE>(smem, arow, brow, Dm, acc);
#pragma unroll
        for (int mi = 0; mi < 4; ++mi)
#pragma unroll
            for (int ni = 0; ni < 4; ++ni) {
                const int m = m0 + wm * 64 + mi * 16 + (lane & 15), n = n0 + wn * 64 + ni * 16 + (lane >> 4) * 4;
                if (n < INW) {
                    const f32x4 v = acc[mi][ni];
                    *(u32x2*)(p.PROJB + (size_t)m * INW + n) = (u32x2){pk2(v[0], v[1]), pk2(v[2], v[3])};
                    if (n >= MG_OFF) *(f32x4*)(p.PG + (size_t)m * 16 + n - MG_OFF) = v;
                }
            }
    }
}

DI void mconv_drain(const Params& p, int l, unsigned char* smem, int max_items);
template <bool DRY>
DI void bp_gemm_out(const Params& p, int l, bool upd, unsigned char* smem, int vb, int G) {
    const int MT = (upd ? NTOK : NL) / 128; constexpr int NT = Dm / 128;
    const float* W = p.w_out + (size_t)l * Dm * Dm;
    const int tid = opaque_tid(), lane = tid & 63, w = tid >> 6, wm = w >> 1, wn = w & 1, a_r = tid >> 3, c4 = (w * 8 + (lane >> 3)) * 4;
    for (int t = vb; t < MT * NT; t += G) {
        const int mt = t / NT, nt = t % NT, m0 = mt * 128, n0 = nt * 128;
        const act_t* arow[4];
#pragma unroll
        for (int i = 0; i < 4; ++i) arow[i] = p.MIX + (size_t)(m0 + a_r + 32 * i) * Dm;
        const act_t* brow[4];
#pragma unroll
        for (int i = 0; i < 4; ++i) brow[i] = p.WOUT_T + ((size_t)l * Dm + n0 + a_r + 32 * i) * Dm;
        f32x4 acc[4][4];
        gemm_mainloop_bb(smem, arow, brow, Dm, acc);
#pragma unroll
        for (int mi = 0; mi < 4; ++mi) {
            const int m = m0 + wm * 64 + mi * 16 + (lane & 15);
            const float* g1 = mod_row(p, l, m) + 2 * Dm;
#pragma unroll
            for (int ni = 0; ni < 4; ++ni) {
                const int n = n0 + wn * 64 + ni * 16 + (lane >> 4) * 4;
                f32x4* xp = (f32x4*)(p.X + (size_t)m * Dm + n);
                const f32x4 xo = l == 0 ? *(const f32x4*)((m < NL ? p.x + (size_t)m * Dm : p.ctx + (size_t)(m - NL) * Dm) + n) : *xp;
                if (DRY) *(f32x4*)((float*)p.PROJB + (size_t)m * Dm + n) = xo + *(const f32x4*)(g1 + n) * acc[mi][ni];
                else *xp = xo + *(const f32x4*)(g1 + n) * acc[mi][ni];
            }
        }
    }
    if (!DRY && vb >= (MT * NT) % G) mconv_drain(p, l, smem, 1);
}

DI int* moe_prep(const Params& p, int l, unsigned char* smem) {
    int* s_moff = (int*)(smem + SM_AUX);
    __syncthreads();
    if (threadIdx.x == 0) { int o = 0; for (int e = 0; e < 32; ++e) { s_moff[e] = o; o += (p.CNT[(l * 32 + e) * 64] + 127) >> 7; } s_moff[32] = o; }
    __syncthreads();
    return s_moff;
}

DI void bp_moe1(const Params& p, int l, unsigned char* smem, int vb, int G) {
    const int* s_moff = moe_prep(p, l, smem);
    const int total = s_moff[32] * 8;
    const int tid = opaque_tid(), lane = tid & 63, w = tid >> 6, wm = w >> 1, wn = w & 1, a_r = tid >> 3, c4 = (w * 8 + (lane >> 3)) * 4;
    for (int t = vb; t < total; t += G) {
        const int mtg = t >> 3, nt = t & 7;
        int e = 0; while (s_moff[e + 1] <= mtg) ++e;
        const int cnt = p.CNT[(l * 32 + e) * 64], lbase = (mtg - s_moff[e]) * 128;
        const act_t* arow[4];
#pragma unroll
        for (int i = 0; i < 4; ++i) { const int li = lbase + a_r + 32 * i; arow[i] = li < cnt ? p.F + (size_t)p.LIST[(size_t)e * NTOK + li] * Dm : p.ZROW; }
        const act_t* brow[4];
#pragma unroll
        for (int i = 0; i < 4; ++i) { const int r = a_r + 32 * i, sel = (r & 63) >> 5, j = nt * 64 + (r >> 6) * 32 + (r & 31); brow[i] = p.W13T + ((size_t)(l & 1) * 32 * 1024 + (size_t)e * 1024 + sel * 512 + j) * Dm; }
        f32x4 acc[4][4];
        gemm_mainloop_bb(smem, arow, brow, Dm, acc);
#pragma unroll
        for (int mi = 0; mi < 4; ++mi)
#pragma unroll
            for (int ni = 0; ni < 2; ++ni) {
                const f32x4 a = acc[mi][ni], b = acc[mi][ni + 2];
                float h[4];
#pragma unroll
                for (int r = 0; r < 4; ++r) h[r] = a[r] / (1.0f + __expf(-a[r])) * b[r];
                const int prow = mtg * 128 + wm * 64 + mi * 16 + (lane & 15), jj = nt * 64 + wn * 32 + ni * 16 + (lane >> 4) * 4;
                *(u32x2*)(p.H + (size_t)prow * 512 + jj) = (u32x2){pk2(h[0], h[1]), pk2(h[2], h[3])};
            }
    }
}

DI void bp_moe2(const Params& p, int l, unsigned char* smem, int vb, int G) {
    const int* s_moff = moe_prep(p, l, smem);
    const int total = s_moff[32] * 8;
    const int tid = opaque_tid(), lane = tid & 63, w = tid >> 6, wm = w >> 1, wn = w & 1, a_r = tid >> 3, c4 = (w * 8 + (lane >> 3)) * 4;
    for (int t = vb; t < total; t += G) {
        const int mtg = t >> 3, nt = t & 7, n0 = nt * 128;
        int e = 0; while (s_moff[e + 1] <= mtg) ++e;
        const act_t* arow[4];
#pragma unroll
        for (int i = 0; i < 4; ++i) arow[i] = p.H + (size_t)(mtg * 128 + a_r + 32 * i) * 512;
        const act_t* brow[4];
#pragma unroll
        for (int i = 0; i < 4; ++i) brow[i] = p.W2T + (((size_t)(l & 1) * 32 + e) * Dm + n0 + a_r + 32 * i) * 512;
        f32x4 acc[4][4];
        gemm_mainloop_bb(smem, arow, brow, 512, acc);
#pragma unroll
        for (int mi = 0; mi < 4; ++mi)
#pragma unroll
            for (int ni = 0; ni < 4; ++ni) {
                const int prow = mtg * 128 + wm * 64 + mi * 16 + (lane & 15), n = n0 + wn * 64 + ni * 16 + (lane >> 4) * 4;
                const f32x4 v = acc[mi][ni];
                *(u32x2*)(p.Y + (size_t)prow * Dm + n) = (u32x2){pk2(v[0], v[1]), pk2(v[2], v[3])};
            }
    }
}

DI void bp_route(const Params& p, int l, bool upd, long gtid, long gsize) {
    ph_norm2_route(p, l, upd, gtid, gsize);
    const long rows = upd ? NTOK : NL;
    for (long row = gtid; row < rows; row += gsize)
#pragma unroll
        for (int kk = 0; kk < 2; ++kk) {
            const int e = p.EID[row * 2 + kk];
            const int pos = atomicAdd(&p.CNT[(l * 32 + e) * 64], 1);
            p.LIST[(size_t)e * NTOK + pos] = (int)row;
            p.POS[row * 2 + kk] = pos;
        }
}

DI void norm1_row(const Params& p, int l, long row, const f32x4 (&x)[4], int lane) {
    float ss = 0.f;
#pragma unroll
    for (int i = 0; i < 4; ++i) ss += x[i][0] * x[i][0] + x[i][1] * x[i][1] + x[i][2] * x[i][2] + x[i][3] * x[i][3];
    ss = wave_sum(ss, lane);
    const float rstd = 1.0f / sqrtf(ss / Dm + EPSF);
    const float* mr = mod_row(p, l, (int)row);
    const float* g = p.norm1_g + l * Dm;
#pragma unroll
    for (int i = 0; i < 4; ++i) {
        const int k = 256 * i + 4 * lane;
        const f32x4 gv = *(const f32x4*)(g + k), sh = *(const f32x4*)(mr + k), sc = *(const f32x4*)(mr + Dm + k);
        const f32x4 y = x[i] * rstd * gv * (1.0f + sc) + sh;
        *(u32x2*)(p.XN + row * Dm + k) = (u32x2){pk2(y[0], y[1]), pk2(y[2], y[3])};
    }
}
DI void bp_norm1(const Params& p, int l, int gwave, int nwaves, int lane) {
    for (long row0 = gwave; row0 < NTOK; row0 += 3 * (long)nwaves) {
        f32x4 x[3][4]; long rw[3];
#pragma unroll
        for (int u = 0; u < 3; ++u) {
            rw[u] = row0 + (long)u * nwaves < NTOK ? row0 + (long)u * nwaves : row0;
            const float* src = rw[u] < NL ? p.x + rw[u] * Dm : p.ctx + (rw[u] - NL) * Dm;
#pragma unroll
            for (int i = 0; i < 4; ++i) x[u][i] = *(const f32x4*)(src + 256 * i + 4 * lane);
        }
#pragma unroll
        for (int u = 0; u < 3; ++u) if (u == 0 || row0 + (long)u * nwaves < NTOK) norm1_row(p, l, rw[u], x[u], lane);
    }
}
template <bool DRY>
DI void bp_combine(const Params& p, int l, bool upd, unsigned char* smem, int gwave, int nwaves, int lane) {
    const int* s_moff = moe_prep(p, l, smem);
    const long rows = upd ? NTOK : NL;
    const long rpw = (rows + nwaves - 1) / nwaves, rbeg = (long)gwave * rpw, rend = rbeg + rpw < rows ? rbeg + rpw : rows;
    constexpr int CU_ = 3;
    int mb_loaded = -1;
    f32x4 g2v[4], mulv[4], addv[4];
    for (long row0 = rbeg; row0 < rend; row0 += CU_) {
        long rw[CU_]; bool ok[CU_]; size_t pa[CU_], pb[CU_]; float g0[CU_], g1[CU_];
#pragma unroll
        for (int u = 0; u < CU_; ++u) {
            rw[u] = row0 + u; ok[u] = rw[u] < rend; if (!ok[u]) rw[u] = row0;
            const int e0 = p.EID[rw[u] * 2], e1 = p.EID[rw[u] * 2 + 1];
            pa[u] = (size_t)s_moff[e0] * 128 + p.POS[rw[u] * 2]; pb[u] = (size_t)s_moff[e1] * 128 + p.POS[rw[u] * 2 + 1];
            g0[u] = p.GATE[rw[u] * 2]; g1[u] = p.GATE[rw[u] * 2 + 1];
        }
        f32x4 ya[CU_][4], xo[CU_][4];
#pragma unroll
        for (int u = 0; u < CU_; ++u)
#pragma unroll
            for (int i = 0; i < 4; ++i) {
                const int k = 256 * i + 4 * lane;
                const u32x2 a2 = *(const u32x2*)(p.Y + pa[u] * Dm + k), b2 = *(const u32x2*)(p.Y + pb[u] * Dm + k);
                ya[u][i] = (f32x4){g0[u] * bflo(a2[0]) + g1[u] * bflo(b2[0]), g0[u] * bfhi(a2[0]) + g1[u] * bfhi(b2[0]), g0[u] * bflo(a2[1]) + g1[u] * bflo(b2[1]), g0[u] * bfhi(a2[1]) + g1[u] * bfhi(b2[1])};
                xo[u][i] = *(const f32x4*)(p.X + rw[u] * Dm + k);
            }
#pragma unroll
        for (int u = 0; u < CU_; ++u) {
            if (!ok[u]) continue;
            const int mb = tok_modrow((int)rw[u]);
            if (mb != mb_loaded) {
                mb_loaded = mb;
                const float* mr = p.mod + ((size_t)l * (Bn + 1) + mb) * MODW;
                const float* mrn = p.mod + ((size_t)(l + 1 < DEPTH ? l + 1 : l) * (Bn + 1) + mb) * MODW;
                const float* gn = p.norm1_g + (l + 1 < DEPTH ? l + 1 : l) * Dm;
#pragma unroll
                for (int i = 0; i < 4; ++i) {
                    const int k = 256 * i + 4 * lane;
                    g2v[i] = *(const f32x4*)(mr + 5 * Dm + k);
                    mulv[i] = *(const f32x4*)(gn + k) * (1.0f + *(const f32x4*)(mrn + Dm + k)); addv[i] = *(const f32x4*)(mrn + k);
                }
            }
            f32x4 x[4]; float ss = 0.f;
#pragma unroll
            for (int i = 0; i < 4; ++i) { x[i] = xo[u][i] + g2v[i] * ya[u][i]; ss += x[i][0] * x[i][0] + x[i][1] * x[i][1] + x[i][2] * x[i][2] + x[i][3] * x[i][3]; }
            if (!DRY) {
#pragma unroll
                for (int i = 0; i < 4; ++i) { const int k = 256 * i + 4 * lane; if (l == DEPTH - 1) *(f32x4*)(p.out + rw[u] * Dm + k) = x[i]; else *(f32x4*)(p.X + rw[u] * Dm + k) = x[i]; }
            }
            if (l < DEPTH - 1) {
                ss = wave_sum(ss, lane);
                const float rstd = 1.0f / sqrtf(ss / Dm + EPSF);
#pragma unroll
                for (int i = 0; i < 4; ++i) {
                    const f32x4 y = x[i] * rstd * mulv[i] + addv[i];
                    *(u32x2*)(p.XN + rw[u] * Dm + 256 * i + 4 * lane) = (u32x2){pk2(y[0], y[1]), pk2(y[2], y[3])};
                }
            }
        }
    }
}

template <int DQK, int DV>
struct AttnCfg {
    static constexpr int KP = DQK * 2 + 16, VP = 144;
    static constexpr int KCH = DQK / 8;
    static constexpr int NK = 64 * KCH, NV = DV * 8, NCH = NK + NV, NLD = (NCH + NTHR - 1) / NTHR;
    static constexpr int LDS_K = 0, LDS_V = 64 * KP, LDS_END = LDS_V + DV * VP;
    static_assert(LDS_END <= GT_END, "attention tile exceeds the LDS budget");
};

template <int DQK, int DV>
DI void attn_block(unsigned char* smem, const act_t* Qb, const act_t* Kb, const act_t* Vt, const int nk, const int q0, f32x16 (&ot)[DV / 32], float& lsum) {
    typedef AttnCfg<DQK, DV> C;
    const int tid = opaque_tid(), lane = tid & 63, w = tid >> 6, h = lane >> 5, qr = lane & 31;
    const int pi = (qr & ~12) | ((qr & 4) << 1) | ((qr & 8) >> 1);
    bf16x8 qf[DQK / 16];
#pragma unroll
    for (int st = 0; st < DQK / 16; ++st) qf[st] = *(const bf16x8*)(Qb + (size_t)(q0 + w * 32 + qr) * DQK + st * 16 + h * 8);
    float m = -1e30f; lsum = 0.f;
#pragma unroll
    for (int db = 0; db < DV / 32; ++db)
#pragma unroll
        for (int r = 0; r < 16; ++r) ot[db][r] = 0.f;
    int goff[C::NLD], ldst[C::NLD];
#pragma unroll
    for (int i = 0; i < C::NLD; ++i) {
        const int c = tid + NTHR * i;
        if (c < C::NK) { const int row = c / C::KCH, part = c % C::KCH; goff[i] = (row * DQK + part * 8) * 2; ldst[i] = C::LDS_K + row * C::KP + part * 16; }
        else { const int cc = (c - C::NK) < C::NV ? c - C::NK : 0, row = cc >> 3, part = cc & 7; goff[i] = (int)((const char*)Vt - (const char*)Kb) + (row * Sn + part * 8) * 2; ldst[i] = C::LDS_V + row * C::VP + part * 16; }
    }
    u32x4 rg[C::NLD];
#pragma unroll
    for (int i = 0; i < C::NLD; ++i) rg[i] = *(const u32x4*)((const char*)Kb + goff[i]);
    const int ntiles = nk >> 6;
    for (int kt = 0; kt < ntiles; ++kt) {
        __syncthreads();
#pragma unroll
        for (int i = 0; i < C::NLD; ++i) if (tid + NTHR * i < C::NCH) *(u32x4*)(smem + ldst[i]) = rg[i];
        __syncthreads();
        if (kt + 1 < ntiles) {
#pragma unroll
            for (int i = 0; i < C::NLD; ++i) rg[i] = *(const u32x4*)((const char*)Kb + goff[i] + (kt + 1) * ((tid + NTHR * i < C::NK) ? 128 * DQK : 128));
        }
        f32x16 sc[2];
        __builtin_amdgcn_s_setprio(1);
#pragma unroll
        for (int kb = 0; kb < 2; ++kb) {
#pragma unroll
            for (int r = 0; r < 16; ++r) sc[kb][r] = 0.f;
#pragma unroll
            for (int st = 0; st < DQK / 16; ++st) {
                const bf16x8 a = *(const bf16x8*)(smem + C::LDS_K + (kb * 32 + pi) * C::KP + st * 32 + h * 16);
                sc[kb] = __builtin_amdgcn_mfma_f32_32x32x16_bf16(a, qf[st], sc[kb], 0, 0, 0);
            }
        }
        __builtin_amdgcn_s_setprio(0);
        float mx = sc[0][0];
#pragma unroll
        for (int kb = 0; kb < 2; ++kb)
#pragma unroll
            for (int r = 0; r < 16; ++r) mx = fmaxf(mx, sc[kb][r]);
        mx = fmaxf(mx, shfl_x(mx, 32, lane));
        const float mn = fmaxf(m, mx), alpha = __builtin_amdgcn_exp2f(m - mn);
        m = mn;
        float ps = 0.f;
#pragma unroll
        for (int kb = 0; kb < 2; ++kb)
#pragma unroll
            for (int r = 0; r < 16; ++r) { sc[kb][r] = __builtin_amdgcn_exp2f(sc[kb][r] - mn); ps += sc[kb][r]; }
        lsum = lsum * alpha + ps;
#pragma unroll
        for (int db = 0; db < DV / 32; ++db)
#pragma unroll
            for (int r = 0; r < 16; ++r) ot[db][r] *= alpha;
#pragma unroll
        for (int kb = 0; kb < 2; ++kb)
#pragma unroll
            for (int s2 = 0; s2 < 2; ++s2) {
                const u32x4 pw = {pk2(sc[kb][8 * s2], sc[kb][8 * s2 + 1]), pk2(sc[kb][8 * s2 + 2], sc[kb][8 * s2 + 3]), pk2(sc[kb][8 * s2 + 4], sc[kb][8 * s2 + 5]), pk2(sc[kb][8 * s2 + 6], sc[kb][8 * s2 + 7])};
                const bf16x8 pf = __builtin_bit_cast(bf16x8, pw);
#pragma unroll
                for (int db = 0; db < DV / 32; ++db) {
                    const bf16x8 a = *(const bf16x8*)(smem + C::LDS_V + (db * 32 + qr) * C::VP + (kb * 32 + 16 * s2 + 8 * h) * 2);
                    ot[db] = __builtin_amdgcn_mfma_f32_32x32x16_bf16(a, pf, ot[db], 0, 0, 0);
                }
            }
    }
    lsum += shfl_x(lsum, 32, lane);
}

DI void bp_attn(const Params& p, int l, bool upd, unsigned char* smem, int bid, int G) {
    constexpr int QTL = Tn / 128, QTC = Cn / 128;
    const int n_dl = Bn * 4 * QTL, n_gl = Bn * 6 * QTL, n_dc = upd ? Bn * 4 * QTC : 0, n_gc = upd ? Bn * 6 * QTC : 0;
    const int tid = opaque_tid(), lane = tid & 63, w = tid >> 6, hh = lane >> 5, qr = lane & 31;
    const float lam_init = lam_init_of(l);
    for (int it = bid; it < n_dl + n_gl + n_dc + n_gc; it += G) {
        int x = it; bool isdiff, isc;
        if (x < n_dl) { isdiff = true; isc = false; }
        else if ((x -= n_dl) < n_gl) { isdiff = false; isc = false; }
        else if ((x -= n_gl) < n_dc) { isdiff = true; isc = true; }
        else { x -= n_dc; isdiff = false; isc = true; }
        const int qt_n = isc ? QTC : QTL, qlen = isc ? Cn : Tn, nk = isc ? Cn : Sn;
        const int qt = x % qt_n, hb = x / qt_n;
        const int q0 = qt * 128;
        if (isdiff) {
            const int h = hb % 4, b = hb / 4;
            const act_t* Vt = p.DVt + (size_t)(b * 4 + h) * 96 * Sn;
            f32x16 ot[3]; float ls;
            f32x4* stash = (f32x4*)(p.DO + ((size_t)blockIdx.x * NTHR + tid) * 48);
            attn_block<48, 96>(smem, (isc ? p.DQC : p.DQL) + ((size_t)(b * 4 + h) * 2) * qlen * 48, p.DK + ((size_t)(b * 4 + h) * 2) * Sn * 48, Vt, nk, q0, ot, ls);
            {
                const float i1 = 1.0f / ls;
#pragma unroll
                for (int db = 0; db < 3; ++db)
#pragma unroll
                    for (int g = 0; g < 4; ++g) stash[db * 4 + g] = (f32x4){ot[db][4 * g] * i1, ot[db][4 * g + 1] * i1, ot[db][4 * g + 2] * i1, ot[db][4 * g + 3] * i1};
            }
            attn_block<48, 96>(smem, (isc ? p.DQC : p.DQL) + ((size_t)(b * 4 + h) * 2 + 1) * qlen * 48, p.DK + ((size_t)(b * 4 + h) * 2 + 1) * Sn * 48, Vt, nk, q0, ot, ls);
            const float* dl = p.diff_lambda + l * 4 * 48;
            float s01 = 0.f, s23 = 0.f;
            for (int i = 0; i < 48; ++i) { s01 += dl[i] * dl[48 + i]; s23 += dl[96 + i] * dl[144 + i]; }
            const float lam = expf(s01) - expf(s23) + lam_init;
            const float i2 = lam / ls;
            float ss = 0.f;
#pragma unroll
            for (int db = 0; db < 3; ++db)
#pragma unroll
                for (int g = 0; g < 4; ++g) {
                    const f32x4 o1 = stash[db * 4 + g];
#pragma unroll
                    for (int r = 0; r < 4; ++r) { const float v = o1[r] - ot[db][4 * g + r] * i2; ot[db][4 * g + r] = v; ss += v * v; }
                }
            ss += shfl_x(ss, 32, lane);
            const float rstd = 1.0f / sqrtf(ss / 96 + EPSF) * (1.0f - lam_init);
            const float* sg = p.diff_subln + l * 96;
            const size_t tok = isc ? (size_t)NL + b * Cn + q0 + w * 32 + qr : (size_t)b * Tn + q0 + w * 32 + qr;
#pragma unroll
            for (int db = 0; db < 3; ++db)
#pragma unroll
                for (int g = 0; g < 4; ++g) {
                    const int dv = db * 32 + 8 * g + 4 * hh;
                    const f32x4 sv = *(const f32x4*)(sg + dv);
                    *(u32x2*)(p.MIX + tok * Dm + h * 96 + dv) = (u32x2){pk2(ot[db][4 * g] * rstd * sv[0], ot[db][4 * g + 1] * rstd * sv[1]),
                                                                      pk2(ot[db][4 * g + 2] * rstd * sv[2], ot[db][4 * g + 3] * rstd * sv[3])};
                }
        } else {
            const int hq = hb % 6, b = hb / 6, kv = hq / 3;
            f32x16 ot[2]; float ls;
            attn_block<64, 64>(smem, (isc ? p.GQC : p.GQL) + (size_t)(b * 6 + hq) * qlen * 64, p.GK + (size_t)(b * 2 + kv) * Sn * 64, p.GVt + (size_t)(b * 2 + kv) * 64 * Sn, nk, q0, ot, ls);
            const float il = 1.0f / ls;
            const size_t tok = isc ? (size_t)NL + b * Cn + q0 + w * 32 + qr : (size_t)b * Tn + q0 + w * 32 + qr;
#pragma unroll
            for (int db = 0; db < 2; ++db)
#pragma unroll
                for (int g = 0; g < 4; ++g) {
                    const int dv = db * 32 + 8 * g + 4 * hh;
                    *(u32x2*)(p.MIX + tok * Dm + 384 + hq * 64 + dv) = (u32x2){pk2(ot[db][4 * g] * il, ot[db][4 * g + 1] * il), pk2(ot[db][4 * g + 2] * il, ot[db][4 * g + 3] * il)};
                }
        }
    }
}

DI void bp_mod(const Params& p, unsigned char* smem, int bid, int G, long gtid, long gsize) {
    const int tid = opaque_tid(), lane = tid & 63, w = tid >> 6;
    float* sl = (float*)smem;
    float* red = sl + (Bn + 1) * Dm;
    for (int i = tid; i < (Bn + 1) * Dm; i += NTHR) sl[i] = silu_f(i < Bn * Dm ? p.c[i] : p.c_ctx[i - Bn * Dm]);
    __syncthreads();
    const int ks = tid >> 4, j4 = tid & 15;
    for (int item = bid; item < DEPTH * (MODW / 64); item += G) {
        const int l = item / (MODW / 64), col = (item % (MODW / 64)) * 64 + j4 * 4;
        const float* wp = p.w_mod + ((size_t)l * Dm + ks * 64) * MODW + col;
        f32x4 acc[Bn + 1];
#pragma unroll
        for (int r = 0; r <= Bn; ++r) acc[r] = (f32x4){0.f, 0.f, 0.f, 0.f};
#pragma unroll 8
        for (int kk = 0; kk < 64; ++kk) {
            const f32x4 wv = *(const f32x4*)(wp + (size_t)kk * MODW);
#pragma unroll
            for (int r = 0; r <= Bn; ++r) acc[r] = acc[r] + sl[r * Dm + ks * 64 + kk] * wv;
        }
#pragma unroll
        for (int r = 0; r <= Bn; ++r)
#pragma unroll
            for (int e = 0; e < 4; ++e) { float v = acc[r][e]; v += shfl_x(v, 16, lane); v += shfl_x(v, 32, lane); acc[r][e] = v; }
        __syncthreads();
        if (lane < 16)
#pragma unroll
            for (int r = 0; r <= Bn; ++r) *(f32x4*)(red + ((w * 16 + lane) * (Bn + 1) + r) * 4) = acc[r];
        __syncthreads();
        if (tid < 16 * (Bn + 1)) {
            const int jj = tid & 15, r = tid >> 4;
            f32x4 t = *(const f32x4*)(p.b_mod + l * MODW + (item % (MODW / 64)) * 64 + jj * 4);
#pragma unroll
            for (int ww = 0; ww < 4; ++ww) t = t + *(const f32x4*)(red + ((ww * 16 + jj) * (Bn + 1) + r) * 4);
            *(f32x4*)(p.mod + ((size_t)l * (Bn + 1) + r) * MODW + (item % (MODW / 64)) * 64 + jj * 4) = t;
        }
    }
    (void)gtid; (void)gsize;
}

DI size_t chunk_slot(int b, int h, int dir, int cid) { return (size_t)((b * 4 + h) * 2 + dir) * NCH + cid; }
DI float wave_incl_scan_add(float v, int lane, bool rev) {
#pragma unroll
    for (int o = 1; o < 64; o <<= 1) { const float t = shfl_i(v, (rev ? lane + o : lane - o) & 63); const bool ok = rev ? (lane + o < 64) : (lane >= o); if (ok) v += t; }
    return v;
}
DI float wave_incl_scan_max(float v, int lane, bool rev) {
#pragma unroll
    for (int o = 1; o < 64; o <<= 1) { const float t = shfl_i(v, (rev ? lane + o : lane - o) & 63); const bool ok = rev ? (lane + o < 64) : (lane >= o); if (ok) v = fmaxf(v, t); }
    return v;
}
DI void bp_post(const Params& p, int l, unsigned char* smem, int bid, int G) {
    const int tid = opaque_tid(), lane = tid & 63, w = tid >> 6;
    constexpr int NGRP = NTOK / 64, N_M = NGRP * 4, N_V = NGRP * 4, N_Q = NTOK / 16;
    volatile int* s_item = (volatile int*)(smem + SM_AUX + 512);
    unsigned* ctr = p.BAR + 3700 + l;
    (void)bid; (void)G;
    for (;;) {
        __syncthreads();
        if (threadIdx.x == 0) *s_item = (int)atomicAdd(ctr, 1u);
        __syncthreads();
        const int item = *s_item;
        if (item >= N_M + N_V + N_Q) break;
        if (item >= N_M + N_V) {
            const int tokb = (item - N_M - N_V) * 16 + w * 4;
            const int j = lane & 15, ug = lane >> 4, third = j / 3;
            f32x4 gvv[6];
#pragma unroll
            for (int st = 0; st < 6; ++st) {
                const int u = st * 4 + ug; const bool d64 = st >= 4;
                const float* gw = !d64 ? ((u >= 8 ? p.diff_k_norm : p.diff_q_norm) + l * 48) : ((u >= 22 ? p.gqa_k_norm : p.gqa_q_norm) + l * 64);
                gvv[st] = (d64 || j < 12) ? *(const f32x4*)(gw + 4 * j) : (f32x4){0.f, 0.f, 0.f, 0.f};
            }
#pragma unroll 2
            for (int t4 = 0; t4 < 4; ++t4) {
                const int tok = tokb + t4; const bool isc = tok >= NL;
                const int b = tok_b(tok), ti = tok_i(tok), sx = tok_s(tok);
                const act_t* pr = p.PROJB + (size_t)tok * INW;
                f32x4 xs[6], t0s[6], t1s[6];
#pragma unroll
                for (int st = 0; st < 6; ++st) {
                    const int u = st * 4 + ug; const bool d64 = st >= 4;
                    const int soff = !d64 ? ((u >= 8 ? DK_OFF : DQ_OFF) + ((u & 7) >> 1) * 96 + (u & 1) * 48) : (u >= 22 ? GK_OFF + (u - 22) * 64 : GQ_OFF + (u - 16) * 64);
                    const bool act = d64 || j < 12;
                    xs[st] = act ? ld4bf(pr + soff + 4 * j) : (f32x4){0.f, 0.f, 0.f, 0.f};
                    const bool second = d64 ? (j >= 8) : (j >= 6);
                    const int pos = second ? (ti & 63) : (ti >> 6);
                    const int fi0 = d64 ? 12 + (j & 3) * 4 : (j - third * 3) * 4;
                    const float* rt = p.ROPE + ((size_t)pos * 28 + (act ? fi0 : 0)) * 2;
                    t0s[st] = *(const f32x4*)rt; t1s[st] = *(const f32x4*)(rt + 4);
                }
#pragma unroll
                for (int st = 0; st < 6; ++st) {
                    const int u = st * 4 + ug; const bool d64 = st >= 4;
                    act_t* dst; float osc;
                    if (!d64) {
                        const bool isk = u >= 8; const int hh = (u & 7) >> 1, ww = u & 1;
                        osc = isk ? 1.0f : 0.14433756729740643f * LOG2E;
                        dst = isk ? p.DK + (((size_t)(b * 4 + hh) * 2 + ww) * Sn + sx) * 48
                                  : (isc ? p.DQC + (((size_t)(b * 4 + hh) * 2 + ww) * Cn + ti) * 48 : p.DQL + (((size_t)(b * 4 + hh) * 2 + ww) * Tn + ti) * 48);
                    } else {
                        const bool isk = u >= 22; const int hh = isk ? u - 22 : u - 16;
                        osc = isk ? 1.0f : 0.125f * LOG2E;
                        dst = isk ? p.GK + ((size_t)(b * 2 + hh) * Sn + sx) * 64 : (isc ? p.GQC + ((size_t)(b * 6 + hh) * Cn + ti) * 64 : p.GQL + ((size_t)(b * 6 + hh) * Tn + ti) * 64);
                    }
                    const bool act = d64 || j < 12;
                    const f32x4 x = xs[st];
                    const float ss = row16_sum(x[0] * x[0] + x[1] * x[1] + x[2] * x[2] + x[3] * x[3]);
                    const float rstd = 1.0f / sqrtf(ss / (d64 ? 64.f : 48.f) + EPSF);
                    f32x4 y = x * rstd * gvv[st];
                    if (!isc) {
                        const int plane = d64 ? (lane ^ 4) : ((third & 1) ? lane - 3 : lane + 3);
                        f32x4 py;
#pragma unroll
                        for (int r = 0; r < 4; ++r) py[r] = shfl_i(y[r], plane);
                        const bool isx2 = d64 ? ((j & 4) != 0) : ((third & 1) != 0);
                        const f32x4 t0 = t0s[st], t1 = t1s[st];
                        const f32x4 cs = {t0[0], t0[2], t1[0], t1[2]}, sn = {t0[1], t0[3], t1[1], t1[3]};
                        y = isx2 ? y * cs + py * sn : y * cs - py * sn;
                    }
                    y = y * osc;
                    if (act) *(u32x2*)(dst + 4 * j) = (u32x2){pk2(y[0], y[1]), pk2(y[2], y[3])};
                }
            }
        } else if (item >= N_M) {
            const int g = (item - N_M) >> 2, qd = (item - N_M) & 3;
            const int tok0 = g * 64;
            const int b = tok_b(tok0), s0 = tok_s(tok0);
            __syncthreads();
#pragma unroll
            for (int i = 0; i < 8; ++i) {
                const int c = tid + NTHR * i, tt = c >> 5, d4 = c & 31, vd = qd * 128 + d4 * 4;
                *(u32x2*)(smem + tt * 264 + d4 * 8) = *(const u32x2*)(p.PROJB + (size_t)(tok0 + tt) * INW + (vd < 384 ? DV_OFF + vd : GV_OFF + vd - 384));
            }
            __syncthreads();
#pragma unroll
            for (int i = 0; i < 4; ++i) {
                const int o = tid + NTHR * i, dloc = o >> 3, t8 = o & 7, vd = qd * 128 + dloc;
                unsigned e[8];
#pragma unroll
                for (int r = 0; r < 8; ++r) e[r] = *(const unsigned short*)(smem + (t8 * 8 + r) * 264 + dloc * 2);
                act_t* dst = vd < 384 ? p.DVt + ((size_t)(b * 4 + vd / 96) * 96 + vd % 96) * Sn : p.GVt + ((size_t)(b * 2 + (vd - 384) / 64) * 64 + (vd - 384) % 64) * Sn;
                *(u32x4*)(dst + s0 + t8 * 8) = (u32x4){e[0] | (e[1] << 16), e[2] | (e[3] << 16), e[4] | (e[5] << 16), e[6] | (e[7] << 16)};
            }
        } else {
            const int g = item >> 2, h = item & 3;
            const int tok0 = g * 64; const bool isc = tok0 >= NL;
            const int b = tok_b(tok0), ti0 = tok_i(tok0);
        float* kf = (float*)smem; float* vf = kf + 64 * 68; float* gl = vf + 64 * 68;
        const int cid = isc ? ti0 / 64 : NCC + ti0 / 64;
            __syncthreads();
            {
                const int tt = tid >> 2, c16 = tid & 3, ti = ti0 + tt, seglen = isc ? Cn : Tn;
                const act_t* pr = p.PROJB + (size_t)(tok0 + tt) * INW;
                const bool hasp = ti > 0, hasn = ti < seglen - 1;
                const float* cw = p.mlstm_conv_w + (size_t)l * 1536; const float* cb = p.mlstm_conv_b + l * 512;
#pragma unroll
                for (int part = 0; part < 2; ++part)
#pragma unroll
                    for (int i4 = 0; i4 < 4; ++i4) {
                        const int ch = part * 256 + h * 64 + c16 * 16 + i4 * 4;
                        f32x4 a = *(const f32x4*)(cb + ch) + ld4bf(pr + MQK_OFF + ch) * *(const f32x4*)(cw + 512 + ch);
                        if (hasp) a = a + ld4bf(pr - INW + MQK_OFF + ch) * *(const f32x4*)(cw + ch);
                        if (hasn) a = a + ld4bf(pr + INW + MQK_OFF + ch) * *(const f32x4*)(cw + 1024 + ch);
#pragma unroll
                        for (int r = 0; r < 4; ++r) a[r] = a[r] / (1.0f + __expf(-a[r]));
                        if (part) { a = a * 0.125f; *(f32x4*)(kf + tt * 68 + c16 * 16 + i4 * 4) = a; }
                        *(u32x2*)(p.MQKB + (size_t)(tok0 + tt) * 512 + ch) = (u32x2){pk2(a[0], a[1]), pk2(a[2], a[3])};
#if !IMPL_MLSTM
                        *(f32x4*)(p.MQK + (size_t)(tok0 + tt) * 512 + ch) = a;
#endif
                    }
#pragma unroll
                for (int i4 = 0; i4 < 4; ++i4) *(f32x4*)(vf + tt * 68 + c16 * 16 + i4 * 4) = ld4bf(pr + MV_OFF + h * 64 + c16 * 16 + i4 * 4);
            }
            if (tid < 64) {
                const float* pr = p.PG + (size_t)(tok0 + tid) * 16; const float* gb = p.mlstm_gate_b + l * 16;
                const f32x4 gt = {pr[h] + gb[h], logsigmoid_f(pr[4 + h] + gb[4 + h]), pr[8 + h] + gb[8 + h], logsigmoid_f(pr[12 + h] + gb[12 + h])};
                gl[tid] = gt[0]; gl[128 + tid] = gt[1]; gl[64 + tid] = gt[2]; gl[192 + tid] = gt[3];
                *(f32x4*)(p.MG4 + ((size_t)(tok0 + tid) * 4 + h) * 4) = gt;
#if !IMPL_MLSTM
                { float* mg = p.MGATE + (size_t)(tok0 + tid) * 16; mg[h] = gt[0]; mg[4 + h] = gt[1]; mg[8 + h] = gt[2]; mg[12 + h] = gt[3]; }
#endif
            }
            __syncthreads();
            if (w < 2) {
                const int dir = w;
                const float lf = gl[128 + dir * 64 + lane], li = gl[dir * 64 + lane];
                const float inc = wave_incl_scan_add(lf, lane, dir == 0);
                const float gg = inc - lf + li;
                float mloc = gg;
#pragma unroll
                for (int o = 32; o > 0; o >>= 1) mloc = fmaxf(mloc, shfl_x(mloc, o, lane));
                gl[256 + dir * 64 + lane] = __expf(gg - mloc);
                const float E = wave_sum(lf, lane);
                if (lane == 0) { float* cs = p.CHS + chunk_slot(b, h, dir, cid) * 2; cs[0] = mloc; cs[1] = E; }
            }
            __syncthreads();
            {
                const int v0 = (tid >> 4) * 4, d0 = (tid & 15) * 4;
                f32x4 a0[4], a1[4];
#pragma unroll
                for (int i = 0; i < 4; ++i) { a0[i] = (f32x4){0.f, 0.f, 0.f, 0.f}; a1[i] = (f32x4){0.f, 0.f, 0.f, 0.f}; }
                for (int sx = 0; sx < 64; ++sx) {
                    const f32x4 vv = *(const f32x4*)(vf + sx * 68 + v0), kk = *(const f32x4*)(kf + sx * 68 + d0);
                    const float w0 = gl[256 + sx], w1 = gl[320 + sx];
#pragma unroll
                    for (int i = 0; i < 4; ++i) { a0[i] = a0[i] + (w0 * vv[i]) * kk; a1[i] = a1[i] + (w1 * vv[i]) * kk; }
                }
                act_t* kv0 = (act_t*)p.KV + chunk_slot(b, h, 0, cid) * 4096; act_t* kv1 = (act_t*)p.KV + chunk_slot(b, h, 1, cid) * 4096;
#pragma unroll
                for (int i = 0; i < 4; ++i) {
                    *(u32x2*)(kv0 + (v0 + i) * 64 + d0) = (u32x2){pk2(a0[i][0], a0[i][1]), pk2(a0[i][2], a0[i][3])};
                    *(u32x2*)(kv1 + (v0 + i) * 64 + d0) = (u32x2){pk2(a1[i][0], a1[i][1]), pk2(a1[i][2], a1[i][3])};
                }
                if (tid < 128) {
                    const int dir = tid >> 6, d = tid & 63;
                    float acc = 0.f;
                    for (int sx = 0; sx < 64; ++sx) acc += gl[256 + dir * 64 + sx] * kf[sx * 68 + d];
                    p.NLC[chunk_slot(b, h, dir, cid) * 64 + d] = acc;
                }
            }
        }
    }
}

constexpr int ML_Q = 0, ML_K = 9216, ML_VT = 18432, ML_C = 29952, ML_QA = 41472, ML_SC = 50688;
constexpr int SC_LI = 0, SC_LF = 128, SC_BB = 256, SC_MT = 384, SC_AA = 512, SC_UU = 640, SC_WCH = 768;
static_assert(ML_SC + (SC_WCH + 80) * 4 <= SMEM_BYTES - 16, "mLSTM LDS layout exceeds the budget");
DI int ml_scanpos(int dir, int cid) { return dir == 0 ? cid : (cid < NCC ? NCC - 1 - cid : NCC + (NCH - 1 - cid)); }
DI int ml_cid_at(int dir, int i) { return dir == 0 ? i : (i < NCC ? NCC - 1 - i : NCH - 1 - (i - NCC)); }
DI void bp_mlstm(const Params& p, int l, bool upd, unsigned char* smem, int bid, int G) {
    const int tid = opaque_tid(), lane = tid & 63, w = tid >> 6;
    float* sc = (float*)(smem + ML_SC);
    constexpr int CPL = Tn / 64;
    const int nlat = Bn * 4 * CPL, nctx = upd ? Bn * 4 * NCC : 0;
    for (int it = bid; it < nlat + nctx; it += G) {
        int b, h, cid;
        if (it < nlat) { cid = NCC + it % CPL; h = (it / CPL) % 4; b = it / (CPL * 4); }
        else { const int x = it - nlat; cid = x % NCC; h = (x / NCC) % 4; b = x / (NCC * 4); }
        const int tok0 = cid < NCC ? NL + b * Cn + cid * 64 : b * Tn + (cid - NCC) * 64;
        __syncthreads();
#pragma unroll
        for (int i = 0; i < 4; ++i) {
            const int c = tid + NTHR * i, isk = c >> 9, cc = c & 511, row = cc >> 3, part = cc & 7;
            *(u32x4*)(smem + (isk ? ML_K : ML_Q) + row * 144 + part * 16) = *(const u32x4*)(p.MQKB + (size_t)(tok0 + row) * 512 + isk * 256 + h * 64 + part * 8);
        }
#pragma unroll
        for (int i = 0; i < 2; ++i) {
            const int c = tid + NTHR * i, tt = c >> 3, v8 = c & 7;
            const u32x4 vv = *(const u32x4*)(p.PROJB + (size_t)(tok0 + tt) * INW + MV_OFF + h * 64 + v8 * 8);
            const unsigned pa = vv[0], pb = vv[1], pc = vv[2], pd = vv[3];
            unsigned char* d0 = smem + ML_VT + (v8 * 8) * 144 + tt * 2;
            *(unsigned short*)(d0) = (unsigned short)pa; *(unsigned short*)(d0 + 144) = (unsigned short)(pa >> 16);
            *(unsigned short*)(d0 + 288) = (unsigned short)pb; *(unsigned short*)(d0 + 432) = (unsigned short)(pb >> 16);
            *(unsigned short*)(d0 + 576) = (unsigned short)pc; *(unsigned short*)(d0 + 720) = (unsigned short)(pc >> 16);
            *(unsigned short*)(d0 + 864) = (unsigned short)pd; *(unsigned short*)(d0 + 1008) = (unsigned short)(pd >> 16);
        }
        if (tid < 144) {
            unsigned zz = 0u; asm volatile("" : "+v"(zz));
            const unsigned one2 = tid < 9 ? 0x3F803F80u : zz;
            *(u32x4*)(smem + ML_VT + 64 * 144 + tid * 16) = (u32x4){one2, one2, one2, one2};
            *(u32x4*)(smem + ML_C + 64 * 144 + tid * 16) = (u32x4){zz, zz, zz, zz};
        }
        if (tid < 64) {
            const f32x4 gt = *(const f32x4*)(p.MG4 + ((size_t)(tok0 + tid) * 4 + h) * 4);
            sc[SC_LI + tid] = gt[0]; sc[SC_LF + tid] = gt[1]; sc[SC_LI + 64 + tid] = gt[2]; sc[SC_LF + 64 + tid] = gt[3];
        }
        __syncthreads();
        if (w < 2) {
            const int dir = w, pj = ml_scanpos(dir, cid);
            const float lf = sc[SC_LF + dir * 64 + lane], li = sc[SC_LI + dir * 64 + lane];
            const float bsum = wave_incl_scan_add(lf, lane, dir == 1);
            const float u = li - bsum;
            const float cm = wave_incl_scan_max(u, lane, dir == 1);
            float m = 0.f;
            for (int i = 0; i < pj; ++i) { const float* cs = p.CHS + chunk_slot(b, h, dir, ml_cid_at(dir, i)) * 2; m = fmaxf(cs[1] + m, cs[0]); }
            float F = 0.f;
            for (int i = pj - 1; i >= 0; --i) { const float* cs = p.CHS + chunk_slot(b, h, dir, ml_cid_at(dir, i)) * 2; if (lane == 0) sc[SC_WCH + dir * 40 + i] = __expf(cs[0] + F - m); F += cs[1]; }
            const float mt = bsum + fmaxf(m, cm);
            sc[SC_BB + dir * 64 + lane] = bsum; sc[SC_UU + dir * 64 + lane] = u; sc[SC_MT + dir * 64 + lane] = mt; sc[SC_AA + dir * 64 + lane] = __expf(bsum + m - mt);
        }
        f32x4 sacc[4];
#pragma unroll
        for (int si = 0; si < 4; ++si) sacc[si] = (f32x4){0.f, 0.f, 0.f, 0.f};
#pragma unroll
        for (int ks = 0; ks < 2; ++ks) {
            const bf16x8 bq = *(const bf16x8*)(smem + ML_Q + (16 * w + (lane & 15)) * 144 + ks * 64 + (lane >> 4) * 16);
#pragma unroll
            for (int si = 0; si < 4; ++si) {
                const bf16x8 ak = *(const bf16x8*)(smem + ML_K + (si * 16 + (lane & 15)) * 144 + ks * 64 + (lane >> 4) * 16);
                sacc[si] = __builtin_amdgcn_mfma_f32_16x16x32_bf16(ak, bq, sacc[si], 0, 0, 0);
            }
        }
        __syncthreads();
        f32x4 hs[4];
#pragma unroll
        for (int vt = 0; vt < 4; ++vt) hs[vt] = (f32x4){0.f, 0.f, 0.f, 0.f};
        const int pcol = 16 * w + (lane & 15);
#pragma unroll 1
        for (int dir = 0; dir < 2; ++dir) {
            {
                const int pj = ml_scanpos(dir, cid);
                f32x4 ca[4]; float na = 0.f;
#pragma unroll
                for (int q4 = 0; q4 < 4; ++q4) ca[q4] = (f32x4){0.f, 0.f, 0.f, 0.f};
                for (int i0 = 0; i0 < pj; i0 += 4) {
                    f32x4 kvv[4][4]; float nv[4], wgs[4];
#pragma unroll
                    for (int u = 0; u < 4; ++u) {
                        const int i = i0 + u < pj ? i0 + u : pj - 1;
                        wgs[u] = i0 + u < pj ? sc[SC_WCH + dir * 40 + i] : 0.f;
                        const size_t slot = chunk_slot(b, h, dir, ml_cid_at(dir, i));
                        const act_t* kv = (const act_t*)p.KV + slot * 4096;
#pragma unroll
                        for (int q4 = 0; q4 < 4; ++q4) kvv[u][q4] = ld4bf(kv + (tid + NTHR * q4) * 4);
                        nv[u] = tid < 64 ? p.NLC[slot * 64 + tid] : 0.f;
                    }
#pragma unroll
                    for (int u = 0; u < 4; ++u) {
#pragma unroll
                        for (int q4 = 0; q4 < 4; ++q4) ca[q4] = ca[q4] + wgs[u] * kvv[u][q4];
                        na += wgs[u] * nv[u];
                    }
                }
#pragma unroll
                for (int q4 = 0; q4 < 4; ++q4) { const int idx = (tid + NTHR * q4) * 4; *(u32x2*)(smem + ML_C + (idx >> 6) * 144 + (idx & 63) * 2) = (u32x2){pk2(ca[q4][0], ca[q4][1]), pk2(ca[q4][2], ca[q4][3])}; }
                if (tid < 64) *(unsigned short*)(smem + ML_C + 64 * 144 + tid * 2) = (unsigned short)pk2(na, 0.f);
            }
            {
                const float mtp = sc[SC_MT + dir * 64 + pcol], bp = sc[SC_BB + dir * 64 + pcol];
#pragma unroll
                for (int si = 0; si < 4; ++si) {
                    const int sb = si * 16 + (lane >> 4) * 4;
                    const f32x4 uu = *(const f32x4*)(sc + SC_UU + dir * 64 + sb);
                    float wv[4];
#pragma unroll
                    for (int r = 0; r < 4; ++r) { const int sx = sb + r; const bool valid = dir == 0 ? (sx <= pcol) : (sx >= pcol); wv[r] = valid ? __expf(bp + uu[r] - mtp) * sacc[si][r] : 0.f; }
                    *(u32x2*)(smem + ML_K + pcol * 144 + sb * 2) = (u32x2){pk2(wv[0], wv[1]), pk2(wv[2], wv[3])};
                }
                const int row = tid >> 2, c16 = tid & 3;
                const float ar = sc[SC_AA + dir * 64 + row];
#pragma unroll
                for (int i2 = 0; i2 < 2; ++i2) {
                    const u32x4 qv = *(const u32x4*)(smem + ML_Q + row * 144 + c16 * 32 + i2 * 16);
                    u32x4 o;
#pragma unroll
                    for (int r = 0; r < 4; ++r) o[r] = pk2(bflo(qv[r]) * ar, bfhi(qv[r]) * ar);
                    *(u32x4*)(smem + ML_QA + row * 144 + c16 * 32 + i2 * 16) = o;
                }
            }
            __syncthreads();
            f32x4 na5[5];
#pragma unroll
            for (int vt = 0; vt < 5; ++vt) na5[vt] = (f32x4){0.f, 0.f, 0.f, 0.f};
#pragma unroll
            for (int ks = 0; ks < 4; ++ks) {
                const bf16x8 bfrag = *(const bf16x8*)(smem + (ks < 2 ? ML_K : ML_QA) + pcol * 144 + (ks & 1) * 64 + (lane >> 4) * 16);
#pragma unroll
                for (int vt = 0; vt < 5; ++vt) {
                    const bf16x8 afrag = *(const bf16x8*)(smem + (ks < 2 ? ML_VT : ML_C) + (vt * 16 + (lane & 15)) * 144 + (ks & 1) * 64 + (lane >> 4) * 16);
                    na5[vt] = __builtin_amdgcn_mfma_f32_16x16x32_bf16(afrag, bfrag, na5[vt], 0, 0, 0);
                }
            }
            const float den = shfl_i(na5[4][0], lane & 15);
            const float dn = 1.0f / fmaxf(fabsf(den), __expf(-sc[SC_MT + dir * 64 + pcol]));
#pragma unroll
            for (int vt = 0; vt < 4; ++vt) hs[vt] = hs[vt] + na5[vt] * dn;
            __syncthreads();
        }
        float ss = 0.f;
#pragma unroll
        for (int vt = 0; vt < 4; ++vt) ss += hs[vt][0] * hs[vt][0] + hs[vt][1] * hs[vt][1] + hs[vt][2] * hs[vt][2] + hs[vt][3] * hs[vt][3];
        ss += shfl_x(ss, 16, lane); ss += shfl_x(ss, 32, lane);
        const float rstd = 1.0f / sqrtf(ss / 64 + EPSF);
        const size_t tok = (size_t)tok0 + pcol;
#pragma unroll
        for (int vt = 0; vt < 4; ++vt) {
            const int v = vt * 16 + (lane >> 4) * 4;
            const f32x4 hn = *(const f32x4*)(p.mlstm_head_norm + l * 256 + h * 64 + v), og = ld4bf(p.PROJB + tok * INW + MO_OFF + h * 64 + v);
            float o[4];
#pragma unroll
            for (int r = 0; r < 4; ++r) o[r] = hs[vt][r] * rstd * hn[r] / (1.0f + __expf(-og[r]));
            *(u32x2*)(p.MIX + tok * Dm + 768 + h * 64 + v) = (u32x2){pk2(o[0], o[1]), pk2(o[2], o[3])};
        }
    }
}

template <bool DRY>
DI void bp_route_fast(const Params& p, int l, bool upd, unsigned char* smem, int bid, int G) {
    const int tid = opaque_tid(), lane = tid & 63, w = tid >> 6;
    const int rows = upd ? NTOK : NL;
    float* Wl = (float*)smem;
    const float* g = p.norm2_g + l * Dm;
    const float* wgp = p.moe_wg + (size_t)l * Dm * 4; const float* wep = p.moe_we + (size_t)l * Dm * 32;
    for (int item = bid; item < rows / 4; item += G) {
        const int r0 = item * 4 + w;
        float rstd[1], pacc[1][36];
#pragma unroll
        for (int rr = 0; rr < 1; ++rr) {
            const float* xr = p.X + (size_t)(r0 + rr) * Dm;
            float ss = 0.f;
#pragma unroll
            for (int j = 0; j < 16; ++j) { const float xv = xr[64 * j + lane]; ss += xv * xv; }
            ss = wave_sum(ss, lane);
            rstd[rr] = 1.0f / sqrtf(ss / Dm + EPSF);
#pragma unroll
            for (int c = 0; c < 36; ++c) pacc[rr][c] = 0.f;
        }
#pragma unroll 1
        for (int ch = 0; ch < 4; ++ch) {
            __syncthreads();
            {
                const int k = ch * 256 + tid;
                *(f32x4*)(Wl + tid * 36) = *(const f32x4*)(wgp + (size_t)k * 4);
#pragma unroll
                for (int q = 0; q < 8; ++q) *(f32x4*)(Wl + tid * 36 + 4 + q * 4) = *(const f32x4*)(wep + (size_t)k * 32 + q * 4);
            }
            __syncthreads();
#pragma unroll
            for (int j = 0; j < 4; ++j) {
                const int k = ch * 256 + 64 * j + lane;
                float f[1];
#pragma unroll
                for (int rr = 0; rr < 1; ++rr) {
                    const float* mr = mod_row(p, l, r0 + rr);
                    f[rr] = p.X[(size_t)(r0 + rr) * Dm + k] * rstd[rr] * g[k] * (1.0f + mr[4 * Dm + k]) + mr[3 * Dm + k];
                    p.F[(size_t)(r0 + rr) * Dm + k] = f2a(f[rr]);
                }
                const float* wr = Wl + (64 * j + lane) * 36;
#pragma unroll
                for (int q = 0; q < 9; ++q) {
                    const f32x4 wq = *(const f32x4*)(wr + q * 4);
#pragma unroll
                    for (int rr = 0; rr < 1; ++rr)
#pragma unroll
                        for (int r = 0; r < 4; ++r) pacc[rr][q * 4 + r] += f[rr] * wq[r];
                }
            }
        }
        __syncthreads();
        float* red = (float*)smem + w * (64 * 37);
#pragma unroll 1
        for (int rr = 0; rr < 1; ++rr) {
#pragma unroll
            for (int c = 0; c < 36; ++c) red[lane * 37 + c] = pacc[0][c];
            __syncthreads();
            float tot = 0.f;
            if (lane < 36) for (int q = 0; q < 64; ++q) tot += red[q * 37 + lane];
            __syncthreads();
            if (lane < 36) red[lane] = tot + (lane < 4 ? p.moe_bg[l * 4 + lane] : p.moe_be[l * 32 + lane - 4]);
            __syncthreads();
            float gmax = red[0]; int gi = 0;
#pragma unroll
            for (int j = 1; j < 4; ++j) { const float v = red[j]; if (v > gmax) { gmax = v; gi = j; } }
            float gsum = 0.f;
#pragma unroll
            for (int j = 0; j < 4; ++j) gsum += expf(red[j] - gmax);
            const float gtop = 1.0f / gsum;
            float e1 = -1e30f, e2 = -1e30f; int i1 = 0, i2 = 0;
#pragma unroll
            for (int j = 0; j < 8; ++j) { const float v = red[4 + gi * 8 + j]; if (v > e1) { e2 = e1; i2 = i1; e1 = v; i1 = j; } else if (v > e2) { e2 = v; i2 = j; } }
            const float g0 = 1.0f / (1.0f + expf(e2 - e1));
            if (lane == 0 && (!DRY || g0 == 123.456f)) {
                const int row = r0 + rr, ea = gi * 8 + i1, eb = gi * 8 + i2;
                p.EID[row * 2] = ea; p.EID[row * 2 + 1] = eb;
                p.GATE[row * 2] = g0 * gtop; p.GATE[row * 2 + 1] = (1.0f - g0) * gtop;
                const int pa = atomicAdd(&p.CNT[(l * 32 + ea) * 64], 1), pb = atomicAdd(&p.CNT[(l * 32 + eb) * 64], 1);
                p.LIST[(size_t)ea * NTOK + pa] = row; p.LIST[(size_t)eb * NTOK + pb] = row;
                p.POS[row * 2] = pa; p.POS[row * 2 + 1] = pb;
            }
            __syncthreads();
        }
    }
}

DI void mconv_item(const Params& p, int l, unsigned char* smem, int it) {
    const int tid = opaque_tid();
    float* T = (float*)smem;
    const int e = it / 24, r = it % 24, mat = r >> 3, q = r & 7;
    const int K = mat < 2 ? Dm : 512, N = mat < 2 ? 512 : Dm;
    const float *w1p = p.moe_w1, *w3p = p.moe_w3, *w2p = p.moe_w2;
    asm volatile("" : "+s"(w1p), "+s"(w3p), "+s"(w2p));
    const float* W = (mat == 0 ? w1p : mat == 1 ? w3p : w2p) + ((size_t)l * 32 + e) * Dm * 512;
    act_t* WT = mat < 2 ? p.W13T + ((size_t)(l & 1) * 32 * 1024 + (size_t)e * 1024 + mat * 512) * Dm : p.W2T + ((size_t)(l & 1) * 32 + e) * Dm * 512;
    const int ntile0 = mat < 2 ? q : 2 * q, nnt = mat < 2 ? 1 : 2, nkt = K / 64;
    const int k = tid >> 2, n16 = (tid & 3) * 16;
    const int n = tid >> 2, k16 = (tid & 3) * 16;
    f32x4 v[4];
#pragma unroll
    for (int i = 0; i < 4; ++i) v[i] = *(const f32x4*)(W + (size_t)k * N + ntile0 * 64 + n16 + i * 4);
    for (int tix = 0; tix < nnt * nkt; ++tix) {
        const int nt = ntile0 + tix / nkt, kt = tix % nkt;
        __syncthreads();
#pragma unroll
        for (int i = 0; i < 4; ++i) { T[k * 65 + n16 + i * 4] = v[i][0]; T[k * 65 + n16 + i * 4 + 1] = v[i][1]; T[k * 65 + n16 + i * 4 + 2] = v[i][2]; T[k * 65 + n16 + i * 4 + 3] = v[i][3]; }
        __syncthreads();
        if (tix + 1 < nnt * nkt) {
            const int nt2 = ntile0 + (tix + 1) / nkt, kt2 = (tix + 1) % nkt;
#pragma unroll
            for (int i = 0; i < 4; ++i) v[i] = *(const f32x4*)(W + (size_t)(kt2 * 64 + k) * N + nt2 * 64 + n16 + i * 4);
        }
        unsigned o[8];
#pragma unroll
        for (int i = 0; i < 8; ++i) o[i] = pk2(T[(k16 + 2 * i) * 65 + n], T[(k16 + 2 * i + 1) * 65 + n]);
        act_t* dst = WT + (size_t)(nt * 64 + n) * K + kt * 64 + k16;
        *(u32x4*)dst = (u32x4){o[0], o[1], o[2], o[3]}; *(u32x4*)(dst + 8) = (u32x4){o[4], o[5], o[6], o[7]};
    }
}

DI void mconv_drain(const Params& p, int l, unsigned char* smem, int max_items) {
    volatile int* s_item = (volatile int*)(smem + SM_AUX + 512);
    unsigned* ctr = p.BAR + 3600 + l;
    for (int n = 0; n < max_items; ++n) {
        __syncthreads();
        if (threadIdx.x == 0) *s_item = (int)atomicAdd(ctr, 1u);
        __syncthreads();
        const int it = *s_item;
        if (it >= 32 * 24) break;
        mconv_item(p, l, smem, it);
    }
}

DI void bp_mixer(const Params& p, int l, bool upd, unsigned char* smem) {
    constexpr int QTL = Tn / 128, QTC = Cn / 128, CPL = Tn / 64, BIG = 1 << 30;
    const int n_al = Bn * 4 * QTL + Bn * 6 * QTL, n_ac = upd ? Bn * 4 * QTC + Bn * 6 * QTC : 0;
    const int n_ml = Bn * 4 * CPL + (upd ? Bn * 4 * NCC : 0);
    const int total = n_al + n_ml + n_ac;
    volatile int* s_item = (volatile int*)(smem + SM_AUX + 512);
    unsigned* ctr = p.BAR + 3500 + l;
#define NEXT_ITEM() ({ __syncthreads(); if (threadIdx.x == 0) *s_item = (int)atomicAdd(ctr, 1u); __syncthreads(); (int)*s_item; })
    int it = NEXT_ITEM();
    while (it < n_al) { bp_attn(p, l, upd, smem, it, BIG); it = NEXT_ITEM(); }
    while (it < n_al + n_ml) { bp_mlstm(p, l, upd, smem, it - n_al, BIG); it = NEXT_ITEM(); }
    while (it < n_al + n_ml + n_ac) { bp_attn(p, l, upd, smem, it - n_ml, BIG); it = NEXT_ITEM(); }
    (void)total;
#undef NEXT_ITEM

}

constexpr int RT_LD = 272, RT_AH = 0, RT_AL = 64 * RT_LD, RT_BH = 128 * RT_LD, RT_BL = RT_BH + 48 * RT_LD, RT_END = RT_BL + 48 * RT_LD;
static_assert(RT_END <= 65536, "router tiles exceed the LDS budget");
DI void mconv_drain(const Params& p, int l, unsigned char* smem, int max_items);
DI void bp_route2(const Params& p, int l, bool upd, unsigned char* smem, int bid, int G) {
    const int tid = opaque_tid(), lane = tid & 63, w = tid >> 6;
    const int rows = upd ? NTOK : NL;
    const float* gn = p.norm2_g + l * Dm;
    for (int item = bid; item < rows / 64; item += G) {
        const int r0 = item * 64;
        {
            const float* mr = mod_row(p, l, r0);
            f32x4 mul[4], add[4];
#pragma unroll
            for (int i = 0; i < 4; ++i) {
                const int k = 256 * i + 4 * lane;
                mul[i] = *(const f32x4*)(gn + k) * (1.0f + *(const f32x4*)(mr + 4 * Dm + k)); add[i] = *(const f32x4*)(mr + 3 * Dm + k);
            }
#pragma unroll 1
            for (int i0 = 0; i0 < 16; i0 += 4) {
                f32x4 x[4][4];
#pragma unroll
                for (int rr = 0; rr < 4; ++rr)
#pragma unroll
                    for (int i = 0; i < 4; ++i) x[rr][i] = *(const f32x4*)(p.X + (size_t)(r0 + w * 16 + i0 + rr) * Dm + 256 * i + 4 * lane);
#pragma unroll
                for (int rr = 0; rr < 4; ++rr) {
                    const int row = r0 + w * 16 + i0 + rr;
                    float ss = 0.f;
#pragma unroll
                    for (int i = 0; i < 4; ++i) ss += x[rr][i][0] * x[rr][i][0] + x[rr][i][1] * x[rr][i][1] + x[rr][i][2] * x[rr][i][2] + x[rr][i][3] * x[rr][i][3];
                    ss = wave_sum(ss, lane);
                    const float rstd = 1.0f / sqrtf(ss / Dm + EPSF);
#pragma unroll
                    for (int i = 0; i < 4; ++i) {
                        const int k = 256 * i + 4 * lane;
                        const f32x4 y = x[rr][i] * rstd * mul[i] + add[i];
                        const unsigned h01 = pk2(y[0], y[1]), h23 = pk2(y[2], y[3]);
                        *(u32x2*)(p.F + (size_t)row * Dm + k) = (u32x2){h01, h23};
                        *(u32x2*)(p.FLO + (size_t)row * Dm + k) = (u32x2){pk2(y[0] - bflo(h01), y[1] - bfhi(h01)), pk2(y[2] - bflo(h23), y[3] - bfhi(h23))};
                    }
                }
            }
        }
        __threadfence_block();
        __syncthreads();
        f32x4 acc[3];
#pragma unroll
        for (int ni = 0; ni < 3; ++ni) acc[ni] = (f32x4){0.f, 0.f, 0.f, 0.f};
        const int s_r = tid >> 4, s_c = tid & 15;
        {
            const act_t* Ah = p.F + (size_t)(r0 + s_r) * Dm + s_c * 8;
            const act_t* Al = p.FLO + (size_t)(r0 + s_r) * Dm + s_c * 8;
            const act_t* Bh = p.WRHI + ((size_t)l * 36 + s_r) * Dm + s_c * 8;
            const act_t* Bl = p.WRLO + ((size_t)l * 36 + s_r) * Dm + s_c * 8;
            u32x4 rah[4], ral[4], rbh[3], rbl[3];
#define RT_LOAD(KOFF) { \
    _Pragma("unroll") for (int i = 0; i < 4; ++i) { rah[i] = *(const u32x4*)(Ah + (size_t)16 * i * Dm + (KOFF)); ral[i] = *(const u32x4*)(Al + (size_t)16 * i * Dm + (KOFF)); } \
    _Pragma("unroll") for (int i = 0; i < 3; ++i) { const bool ok = s_r + 16 * i < 36; \
        rbh[i] = ok ? *(const u32x4*)(Bh + (size_t)16 * i * Dm + (KOFF)) : (u32x4){0u, 0u, 0u, 0u}; rbl[i] = ok ? *(const u32x4*)(Bl + (size_t)16 * i * Dm + (KOFF)) : (u32x4){0u, 0u, 0u, 0u}; } }
            RT_LOAD(0)
#pragma unroll 1
            for (int k0 = 0; k0 < Dm; k0 += 128) {
                __syncthreads();
#pragma unroll
                for (int i = 0; i < 4; ++i) { *(u32x4*)(smem + RT_AH + (s_r + 16 * i) * RT_LD + s_c * 16) = rah[i]; *(u32x4*)(smem + RT_AL + (s_r + 16 * i) * RT_LD + s_c * 16) = ral[i]; }
#pragma unroll
                for (int i = 0; i < 3; ++i) { *(u32x4*)(smem + RT_BH + (s_r + 16 * i) * RT_LD + s_c * 16) = rbh[i]; *(u32x4*)(smem + RT_BL + (s_r + 16 * i) * RT_LD + s_c * 16) = rbl[i]; }
                __syncthreads();
                if (k0 + 128 < Dm) RT_LOAD(k0 + 128)
#pragma unroll
                for (int kk = 0; kk < 4; ++kk) {
                    const int fo = (lane & 15) * RT_LD + kk * 64 + (lane >> 4) * 16;
                    const bf16x8 ah = *(const bf16x8*)(smem + RT_AH + w * 16 * RT_LD + fo), al = *(const bf16x8*)(smem + RT_AL + w * 16 * RT_LD + fo);
#pragma unroll
                    for (int ni = 0; ni < 3; ++ni) {
                        const bf16x8 bh = *(const bf16x8*)(smem + RT_BH + ni * 16 * RT_LD + fo), bl = *(const bf16x8*)(smem + RT_BL + ni * 16 * RT_LD + fo);
                        acc[ni] = __builtin_amdgcn_mfma_f32_16x16x32_bf16(bh, ah, acc[ni], 0, 0, 0);
                        acc[ni] = __builtin_amdgcn_mfma_f32_16x16x32_bf16(bh, al, acc[ni], 0, 0, 0);
                        acc[ni] = __builtin_amdgcn_mfma_f32_16x16x32_bf16(bl, ah, acc[ni], 0, 0, 0);
                    }
                }
            }
#undef RT_LOAD
        }
        __syncthreads();
        float* lg = (float*)smem;
#pragma unroll
        for (int ni = 0; ni < 3; ++ni)
#pragma unroll
            for (int r = 0; r < 4; ++r) lg[(w * 16 + (lane & 15)) * 49 + ni * 16 + (lane >> 4) * 4 + r] = acc[ni][r];
        __syncthreads();
        int* hist = (int*)(smem + 16384);
        if (tid < 64) hist[tid] = 0;
        __syncthreads();
        int ea = 0, eb = 0, ra = 0, rb = 0;
        if (tid < 64) {
            const float* rl = lg + tid * 49;
            float ag[4];
            float gmax = -1e30f; int gi = 0;
#pragma unroll
            for (int j = 0; j < 4; ++j) { ag[j] = rl[j] + p.moe_bg[l * 4 + j]; if (ag[j] > gmax) { gmax = ag[j]; gi = j; } }
            float gsum = 0.f;
#pragma unroll
            for (int j = 0; j < 4; ++j) gsum += expf(ag[j] - gmax);
            const float gtop = 1.0f / gsum;
            float e1 = -1e30f, e2 = -1e30f; int i1 = 0, i2 = 0;
#pragma unroll
            for (int j = 0; j < 8; ++j) { const float v = rl[4 + gi * 8 + j] + p.moe_be[l * 32 + gi * 8 + j]; if (v > e1) { e2 = e1; i2 = i1; e1 = v; i1 = j; } else if (v > e2) { e2 = v; i2 = j; } }
            const float g0 = 1.0f / (1.0f + expf(e2 - e1));
            const int row = r0 + tid; ea = gi * 8 + i1; eb = gi * 8 + i2;
            p.EID[row * 2] = ea; p.EID[row * 2 + 1] = eb;
            p.GATE[row * 2] = g0 * gtop; p.GATE[row * 2 + 1] = (1.0f - g0) * gtop;
            ra = atomicAdd(&hist[ea], 1); rb = atomicAdd(&hist[eb], 1);
        }
        __syncthreads();
        if (tid < 32 && hist[tid] > 0) hist[32 + tid] = atomicAdd(&p.CNT[(l * 32 + tid) * 64], hist[tid]);
        __syncthreads();
        if (tid < 64) {
            const int row = r0 + tid, pa = hist[32 + ea] + ra, pb = hist[32 + eb] + rb;
            p.LIST[(size_t)ea * NTOK + pa] = row; p.LIST[(size_t)eb * NTOK + pb] = row;
            p.POS[row * 2] = pa; p.POS[row * 2 + 1] = pb;
        }
        __syncthreads();
    }
    mconv_drain(p, l, smem, 1 << 30);
}

constexpr int PPL = 9;
constexpr int NPH = 2 + PPL * DEPTH;
static inline bool phase_in_mega(int ph) {
    if (ph < 2) return true;
    const int s = (ph - 2) % PPL;
    return s == 1 ? IMPL_POST : s == 2 ? IMPL_ATTN : s == 3 ? IMPL_MLSTM : s == 5 ? IMPL_ROUTE : true;
}

#define XB_TMO      128
#define XB_XCNT(j)  (256  + 64 * (j))
#define XB_XSUB(j)  (1280 + 64 * (j))
#define XB_XGEN(j)  (2304 + 64 * (j))
#define XB_TOP      3328
#define XB_TOPGEN   3392
#define XCD_BAR_WORDS 3456
#define XB_SPIN_CAP (1u << 22)
#define LAS __attribute__((address_space(3)))
DI unsigned xb_ld(unsigned* p) { return __hip_atomic_load(p, __ATOMIC_RELAXED, __HIP_MEMORY_SCOPE_AGENT); }
DI unsigned xb_add(unsigned* p, unsigned v) { return __hip_atomic_fetch_add(p, v, __ATOMIC_RELAXED, __HIP_MEMORY_SCOPE_AGENT); }
DI unsigned xb_xcc_id() { return (unsigned)__builtin_amdgcn_s_getreg((3 << 11) | 20) & 0xFu; }
#define XB_SPIN(cond, bar) do { unsigned _sp = 0; while (cond) { __builtin_amdgcn_s_sleep(1); \
    if ((++_sp & 255u) == 0u) { if (xb_ld(&(bar)[XB_TMO])) break; if (_sp > XB_SPIN_CAP) { atomicAdd(&(bar)[XB_TMO], 1u); break; } } } } while (0)
struct XcdBarrier { unsigned* bar; unsigned x; volatile LAS unsigned* st; };
DI XcdBarrier xcd_barrier_post(unsigned* bar, volatile LAS unsigned* st) {
    XcdBarrier b; b.bar = bar; b.x = xb_xcc_id(); b.st = st;
    if (threadIdx.x == 0) (void)xb_add(&bar[XB_XCNT(b.x)], 1u);
    return b;
}
DI void xcd_barrier_complete(unsigned* bar, unsigned x, unsigned& nloc, unsigned& nx) {
    const unsigned G = gridDim.x * gridDim.y * gridDim.z;
    unsigned sum, cnt, mine, sp = 0u;
    for (;;) {
        sum = 0u; cnt = 0u; mine = 0u;
#pragma unroll
        for (unsigned j = 0; j < 16; ++j) { const unsigned c = xb_ld(&bar[XB_XCNT(j)]); sum += c; cnt += (c > 0u) ? 1u : 0u; mine = (j == x) ? c : mine; }
        if (sum == G) break;
        __builtin_amdgcn_s_sleep(1);
        if ((++sp & 255u) == 0u) { if (xb_ld(&bar[XB_TMO])) break; if (sp > XB_SPIN_CAP) { atomicAdd(&bar[XB_TMO], 1u); break; } }
    }
    nloc = mine > 0u ? mine : 1u; nx = cnt > 0u ? cnt : 1u;
}
DI void xcd_barrier(const XcdBarrier& b) {
    asm volatile("s_waitcnt vmcnt(0)" ::: "memory");
    __syncthreads();
    if (threadIdx.x == 0) {
        unsigned* bar = b.bar;
        __builtin_amdgcn_s_waitcnt(0);
        unsigned nloc = b.st[0], nx = b.st[1];
        if (nloc == 0u) { xcd_barrier_complete(bar, b.x, nloc, nx); b.st[0] = nloc; b.st[1] = nx; }
        const unsigned old = xb_add(&bar[XB_XSUB(b.x)], 1u);
        const unsigned gen = old / nloc;
        if (old + 1u == (gen + 1u) * nloc) {
            __builtin_amdgcn_fence(__ATOMIC_RELEASE, "agent");
            asm volatile("s_waitcnt vmcnt(0)" ::: "memory");
            const unsigned og = xb_add(&bar[XB_TOP], 1u);
            const unsigned tg = og / nx;
            if (og + 1u == (tg + 1u) * nx) xb_add(&bar[XB_TOPGEN], 1u);
            else XB_SPIN(xb_ld(&bar[XB_TOPGEN]) == tg, bar);
            __builtin_amdgcn_fence(__ATOMIC_ACQUIRE, "agent");
            xb_add(&bar[XB_XGEN(b.x)], 1u);
            asm volatile("s_waitcnt vmcnt(0)" ::: "memory");
        } else {
            XB_SPIN(xb_ld(&bar[XB_XGEN(b.x)]) == gen, bar);
            __builtin_amdgcn_fence(__ATOMIC_ACQUIRE, "agent");
            asm volatile("s_waitcnt vmcnt(0)" ::: "memory");
        }
    }
    __syncthreads();
}

__global__ void __launch_bounds__(NTHR) k_naive(Params p, int ph) {
    const long gtid = (long)blockIdx.x * NTHR + threadIdx.x, gsize = (long)gridDim.x * NTHR;
    const int l = (ph - 2) / PPL, s = (ph - 2) % PPL;
    const bool upd = l < DEPTH - 1;
    (void)gtid; (void)gsize; (void)l; (void)s; (void)upd;
#if !IMPL_POST
    if (s == 1) ph_post(p, l, gtid, gsize);
#endif
#if !IMPL_ATTN
    if (s == 2) { ph_attn_diff(p, l, upd, gtid, gsize); ph_attn_gqa(p, l, upd, gtid, gsize); }
#endif
#if !IMPL_MLSTM
    if (s == 3) ph_mlstm(p, l, upd, gtid, gsize);
#endif
#if !IMPL_ROUTE
    if (s == 5) bp_route(p, l, upd, gtid, gsize);
#endif
}

__global__ void __launch_bounds__(NTHR, 2) k_mega(Params p_arg, int ph_begin, int ph_end) {
    extern __shared__ __attribute__((aligned(16))) unsigned char smem[];
    const Params& p0 = p_arg;
    cg::grid_group grid = cg::this_grid();
    const int G = gridDim.x, vb = xcd_remap(blockIdx.x, G);
    volatile LAS unsigned* xb_st = (volatile LAS unsigned*)(smem + SMEM_BYTES - 16);
    if (threadIdx.x == 0) { xb_st[0] = 0u; xb_st[1] = 0u; xb_st[2] = 0u; }
    __syncthreads();
    const XcdBarrier xb = xcd_barrier_post(p0.BAR, xb_st);
    for (int ph = ph_begin; ph < ph_end; ++ph) {
        Params p;
#if defined(__HIP_DEVICE_COMPILE__)
        {
            typedef const __attribute__((address_space(4))) unsigned long long* kp_t;
            kp_t pk = (kp_t)__builtin_amdgcn_kernarg_segment_ptr();
            asm volatile("" : "+s"(pk));
            static_assert(sizeof(Params) % 8 == 0, "Params is a list of pointers");
#pragma unroll
            for (unsigned i = 0; i < sizeof(Params) / 8; ++i) {
                char* gp = (char*)(__attribute__((address_space(1))) char*)pk[i];
                __builtin_memcpy((char*)&p + 8 * i, &gp, 8);
            }
        }
#else
        p = p0;
#endif
#ifdef PROBE_TS
        if (blockIdx.x == 0 && threadIdx.x == 0) { typedef const __attribute__((address_space(4))) unsigned long long* kp_t; kp_t pk = (kp_t)__builtin_amdgcn_kernarg_segment_ptr(); ((unsigned long long*)pk[offsetof(Params, TS) / 8])[ph] = __builtin_amdgcn_s_memrealtime(); }
#endif
        const int tid = opaque_tid(), lane = tid & 63;
        const long gtid = (long)blockIdx.x * NTHR + tid, gsize = (long)G * NTHR;
        const int gwave = (int)(gtid >> 6), nwaves = (int)(gsize >> 6);
        if (ph == 0) {
            bp_mod(p, smem, blockIdx.x, G, gtid, gsize);
            bp_wconv(p, smem, G - 1 - blockIdx.x, G);
            if (gtid < DEPTH * 32 * 64) p.CNT[gtid] = 0;
            for (long it = gtid; it < (long)DEPTH * 36 * Dm; it += gsize) {
                const int k = (int)(it % Dm), n = (int)((it / Dm) % 36), ll = (int)(it / (36 * Dm));
                const float wv = n < 4 ? p.moe_wg[((size_t)ll * Dm + k) * 4 + n] : p.moe_we[((size_t)ll * Dm + k) * 32 + n - 4];
                const act_t hi = f2a(wv);
                p.WRHI[it] = hi; p.WRLO[it] = f2a(wv - a2f(hi));
            }
            if (gtid < 512) ((unsigned long long*)p.ZROW)[gtid] = 0ull;
            if (gtid < 64 * 28) {
                const int pos = (int)gtid / 28, fi = (int)gtid % 28, nf = fi < 12 ? 12 : 16, i = fi < 12 ? fi : fi - 12;
                const float ang = (float)pos * expf(-(float)i / (float)nf * 9.210340371976184f);
                p.ROPE[gtid * 2] = cosf(ang); p.ROPE[gtid * 2 + 1] = sinf(ang);
            }
        } else if (ph == 1) {
            bp_norm1(p, 0, gwave, nwaves, lane);
        } else {
            const int l = (ph - 2) / PPL, s = (ph - 2) % PPL;
            const bool upd = l < DEPTH - 1;
#ifdef PROBE_DUP
            if ((PROBE_DUP >> s) & 1) {
                if (s == 0) bp_gemm_in<PROBE_MODE>(p, l, smem, vb, G);
                if (s == 1) bp_post(p, l, smem, blockIdx.x, G);
                if (s == 6) bp_moe1(p, l, smem, vb, G);
                if (s == 7) bp_moe2(p, l, smem, vb, G);
                if (s == 4) bp_gemm_out<true>(p, l, upd, smem, vb, G);
                if (s == 8 && l < DEPTH - 1) bp_combine<true>(p, l, upd, smem, gwave, nwaves, lane);
            }
#endif
            switch (s) {
                case 0: bp_gemm_in(p, l, smem, vb, G); break;
#if IMPL_POST
                case 1: bp_post(p, l, smem, blockIdx.x, G); break;
#endif
#if IMPL_ATTN
                case 2: bp_mixer(p, l, upd, smem); break;
#endif
#if IMPL_MLSTM
                case 3: break;
#endif
#if IMPL_ROUTE
                case 5: bp_route2(p, l, upd, smem, blockIdx.x, G); break;
#endif
                case 4: bp_gemm_out<false>(p, l, upd, smem, vb, G); break;
                case 6: bp_moe1(p, l, smem, vb, G); break;
                case 7: bp_moe2(p, l, smem, vb, G); break;
                case 8: bp_combine<false>(p, l, upd, smem, gwave, nwaves, lane); break;
                default: break;
            }
        }
        if (ph + 1 < ph_end && !(ph >= 2 && (ph - 2) % PPL == 2 && IMPL_ATTN && IMPL_MLSTM)) {
            if (ph_end < 0) grid.sync();
            xcd_barrier(xb);
#ifdef PROBE_DUP
            if (PROBE_DUP & 1024) xcd_barrier(xb);
#endif
        }
    }
#ifdef PROBE_TS
    if (blockIdx.x == 0 && __builtin_amdgcn_mbcnt_hi(~0u, __builtin_amdgcn_mbcnt_lo(~0u, 0u)) == 0u && atomicAdd((unsigned*)(smem + SMEM_BYTES - 8), 1u) == 0u) {
        struct { unsigned long long* TS; float* out; } p;
        { typedef const __attribute__((address_space(4))) unsigned long long* kp_t; kp_t pk = (kp_t)__builtin_amdgcn_kernarg_segment_ptr(); p.TS = (unsigned long long*)pk[offsetof(Params, TS) / 8]; p.out = (float*)pk[offsetof(Params, out) / 8]; }
        p.TS[NPH] = __builtin_amdgcn_s_memrealtime();
        unsigned long long tot = 0;
        if (PROBE_TS == 9) tot = p.TS[2] - p.TS[0];
        else if (PROBE_TS == 10) tot = p.TS[NPH] - p.TS[0];
        else for (int l = 0; l < DEPTH; ++l) tot += p.TS[2 + l * PPL + PROBE_TS + 1] - p.TS[2 + l * PPL + PROBE_TS];
        p.out[0] += (float)tot * 0.01f / PROBE_SCALE;
    }
#endif
}

extern "C" void kernel_launch(void* const* d_in, const int* in_sizes, int n_in, void* d_out, int out_size, void* d_ws, size_t ws_size, hipStream_t stream) {
    Params p;
    memset((void*)&p, 0, sizeof(p));
    fill_inputs(p, d_in, d_out);
    carve(p, d_ws);
    static int grid_blocks = 0;
    if (!grid_blocks) {
        int dev = 0, cus = 0, per_cu = 0;
        (void)hipGetDevice(&dev);
        (void)hipDeviceGetAttribute(&cus, hipDeviceAttributeMultiprocessorCount, dev);
        (void)hipFuncSetAttribute((const void*)k_mega, hipFuncAttributeMaxDynamicSharedMemorySize, SMEM_BYTES);
        (void)hipOccupancyMaxActiveBlocksPerMultiprocessor(&per_cu, k_mega, NTHR, SMEM_BYTES);
        if (per_cu > 2) per_cu = 2;
        if (per_cu < 1) per_cu = 1;
        grid_blocks = cus * per_cu;
    }
    (void)hipMemsetAsync(p.BAR, 0, 4096 * sizeof(unsigned), stream);
    int ph = 0;
    while (ph < NPH) {
        if (phase_in_mega(ph)) {
            int b = ph, e = ph;
            while (e < NPH && phase_in_mega(e)) ++e;
            void* args[] = {&p, &b, &e};
            (void)hipLaunchCooperativeKernel((void*)k_mega, dim3(grid_blocks), dim3(NTHR), args, SMEM_BYTES, stream);
            ph = e;
        } else {
            k_naive<<<2048, NTHR, 0, stream>>>(p, ph);
            ++ph;
        }
    }
}
#endif
```

```cpp
#ifndef HOST_TEST
#include <hip/hip_runtime.h>
#include <hip/hip_cooperative_groups.h>
#include <string.h>
namespace cg = cooperative_groups;
#define HD __host__ __device__ __forceinline__
#else
#include <math.h>
#include <string.h>
#define HD inline
#endif
#include <stdint.h>
#include <stddef.h>

#ifndef CFG_B
#define CFG_B 8
#define CFG_T 2048
#define CFG_C 256
#define CFG_DEPTH 4
#endif
#ifndef MK_LAUNCHES
#define MK_LAUNCHES 1
#endif

constexpr int Bn = CFG_B, Tn = CFG_T, Cn = CFG_C, DEPTH = CFG_DEPTH;
constexpr int Dm = 1024, INW = 2832, MODW = 6144;
constexpr int NL = Bn * Tn, NC = Bn * Cn, NTOK = NL + NC, Sn = Cn + Tn;
constexpr int DQ_OFF = 0, DK_OFF = 384, DV_OFF = 768, GQ_OFF = 1152, GK_OFF = 1536, GV_OFF = 1664, MQK_OFF = 1792, MV_OFF = 2304, MO_OFF = 2560, MG_OFF = 2816;
constexpr int NCH = Sn / 64, NCC = Cn / 64;
constexpr int PMAX = 2 * NTOK + 32 * 128;
constexpr float EPSF = 1e-6f;
constexpr float LOG2E = 1.4426950408889634f;

#ifdef ACT_F32
typedef float act_t;
HD act_t f2a(float f) { return f; }
HD float a2f(act_t a) { return a; }
#else
typedef unsigned short act_t;
HD act_t f2a(float f) { unsigned u; memcpy(&u, &f, 4); u += 0x7fffu + ((u >> 16) & 1u); return (act_t)(u >> 16); }
HD float a2f(act_t a) { unsigned u = ((unsigned)a) << 16; float f; memcpy(&f, &u, 4); return f; }
#endif

HD float silu_f(float x) { return x / (1.0f + expf(-x)); }
HD float sigmoid_f(float x) { return 1.0f / (1.0f + expf(-x)); }
HD float logsigmoid_f(float x) { return fminf(x, 0.0f) - log1pf(expf(-fabsf(x))); }
HD float lam_init_of(int l) { return 0.8f - 0.6f * expf(-0.3f * (float)l); }

struct Params {
    const float *x, *c, *ctx, *c_ctx, *norm1_g, *norm2_g, *w_mod, *b_mod, *w_in, *w_out, *diff_q_norm, *diff_k_norm, *diff_lambda, *diff_subln,
        *gqa_q_norm, *gqa_k_norm, *mlstm_conv_w, *mlstm_conv_b, *mlstm_gate_b, *mlstm_head_norm, *moe_wg, *moe_bg, *moe_we, *moe_be, *moe_w1, *moe_w3, *moe_w2;
    float* out;
    float *mod, *X, *PROJ, *MQK, *MGATE, *DO, *GATE, *HN;
    act_t *XN, *DQL, *DQC, *DK, *DVt, *GQL, *GQC, *GK, *GVt, *MIX, *F;
    int* EID;
    int *CNT, *LIST, *POS;
    act_t *H, *Y;
    float *ROPE, *KV, *NLC, *CHS, *MG4;
    act_t* MQKB;
    unsigned* BAR;
    act_t *WIN_T, *WOUT_T;
    unsigned long long* TS;
    act_t *FLO, *WRHI, *WRLO, *ZROW;
    act_t *W13T, *W2T;
    act_t* PROJB; float* PG;
};

HD bool tok_ctx(int tok) { return tok >= NL; }
HD int tok_b(int tok) { return tok < NL ? tok / Tn : (tok - NL) / Cn; }
HD int tok_i(int tok) { return tok < NL ? tok % Tn : (tok - NL) % Cn; }
HD int tok_s(int tok) { return tok < NL ? Cn + tok % Tn : (tok - NL) % Cn; }
HD int tok_modrow(int tok) { return tok < NL ? tok / Tn : Bn; }
HD int tok_of(int b, int s) { return s < Cn ? NL + b * Cn + s : b * Tn + (s - Cn); }
HD const float* mod_row(const Params& p, int l, int tok) { return p.mod + ((size_t)l * (Bn + 1) + tok_modrow(tok)) * MODW; }

HD void ph_mod(const Params& p, long gtid, long gsize) {
    for (long it = gtid; it < (long)DEPTH * MODW; it += gsize) {
        const int l = (int)(it / MODW), j = (int)(it % MODW);
        float acc[Bn + 1];
#pragma unroll
        for (int r = 0; r <= Bn; ++r) acc[r] = 0.f;
        const float* w = p.w_mod + (size_t)l * Dm * MODW + j;
        for (int k = 0; k < Dm; ++k) {
            const float wv = w[(size_t)k * MODW];
#pragma unroll
            for (int r = 0; r < Bn; ++r) acc[r] += silu_f(p.c[r * Dm + k]) * wv;
            acc[Bn] += silu_f(p.c_ctx[k]) * wv;
        }
        const float bb = p.b_mod[l * MODW + j];
#pragma unroll
        for (int r = 0; r <= Bn; ++r) p.mod[((size_t)l * (Bn + 1) + r) * MODW + j] = acc[r] + bb;
    }
    for (long it = gtid; it < (long)NTOK * Dm; it += gsize) p.X[it] = it < (long)NL * Dm ? p.x[it] : p.ctx[it - (long)NL * Dm];
}

HD void ph_norm1(const Params& p, int l, long gtid, long gsize) {
    for (long row = gtid; row < NTOK; row += gsize) {
        const float* xr = p.X + row * Dm;
        float ss = 0.f;
        for (int k = 0; k < Dm; ++k) ss += xr[k] * xr[k];
        const float rstd = 1.0f / sqrtf(ss / Dm + EPSF);
        const float* mr = mod_row(p, l, (int)row);
        const float* g = p.norm1_g + l * Dm;
        for (int k = 0; k < Dm; ++k) p.XN[row * Dm + k] = f2a(xr[k] * rstd * g[k] * (1.0f + mr[Dm + k]) + mr[k]);
    }
}

HD void ph_gemm_in(const Params& p, int l, long gtid, long gsize) {
    const float* W = p.w_in + (size_t)l * Dm * INW;
    for (long it = gtid; it < (long)NTOK * INW; it += gsize) {
        const long m = it / INW; const int n = (int)(it % INW);
        const act_t* a = p.XN + m * Dm;
        float acc = 0.f;
        for (int k = 0; k < Dm; ++k) acc += a2f(a[k]) * W[(size_t)k * INW + n];
        p.PROJ[it] = acc;
    }
}

template <int DHn>
HD void qk_unit(const float* src, const float* g, bool rope, int t, float oscale, float (&y)[DHn]) {
    float ss = 0.f;
#pragma unroll
    for (int i = 0; i < DHn; ++i) { y[i] = src[i]; ss += y[i] * y[i]; }
    const float rstd = 1.0f / sqrtf(ss / DHn + EPSF);
#pragma unroll
    for (int i = 0; i < DHn; ++i) y[i] = y[i] * rstd * g[i];
    if (rope) {
        constexpr int half = DHn / 2, nf = half / 2;
        const float posr = (float)(t / 64), posc = (float)(t % 64);
#pragma unroll
        for (int hsel = 0; hsel < 2; ++hsel) {
            const float pos = hsel ? posc : posr;
#pragma unroll
            for (int i = 0; i < nf; ++i) {
                const float fr = expf(-(float)i / (float)nf * 9.210340371976184f);
                const float ang = pos * fr;
                const float cs = cosf(ang), sn = sinf(ang);
                const float x1 = y[hsel * half + i], x2 = y[hsel * half + nf + i];
                y[hsel * half + i] = x1 * cs - x2 * sn;
                y[hsel * half + nf + i] = x2 * cs + x1 * sn;
            }
        }
    }
#pragma unroll
    for (int i = 0; i < DHn; ++i) y[i] *= oscale;
}

HD void ph_post(const Params& p, int l, long gtid, long gsize) {
    constexpr int NU = 27;
    for (long it = gtid; it < (long)NTOK * NU; it += gsize) {
        const int tok = (int)(it / NU), u = (int)(it % NU);
        const bool isc = tok_ctx(tok);
        const int b = tok_b(tok), ti = tok_i(tok), s = tok_s(tok);
        const float* pr = p.PROJ + (size_t)tok * INW;
        if (u < 16) {
            const bool isk = u >= 8; const int h = (u & 7) >> 1, w = u & 1;
            float y[48];
            qk_unit<48>(pr + (isk ? DK_OFF : DQ_OFF) + h * 96 + w * 48, (isk ? p.diff_k_norm : p.diff_q_norm) + l * 48, !isc, ti,
                        isk ? 1.0f : 0.14433756729740643f * LOG2E, y);
            act_t* dst = isk ? p.DK + (((size_t)(b * 4 + h) * 2 + w) * Sn + s) * 48
                             : (isc ? p.DQC + (((size_t)(b * 4 + h) * 2 + w) * Cn + ti) * 48 : p.DQL + (((size_t)(b * 4 + h) * 2 + w) * Tn + ti) * 48);
#pragma unroll
            for (int i = 0; i < 48; ++i) dst[i] = f2a(y[i]);
        } else if (u < 24) {
            const bool isk = u >= 22; const int h = isk ? u - 22 : u - 16;
            float y[64];
            qk_unit<64>(pr + (isk ? GK_OFF : GQ_OFF) + h * 64, (isk ? p.gqa_k_norm : p.gqa_q_norm) + l * 64, !isc, ti, isk ? 1.0f : 0.125f * LOG2E, y);
            act_t* dst = isk ? p.GK + ((size_t)(b * 2 + h) * Sn + s) * 64
                             : (isc ? p.GQC + ((size_t)(b * 6 + h) * Cn + ti) * 64 : p.GQL + ((size_t)(b * 6 + h) * Tn + ti) * 64);
#pragma unroll
            for (int i = 0; i < 64; ++i) dst[i] = f2a(y[i]);
        } else if (u == 24) {
            for (int j = 0; j < 384; ++j) p.DVt[((size_t)(b * 4 + j / 96) * 96 + j % 96) * Sn + s] = f2a(pr[DV_OFF + j]);
        } else if (u == 25) {
            for (int j = 0; j < 128; ++j) p.GVt[((size_t)(b * 2 + j / 64) * 64 + j % 64) * Sn + s] = f2a(pr[GV_OFF + j]);
        } else {
            const int seglen = isc ? Cn : Tn;
            const float* cw = p.mlstm_conv_w + (size_t)l * 3 * 512; const float* cb = p.mlstm_conv_b + l * 512;
            for (int ch = 0; ch < 512; ++ch) {
                float a = cb[ch] + pr[MQK_OFF + ch] * cw[512 + ch];
                if (ti > 0) a += pr[MQK_OFF + ch - INW] * cw[ch];
                if (ti < seglen - 1) a += pr[MQK_OFF + ch + INW] * cw[1024 + ch];
                a = silu_f(a);
                p.MQK[(size_t)tok * 512 + ch] = ch >= 256 ? a * 0.125f : a;
            }
            const float* gb = p.mlstm_gate_b + l * 16;
            for (int j = 0; j < 16; ++j) {
                const float gv = pr[MG_OFF + j] + gb[j];
                p.MGATE[(size_t)tok * 16 + j] = ((j >> 2) & 1) ? logsigmoid_f(gv) : gv;
            }
        }
    }
}

HD void ph_attn_diff(const Params& p, int l, bool upd, long gtid, long gsize) {
    const int nq = upd ? Tn + Cn : Tn;
    const float lam_init = lam_init_of(l);
    for (long it = gtid; it < (long)Bn * 4 * nq; it += gsize) {
        const int qi = (int)(it % nq), h = (int)((it / nq) % 4), b = (int)(it / ((long)nq * 4));
        const bool isc = qi >= Tn; const int ti = isc ? qi - Tn : qi;
        const int nk = isc ? Cn : Sn;
        const int tok = isc ? NL + b * Cn + ti : b * Tn + ti;
        float* dob = p.DO + ((size_t)(b * 4 + h) * (Tn + Cn) + qi) * 96;
        const act_t* vt = p.DVt + (size_t)(b * 4 + h) * 96 * Sn;
        float l2 = 1.f;
        float o[96];
        for (int w = 0; w < 2; ++w) {
            const act_t* qp = isc ? p.DQC + (((size_t)(b * 4 + h) * 2 + w) * Cn + ti) * 48 : p.DQL + (((size_t)(b * 4 + h) * 2 + w) * Tn + ti) * 48;
            const act_t* kp = p.DK + ((size_t)(b * 4 + h) * 2 + w) * Sn * 48;
            float q[48];
#pragma unroll
            for (int i = 0; i < 48; ++i) q[i] = a2f(qp[i]);
#pragma unroll
            for (int i = 0; i < 96; ++i) o[i] = 0.f;
            float m = -1e30f, lsum = 0.f;
            for (int s = 0; s < nk; ++s) {
                float sc = 0.f;
#pragma unroll
                for (int i = 0; i < 48; ++i) sc += q[i] * a2f(kp[(size_t)s * 48 + i]);
                const float mn = fmaxf(m, sc), alpha = exp2f(m - mn), pe = exp2f(sc - mn);
                lsum = lsum * alpha + pe;
#pragma unroll
                for (int i = 0; i < 96; ++i) o[i] = o[i] * alpha + pe * a2f(vt[(size_t)i * Sn + s]);
                m = mn;
            }
            if (w == 0) {
#pragma unroll
                for (int i = 0; i < 96; ++i) dob[i] = o[i] / lsum;
            } else l2 = lsum;
        }
        const float* dl = p.diff_lambda + l * 4 * 48;
        float s01 = 0.f, s23 = 0.f;
        for (int i = 0; i < 48; ++i) { s01 += dl[i] * dl[48 + i]; s23 += dl[96 + i] * dl[144 + i]; }
        const float lam = expf(s01) - expf(s23) + lam_init;
        float ss = 0.f;
#pragma unroll
        for (int i = 0; i < 96; ++i) { o[i] = dob[i] - lam * o[i] / l2; ss += o[i] * o[i]; }
        const float rstd = 1.0f / sqrtf(ss / 96 + EPSF);
        const float* sg = p.diff_subln + l * 96;
#pragma unroll
        for (int i = 0; i < 96; ++i) p.MIX[(size_t)tok * Dm + h * 96 + i] = f2a(o[i] * rstd * sg[i] * (1.0f - lam_init));
    }
}

HD void ph_attn_gqa(const Params& p, int l, bool upd, long gtid, long gsize) {
    const int nq = upd ? Tn + Cn : Tn;
    for (long it = gtid; it < (long)Bn * 6 * nq; it += gsize) {
        const int qi = (int)(it % nq), hq = (int)((it / nq) % 6), b = (int)(it / ((long)nq * 6));
        const bool isc = qi >= Tn; const int ti = isc ? qi - Tn : qi;
        const int nk = isc ? Cn : Sn, kv = hq / 3;
        const int tok = isc ? NL + b * Cn + ti : b * Tn + ti;
        const act_t* qp = isc ? p.GQC + ((size_t)(b * 6 + hq) * Cn + ti) * 64 : p.GQL + ((size_t)(b * 6 + hq) * Tn + ti) * 64;
        const act_t* kp = p.GK + (size_t)(b * 2 + kv) * Sn * 64;
        const act_t* vt = p.GVt + (size_t)(b * 2 + kv) * 64 * Sn;
        float q[64], o[64];
#pragma unroll
        for (int i = 0; i < 64; ++i) { q[i] = a2f(qp[i]); o[i] = 0.f; }
        float m = -1e30f, lsum = 0.f;
        for (int s = 0; s < nk; ++s) {
            float sc = 0.f;
#pragma unroll
            for (int i = 0; i < 64; ++i) sc += q[i] * a2f(kp[(size_t)s * 64 + i]);
            const float mn = fmaxf(m, sc), alpha = exp2f(m - mn), pe = exp2f(sc - mn);
            lsum = lsum * alpha + pe;
#pragma unroll
            for (int i = 0; i < 64; ++i) o[i] = o[i] * alpha + pe * a2f(vt[(size_t)i * Sn + s]);
            m = mn;
        }
#pragma unroll
        for (int i = 0; i < 64; ++i) p.MIX[(size_t)tok * Dm + 384 + hq * 64 + i] = f2a(o[i] / lsum);
    }
}

HD void mlstm_dir_naive(const Params& p, int b, int h, bool isc, int ti, int dir, const float (&q)[64], float (&hout)[64]) {
    float num[64];
#pragma unroll
    for (int i = 0; i < 64; ++i) num[i] = 0.f;
    float den = 0.f, m = -1e30f, Dg = 0.f;
    for (int seg = 0; seg < (isc ? 1 : 2); ++seg) {
        const bool sc_ = seg == 1 ? true : isc;
        const int len = sc_ ? Cn : Tn;
        int cnt, start, step;
        if (seg == 0) { start = ti; step = dir == 0 ? -1 : 1; cnt = dir == 0 ? ti + 1 : len - ti; }
        else { start = dir == 0 ? len - 1 : 0; step = dir == 0 ? -1 : 1; cnt = len; }
        for (int c = 0, si = start; c < cnt; ++c, si += step) {
            const int tk = sc_ ? NL + b * Cn + si : b * Tn + si;
            const float li = p.MGATE[(size_t)tk * 16 + dir * 8 + h], lf = p.MGATE[(size_t)tk * 16 + dir * 8 + 4 + h];
            const float lw = Dg + li;
            const float* kr = p.MQK + (size_t)tk * 512 + 256 + h * 64;
            const float* vr = p.PROJ + (size_t)tk * INW + MV_OFF + h * 64;
            float qk = 0.f;
#pragma unroll
            for (int i = 0; i < 64; ++i) qk += q[i] * kr[i];
            const float mn = fmaxf(m, lw), alpha = expf(m - mn), w = expf(lw - mn) * qk;
            den = den * alpha + w;
#pragma unroll
            for (int i = 0; i < 64; ++i) num[i] = num[i] * alpha + w * vr[i];
            m = mn;
            Dg += lf;
        }
    }
    const float dn = fmaxf(fabsf(den), expf(-m));
#pragma unroll
    for (int i = 0; i < 64; ++i) hout[i] += num[i] / dn;
}

HD void ph_mlstm(const Params& p, int l, bool upd, long gtid, long gsize) {
    const int nq = upd ? Tn + Cn : Tn;
    for (long it = gtid; it < (long)Bn * 4 * nq; it += gsize) {
        const int qi = (int)(it % nq), h = (int)((it / nq) % 4), b = (int)(it / ((long)nq * 4));
        const bool isc = qi >= Tn; const int ti = isc ? qi - Tn : qi;
        const int tok = isc ? NL + b * Cn + ti : b * Tn + ti;
        float q[64], hh[64];
#pragma unroll
        for (int i = 0; i < 64; ++i) { q[i] = p.MQK[(size_t)tok * 512 + h * 64 + i]; hh[i] = 0.f; }
        mlstm_dir_naive(p, b, h, isc, ti, 0, q, hh);
        mlstm_dir_naive(p, b, h, isc, ti, 1, q, hh);
        float ss = 0.f;
#pragma unroll
        for (int i = 0; i < 64; ++i) ss += hh[i] * hh[i];
        const float rstd = 1.0f / sqrtf(ss / 64 + EPSF);
        const float* hn = p.mlstm_head_norm + l * 256 + h * 64;
        const float* og = p.PROJ + (size_t)tok * INW + MO_OFF + h * 64;
#pragma unroll
        for (int i = 0; i < 64; ++i) p.MIX[(size_t)tok * Dm + 768 + h * 64 + i] = f2a(hh[i] * rstd * hn[i] * sigmoid_f(og[i]));
    }
}

HD void ph_gemm_out(const Params& p, int l, bool upd, long gtid, long gsize) {
    const float* W = p.w_out + (size_t)l * Dm * Dm;
    const long rows = upd ? NTOK : NL;
    for (long it = gtid; it < rows * Dm; it += gsize) {
        const long m = it / Dm; const int n = (int)(it % Dm);
        const act_t* a = p.MIX + m * Dm;
        float acc = 0.f;
        for (int k = 0; k < Dm; ++k) acc += a2f(a[k]) * W[(size_t)k * Dm + n];
        p.X[it] += mod_row(p, l, (int)m)[2 * Dm + n] * acc;
    }
}

HD void ph_norm2_route(const Params& p, int l, bool upd, long gtid, long gsize) {
    const long rows = upd ? NTOK : NL;
    for (long row = gtid; row < rows; row += gsize) {
        const float* xr = p.X + row * Dm;
        float ss = 0.f;
        for (int k = 0; k < Dm; ++k) ss += xr[k] * xr[k];
        const float rstd = 1.0f / sqrtf(ss / Dm + EPSF);
        const float* mr = mod_row(p, l, (int)row);
        const float* g = p.norm2_g + l * Dm;
        const float* wg = p.moe_wg + (size_t)l * Dm * 4; const float* we = p.moe_we + (size_t)l * Dm * 32;
        float ag[4], ae[32];
#pragma unroll
        for (int j = 0; j < 4; ++j) ag[j] = 0.f;
#pragma unroll
        for (int j = 0; j < 32; ++j) ae[j] = 0.f;
        for (int k = 0; k < Dm; ++k) {
            const float f = xr[k] * rstd * g[k] * (1.0f + mr[4 * Dm + k]) + mr[3 * Dm + k];
            p.F[row * Dm + k] = f2a(f);
#pragma unroll
            for (int j = 0; j < 4; ++j) ag[j] += f * wg[k * 4 + j];
#pragma unroll
            for (int j = 0; j < 32; ++j) ae[j] += f * we[k * 32 + j];
        }
        float gmax = -1e30f; int gi = 0;
#pragma unroll
        for (int j = 0; j < 4; ++j) { ag[j] += p.moe_bg[l * 4 + j]; if (ag[j] > gmax) { gmax = ag[j]; gi = j; } }
        float gsum = 0.f;
#pragma unroll
        for (int j = 0; j < 4; ++j) gsum += expf(ag[j] - gmax);
        const float gtop = 1.0f / gsum;
        float e1 = -1e30f, e2 = -1e30f; int i1 = 0, i2 = 0;
#pragma unroll
        for (int grp = 0; grp < 4; ++grp) {
            if (grp == gi) {
#pragma unroll
                for (int j = 0; j < 8; ++j) {
                    const float v = ae[grp * 8 + j] + p.moe_be[l * 32 + grp * 8 + j];
                    if (v > e1) { e2 = e1; i2 = i1; e1 = v; i1 = j; } else if (v > e2) { e2 = v; i2 = j; }
                }
            }
        }
        const float g0 = 1.0f / (1.0f + expf(e2 - e1));
        p.EID[row * 2] = gi * 8 + i1; p.EID[row * 2 + 1] = gi * 8 + i2;
        p.GATE[row * 2] = g0 * gtop; p.GATE[row * 2 + 1] = (1.0f - g0) * gtop;
    }
}

HD void ph_moe1(const Params& p, int l, bool upd, long gtid, long gsize) {
    const long rows = upd ? NTOK : NL;
    for (long it = gtid; it < rows * 2 * 512; it += gsize) {
        const long rk = it / 512; const int j = (int)(it % 512);
        const long row = rk >> 1;
        const int e = p.EID[rk];
        const float* W1 = p.moe_w1 + ((size_t)l * 32 + e) * Dm * 512 + j; const float* W3 = p.moe_w3 + ((size_t)l * 32 + e) * Dm * 512 + j;
        const act_t* f = p.F + row * Dm;
        float a = 0.f, bb = 0.f;
        for (int k = 0; k < Dm; ++k) { const float fv = a2f(f[k]); a += fv * W1[(size_t)k * 512]; bb += fv * W3[(size_t)k * 512]; }
        p.HN[it] = silu_f(a) * bb;
    }
}

HD void ph_moe2(const Params& p, int l, bool upd, long gtid, long gsize) {
    const long rows = upd ? NTOK : NL;
    for (long it = gtid; it < rows * Dm; it += gsize) {
        const long row = it / Dm; const int d = (int)(it % Dm);
        float y = 0.f;
        for (int kk = 0; kk < 2; ++kk) {
            const int e = p.EID[row * 2 + kk];
            const float* W2 = p.moe_w2 + ((size_t)l * 32 + e) * 512 * Dm + d;
            const float* hn = p.HN + (row * 2 + kk) * 512;
            float acc = 0.f;
            for (int j = 0; j < 512; ++j) acc += hn[j] * W2[(size_t)j * Dm];
            y += p.GATE[row * 2 + kk] * acc;
        }
        const float xn = p.X[it] + mod_row(p, l, (int)row)[5 * Dm + d] * y;
        p.X[it] = xn;
        if (l == DEPTH - 1) p.out[it] = xn;
    }
}

constexpr int PH_PER_LAYER = 8;
constexpr int N_PHASES = 1 + DEPTH * PH_PER_LAYER;
HD void run_phase(const Params& p, int ph, long gtid, long gsize) {
    if (ph == 0) { ph_mod(p, gtid, gsize); return; }
    const int l = (ph - 1) / PH_PER_LAYER, s = (ph - 1) % PH_PER_LAYER;
    const bool upd = l < DEPTH - 1;
    switch (s) {
        case 0: ph_norm1(p, l, gtid, gsize); break;
        case 1: ph_gemm_in(p, l, gtid, gsize); break;
        case 2: ph_post(p, l, gtid, gsize); break;
        case 3: ph_attn_diff(p, l, upd, gtid, gsize); ph_attn_gqa(p, l, upd, gtid, gsize); ph_mlstm(p, l, upd, gtid, gsize); break;
        case 4: ph_gemm_out(p, l, upd, gtid, gsize); break;
        case 5: ph_norm2_route(p, l, upd, gtid, gsize); break;
        case 6: ph_moe1(p, l, upd, gtid, gsize); break;
        default: ph_moe2(p, l, upd, gtid, gsize); break;
    }
}

struct Carver { char* base; size_t off; template <class T> T* take(size_t n) { T* r = (T*)(base + off); off += (n * sizeof(T) + 255) & ~(size_t)255; return r; } };
static inline size_t carve(Params& p, void* ws) {
    Carver c{(char*)ws, 0};
    p.mod = c.take<float>((size_t)DEPTH * (Bn + 1) * MODW);
    p.X = c.take<float>((size_t)NTOK * Dm);
#ifdef HOST_TEST
    p.PROJ = c.take<float>((size_t)NTOK * INW);
#endif
#ifdef HOST_TEST
    p.MQK = c.take<float>((size_t)NTOK * 512);
    p.MGATE = c.take<float>((size_t)NTOK * 16);
#endif
    p.DO = c.take<float>((size_t)Bn * 4 * (Tn + Cn) * 96);
    p.GATE = c.take<float>((size_t)NTOK * 2);
#ifdef HOST_TEST
    p.HN = c.take<float>((size_t)NTOK * 2 * 512);
#endif
    p.XN = c.take<act_t>((size_t)NTOK * Dm);
    p.DQL = c.take<act_t>((size_t)Bn * 4 * 2 * Tn * 48);
    p.DQC = c.take<act_t>((size_t)Bn * 4 * 2 * Cn * 48);
    p.DK = c.take<act_t>((size_t)Bn * 4 * 2 * Sn * 48);
    p.DVt = c.take<act_t>((size_t)Bn * 4 * 96 * Sn);
    p.GQL = c.take<act_t>((size_t)Bn * 6 * Tn * 64);
    p.GQC = c.take<act_t>((size_t)Bn * 6 * Cn * 64);
    p.GK = c.take<act_t>((size_t)Bn * 2 * Sn * 64);
    p.GVt = c.take<act_t>((size_t)Bn * 2 * 64 * Sn);
    p.MIX = c.take<act_t>((size_t)NTOK * Dm);
    p.F = c.take<act_t>((size_t)NTOK * Dm);
    p.EID = c.take<int>((size_t)NTOK * 2);
    p.CNT = c.take<int>((size_t)DEPTH * 32 * 64);
    p.LIST = c.take<int>((size_t)32 * NTOK);
    p.POS = c.take<int>((size_t)NTOK * 2);
    p.H = c.take<act_t>((size_t)PMAX * 512);
    p.Y = c.take<act_t>((size_t)PMAX * Dm);
    p.ROPE = c.take<float>((size_t)64 * 28 * 2);
    p.KV = c.take<float>((size_t)Bn * 4 * 2 * NCH * 4096);
    p.NLC = c.take<float>((size_t)Bn * 4 * 2 * NCH * 64);
    p.CHS = c.take<float>((size_t)Bn * 4 * 2 * NCH * 2);
    p.MG4 = c.take<float>((size_t)NTOK * 16);
    p.MQKB = c.take<act_t>((size_t)NTOK * 512);
    p.BAR = c.take<unsigned>(4096);
    p.WIN_T = c.take<act_t>((size_t)DEPTH * INW * Dm);
    p.WOUT_T = c.take<act_t>((size_t)DEPTH * Dm * Dm);
    p.TS = c.take<unsigned long long>(256);
    p.FLO = c.take<act_t>((size_t)NTOK * Dm);
    p.WRHI = c.take<act_t>((size_t)DEPTH * 36 * Dm);
    p.WRLO = c.take<act_t>((size_t)DEPTH * 36 * Dm);
    p.ZROW = c.take<act_t>(2048);
    p.W13T = c.take<act_t>((size_t)2 * 32 * 1024 * Dm);
    p.W2T = c.take<act_t>((size_t)2 * 32 * Dm * 512);
    p.PROJB = c.take<act_t>((size_t)NTOK * INW);
    p.PG = c.take<float>((size_t)NTOK * 16);
    return c.off;
}
static inline void fill_inputs(Params& p, void* const* d_in, void* d_out) {
    const float** f = (const float**)&p;
    for (int i = 0; i < 27; ++i) f[i] = (const float*)d_in[i];
    p.out = (float*)d_out;
}


#ifndef HOST_TEST
typedef short bf16x8 __attribute__((ext_vector_type(8)));
typedef float f32x2 __attribute__((ext_vector_type(2)));
typedef float f32x4 __attribute__((ext_vector_type(4)));
typedef float f32x16 __attribute__((ext_vector_type(16)));
typedef unsigned u32x2 __attribute__((ext_vector_type(2)));
typedef unsigned u32x4 __attribute__((ext_vector_type(4)));
typedef __bf16 bf16x2_t __attribute__((ext_vector_type(2)));
#define DI __device__ __forceinline__
DI unsigned pk2(float a, float b) { f32x2 v = {a, b}; return __builtin_bit_cast(unsigned, __builtin_convertvector(v, bf16x2_t)); }
DI float bflo(unsigned u) { return __uint_as_float(u << 16); }
DI float bfhi(unsigned u) { return __uint_as_float(u & 0xffff0000u); }
DI f32x4 ld4bf(const act_t* q) { const u32x2 v = *(const u32x2*)q; return (f32x4){bflo(v[0]), bfhi(v[0]), bflo(v[1]), bfhi(v[1])}; }
DI float shfl_i(float v, int src) { return __int_as_float(__builtin_amdgcn_ds_bpermute(src << 2, __float_as_int(v))); }
DI float shfl_x(float v, int o, int lane) { return shfl_i(v, lane ^ o); }
DI float row16_sum(float v) {
#define ROR_(x, n) __int_as_float(__builtin_amdgcn_update_dpp(0, __float_as_int(x), 0x120 + (n), 0xF, 0xF, false))
    v += ROR_(v, 8); v += ROR_(v, 4); v += ROR_(v, 2); v += ROR_(v, 1);
#undef ROR_
    return v;
}
DI float wave_sum(float v, int lane) {
#pragma unroll
    for (int o = 32; o > 0; o >>= 1) v += shfl_x(v, o, lane);
    return v;
}

constexpr int NTHR = 256;
DI void lds_barrier() { asm volatile("s_waitcnt lgkmcnt(0)" ::: "memory"); __builtin_amdgcn_s_barrier(); asm volatile("" ::: "memory"); }
DI int opaque_tid() { int t = threadIdx.x; asm volatile("" : "+v"(t)); return t; }
constexpr int GT_LD = 144;
constexpr int GT_AS = 0, GT_BS = 128 * GT_LD, GT_END = 256 * GT_LD;
constexpr int SM_AUX = 65536;
constexpr int SMEM_BYTES = 66 * 1024;

#ifndef IMPL_POST
#define IMPL_POST 1
#endif
#ifndef IMPL_ATTN
#define IMPL_ATTN 1
#endif
#ifndef IMPL_MLSTM
#define IMPL_MLSTM 1
#endif
#ifndef IMPL_ROUTE
#define IMPL_ROUTE 1
#endif
DI int gt_off(int r, int c) { return r * 128 + ((c ^ ((r >> 1) & 7)) << 4); }
constexpr int GT_STAGE = 32768, GT_B = 16384;
#define GT_COMPUTE(BUF) \
    _Pragma("unroll") for (int kk = 0; kk < 2; ++kk) { \
        bf16x8 af[4], bfr[4]; \
        _Pragma("unroll") for (int mi = 0; mi < 4; ++mi) af[mi] = *(const bf16x8*)(smem + (BUF) * GT_STAGE + gt_off(wm * 64 + mi * 16 + (lane & 15), kk * 4 + (lane >> 4))); \
        _Pragma("unroll") for (int ni = 0; ni < 4; ++ni) bfr[ni] = *(const bf16x8*)(smem + (BUF) * GT_STAGE + GT_B + gt_off(wn * 64 + ni * 16 + (lane & 15), kk * 4 + (lane >> 4))); \
        _Pragma("unroll") for (int mi = 0; mi < 4; ++mi) \
            _Pragma("unroll") for (int ni = 0; ni < 4; ++ni) acc[mi][ni] = __builtin_amdgcn_mfma_f32_16x16x32_bf16(bfr[ni], af[mi], acc[mi][ni], 0, 0, 0); }

DI void gemm_mainloop(unsigned char* smem, const act_t* const (&arow)[4], const float* bptr, const int ldb, const int K, f32x4 (&acc)[4][4]) {
    const int tid = opaque_tid(), lane = tid & 63, w = tid >> 6, wm = w >> 1, wn = w & 1;
    const int a_r = tid >> 3, a_c = tid & 7, kg = lane & 7, c4 = (w * 8 + (lane >> 3)) * 4;
#pragma unroll
    for (int mi = 0; mi < 4; ++mi)
#pragma unroll
        for (int ni = 0; ni < 4; ++ni) acc[mi][ni] = (f32x4){0.f, 0.f, 0.f, 0.f};
    u32x4 ra[4]; f32x4 rb[8];
#define GT_LOAD(KOFF) { \
    _Pragma("unroll") for (int i = 0; i < 4; ++i) ra[i] = *(const u32x4*)(arow[i] + (KOFF) + a_c * 8); \
    _Pragma("unroll") for (int r = 0; r < 8; ++r) rb[r] = *(const f32x4*)(bptr + (size_t)((KOFF) + kg * 8 + r) * ldb); }
#define GT_WRITE(BUF) { \
    _Pragma("unroll") for (int i = 0; i < 4; ++i) *(u32x4*)(smem + (BUF) * GT_STAGE + gt_off(a_r + 32 * i, a_c)) = ra[i]; \
    _Pragma("unroll") for (int i = 0; i < 4; ++i) { \
        const u32x4 q = {pk2(rb[0][i], rb[1][i]), pk2(rb[2][i], rb[3][i]), pk2(rb[4][i], rb[5][i]), pk2(rb[6][i], rb[7][i])}; \
        *(u32x4*)(smem + (BUF) * GT_STAGE + GT_B + gt_off(c4 + i, kg)) = q; } }
    const int nt = K >> 6;
    __syncthreads();
    GT_LOAD(0)
    GT_WRITE(0)
    __syncthreads();
    if (nt > 1) GT_LOAD(64)
    for (int t = 0; t < nt; ++t) {
        const int buf = t & 1;
        GT_COMPUTE(buf)
        if (t + 1 < nt) GT_WRITE(buf ^ 1)
        __syncthreads();
        if (t + 2 < nt) GT_LOAD((t + 2) * 64)
    }
#undef GT_LOAD
#undef GT_WRITE
}

#define LDSP __attribute__((address_space(3)))
template <int MODE = 0>
DI void gemm_mainloop_bb(unsigned char* smem, const act_t* const (&arow)[4], const act_t* const (&brow)[4], const int K, f32x4 (&acc)[4][4]) {
    const int tid = opaque_tid(), lane = tid & 63, w = tid >> 6, wm = w >> 1, wn = w & 1;
    const int wu = __builtin_amdgcn_readfirstlane(w);
#pragma unroll
    for (int mi = 0; mi < 4; ++mi)
#pragma unroll
        for (int ni = 0; ni < 4; ++ni) acc[mi][ni] = (f32x4){0.f, 0.f, 0.f, 0.f};
    const int csrc = ((lane & 7) ^ ((4 * w + (lane >> 4)) & 7)) * 8;
#define GB_DMA(KOFF, BUF) { \
    _Pragma("unroll") for (int i = 0; i < 4; ++i) { \
        __builtin_amdgcn_global_load_lds((const unsigned*)(arow[i] + (KOFF) + csrc), (LDSP unsigned*)(smem + (BUF) * GT_STAGE + (4 * i + wu) * 1024), 16, 0, 0); \
        __builtin_amdgcn_global_load_lds((const unsigned*)(brow[i] + (KOFF) + csrc), (LDSP unsigned*)(smem + (BUF) * GT_STAGE + GT_B + (4 * i + wu) * 1024), 16, 0, 0); } }
    const int nt = K >> 6;
    __syncthreads();
    GB_DMA(0, 0)
    asm volatile("s_waitcnt vmcnt(0)" ::: "memory");
    __syncthreads();
    for (int t = 0; t < nt; ++t) {
        const int buf = t & 1;
        if (t + 1 < nt) GB_DMA((t + 1) * 64, buf ^ 1)
        GT_COMPUTE(buf)
        asm volatile("s_waitcnt vmcnt(0)" ::: "memory");
        __syncthreads();
    }
#undef GB_DMA
}

DI int g32_off(int r, int c) { return r * 64 + ((c ^ (((r >> 2) & 1) * 3)) << 4); }
DI void gemm_mainloop_big(unsigned char* smem, const act_t* const (&arow)[4], const act_t* const (&brow)[2], const int K, f32x4 (&acc)[8][4]) {
    const int tid = opaque_tid(), lane = tid & 63, w = tid >> 6, wm = w >> 1, wn = w & 1;
    const int wu = __builtin_amdgcn_readfirstlane(w);
#pragma unroll
    for (int mi = 0; mi < 8; ++mi)
#pragma unroll
        for (int ni = 0; ni < 4; ++ni) acc[mi][ni] = (f32x4){0.f, 0.f, 0.f, 0.f};
    const int csrc = ((lane & 3) ^ (((lane >> 4) & 1) * 3)) * 8;
    constexpr int STG = 24576, BOFF = 16384;
#define GB_DMA(T, BUF) { const int ko_ = (T) * 32 + csrc; unsigned char* st_ = smem + (BUF) * STG; \
    _Pragma("unroll") for (int j = 0; j < 4; ++j) __builtin_amdgcn_global_load_lds((const unsigned*)(arow[j] + ko_), (LDSP unsigned*)(st_ + (4 * wu + j) * 1024), 16, 0, 0); \
    _Pragma("unroll") for (int j = 0; j < 2; ++j) __builtin_amdgcn_global_load_lds((const unsigned*)(brow[j] + ko_), (LDSP unsigned*)(st_ + BOFF + (2 * wu + j) * 1024), 16, 0, 0); }
    const int nt = K >> 5;
    __syncthreads();
    GB_DMA(0, 0)
    asm volatile("s_waitcnt vmcnt(0)" ::: "memory");
    __syncthreads();
    for (int t = 0; t < nt; ++t) {
        const int buf = t & 1;
        if (t + 1 < nt) GB_DMA(t + 1, buf ^ 1)
        const unsigned char* st = smem + buf * STG;
        bf16x8 bfr[4];
#pragma unroll
        for (int ni = 0; ni < 4; ++ni) bfr[ni] = *(const bf16x8*)(st + BOFF + g32_off(wn * 64 + ni * 16 + (lane & 15), lane >> 4));
#pragma unroll
        for (int mi = 0; mi < 8; ++mi) {
            const bf16x8 af = *(const bf16x8*)(st + g32_off(wm * 128 + mi * 16 + (lane & 15), lane >> 4));
#pragma unroll
            for (int ni = 0; ni < 4; ++ni) acc[mi][ni] = __builtin_amdgcn_mfma_f32_16x16x32_bf16(bfr[ni], af, acc[mi][ni], 0, 0, 0);
        }
        asm volatile("s_waitcnt vmcnt(0)" ::: "memory");
        __syncthreads();
    }
#undef GB_DMA
}

DI void bp_wconv(const Params& p, unsigned char* smem, int bid, int G) {
    const int tid = opaque_tid();
    float* T = (float*)smem;
    constexpr int NT_IN = (INW + 63) / 64, NT_OUT = Dm / 64, KT = Dm / 64;
    constexpr int PER_L = (NT_IN + NT_OUT) * KT;
    const int k = tid >> 2, n16 = (tid & 3) * 16;
    const int n = tid >> 2, k16 = (tid & 3) * 16;
    f32x4 v[4];
#define WC_DECODE(ITEM) const int l_ = (ITEM) / PER_L, r_ = (ITEM) % PER_L; const bool isout_ = r_ >= NT_IN * KT; \
        const int rr_ = isout_ ? r_ - NT_IN * KT : r_, nt_ = rr_ / KT, kt_ = rr_ % KT, N_ = isout_ ? Dm : INW; \
        const float* W_ = isout_ ? p.w_out + (size_t)l_ * Dm * Dm : p.w_in + (size_t)l_ * Dm * INW;
#define WC_LOAD(ITEM) { WC_DECODE(ITEM) \
        _Pragma("unroll") for (int i = 0; i < 4; ++i) { const int nn = nt_ * 64 + n16 + i * 4; v[i] = nn < N_ ? *(const f32x4*)(W_ + (size_t)(kt_ * 64 + k) * N_ + nn) : (f32x4){0.f, 0.f, 0.f, 0.f}; } }
    if (bid < DEPTH * PER_L) WC_LOAD(bid)
    for (int item = bid; item < DEPTH * PER_L; item += G) {
        __syncthreads();
#pragma unroll
        for (int i = 0; i < 4; ++i) { T[k * 65 + n16 + i * 4] = v[i][0]; T[k * 65 + n16 + i * 4 + 1] = v[i][1]; T[k * 65 + n16 + i * 4 + 2] = v[i][2]; T[k * 65 + n16 + i * 4 + 3] = v[i][3]; }
        __syncthreads();
        if (item + G < DEPTH * PER_L) WC_LOAD(item + G)
        WC_DECODE(item)
        (void)W_;
        act_t* WT = isout_ ? p.WOUT_T + (size_t)l_ * Dm * Dm : p.WIN_T + (size_t)l_ * INW * Dm;
        if (nt_ * 64 + n < N_) {
            unsigned o[8];
#pragma unroll
            for (int i = 0; i < 8; ++i) o[i] = pk2(T[(k16 + 2 * i) * 65 + n], T[(k16 + 2 * i + 1) * 65 + n]);
            act_t* dst = WT + (size_t)(nt_ * 64 + n) * Dm + kt_ * 64 + k16;
            *(u32x4*)dst = (u32x4){o[0], o[1], o[2], o[3]}; *(u32x4*)(dst + 8) = (u32x4){o[4], o[5], o[6], o[7]};
        }
    }
#undef WC_LOAD
#undef WC_DECODE
}

DI int xcd_remap(int b, int G) { return (G & 7) == 0 ? (b & 7) * (G >> 3) + (b >> 3) : b; }

template <int MODE = 0>
DI void bp_gemm_in(const Params& p, int l, unsigned char* smem, int vb, int G) {
    constexpr int MTB = NTOK / 256, NT = (INW + 127) / 128;
    const int tid = opaque_tid(), lane = tid & 63, w = tid >> 6, wm = w >> 1, wn = w & 1;
    const int nbig_all = MTB * NT, nbig = (nbig_all / G) * G;
    for (int t = vb; t < nbig; t += G) {
        const int mt = t / NT, nt = t % NT, m0 = mt * 256, n0 = nt * 128;
        const act_t* arow[4]; const act_t* brow[2];
#pragma unroll
        for (int j = 0; j < 4; ++j) arow[j] = p.XN + (size_t)(m0 + 64 * w + 16 * j + (lane >> 2)) * Dm;
#pragma unroll
        for (int j = 0; j < 2; ++j) { const int r = 32 * w + 16 * j + (lane >> 2); brow[j] = n0 + r < INW ? p.WIN_T + ((size_t)l * INW + n0 + r) * Dm : p.ZROW; }
        f32x4 acc[8][4];
        gemm_mainloop_big(smem, arow, brow, Dm, acc);
#pragma unroll
        for (int mi = 0; mi < 8; ++mi)
#pragma unroll
            for (int ni = 0; ni < 4; ++ni) {
                const int m = m0 + wm * 128 + mi * 16 + (lane & 15), n = n0 + wn * 64 + ni * 16 + (lane >> 4) * 4;
                if (n < INW) {
                    const f32x4 v = acc[mi][ni];
                    *(u32x2*)(p.PROJB + (size_t)m * INW + n) = (u32x2){pk2(v[0], v[1]), pk2(v[2], v[3])};
                    if (n >= MG_OFF) *(f32x4*)(p.PG + (size_t)m * 16 + n - MG_OFF) = v;
                }
            }
    }
    const int a_r = tid >> 3;
    for (int t = vb; t < 2 * (nbig_all - nbig); t += G) {
        const int tb = nbig + (t >> 1), mt = tb / NT, nt = tb % NT, m0 = mt * 256 + (t & 1) * 128, n0 = nt * 128;
        const act_t* arow[4]; const act_t* brow[4];
#pragma unroll
        for (int i = 0; i < 4; ++i) { arow[i] = p.XN + (size_t)(m0 + a_r + 32 * i) * Dm; brow[i] = n0 + a_r + 32 * i < INW ? p.WIN_T + ((size_t)l * INW + n0 + a_r + 32 * i) * Dm : p.ZROW; }
        f32x4 acc[4][4];
        gemm_mainloop_bb<MODE>(smem, arow, brow, Dm, acc);
#pragma unroll
        for (int mi = 0; mi < 4; ++mi)
#pragma unroll
            for (int ni = 0; ni < 4; ++ni) {
                const int m = m0 + wm * 64 + mi * 16 + (lane & 15), n = n0 + wn * 64 + ni * 16 + (lane >> 4) * 4;
                if (n < INW) {
                    const f32x4 v = acc[mi][ni];
                    *(u32x2*)(p.PROJB + (size_t)m * INW + n) = (u32x2){pk2(v[0], v[1]), pk2(v[2], v[3])};
                    if (n >= MG_OFF) *(f32x4*)(p.PG + (size_t)m * 16 + n - MG_OFF) = v;
                }
            }
    }
}

DI void mconv_drain(const Params& p, int l, unsigned char* smem, int max_items);
template <bool DRY>
DI void bp_gemm_out(const Params& p, int l, bool upd, unsigned char* smem, int vb, int G) {
    const int MT = (upd ? NTOK : NL) / 128; constexpr int NT = Dm / 128;
    const float* W = p.w_out + (size_t)l * Dm * Dm;
    const int tid = opaque_tid(), lane = tid & 63, w = tid >> 6, wm = w >> 1, wn = w & 1, a_r = tid >> 3, c4 = (w * 8 + (lane >> 3)) * 4;
    for (int t = vb; t < MT * NT; t += G) {
        const int mt = t / NT, nt = t % NT, m0 = mt * 128, n0 = nt * 128;
        const act_t* arow[4];
#pragma unroll
        for (int i = 0; i < 4; ++i) arow[i] = p.MIX + (size_t)(m0 + a_r + 32 * i) * Dm;
        const act_t* brow[4];
#pragma unroll
        for (int i = 0; i < 4; ++i) brow[i] = p.WOUT_T + ((size_t)l * Dm + n0 + a_r + 32 * i) * Dm;
        f32x4 acc[4][4];
        gemm_mainloop_bb(smem, arow, brow, Dm, acc);
#pragma unroll
        for (int mi = 0; mi < 4; ++mi) {
            const int m = m0 + wm * 64 + mi * 16 + (lane & 15);
            const float* g1 = mod_row(p, l, m) + 2 * Dm;
#pragma unroll
            for (int ni = 0; ni < 4; ++ni) {
                const int n = n0 + wn * 64 + ni * 16 + (lane >> 4) * 4;
                f32x4* xp = (f32x4*)(p.X + (size_t)m * Dm + n);
                const f32x4 xo = l == 0 ? *(const f32x4*)((m < NL ? p.x + (size_t)m * Dm : p.ctx + (size_t)(m - NL) * Dm) + n) : *xp;
                if (DRY) *(f32x4*)((float*)p.PROJB + (size_t)m * Dm + n) = xo + *(const f32x4*)(g1 + n) * acc[mi][ni];
                else *xp = xo + *(const f32x4*)(g1 + n) * acc[mi][ni];
            }
        }
    }
    if (!DRY && vb >= (MT * NT) % G) mconv_drain(p, l, smem, 1);
}

DI int* moe_prep(const Params& p, int l, unsigned char* smem) {
    int* s_moff = (int*)(smem + SM_AUX);
    __syncthreads();
    const int t_ = opaque_tid();
    if (t_ < 32) s_moff[64 + t_] = (p.CNT[(l * 32 + t_) * 64] + 127) >> 7;
    __syncthreads();
    if (t_ == 0) { int o = 0; for (int e = 0; e < 32; ++e) { s_moff[e] = o; o += s_moff[64 + e]; } s_moff[32] = o; }
    __syncthreads();
    return s_moff;
}

DI void bp_moe1(const Params& p, int l, unsigned char* smem, int vb, int G) {
    const int* s_moff = moe_prep(p, l, smem);
    const int total = s_moff[32] * 8;
    const int tid = opaque_tid(), lane = tid & 63, w = tid >> 6, wm = w >> 1, wn = w & 1, a_r = tid >> 3, c4 = (w * 8 + (lane >> 3)) * 4;
    for (int t = vb; t < total; t += G) {
        const int mtg = t >> 3, nt = t & 7;
        int e = 0; while (s_moff[e + 1] <= mtg) ++e;
        const int cnt = p.CNT[(l * 32 + e) * 64], lbase = (mtg - s_moff[e]) * 128;
        const act_t* arow[4];
#pragma unroll
        for (int i = 0; i < 4; ++i) { const int li = lbase + a_r + 32 * i; arow[i] = li < cnt ? p.F + (size_t)p.LIST[(size_t)e * NTOK + li] * Dm : p.ZROW; }
        const act_t* brow[4];
#pragma unroll
        for (int i = 0; i < 4; ++i) { const int r = a_r + 32 * i, sel = (r & 63) >> 5, j = nt * 64 + (r >> 6) * 32 + (r & 31); brow[i] = p.W13T + ((size_t)(l & 1) * 32 * 1024 + (size_t)e * 1024 + sel * 512 + j) * Dm; }
        f32x4 acc[4][4];
        gemm_mainloop_bb(smem, arow, brow, Dm, acc);
#pragma unroll
        for (int mi = 0; mi < 4; ++mi)
#pragma unroll
            for (int ni = 0; ni < 2; ++ni) {
                const f32x4 a = acc[mi][ni], b = acc[mi][ni + 2];
                float h[4];
#pragma unroll
                for (int r = 0; r < 4; ++r) h[r] = a[r] / (1.0f + __expf(-a[r])) * b[r];
                const int prow = mtg * 128 + wm * 64 + mi * 16 + (lane & 15), jj = nt * 64 + wn * 32 + ni * 16 + (lane >> 4) * 4;
                *(u32x2*)(p.H + (size_t)prow * 512 + jj) = (u32x2){pk2(h[0], h[1]), pk2(h[2], h[3])};
            }
    }
}

DI void bp_moe2(const Params& p, int l, unsigned char* smem, int vb, int G) {
    const int* s_moff = moe_prep(p, l, smem);
    const int total = s_moff[32] * 8;
    const int tid = opaque_tid(), lane = tid & 63, w = tid >> 6, wm = w >> 1, wn = w & 1, a_r = tid >> 3, c4 = (w * 8 + (lane >> 3)) * 4;
    for (int t = vb; t < total; t += G) {
        const int mtg = t >> 3, nt = t & 7, n0 = nt * 128;
        int e = 0; while (s_moff[e + 1] <= mtg) ++e;
        const act_t* arow[4];
#pragma unroll
        for (int i = 0; i < 4; ++i) arow[i] = p.H + (size_t)(mtg * 128 + a_r + 32 * i) * 512;
        const act_t* brow[4];
#pragma unroll
        for (int i = 0; i < 4; ++i) brow[i] = p.W2T + (((size_t)(l & 1) * 32 + e) * Dm + n0 + a_r + 32 * i) * 512;
        f32x4 acc[4][4];
        gemm_mainloop_bb(smem, arow, brow, 512, acc);
#pragma unroll
        for (int mi = 0; mi < 4; ++mi)
#pragma unroll
            for (int ni = 0; ni < 4; ++ni) {
                const int prow = mtg * 128 + wm * 64 + mi * 16 + (lane & 15), n = n0 + wn * 64 + ni * 16 + (lane >> 4) * 4;
                const f32x4 v = acc[mi][ni];
                *(u32x2*)(p.Y + (size_t)prow * Dm + n) = (u32x2){pk2(v[0], v[1]), pk2(v[2], v[3])};
            }
    }
}

DI void bp_route(const Params& p, int l, bool upd, long gtid, long gsize) {
    ph_norm2_route(p, l, upd, gtid, gsize);
    const long rows = upd ? NTOK : NL;
    for (long row = gtid; row < rows; row += gsize)
#pragma unroll
        for (int kk = 0; kk < 2; ++kk) {
            const int e = p.EID[row * 2 + kk];
            const int pos = atomicAdd(&p.CNT[(l * 32 + e) * 64], 1);
            p.LIST[(size_t)e * NTOK + pos] = (int)row;
            p.POS[row * 2 + kk] = pos;
        }
}

DI void norm1_row(const Params& p, int l, long row, const f32x4 (&x)[4], int lane) {
    float ss = 0.f;
#pragma unroll
    for (int i = 0; i < 4; ++i) ss += x[i][0] * x[i][0] + x[i][1] * x[i][1] + x[i][2] * x[i][2] + x[i][3] * x[i][3];
    ss = wave_sum(ss, lane);
    const float rstd = 1.0f / sqrtf(ss / Dm + EPSF);
    const float* mr = mod_row(p, l, (int)row);
    const float* g = p.norm1_g + l * Dm;
#pragma unroll
    for (int i = 0; i < 4; ++i) {
        const int k = 256 * i + 4 * lane;
        const f32x4 gv = *(const f32x4*)(g + k), sh = *(const f32x4*)(mr + k), sc = *(const f32x4*)(mr + Dm + k);
        const f32x4 y = x[i] * rstd * gv * (1.0f + sc) + sh;
        *(u32x2*)(p.XN + row * Dm + k) = (u32x2){pk2(y[0], y[1]), pk2(y[2], y[3])};
    }
}
DI void bp_norm1(const Params& p, int l, int gwave, int nwaves, int lane) {
    for (long row0 = gwave; row0 < NTOK; row0 += 3 * (long)nwaves) {
        f32x4 x[3][4]; long rw[3];
#pragma unroll
        for (int u = 0; u < 3; ++u) {
            rw[u] = row0 + (long)u * nwaves < NTOK ? row0 + (long)u * nwaves : row0;
            const float* src = rw[u] < NL ? p.x + rw[u] * Dm : p.ctx + (rw[u] - NL) * Dm;
#pragma unroll
            for (int i = 0; i < 4; ++i) x[u][i] = *(const f32x4*)(src + 256 * i + 4 * lane);
        }
#pragma unroll
        for (int u = 0; u < 3; ++u) if (u == 0 || row0 + (long)u * nwaves < NTOK) norm1_row(p, l, rw[u], x[u], lane);
    }
}
template <bool DRY>
DI void bp_combine(const Params& p, int l, bool upd, unsigned char* smem, int gwave, int nwaves, int lane) {
    const int* s_moff = moe_prep(p, l, smem);
    const long rows = upd ? NTOK : NL;
    const long rpw = (rows + nwaves - 1) / nwaves, rbeg = (long)gwave * rpw, rend = rbeg + rpw < rows ? rbeg + rpw : rows;
    constexpr int CU_ = 3;
    int mb_loaded = -1;
    f32x4 g2v[4], mulv[4], addv[4];
    for (long row0 = rbeg; row0 < rend; row0 += CU_) {
        long rw[CU_]; bool ok[CU_]; size_t pa[CU_], pb[CU_]; float g0[CU_], g1[CU_];
#pragma unroll
        for (int u = 0; u < CU_; ++u) {
            rw[u] = row0 + u; ok[u] = rw[u] < rend; if (!ok[u]) rw[u] = row0;
            const int e0 = p.EID[rw[u] * 2], e1 = p.EID[rw[u] * 2 + 1];
            pa[u] = (size_t)s_moff[e0] * 128 + p.POS[rw[u] * 2]; pb[u] = (size_t)s_moff[e1] * 128 + p.POS[rw[u] * 2 + 1];
            g0[u] = p.GATE[rw[u] * 2]; g1[u] = p.GATE[rw[u] * 2 + 1];
        }
        f32x4 ya[CU_][4], xo[CU_][4];
#pragma unroll
        for (int u = 0; u < CU_; ++u)
#pragma unroll
            for (int i = 0; i < 4; ++i) {
                const int k = 256 * i + 4 * lane;
                const u32x2 a2 = *(const u32x2*)(p.Y + pa[u] * Dm + k), b2 = *(const u32x2*)(p.Y + pb[u] * Dm + k);
                ya[u][i] = (f32x4){g0[u] * bflo(a2[0]) + g1[u] * bflo(b2[0]), g0[u] * bfhi(a2[0]) + g1[u] * bfhi(b2[0]), g0[u] * bflo(a2[1]) + g1[u] * bflo(b2[1]), g0[u] * bfhi(a2[1]) + g1[u] * bfhi(b2[1])};
                xo[u][i] = *(const f32x4*)(p.X + rw[u] * Dm + k);
            }
#pragma unroll
        for (int u = 0; u < CU_; ++u) {
            if (!ok[u]) continue;
            const int mb = tok_modrow((int)rw[u]);
            if (mb != mb_loaded) {
                mb_loaded = mb;
                const float* mr = p.mod + ((size_t)l * (Bn + 1) + mb) * MODW;
                const float* mrn = p.mod + ((size_t)(l + 1 < DEPTH ? l + 1 : l) * (Bn + 1) + mb) * MODW;
                const float* gn = p.norm1_g + (l + 1 < DEPTH ? l + 1 : l) * Dm;
#pragma unroll
                for (int i = 0; i < 4; ++i) {
                    const int k = 256 * i + 4 * lane;
                    g2v[i] = *(const f32x4*)(mr + 5 * Dm + k);
                    mulv[i] = *(const f32x4*)(gn + k) * (1.0f + *(const f32x4*)(mrn + Dm + k)); addv[i] = *(const f32x4*)(mrn + k);
                }
            }
            f32x4 x[4]; float ss = 0.f;
#pragma unroll
            for (int i = 0; i < 4; ++i) { x[i] = xo[u][i] + g2v[i] * ya[u][i]; ss += x[i][0] * x[i][0] + x[i][1] * x[i][1] + x[i][2] * x[i][2] + x[i][3] * x[i][3]; }
            if (!DRY) {
#pragma unroll
                for (int i = 0; i < 4; ++i) { const int k = 256 * i + 4 * lane; if (l == DEPTH - 1) *(f32x4*)(p.out + rw[u] * Dm + k) = x[i]; else *(f32x4*)(p.X + rw[u] * Dm + k) = x[i]; }
            }
            if (l < DEPTH - 1) {
                ss = wave_sum(ss, lane);
                const float rstd = 1.0f / sqrtf(ss / Dm + EPSF);
#pragma unroll
                for (int i = 0; i < 4; ++i) {
                    const f32x4 y = x[i] * rstd * mulv[i] + addv[i];
                    *(u32x2*)(p.XN + rw[u] * Dm + 256 * i + 4 * lane) = (u32x2){pk2(y[0], y[1]), pk2(y[2], y[3])};
                }
            }
        }
    }
}

template <int DQK, int DV>
struct AttnCfg {
    static constexpr int KP = DQK * 2 + 16, VP = 144;
    static constexpr int KCH = DQK / 8;
    static constexpr int NK = 64 * KCH, NV = DV * 8, NCH = NK + NV, NLD = (NCH + NTHR - 1) / NTHR;
    static constexpr int LDS_K = 0, LDS_V = 64 * KP, LDS_END = LDS_V + DV * VP;
    static_assert(LDS_END <= GT_END, "attention tile exceeds the LDS budget");
};

template <int DQK, int DV>
DI void attn_block(unsigned char* smem, const act_t* Qb, const act_t* Kb, const act_t* Vt, const int nk, const int q0, f32x16 (&ot)[DV / 32], float& lsum) {
    typedef AttnCfg<DQK, DV> C;
    const int tid = opaque_tid(), lane = tid & 63, w = tid >> 6, h = lane >> 5, qr = lane & 31;
    const int pi = (qr & ~12) | ((qr & 4) << 1) | ((qr & 8) >> 1);
    bf16x8 qf[DQK / 16];
#pragma unroll
    for (int st = 0; st < DQK / 16; ++st) qf[st] = *(const bf16x8*)(Qb + (size_t)(q0 + w * 32 + qr) * DQK + st * 16 + h * 8);
    float m = -1e30f; lsum = 0.f;
#pragma unroll
    for (int db = 0; db < DV / 32; ++db)
#pragma unroll
        for (int r = 0; r < 16; ++r) ot[db][r] = 0.f;
    int goff[C::NLD], ldst[C::NLD];
#pragma unroll
    for (int i = 0; i < C::NLD; ++i) {
        const int c = tid + NTHR * i;
        if (c < C::NK) { const int row = c / C::KCH, part = c % C::KCH; goff[i] = (row * DQK + part * 8) * 2; ldst[i] = C::LDS_K + row * C::KP + part * 16; }
        else { const int cc = (c - C::NK) < C::NV ? c - C::NK : 0, row = cc >> 3, part = cc & 7; goff[i] = (int)((const char*)Vt - (const char*)Kb) + (row * Sn + part * 8) * 2; ldst[i] = C::LDS_V + row * C::VP + part * 16; }
    }
    u32x4 rg[C::NLD];
#pragma unroll
    for (int i = 0; i < C::NLD; ++i) rg[i] = *(const u32x4*)((const char*)Kb + goff[i]);
    const int ntiles = nk >> 6;
    for (int kt = 0; kt < ntiles; ++kt) {
        __syncthreads();
#pragma unroll
        for (int i = 0; i < C::NLD; ++i) if (tid + NTHR * i < C::NCH) *(u32x4*)(smem + ldst[i]) = rg[i];
        __syncthreads();
        if (kt + 1 < ntiles) {
#pragma unroll
            for (int i = 0; i < C::NLD; ++i) rg[i] = *(const u32x4*)((const char*)Kb + goff[i] + (kt + 1) * ((tid + NTHR * i < C::NK) ? 128 * DQK : 128));
        }
        f32x16 sc[2];
        __builtin_amdgcn_s_setprio(1);
#pragma unroll
        for (int kb = 0; kb < 2; ++kb) {
#pragma unroll
            for (int r = 0; r < 16; ++r) sc[kb][r] = 0.f;
#pragma unroll
            for (int st = 0; st < DQK / 16; ++st) {
                const bf16x8 a = *(const bf16x8*)(smem + C::LDS_K + (kb * 32 + pi) * C::KP + st * 32 + h * 16);
                sc[kb] = __builtin_amdgcn_mfma_f32_32x32x16_bf16(a, qf[st], sc[kb], 0, 0, 0);
            }
        }
        __builtin_amdgcn_s_setprio(0);
        float mx = sc[0][0];
#pragma unroll
        for (int kb = 0; kb < 2; ++kb)
#pragma unroll
            for (int r = 0; r < 16; ++r) mx = fmaxf(mx, sc[kb][r]);
        mx = fmaxf(mx, shfl_x(mx, 32, lane));
        const float mn = fmaxf(m, mx), alpha = __builtin_amdgcn_exp2f(m - mn);
        m = mn;
        float ps = 0.f;
#pragma unroll
        for (int kb = 0; kb < 2; ++kb)
#pragma unroll
            for (int r = 0; r < 16; ++r) { sc[kb][r] = __builtin_amdgcn_exp2f(sc[kb][r] - mn); ps += sc[kb][r]; }
        lsum = lsum * alpha + ps;
#pragma unroll
        for (int db = 0; db < DV / 32; ++db)
#pragma unroll
            for (int r = 0; r < 16; ++r) ot[db][r] *= alpha;
#pragma unroll
        for (int kb = 0; kb < 2; ++kb)
#pragma unroll
            for (int s2 = 0; s2 < 2; ++s2) {
                const u32x4 pw = {pk2(sc[kb][8 * s2], sc[kb][8 * s2 + 1]), pk2(sc[kb][8 * s2 + 2], sc[kb][8 * s2 + 3]), pk2(sc[kb][8 * s2 + 4], sc[kb][8 * s2 + 5]), pk2(sc[kb][8 * s2 + 6], sc[kb][8 * s2 + 7])};
                const bf16x8 pf = __builtin_bit_cast(bf16x8, pw);
#pragma unroll
                for (int db = 0; db < DV / 32; ++db) {
                    const bf16x8 a = *(const bf16x8*)(smem + C::LDS_V + (db * 32 + qr) * C::VP + (kb * 32 + 16 * s2 + 8 * h) * 2);
                    ot[db] = __builtin_amdgcn_mfma_f32_32x32x16_bf16(a, pf, ot[db], 0, 0, 0);
                }
            }
    }
    lsum += shfl_x(lsum, 32, lane);
}

DI void bp_attn(const Params& p, int l, bool upd, unsigned char* smem, int bid, int G) {
    constexpr int QTL = Tn / 128, QTC = Cn / 128;
    const int n_dl = Bn * 4 * QTL, n_gl = Bn * 6 * QTL, n_dc = upd ? Bn * 4 * QTC : 0, n_gc = upd ? Bn * 6 * QTC : 0;
    const int tid = opaque_tid(), lane = tid & 63, w = tid >> 6, hh = lane >> 5, qr = lane & 31;
    const float lam_init = lam_init_of(l);
    for (int it = bid; it < n_dl + n_gl + n_dc + n_gc; it += G) {
        int x = it; bool isdiff, isc;
        if (x < n_dl) { isdiff = true; isc = false; }
        else if ((x -= n_dl) < n_gl) { isdiff = false; isc = false; }
        else if ((x -= n_gl) < n_dc) { isdiff = true; isc = true; }
        else { x -= n_dc; isdiff = false; isc = true; }
        const int qt_n = isc ? QTC : QTL, qlen = isc ? Cn : Tn, nk = isc ? Cn : Sn;
        const int qt = x % qt_n, hb = x / qt_n;
        const int q0 = qt * 128;
        if (isdiff) {
            const int h = hb % 4, b = hb / 4;
            const act_t* Vt = p.DVt + (size_t)(b * 4 + h) * 96 * Sn;
            f32x16 ot[3]; float ls;
            f32x4* stash = (f32x4*)(p.DO + ((size_t)blockIdx.x * NTHR + tid) * 48);
            attn_block<48, 96>(smem, (isc ? p.DQC : p.DQL) + ((size_t)(b * 4 + h) * 2) * qlen * 48, p.DK + ((size_t)(b * 4 + h) * 2) * Sn * 48, Vt, nk, q0, ot, ls);
            {
                const float i1 = 1.0f / ls;
#pragma unroll
                for (int db = 0; db < 3; ++db)
#pragma unroll
                    for (int g = 0; g < 4; ++g) stash[db * 4 + g] = (f32x4){ot[db][4 * g] * i1, ot[db][4 * g + 1] * i1, ot[db][4 * g + 2] * i1, ot[db][4 * g + 3] * i1};
            }
            attn_block<48, 96>(smem, (isc ? p.DQC : p.DQL) + ((size_t)(b * 4 + h) * 2 + 1) * qlen * 48, p.DK + ((size_t)(b * 4 + h) * 2 + 1) * Sn * 48, Vt, nk, q0, ot, ls);
            const float* dl = p.diff_lambda + l * 4 * 48;
            float s01 = 0.f, s23 = 0.f;
            for (int i = 0; i < 48; ++i) { s01 += dl[i] * dl[48 + i]; s23 += dl[96 + i] * dl[144 + i]; }
            const float lam = expf(s01) - expf(s23) + lam_init;
            const float i2 = lam / ls;
            float ss = 0.f;
#pragma unroll
            for (int db = 0; db < 3; ++db)
#pragma unroll
                for (int g = 0; g < 4; ++g) {
                    const f32x4 o1 = stash[db * 4 + g];
#pragma unroll
                    for (int r = 0; r < 4; ++r) { const float v = o1[r] - ot[db][4 * g + r] * i2; ot[db][4 * g + r] = v; ss += v * v; }
                }
            ss += shfl_x(ss, 32, lane);
            const float rstd = 1.0f / sqrtf(ss / 96 + EPSF) * (1.0f - lam_init);
            const float* sg = p.diff_subln + l * 96;
            const size_t tok = isc ? (size_t)NL + b * Cn + q0 + w * 32 + qr : (size_t)b * Tn + q0 + w * 32 + qr;
#pragma unroll
            for (int db = 0; db < 3; ++db)
#pragma unroll
                for (int g = 0; g < 4; ++g) {
                    const int dv = db * 32 + 8 * g + 4 * hh;
                    const f32x4 sv = *(const f32x4*)(sg + dv);
                    *(u32x2*)(p.MIX + tok * Dm + h * 96 + dv) = (u32x2){pk2(ot[db][4 * g] * rstd * sv[0], ot[db][4 * g + 1] * rstd * sv[1]),
                                                                      pk2(ot[db][4 * g + 2] * rstd * sv[2], ot[db][4 * g + 3] * rstd * sv[3])};
                }
        } else {
            const int hq = hb % 6, b = hb / 6, kv = hq / 3;
            f32x16 ot[2]; float ls;
            attn_block<64, 64>(smem, (isc ? p.GQC : p.GQL) + (size_t)(b * 6 + hq) * qlen * 64, p.GK + (size_t)(b * 2 + kv) * Sn * 64, p.GVt + (size_t)(b * 2 + kv) * 64 * Sn, nk, q0, ot, ls);
            const float il = 1.0f / ls;
            const size_t tok = isc ? (size_t)NL + b * Cn + q0 + w * 32 + qr : (size_t)b * Tn + q0 + w * 32 + qr;
#pragma unroll
            for (int db = 0; db < 2; ++db)
#pragma unroll
                for (int g = 0; g < 4; ++g) {
                    const int dv = db * 32 + 8 * g + 4 * hh;
                    *(u32x2*)(p.MIX + tok * Dm + 384 + hq * 64 + dv) = (u32x2){pk2(ot[db][4 * g] * il, ot[db][4 * g + 1] * il), pk2(ot[db][4 * g + 2] * il, ot[db][4 * g + 3] * il)};
                }
        }
    }
}

DI void bp_mod(const Params& p, unsigned char* smem, int bid, int G, long gtid, long gsize) {
    const int tid = opaque_tid(), lane = tid & 63, w = tid >> 6;
    float* sl = (float*)smem;
    float* red = sl + (Bn + 1) * Dm;
    for (int i = tid; i < (Bn + 1) * Dm; i += NTHR) sl[i] = silu_f(i < Bn * Dm ? p.c[i] : p.c_ctx[i - Bn * Dm]);
    __syncthreads();
    const int ks = tid >> 4, j4 = tid & 15;
    for (int item = bid; item < DEPTH * (MODW / 64); item += G) {
        const int l = item / (MODW / 64), col = (item % (MODW / 64)) * 64 + j4 * 4;
        const float* wp = p.w_mod + ((size_t)l * Dm + ks * 64) * MODW + col;
        f32x4 acc[Bn + 1];
#pragma unroll
        for (int r = 0; r <= Bn; ++r) acc[r] = (f32x4){0.f, 0.f, 0.f, 0.f};
#pragma unroll 8
        for (int kk = 0; kk < 64; ++kk) {
            const f32x4 wv = *(const f32x4*)(wp + (size_t)kk * MODW);
#pragma unroll
            for (int r = 0; r <= Bn; ++r) acc[r] = acc[r] + sl[r * Dm + ks * 64 + kk] * wv;
        }
#pragma unroll
        for (int r = 0; r <= Bn; ++r)
#pragma unroll
            for (int e = 0; e < 4; ++e) { float v = acc[r][e]; v += shfl_x(v, 16, lane); v += shfl_x(v, 32, lane); acc[r][e] = v; }
        __syncthreads();
        if (lane < 16)
#pragma unroll
            for (int r = 0; r <= Bn; ++r) *(f32x4*)(red + ((w * 16 + lane) * (Bn + 1) + r) * 4) = acc[r];
        __syncthreads();
        if (tid < 16 * (Bn + 1)) {
            const int jj = tid & 15, r = tid >> 4;
            f32x4 t = *(const f32x4*)(p.b_mod + l * MODW + (item % (MODW / 64)) * 64 + jj * 4);
#pragma unroll
            for (int ww = 0; ww < 4; ++ww) t = t + *(const f32x4*)(red + ((ww * 16 + jj) * (Bn + 1) + r) * 4);
            *(f32x4*)(p.mod + ((size_t)l * (Bn + 1) + r) * MODW + (item % (MODW / 64)) * 64 + jj * 4) = t;
        }
    }
    (void)gtid; (void)gsize;
}

DI size_t chunk_slot(int b, int h, int dir, int cid) { return (size_t)((b * 4 + h) * 2 + dir) * NCH + cid; }
DI float wave_incl_scan_add(float v, int lane, bool rev) {
#pragma unroll
    for (int o = 1; o < 64; o <<= 1) { const float t = shfl_i(v, (rev ? lane + o : lane - o) & 63); const bool ok = rev ? (lane + o < 64) : (lane >= o); if (ok) v += t; }
    return v;
}
DI float wave_incl_scan_max(float v, int lane, bool rev) {
#pragma unroll
    for (int o = 1; o < 64; o <<= 1) { const float t = shfl_i(v, (rev ? lane + o : lane - o) & 63); const bool ok = rev ? (lane + o < 64) : (lane >= o); if (ok) v = fmaxf(v, t); }
    return v;
}
DI void bp_post(const Params& p, int l, unsigned char* smem, int bid, int G) {
    const int tid = opaque_tid(), lane = tid & 63, w = tid >> 6;
    constexpr int NGRP = NTOK / 64, N_M = NGRP * 4, N_V = NGRP * 4, N_Q = NTOK / 16;
    volatile int* s_item = (volatile int*)(smem + SM_AUX + 512);
    unsigned* ctr = p.BAR + 3700 + l;
    (void)bid; (void)G;
    for (;;) {
        __syncthreads();
        if (threadIdx.x == 0) *s_item = (int)atomicAdd(ctr, 1u);
        __syncthreads();
        const int item = *s_item;
        if (item >= N_M + N_V + N_Q) break;
        if (item >= N_M + N_V) {
            const int tokb = (item - N_M - N_V) * 16 + w * 4;
            const int j = lane & 15, ug = lane >> 4, third = j / 3;
            f32x4 gvv[6];
#pragma unroll
            for (int st = 0; st < 6; ++st) {
                const int u = st * 4 + ug; const bool d64 = st >= 4;
                const float* gw = !d64 ? ((u >= 8 ? p.diff_k_norm : p.diff_q_norm) + l * 48) : ((u >= 22 ? p.gqa_k_norm : p.gqa_q_norm) + l * 64);
                gvv[st] = (d64 || j < 12) ? *(const f32x4*)(gw + 4 * j) : (f32x4){0.f, 0.f, 0.f, 0.f};
            }
#pragma unroll 2
            for (int t4 = 0; t4 < 4; ++t4) {
                const int tok = tokb + t4; const bool isc = tok >= NL;
                const int b = tok_b(tok), ti = tok_i(tok), sx = tok_s(tok);
                const act_t* pr = p.PROJB + (size_t)tok * INW;
                f32x4 xs[6], t0s[6], t1s[6];
#pragma unroll
                for (int st = 0; st < 6; ++st) {
                    const int u = st * 4 + ug; const bool d64 = st >= 4;
                    const int soff = !d64 ? ((u >= 8 ? DK_OFF : DQ_OFF) + ((u & 7) >> 1) * 96 + (u & 1) * 48) : (u >= 22 ? GK_OFF + (u - 22) * 64 : GQ_OFF + (u - 16) * 64);
                    const bool act = d64 || j < 12;
                    xs[st] = act ? ld4bf(pr + soff + 4 * j) : (f32x4){0.f, 0.f, 0.f, 0.f};
                    const bool second = d64 ? (j >= 8) : (j >= 6);
                    const int pos = second ? (ti & 63) : (ti >> 6);
                    const int fi0 = d64 ? 12 + (j & 3) * 4 : (j - third * 3) * 4;
                    const float* rt = p.ROPE + ((size_t)pos * 28 + (act ? fi0 : 0)) * 2;
                    t0s[st] = *(const f32x4*)rt; t1s[st] = *(const f32x4*)(rt + 4);
                }
#pragma unroll
                for (int st = 0; st < 6; ++st) {
                    const int u = st * 4 + ug; const bool d64 = st >= 4;
                    act_t* dst; float osc;
                    if (!d64) {
                        const bool isk = u >= 8; const int hh = (u & 7) >> 1, ww = u & 1;
                        osc = isk ? 1.0f : 0.14433756729740643f * LOG2E;
                        dst = isk ? p.DK + (((size_t)(b * 4 + hh) * 2 + ww) * Sn + sx) * 48
                                  : (isc ? p.DQC + (((size_t)(b * 4 + hh) * 2 + ww) * Cn + ti) * 48 : p.DQL + (((size_t)(b * 4 + hh) * 2 + ww) * Tn + ti) * 48);
                    } else {
                        const bool isk = u >= 22; const int hh = isk ? u - 22 : u - 16;
                        osc = isk ? 1.0f : 0.125f * LOG2E;
                        dst = isk ? p.GK + ((size_t)(b * 2 + hh) * Sn + sx) * 64 : (isc ? p.GQC + ((size_t)(b * 6 + hh) * Cn + ti) * 64 : p.GQL + ((size_t)(b * 6 + hh) * Tn + ti) * 64);
                    }
                    const bool act = d64 || j < 12;
                    const f32x4 x = xs[st];
                    const float ss = row16_sum(x[0] * x[0] + x[1] * x[1] + x[2] * x[2] + x[3] * x[3]);
                    const float rstd = 1.0f / sqrtf(ss / (d64 ? 64.f : 48.f) + EPSF);
                    f32x4 y = x * rstd * gvv[st];
                    if (!isc) {
                        const int plane = d64 ? (lane ^ 4) : ((third & 1) ? lane - 3 : lane + 3);
                        f32x4 py;
#pragma unroll
                        for (int r = 0; r < 4; ++r) py[r] = shfl_i(y[r], plane);
                        const bool isx2 = d64 ? ((j & 4) != 0) : ((third & 1) != 0);
                        const f32x4 t0 = t0s[st], t1 = t1s[st];
                        const f32x4 cs = {t0[0], t0[2], t1[0], t1[2]}, sn = {t0[1], t0[3], t1[1], t1[3]};
                        y = isx2 ? y * cs + py * sn : y * cs - py * sn;
                    }
                    y = y * osc;
                    if (act) *(u32x2*)(dst + 4 * j) = (u32x2){pk2(y[0], y[1]), pk2(y[2], y[3])};
                }
            }
        } else if (item >= N_M) {
            const int g = (item - N_M) >> 2, qd = (item - N_M) & 3;
            const int tok0 = g * 64;
            const int b = tok_b(tok0), s0 = tok_s(tok0);
            __syncthreads();
#pragma unroll
            for (int i = 0; i < 8; ++i) {
                const int c = tid + NTHR * i, tt = c >> 5, d4 = c & 31, vd = qd * 128 + d4 * 4;
                *(u32x2*)(smem + tt * 264 + d4 * 8) = *(const u32x2*)(p.PROJB + (size_t)(tok0 + tt) * INW + (vd < 384 ? DV_OFF + vd : GV_OFF + vd - 384));
            }
            __syncthreads();
#pragma unroll
            for (int i = 0; i < 4; ++i) {
                const int o = tid + NTHR * i, dloc = o >> 3, t8 = o & 7, vd = qd * 128 + dloc;
                unsigned e[8];
#pragma unroll
                for (int r = 0; r < 8; ++r) e[r] = *(const unsigned short*)(smem + (t8 * 8 + r) * 264 + dloc * 2);
                act_t* dst = vd < 384 ? p.DVt + ((size_t)(b * 4 + vd / 96) * 96 + vd % 96) * Sn : p.GVt + ((size_t)(b * 2 + (vd - 384) / 64) * 64 + (vd - 384) % 64) * Sn;
                *(u32x4*)(dst + s0 + t8 * 8) = (u32x4){e[0] | (e[1] << 16), e[2] | (e[3] << 16), e[4] | (e[5] << 16), e[6] | (e[7] << 16)};
            }
        } else {
            const int g = item >> 2, h = item & 3;
            const int tok0 = g * 64; const bool isc = tok0 >= NL;
            const int b = tok_b(tok0), ti0 = tok_i(tok0);
        float* kf = (float*)smem; float* vf = kf + 64 * 68; float* gl = vf + 64 * 68;
        const int cid = isc ? ti0 / 64 : NCC + ti0 / 64;
            __syncthreads();
            {
                const int tt = tid >> 2, c16 = tid & 3, ti = ti0 + tt, seglen = isc ? Cn : Tn;
                const act_t* pr = p.PROJB + (size_t)(tok0 + tt) * INW;
                const bool hasp = ti > 0, hasn = ti < seglen - 1;
                const float* cw = p.mlstm_conv_w + (size_t)l * 1536; const float* cb = p.mlstm_conv_b + l * 512;
#pragma unroll
                for (int part = 0; part < 2; ++part)
#pragma unroll
                    for (int i4 = 0; i4 < 4; ++i4) {
                        const int ch = part * 256 + h * 64 + c16 * 16 + i4 * 4;
                        f32x4 a = *(const f32x4*)(cb + ch) + ld4bf(pr + MQK_OFF + ch) * *(const f32x4*)(cw + 512 + ch);
                        if (hasp) a = a + ld4bf(pr - INW + MQK_OFF + ch) * *(const f32x4*)(cw + ch);
                        if (hasn) a = a + ld4bf(pr + INW + MQK_OFF + ch) * *(const f32x4*)(cw + 1024 + ch);
#pragma unroll
                        for (int r = 0; r < 4; ++r) a[r] = a[r] / (1.0f + __expf(-a[r]));
                        if (part) { a = a * 0.125f; *(f32x4*)(kf + tt * 68 + c16 * 16 + i4 * 4) = a; }
                        *(u32x2*)(p.MQKB + (size_t)(tok0 + tt) * 512 + ch) = (u32x2){pk2(a[0], a[1]), pk2(a[2], a[3])};
#if !IMPL_MLSTM
                        *(f32x4*)(p.MQK + (size_t)(tok0 + tt) * 512 + ch) = a;
#endif
                    }
#pragma unroll
                for (int i4 = 0; i4 < 4; ++i4) *(f32x4*)(vf + tt * 68 + c16 * 16 + i4 * 4) = ld4bf(pr + MV_OFF + h * 64 + c16 * 16 + i4 * 4);
            }
            if (tid < 64) {
                const float* pr = p.PG + (size_t)(tok0 + tid) * 16; const float* gb = p.mlstm_gate_b + l * 16;
                const f32x4 gt = {pr[h] + gb[h], logsigmoid_f(pr[4 + h] + gb[4 + h]), pr[8 + h] + gb[8 + h], logsigmoid_f(pr[12 + h] + gb[12 + h])};
                gl[tid] = gt[0]; gl[128 + tid] = gt[1]; gl[64 + tid] = gt[2]; gl[192 + tid] = gt[3];
                *(f32x4*)(p.MG4 + ((size_t)(tok0 + tid) * 4 + h) * 4) = gt;
#if !IMPL_MLSTM
                { float* mg = p.MGATE + (size_t)(tok0 + tid) * 16; mg[h] = gt[0]; mg[4 + h] = gt[1]; mg[8 + h] = gt[2]; mg[12 + h] = gt[3]; }
#endif
            }
            __syncthreads();
            if (w < 2) {
                const int dir = w;
                const float lf = gl[128 + dir * 64 + lane], li = gl[dir * 64 + lane];
                const float inc = wave_incl_scan_add(lf, lane, dir == 0);
                const float gg = inc - lf + li;
                float mloc = gg;
#pragma unroll
                for (int o = 32; o > 0; o >>= 1) mloc = fmaxf(mloc, shfl_x(mloc, o, lane));
                gl[256 + dir * 64 + lane] = __expf(gg - mloc);
                const float E = wave_sum(lf, lane);
                if (lane == 0) { float* cs = p.CHS + chunk_slot(b, h, dir, cid) * 2; cs[0] = mloc; cs[1] = E; }
            }
            __syncthreads();
            {
                const int v0 = (tid >> 4) * 4, d0 = (tid & 15) * 4;
                f32x4 a0[4], a1[4];
#pragma unroll
                for (int i = 0; i < 4; ++i) { a0[i] = (f32x4){0.f, 0.f, 0.f, 0.f}; a1[i] = (f32x4){0.f, 0.f, 0.f, 0.f}; }
                for (int sx = 0; sx < 64; ++sx) {
                    const f32x4 vv = *(const f32x4*)(vf + sx * 68 + v0), kk = *(const f32x4*)(kf + sx * 68 + d0);
                    const float w0 = gl[256 + sx], w1 = gl[320 + sx];
#pragma unroll
                    for (int i = 0; i < 4; ++i) { a0[i] = a0[i] + (w0 * vv[i]) * kk; a1[i] = a1[i] + (w1 * vv[i]) * kk; }
                }
                act_t* kv0 = (act_t*)p.KV + chunk_slot(b, h, 0, cid) * 4096; act_t* kv1 = (act_t*)p.KV + chunk_slot(b, h, 1, cid) * 4096;
#pragma unroll
                for (int i = 0; i < 4; ++i) {
                    *(u32x2*)(kv0 + (v0 + i) * 64 + d0) = (u32x2){pk2(a0[i][0], a0[i][1]), pk2(a0[i][2], a0[i][3])};
                    *(u32x2*)(kv1 + (v0 + i) * 64 + d0) = (u32x2){pk2(a1[i][0], a1[i][1]), pk2(a1[i][2], a1[i][3])};
                }
                if (tid < 128) {
                    const int dir = tid >> 6, d = tid & 63;
                    float acc = 0.f;
                    for (int sx = 0; sx < 64; ++sx) acc += gl[256 + dir * 64 + sx] * kf[sx * 68 + d];
                    p.NLC[chunk_slot(b, h, dir, cid) * 64 + d] = acc;
                }
            }
        }
    }
}

constexpr int ML_Q = 0, ML_K = 9216, ML_VT = 18432, ML_C = 29952, ML_QA = 41472, ML_SC = 50688;
constexpr int SC_LI = 0, SC_LF = 128, SC_BB = 256, SC_MT = 384, SC_AA = 512, SC_UU = 640, SC_WCH = 768, SC_CHS = 848;
static_assert(ML_SC + (SC_CHS + 4 * NCH) * 4 <= 65536, "mLSTM LDS layout exceeds the budget");
DI int ml_scanpos(int dir, int cid) { return dir == 0 ? cid : (cid < NCC ? NCC - 1 - cid : NCC + (NCH - 1 - cid)); }
DI int ml_cid_at(int dir, int i) { return dir == 0 ? i : (i < NCC ? NCC - 1 - i : NCH - 1 - (i - NCC)); }
DI void bp_mlstm(const Params& p, int l, bool upd, unsigned char* smem, int bid, int G) {
    const int tid = opaque_tid(), lane = tid & 63, w = tid >> 6;
    float* sc = (float*)(smem + ML_SC);
    constexpr int CPL = Tn / 64;
    const int nlat = Bn * 4 * CPL, nctx = upd ? Bn * 4 * NCC : 0;
    for (int it = bid; it < nlat + nctx; it += G) {
        int b, h, cid;
        if (it < nlat) { cid = NCC + it % CPL; h = (it / CPL) % 4; b = it / (CPL * 4); }
        else { const int x = it - nlat; cid = x % NCC; h = (x / NCC) % 4; b = x / (NCC * 4); }
        const int tok0 = cid < NCC ? NL + b * Cn + cid * 64 : b * Tn + (cid - NCC) * 64;
        __syncthreads();
#pragma unroll
        for (int i = 0; i < 4; ++i) {
            const int c = tid + NTHR * i, isk = c >> 9, cc = c & 511, row = cc >> 3, part = cc & 7;
            *(u32x4*)(smem + (isk ? ML_K : ML_Q) + row * 144 + part * 16) = *(const u32x4*)(p.MQKB + (size_t)(tok0 + row) * 512 + isk * 256 + h * 64 + part * 8);
        }
#pragma unroll
        for (int i = 0; i < 2; ++i) {
            const int c = tid + NTHR * i, tt = c >> 3, v8 = c & 7;
            const u32x4 vv = *(const u32x4*)(p.PROJB + (size_t)(tok0 + tt) * INW + MV_OFF + h * 64 + v8 * 8);
            const unsigned pa = vv[0], pb = vv[1], pc = vv[2], pd = vv[3];
            unsigned char* d0 = smem + ML_VT + (v8 * 8) * 144 + tt * 2;
            *(unsigned short*)(d0) = (unsigned short)pa; *(unsigned short*)(d0 + 144) = (unsigned short)(pa >> 16);
            *(unsigned short*)(d0 + 288) = (unsigned short)pb; *(unsigned short*)(d0 + 432) = (unsigned short)(pb >> 16);
            *(unsigned short*)(d0 + 576) = (unsigned short)pc; *(unsigned short*)(d0 + 720) = (unsigned short)(pc >> 16);
            *(unsigned short*)(d0 + 864) = (unsigned short)pd; *(unsigned short*)(d0 + 1008) = (unsigned short)(pd >> 16);
        }
        if (tid < 144) {
            unsigned zz = 0u; asm volatile("" : "+v"(zz));
            const unsigned one2 = tid < 9 ? 0x3F803F80u : zz;
            *(u32x4*)(smem + ML_VT + 64 * 144 + tid * 16) = (u32x4){one2, one2, one2, one2};
            *(u32x4*)(smem + ML_C + 64 * 144 + tid * 16) = (u32x4){zz, zz, zz, zz};
        }
        if (tid < 64) {
            const f32x4 gt = *(const f32x4*)(p.MG4 + ((size_t)(tok0 + tid) * 4 + h) * 4);
            sc[SC_LI + tid] = gt[0]; sc[SC_LF + tid] = gt[1]; sc[SC_LI + 64 + tid] = gt[2]; sc[SC_LF + 64 + tid] = gt[3];
        } else if (tid < 64 + 2 * NCH) {
            const int dir = (tid - 64) / NCH, i = (tid - 64) % NCH;
            const f32x2 cs = *(const f32x2*)(p.CHS + chunk_slot(b, h, dir, ml_cid_at(dir, i)) * 2);
            sc[SC_CHS + (dir * NCH + i) * 2] = cs[0]; sc[SC_CHS + (dir * NCH + i) * 2 + 1] = cs[1];
        }
        __syncthreads();
        if (w < 2) {
            const int dir = w, pj = ml_scanpos(dir, cid);
            const float lf = sc[SC_LF + dir * 64 + lane], li = sc[SC_LI + dir * 64 + lane];
            const float bsum = wave_incl_scan_add(lf, lane, dir == 1);
            const float u = li - bsum;
            const float cm = wave_incl_scan_max(u, lane, dir == 1);
            float m = 0.f;
            for (int i = 0; i < pj; ++i) { const float* cs = sc + SC_CHS + (dir * NCH + i) * 2; m = fmaxf(cs[1] + m, cs[0]); }
            float F = 0.f;
            for (int i = pj - 1; i >= 0; --i) { const float* cs = sc + SC_CHS + (dir * NCH + i) * 2; if (lane == 0) sc[SC_WCH + dir * 40 + i] = __expf(cs[0] + F - m); F += cs[1]; }
            const float mt = bsum + fmaxf(m, cm);
            sc[SC_BB + dir * 64 + lane] = bsum; sc[SC_UU + dir * 64 + lane] = u; sc[SC_MT + dir * 64 + lane] = mt; sc[SC_AA + dir * 64 + lane] = __expf(bsum + m - mt);
        }
        f32x4 sacc[4];
#pragma unroll
        for (int si = 0; si < 4; ++si) sacc[si] = (f32x4){0.f, 0.f, 0.f, 0.f};
#pragma unroll
        for (int ks = 0; ks < 2; ++ks) {
            const bf16x8 bq = *(const bf16x8*)(smem + ML_Q + (16 * w + (lane & 15)) * 144 + ks * 64 + (lane >> 4) * 16);
#pragma unroll
            for (int si = 0; si < 4; ++si) {
                const bf16x8 ak = *(const bf16x8*)(smem + ML_K + (si * 16 + (lane & 15)) * 144 + ks * 64 + (lane >> 4) * 16);
                sacc[si] = __builtin_amdgcn_mfma_f32_16x16x32_bf16(ak, bq, sacc[si], 0, 0, 0);
            }
        }
        __syncthreads();
        f32x4 hs[4];
#pragma unroll
        for (int vt = 0; vt < 4; ++vt) hs[vt] = (f32x4){0.f, 0.f, 0.f, 0.f};
        const int pcol = 16 * w + (lane & 15);
#pragma unroll 1
        for (int dir = 0; dir < 2; ++dir) {
            {
                const int pj = ml_scanpos(dir, cid);
                f32x4 ca[4]; float na = 0.f;
#pragma unroll
                for (int q4 = 0; q4 < 4; ++q4) ca[q4] = (f32x4){0.f, 0.f, 0.f, 0.f};
                for (int i0 = 0; i0 < pj; i0 += 4) {
                    f32x4 kvv[4][4]; float nv[4], wgs[4];
#pragma unroll
                    for (int u = 0; u < 4; ++u) {
                        const int i = i0 + u < pj ? i0 + u : pj - 1;
                        wgs[u] = i0 + u < pj ? sc[SC_WCH + dir * 40 + i] : 0.f;
                        const size_t slot = chunk_slot(b, h, dir, ml_cid_at(dir, i));
                        const act_t* kv = (const act_t*)p.KV + slot * 4096;
#pragma unroll
                        for (int q4 = 0; q4 < 4; ++q4) kvv[u][q4] = ld4bf(kv + (tid + NTHR * q4) * 4);
                        nv[u] = tid < 64 ? p.NLC[slot * 64 + tid] : 0.f;
                    }
#pragma unroll
                    for (int u = 0; u < 4; ++u) {
#pragma unroll
                        for (int q4 = 0; q4 < 4; ++q4) ca[q4] = ca[q4] + wgs[u] * kvv[u][q4];
                        na += wgs[u] * nv[u];
                    }
                }
#pragma unroll
                for (int q4 = 0; q4 < 4; ++q4) { const int idx = (tid + NTHR * q4) * 4; *(u32x2*)(smem + ML_C + (idx >> 6) * 144 + (idx & 63) * 2) = (u32x2){pk2(ca[q4][0], ca[q4][1]), pk2(ca[q4][2], ca[q4][3])}; }
                if (tid < 64) *(unsigned short*)(smem + ML_C + 64 * 144 + tid * 2) = (unsigned short)pk2(na, 0.f);
            }
            {
                const float mtp = sc[SC_MT + dir * 64 + pcol], bp = sc[SC_BB + dir * 64 + pcol];
#pragma unroll
                for (int si = 0; si < 4; ++si) {
                    const int sb = si * 16 + (lane >> 4) * 4;
                    const f32x4 uu = *(const f32x4*)(sc + SC_UU + dir * 64 + sb);
                    float wv[4];
#pragma unroll
                    for (int r = 0; r < 4; ++r) { const int sx = sb + r; const bool valid = dir == 0 ? (sx <= pcol) : (sx >= pcol); wv[r] = valid ? __expf(bp + uu[r] - mtp) * sacc[si][r] : 0.f; }
                    *(u32x2*)(smem + ML_K + pcol * 144 + sb * 2) = (u32x2){pk2(wv[0], wv[1]), pk2(wv[2], wv[3])};
                }
                const int row = tid >> 2, c16 = tid & 3;
                const float ar = sc[SC_AA + dir * 64 + row];
#pragma unroll
                for (int i2 = 0; i2 < 2; ++i2) {
                    const u32x4 qv = *(const u32x4*)(smem + ML_Q + row * 144 + c16 * 32 + i2 * 16);
                    u32x4 o;
#pragma unroll
                    for (int r = 0; r < 4; ++r) o[r] = pk2(bflo(qv[r]) * ar, bfhi(qv[r]) * ar);
                    *(u32x4*)(smem + ML_QA + row * 144 + c16 * 32 + i2 * 16) = o;
                }
            }
            __syncthreads();
            f32x4 na5[5];
#pragma unroll
            for (int vt = 0; vt < 5; ++vt) na5[vt] = (f32x4){0.f, 0.f, 0.f, 0.f};
#pragma unroll
            for (int ks = 0; ks < 4; ++ks) {
                const bf16x8 bfrag = *(const bf16x8*)(smem + (ks < 2 ? ML_K : ML_QA) + pcol * 144 + (ks & 1) * 64 + (lane >> 4) * 16);
#pragma unroll
                for (int vt = 0; vt < 5; ++vt) {
                    const bf16x8 afrag = *(const bf16x8*)(smem + (ks < 2 ? ML_VT : ML_C) + (vt * 16 + (lane & 15)) * 144 + (ks & 1) * 64 + (lane >> 4) * 16);
                    na5[vt] = __builtin_amdgcn_mfma_f32_16x16x32_bf16(afrag, bfrag, na5[vt], 0, 0, 0);
                }
            }
            const float den = shfl_i(na5[4][0], lane & 15);
            const float dn = 1.0f / fmaxf(fabsf(den), __expf(-sc[SC_MT + dir * 64 + pcol]));
#pragma unroll
            for (int vt = 0; vt < 4; ++vt) hs[vt] = hs[vt] + na5[vt] * dn;
            __syncthreads();
        }
        float ss = 0.f;
#pragma unroll
        for (int vt = 0; vt < 4; ++vt) ss += hs[vt][0] * hs[vt][0] + hs[vt][1] * hs[vt][1] + hs[vt][2] * hs[vt][2] + hs[vt][3] * hs[vt][3];
        ss += shfl_x(ss, 16, lane); ss += shfl_x(ss, 32, lane);
        const float rstd = 1.0f / sqrtf(ss / 64 + EPSF);
        const size_t tok = (size_t)tok0 + pcol;
#pragma unroll
        for (int vt = 0; vt < 4; ++vt) {
            const int v = vt * 16 + (lane >> 4) * 4;
            const f32x4 hn = *(const f32x4*)(p.mlstm_head_norm + l * 256 + h * 64 + v), og = ld4bf(p.PROJB + tok * INW + MO_OFF + h * 64 + v);
            float o[4];
#pragma unroll
            for (int r = 0; r < 4; ++r) o[r] = hs[vt][r] * rstd * hn[r] / (1.0f + __expf(-og[r]));
            *(u32x2*)(p.MIX + tok * Dm + 768 + h * 64 + v) = (u32x2){pk2(o[0], o[1]), pk2(o[2], o[3])};
        }
    }
}

template <bool DRY>
DI void bp_route_fast(const Params& p, int l, bool upd, unsigned char* smem, int bid, int G) {
    const int tid = opaque_tid(), lane = tid & 63, w = tid >> 6;
    const int rows = upd ? NTOK : NL;
    float* Wl = (float*)smem;
    const float* g = p.norm2_g + l * Dm;
    const float* wgp = p.moe_wg + (size_t)l * Dm * 4; const float* wep = p.moe_we + (size_t)l * Dm * 32;
    for (int item = bid; item < rows / 4; item += G) {
        const int r0 = item * 4 + w;
        float rstd[1], pacc[1][36];
#pragma unroll
        for (int rr = 0; rr < 1; ++rr) {
            const float* xr = p.X + (size_t)(r0 + rr) * Dm;
            float ss = 0.f;
#pragma unroll
            for (int j = 0; j < 16; ++j) { const float xv = xr[64 * j + lane]; ss += xv * xv; }
            ss = wave_sum(ss, lane);
            rstd[rr] = 1.0f / sqrtf(ss / Dm + EPSF);
#pragma unroll
            for (int c = 0; c < 36; ++c) pacc[rr][c] = 0.f;
        }
#pragma unroll 1
        for (int ch = 0; ch < 4; ++ch) {
            __syncthreads();
            {
                const int k = ch * 256 + tid;
                *(f32x4*)(Wl + tid * 36) = *(const f32x4*)(wgp + (size_t)k * 4);
#pragma unroll
                for (int q = 0; q < 8; ++q) *(f32x4*)(Wl + tid * 36 + 4 + q * 4) = *(const f32x4*)(wep + (size_t)k * 32 + q * 4);
            }
            __syncthreads();
#pragma unroll
            for (int j = 0; j < 4; ++j) {
                const int k = ch * 256 + 64 * j + lane;
                float f[1];
#pragma unroll
                for (int rr = 0; rr < 1; ++rr) {
                    const float* mr = mod_row(p, l, r0 + rr);
                    f[rr] = p.X[(size_t)(r0 + rr) * Dm + k] * rstd[rr] * g[k] * (1.0f + mr[4 * Dm + k]) + mr[3 * Dm + k];
                    p.F[(size_t)(r0 + rr) * Dm + k] = f2a(f[rr]);
                }
                const float* wr = Wl + (64 * j + lane) * 36;
#pragma unroll
                for (int q = 0; q < 9; ++q) {
                    const f32x4 wq = *(const f32x4*)(wr + q * 4);
#pragma unroll
                    for (int rr = 0; rr < 1; ++rr)
#pragma unroll
                        for (int r = 0; r < 4; ++r) pacc[rr][q * 4 + r] += f[rr] * wq[r];
                }
            }
        }
        __syncthreads();
        float* red = (float*)smem + w * (64 * 37);
#pragma unroll 1
        for (int rr = 0; rr < 1; ++rr) {
#pragma unroll
            for (int c = 0; c < 36; ++c) red[lane * 37 + c] = pacc[0][c];
            __syncthreads();
            float tot = 0.f;
            if (lane < 36) for (int q = 0; q < 64; ++q) tot += red[q * 37 + lane];
            __syncthreads();
            if (lane < 36) red[lane] = tot + (lane < 4 ? p.moe_bg[l * 4 + lane] : p.moe_be[l * 32 + lane - 4]);
            __syncthreads();
            float gmax = red[0]; int gi = 0;
#pragma unroll
            for (int j = 1; j < 4; ++j) { const float v = red[j]; if (v > gmax) { gmax = v; gi = j; } }
            float gsum = 0.f;
#pragma unroll
            for (int j = 0; j < 4; ++j) gsum += expf(red[j] - gmax);
            const float gtop = 1.0f / gsum;
            float e1 = -1e30f, e2 = -1e30f; int i1 = 0, i2 = 0;
#pragma unroll
            for (int j = 0; j < 8; ++j) { const float v = red[4 + gi * 8 + j]; if (v > e1) { e2 = e1; i2 = i1; e1 = v; i1 = j; } else if (v > e2) { e2 = v; i2 = j; } }
            const float g0 = 1.0f / (1.0f + expf(e2 - e1));
            if (lane == 0 && (!DRY || g0 == 123.456f)) {
                const int row = r0 + rr, ea = gi * 8 + i1, eb = gi * 8 + i2;
                p.EID[row * 2] = ea; p.EID[row * 2 + 1] = eb;
                p.GATE[row * 2] = g0 * gtop; p.GATE[row * 2 + 1] = (1.0f - g0) * gtop;
                const int pa = atomicAdd(&p.CNT[(l * 32 + ea) * 64], 1), pb = atomicAdd(&p.CNT[(l * 32 + eb) * 64], 1);
                p.LIST[(size_t)ea * NTOK + pa] = row; p.LIST[(size_t)eb * NTOK + pb] = row;
                p.POS[row * 2] = pa; p.POS[row * 2 + 1] = pb;
            }
            __syncthreads();
        }
    }
}

DI void mconv_item(const Params& p, int l, unsigned char* smem, int it) {
    const int tid = opaque_tid();
    float* T = (float*)smem;
    const int e = it / 24, r = it % 24, mat = r >> 3, q = r & 7;
    const int K = mat < 2 ? Dm : 512, N = mat < 2 ? 512 : Dm;
    const float *w1p = p.moe_w1, *w3p = p.moe_w3, *w2p = p.moe_w2;
    asm volatile("" : "+s"(w1p), "+s"(w3p), "+s"(w2p));
    const float* W = (mat == 0 ? w1p : mat == 1 ? w3p : w2p) + ((size_t)l * 32 + e) * Dm * 512;
    act_t* WT = mat < 2 ? p.W13T + ((size_t)(l & 1) * 32 * 1024 + (size_t)e * 1024 + mat * 512) * Dm : p.W2T + ((size_t)(l & 1) * 32 + e) * Dm * 512;
    const int ntile0 = mat < 2 ? q : 2 * q, nnt = mat < 2 ? 1 : 2, nkt = K / 64;
    const int k = tid >> 2, n16 = (tid & 3) * 16;
    const int n = tid >> 2, k16 = (tid & 3) * 16;
    f32x4 v[4];
#pragma unroll
    for (int i = 0; i < 4; ++i) v[i] = *(const f32x4*)(W + (size_t)k * N + ntile0 * 64 + n16 + i * 4);
    for (int tix = 0; tix < nnt * nkt; ++tix) {
        const int nt = ntile0 + tix / nkt, kt = tix % nkt;
        __syncthreads();
#pragma unroll
        for (int i = 0; i < 4; ++i) { T[k * 65 + n16 + i * 4] = v[i][0]; T[k * 65 + n16 + i * 4 + 1] = v[i][1]; T[k * 65 + n16 + i * 4 + 2] = v[i][2]; T[k * 65 + n16 + i * 4 + 3] = v[i][3]; }
        __syncthreads();
        if (tix + 1 < nnt * nkt) {
            const int nt2 = ntile0 + (tix + 1) / nkt, kt2 = (tix + 1) % nkt;
#pragma unroll
            for (int i = 0; i < 4; ++i) v[i] = *(const f32x4*)(W + (size_t)(kt2 * 64 + k) * N + nt2 * 64 + n16 + i * 4);
        }
        unsigned o[8];
#pragma unroll
        for (int i = 0; i < 8; ++i) o[i] = pk2(T[(k16 + 2 * i) * 65 + n], T[(k16 + 2 * i + 1) * 65 + n]);
        act_t* dst = WT + (size_t)(nt * 64 + n) * K + kt * 64 + k16;
        *(u32x4*)dst = (u32x4){o[0], o[1], o[2], o[3]}; *(u32x4*)(dst + 8) = (u32x4){o[4], o[5], o[6], o[7]};
    }
}

DI void mconv_drain(const Params& p, int l, unsigned char* smem, int max_items) {
    volatile int* s_item = (volatile int*)(smem + SM_AUX + 512);
    unsigned* ctr = p.BAR + 3600 + l;
    for (int n = 0; n < max_items; ++n) {
        __syncthreads();
        if (threadIdx.x == 0) *s_item = (int)atomicAdd(ctr, 1u);
        __syncthreads();
        const int it = *s_item;
        if (it >= 32 * 24) break;
        mconv_item(p, l, smem, it);
    }
}

DI void bp_mixer(const Params& p, int l, bool upd, unsigned char* smem) {
    constexpr int QTL = Tn / 128, QTC = Cn / 128, CPL = Tn / 64, BIG = 1 << 30;
    const int n_al = Bn * 4 * QTL + Bn * 6 * QTL, n_ac = upd ? Bn * 4 * QTC + Bn * 6 * QTC : 0;
    const int n_ml = Bn * 4 * CPL + (upd ? Bn * 4 * NCC : 0);
    const int total = n_al + n_ml + n_ac;
    volatile int* s_item = (volatile int*)(smem + SM_AUX + 512);
    unsigned* ctr = p.BAR + 3500 + l;
#define NEXT_ITEM() ({ __syncthreads(); if (threadIdx.x == 0) *s_item = (int)atomicAdd(ctr, 1u); __syncthreads(); (int)*s_item; })
    int it = NEXT_ITEM();
    while (it < n_al) { bp_attn(p, l, upd, smem, it, BIG); it = NEXT_ITEM(); }
    while (it < n_al + n_ml) { bp_mlstm(p, l, upd, smem, it - n_al, BIG); it = NEXT_ITEM(); }
    while (it < n_al + n_ml + n_ac) { bp_attn(p, l, upd, smem, it - n_ml, BIG); it = NEXT_ITEM(); }
    (void)total;
#undef NEXT_ITEM

}

constexpr int RT_LD = 272, RT_AH = 0, RT_AL = 64 * RT_LD, RT_BH = 128 * RT_LD, RT_BL = RT_BH + 48 * RT_LD, RT_END = RT_BL + 48 * RT_LD;
static_assert(RT_END <= 65536, "router tiles exceed the LDS budget");
DI void mconv_drain(const Params& p, int l, unsigned char* smem, int max_items);
DI void bp_route2(const Params& p, int l, bool upd, unsigned char* smem, int bid, int G) {
    const int tid = opaque_tid(), lane = tid & 63, w = tid >> 6;
    const int rows = upd ? NTOK : NL;
    const float* gn = p.norm2_g + l * Dm;
    for (int item = bid; item < rows / 64; item += G) {
        const int r0 = item * 64;
        {
            const float* mr = mod_row(p, l, r0);
            f32x4 mul[4], add[4];
#pragma unroll
            for (int i = 0; i < 4; ++i) {
                const int k = 256 * i + 4 * lane;
                mul[i] = *(const f32x4*)(gn + k) * (1.0f + *(const f32x4*)(mr + 4 * Dm + k)); add[i] = *(const f32x4*)(mr + 3 * Dm + k);
            }
#pragma unroll 1
            for (int i0 = 0; i0 < 16; i0 += 4) {
                f32x4 x[4][4];
#pragma unroll
                for (int rr = 0; rr < 4; ++rr)
#pragma unroll
                    for (int i = 0; i < 4; ++i) x[rr][i] = *(const f32x4*)(p.X + (size_t)(r0 + w * 16 + i0 + rr) * Dm + 256 * i + 4 * lane);
#pragma unroll
                for (int rr = 0; rr < 4; ++rr) {
                    const int row = r0 + w * 16 + i0 + rr;
                    float ss = 0.f;
#pragma unroll
                    for (int i = 0; i < 4; ++i) ss += x[rr][i][0] * x[rr][i][0] + x[rr][i][1] * x[rr][i][1] + x[rr][i][2] * x[rr][i][2] + x[rr][i][3] * x[rr][i][3];
                    ss = wave_sum(ss, lane);
                    const float rstd = 1.0f / sqrtf(ss / Dm + EPSF);
#pragma unroll
                    for (int i = 0; i < 4; ++i) {
                        const int k = 256 * i + 4 * lane;
                        const f32x4 y = x[rr][i] * rstd * mul[i] + add[i];
                        const unsigned h01 = pk2(y[0], y[1]), h23 = pk2(y[2], y[3]);
                        *(u32x2*)(p.F + (size_t)row * Dm + k) = (u32x2){h01, h23};
                        *(u32x2*)(p.FLO + (size_t)row * Dm + k) = (u32x2){pk2(y[0] - bflo(h01), y[1] - bfhi(h01)), pk2(y[2] - bflo(h23), y[3] - bfhi(h23))};
                    }
                }
            }
        }
        __threadfence_block();
        __syncthreads();
        f32x4 acc[3];
#pragma unroll
        for (int ni = 0; ni < 3; ++ni) acc[ni] = (f32x4){0.f, 0.f, 0.f, 0.f};
        const int s_r = tid >> 4, s_c = tid & 15;
        {
            const act_t* Ah = p.F + (size_t)(r0 + s_r) * Dm + s_c * 8;
            const act_t* Al = p.FLO + (size_t)(r0 + s_r) * Dm + s_c * 8;
            const act_t* Bh = p.WRHI + ((size_t)l * 36 + s_r) * Dm + s_c * 8;
            const act_t* Bl = p.WRLO + ((size_t)l * 36 + s_r) * Dm + s_c * 8;
            u32x4 rah[4], ral[4], rbh[3], rbl[3];
#define RT_LOAD(KOFF) { \
    _Pragma("unroll") for (int i = 0; i < 4; ++i) { rah[i] = *(const u32x4*)(Ah + (size_t)16 * i * Dm + (KOFF)); ral[i] = *(const u32x4*)(Al + (size_t)16 * i * Dm + (KOFF)); } \
    _Pragma("unroll") for (int i = 0; i < 3; ++i) { const bool ok = s_r + 16 * i < 36; \
        rbh[i] = ok ? *(const u32x4*)(Bh + (size_t)16 * i * Dm + (KOFF)) : (u32x4){0u, 0u, 0u, 0u}; rbl[i] = ok ? *(const u32x4*)(Bl + (size_t)16 * i * Dm + (KOFF)) : (u32x4){0u, 0u, 0u, 0u}; } }
            RT_LOAD(0)
#pragma unroll 1
            for (int k0 = 0; k0 < Dm; k0 += 128) {
                __syncthreads();
#pragma unroll
                for (int i = 0; i < 4; ++i) { *(u32x4*)(smem + RT_AH + (s_r + 16 * i) * RT_LD + s_c * 16) = rah[i]; *(u32x4*)(smem + RT_AL + (s_r + 16 * i) * RT_LD + s_c * 16) = ral[i]; }
#pragma unroll
                for (int i = 0; i < 3; ++i) { *(u32x4*)(smem + RT_BH + (s_r + 16 * i) * RT_LD + s_c * 16) = rbh[i]; *(u32x4*)(smem + RT_BL + (s_r + 16 * i) * RT_LD + s_c * 16) = rbl[i]; }
                __syncthreads();
                if (k0 + 128 < Dm) RT_LOAD(k0 + 128)
#pragma unroll
                for (int kk = 0; kk < 4; ++kk) {
                    const int fo = (lane & 15) * RT_LD + kk * 64 + (lane >> 4) * 16;
                    const bf16x8 ah = *(const bf16x8*)(smem + RT_AH + w * 16 * RT_LD + fo), al = *(const bf16x8*)(smem + RT_AL + w * 16 * RT_LD + fo);
#pragma unroll
                    for (int ni = 0; ni < 3; ++ni) {
                        const bf16x8 bh = *(const bf16x8*)(smem + RT_BH + ni * 16 * RT_LD + fo), bl = *(const bf16x8*)(smem + RT_BL + ni * 16 * RT_LD + fo);
                        acc[ni] = __builtin_amdgcn_mfma_f32_16x16x32_bf16(bh, ah, acc[ni], 0, 0, 0);
                        acc[ni] = __builtin_amdgcn_mfma_f32_16x16x32_bf16(bh, al, acc[ni], 0, 0, 0);
                        acc[ni] = __builtin_amdgcn_mfma_f32_16x16x32_bf16(bl, ah, acc[ni], 0, 0, 0);
                    }
                }
            }
#undef RT_LOAD
        }
        __syncthreads();
        float* lg = (float*)smem;
#pragma unroll
        for (int ni = 0; ni < 3; ++ni)
#pragma unroll
            for (int r = 0; r < 4; ++r) lg[(w * 16 + (lane & 15)) * 49 + ni * 16 + (lane >> 4) * 4 + r] = acc[ni][r];
        __syncthreads();
        int* hist = (int*)(smem + 16384);
        if (tid < 64) hist[tid] = 0;
        __syncthreads();
        int ea = 0, eb = 0, ra = 0, rb = 0;
        if (tid < 64) {
            const float* rl = lg + tid * 49;
            float ag[4];
            float gmax = -1e30f; int gi = 0;
#pragma unroll
            for (int j = 0; j < 4; ++j) { ag[j] = rl[j] + p.moe_bg[l * 4 + j]; if (ag[j] > gmax) { gmax = ag[j]; gi = j; } }
            float gsum = 0.f;
#pragma unroll
            for (int j = 0; j < 4; ++j) gsum += expf(ag[j] - gmax);
            const float gtop = 1.0f / gsum;
            float e1 = -1e30f, e2 = -1e30f; int i1 = 0, i2 = 0;
#pragma unroll
            for (int j = 0; j < 8; ++j) { const float v = rl[4 + gi * 8 + j] + p.moe_be[l * 32 + gi * 8 + j]; if (v > e1) { e2 = e1; i2 = i1; e1 = v; i1 = j; } else if (v > e2) { e2 = v; i2 = j; } }
            const float g0 = 1.0f / (1.0f + expf(e2 - e1));
            const int row = r0 + tid; ea = gi * 8 + i1; eb = gi * 8 + i2;
            p.EID[row * 2] = ea; p.EID[row * 2 + 1] = eb;
            p.GATE[row * 2] = g0 * gtop; p.GATE[row * 2 + 1] = (1.0f - g0) * gtop;
            ra = atomicAdd(&hist[ea], 1); rb = atomicAdd(&hist[eb], 1);
        }
        __syncthreads();
        if (tid < 32 && hist[tid] > 0) hist[32 + tid] = atomicAdd(&p.CNT[(l * 32 + tid) * 64], hist[tid]);
        __syncthreads();
        if (tid < 64) {
            const int row = r0 + tid, pa = hist[32 + ea] + ra, pb = hist[32 + eb] + rb;
            p.LIST[(size_t)ea * NTOK + pa] = row; p.LIST[(size_t)eb * NTOK + pb] = row;
            p.POS[row * 2] = pa; p.POS[row * 2 + 1] = pb;
        }
        __syncthreads();
    }
    mconv_drain(p, l, smem, 1 << 30);
}

constexpr int PPL = 9;
constexpr int NPH = 2 + PPL * DEPTH;
static inline bool phase_in_mega(int ph) {
    if (ph < 2) return true;
    const int s = (ph - 2) % PPL;
    return s == 1 ? IMPL_POST : s == 2 ? IMPL_ATTN : s == 3 ? IMPL_MLSTM : s == 5 ? IMPL_ROUTE : true;
}

#define XB_TMO      128
#define XB_XCNT(j)  (256  + 64 * (j))
#define XB_XSUB(j)  (1280 + 64 * (j))
#define XB_XGEN(j)  (2304 + 64 * (j))
#define XB_TOP      3328
#define XB_TOPGEN   3392
#define XCD_BAR_WORDS 3456
#define XB_SPIN_CAP (1u << 22)
#define LAS __attribute__((address_space(3)))
DI unsigned xb_ld(unsigned* p) { return __hip_atomic_load(p, __ATOMIC_RELAXED, __HIP_MEMORY_SCOPE_AGENT); }
DI unsigned xb_add(unsigned* p, unsigned v) { return __hip_atomic_fetch_add(p, v, __ATOMIC_RELAXED, __HIP_MEMORY_SCOPE_AGENT); }
DI unsigned xb_xcc_id() { return (unsigned)__builtin_amdgcn_s_getreg((3 << 11) | 20) & 0xFu; }
#define XB_SPIN(cond, bar) do { unsigned _sp = 0; while (cond) { __builtin_amdgcn_s_sleep(1); \
    if ((++_sp & 255u) == 0u) { if (xb_ld(&(bar)[XB_TMO])) break; if (_sp > XB_SPIN_CAP) { atomicAdd(&(bar)[XB_TMO], 1u); break; } } } } while (0)
struct XcdBarrier { unsigned* bar; unsigned x; volatile LAS unsigned* st; };
DI XcdBarrier xcd_barrier_post(unsigned* bar, volatile LAS unsigned* st) {
    XcdBarrier b; b.bar = bar; b.x = xb_xcc_id(); b.st = st;
    if (threadIdx.x == 0) (void)xb_add(&bar[XB_XCNT(b.x)], 1u);
    return b;
}
DI void xcd_barrier_complete(unsigned* bar, unsigned x, unsigned& nloc, unsigned& nx) {
    const unsigned G = gridDim.x * gridDim.y * gridDim.z;
    unsigned sum, cnt, mine, sp = 0u;
    for (;;) {
        sum = 0u; cnt = 0u; mine = 0u;
#pragma unroll
        for (unsigned j = 0; j < 16; ++j) { const unsigned c = xb_ld(&bar[XB_XCNT(j)]); sum += c; cnt += (c > 0u) ? 1u : 0u; mine = (j == x) ? c : mine; }
        if (sum == G) break;
        __builtin_amdgcn_s_sleep(1);
        if ((++sp & 255u) == 0u) { if (xb_ld(&bar[XB_TMO])) break; if (sp > XB_SPIN_CAP) { atomicAdd(&bar[XB_TMO], 1u); break; } }
    }
    nloc = mine > 0u ? mine : 1u; nx = cnt > 0u ? cnt : 1u;
}
DI void xcd_barrier(const XcdBarrier& b) {
    asm volatile("s_waitcnt vmcnt(0)" ::: "memory");
    __syncthreads();
    if (threadIdx.x == 0) {
        unsigned* bar = b.bar;
        __builtin_amdgcn_s_waitcnt(0);
        unsigned nloc = b.st[0], nx = b.st[1];
        if (nloc == 0u) { xcd_barrier_complete(bar, b.x, nloc, nx); b.st[0] = nloc; b.st[1] = nx; }
        const unsigned old = xb_add(&bar[XB_XSUB(b.x)], 1u);
        const unsigned gen = old / nloc;
        if (old + 1u == (gen + 1u) * nloc) {
            __builtin_amdgcn_fence(__ATOMIC_RELEASE, "agent");
            asm volatile("s_waitcnt vmcnt(0)" ::: "memory");
            const unsigned og = xb_add(&bar[XB_TOP], 1u);
            const unsigned tg = og / nx;
            if (og + 1u == (tg + 1u) * nx) xb_add(&bar[XB_TOPGEN], 1u);
            else XB_SPIN(xb_ld(&bar[XB_TOPGEN]) == tg, bar);
            __builtin_amdgcn_fence(__ATOMIC_ACQUIRE, "agent");
            xb_add(&bar[XB_XGEN(b.x)], 1u);
            asm volatile("s_waitcnt vmcnt(0)" ::: "memory");
        } else {
            XB_SPIN(xb_ld(&bar[XB_XGEN(b.x)]) == gen, bar);
            __builtin_amdgcn_fence(__ATOMIC_ACQUIRE, "agent");
            asm volatile("s_waitcnt vmcnt(0)" ::: "memory");
        }
    }
    __syncthreads();
}

__global__ void __launch_bounds__(NTHR) k_naive(Params p, int ph) {
    const long gtid = (long)blockIdx.x * NTHR + threadIdx.x, gsize = (long)gridDim.x * NTHR;
    const int l = (ph - 2) / PPL, s = (ph - 2) % PPL;
    const bool upd = l < DEPTH - 1;
    (void)gtid; (void)gsize; (void)l; (void)s; (void)upd;
#if !IMPL_POST
    if (s == 1) ph_post(p, l, gtid, gsize);
#endif
#if !IMPL_ATTN
    if (s == 2) { ph_attn_diff(p, l, upd, gtid, gsize); ph_attn_gqa(p, l, upd, gtid, gsize); }
#endif
#if !IMPL_MLSTM
    if (s == 3) ph_mlstm(p, l, upd, gtid, gsize);
#endif
#if !IMPL_ROUTE
    if (s == 5) bp_route(p, l, upd, gtid, gsize);
#endif
}

__global__ void __launch_bounds__(NTHR, 2) k_mega(Params p_arg, int ph_begin, int ph_end) {
    extern __shared__ __attribute__((aligned(16))) unsigned char smem[];
    const Params& p0 = p_arg;
    cg::grid_group grid = cg::this_grid();
    const int G = gridDim.x, vb = xcd_remap(blockIdx.x, G);
    volatile LAS unsigned* xb_st = (volatile LAS unsigned*)(smem + SMEM_BYTES - 16);
    if (threadIdx.x == 0) { xb_st[0] = 0u; xb_st[1] = 0u; xb_st[2] = 0u; }
    __syncthreads();
    const XcdBarrier xb = xcd_barrier_post(p0.BAR, xb_st);
    for (int ph = ph_begin; ph < ph_end; ++ph) {
        Params p;
#if defined(__HIP_DEVICE_COMPILE__)
        {
            typedef const __attribute__((address_space(4))) unsigned long long* kp_t;
            kp_t pk = (kp_t)__builtin_amdgcn_kernarg_segment_ptr();
            asm volatile("" : "+s"(pk));
            static_assert(sizeof(Params) % 8 == 0, "Params is a list of pointers");
#pragma unroll
            for (unsigned i = 0; i < sizeof(Params) / 8; ++i) {
                char* gp = (char*)(__attribute__((address_space(1))) char*)pk[i];
                __builtin_memcpy((char*)&p + 8 * i, &gp, 8);
            }
        }
#else
        p = p0;
#endif
#ifdef PROBE_TS
        if (blockIdx.x == 0 && threadIdx.x == 0) { typedef const __attribute__((address_space(4))) unsigned long long* kp_t; kp_t pk = (kp_t)__builtin_amdgcn_kernarg_segment_ptr(); ((unsigned long long*)pk[offsetof(Params, TS) / 8])[ph] = __builtin_amdgcn_s_memrealtime(); }
#endif
        const int tid = opaque_tid(), lane = tid & 63;
        const long gtid = (long)blockIdx.x * NTHR + tid, gsize = (long)G * NTHR;
        const int gwave = (int)(gtid >> 6), nwaves = (int)(gsize >> 6);
        if (ph == 0) {
            bp_mod(p, smem, blockIdx.x, G, gtid, gsize);
            bp_wconv(p, smem, G - 1 - blockIdx.x, G);
            if (gtid < DEPTH * 32 * 64) p.CNT[gtid] = 0;
            for (long it = gtid; it < (long)DEPTH * 36 * Dm; it += gsize) {
                const int k = (int)(it % Dm), n = (int)((it / Dm) % 36), ll = (int)(it / (36 * Dm));
                const float wv = n < 4 ? p.moe_wg[((size_t)ll * Dm + k) * 4 + n] : p.moe_we[((size_t)ll * Dm + k) * 32 + n - 4];
                const act_t hi = f2a(wv);
                p.WRHI[it] = hi; p.WRLO[it] = f2a(wv - a2f(hi));
            }
            if (gtid < 512) ((unsigned long long*)p.ZROW)[gtid] = 0ull;
            if (gtid < 64 * 28) {
                const int pos = (int)gtid / 28, fi = (int)gtid % 28, nf = fi < 12 ? 12 : 16, i = fi < 12 ? fi : fi - 12;
                const float ang = (float)pos * expf(-(float)i / (float)nf * 9.210340371976184f);
                p.ROPE[gtid * 2] = cosf(ang); p.ROPE[gtid * 2 + 1] = sinf(ang);
            }
        } else if (ph == 1) {
            bp_norm1(p, 0, gwave, nwaves, lane);
        } else {
            const int l = (ph - 2) / PPL, s = (ph - 2) % PPL;
            const bool upd = l < DEPTH - 1;
#ifdef PROBE_DUP
            if ((PROBE_DUP >> s) & 1) {
                if (s == 0) bp_gemm_in<PROBE_MODE>(p, l, smem, vb, G);
                if (s == 1) bp_post(p, l, smem, blockIdx.x, G);
                if (s == 6) bp_moe1(p, l, smem, vb, G);
                if (s == 7) bp_moe2(p, l, smem, vb, G);
                if (s == 4) bp_gemm_out<true>(p, l, upd, smem, vb, G);
                if (s == 8 && l < DEPTH - 1) bp_combine<true>(p, l, upd, smem, gwave, nwaves, lane);
            }
#endif
            switch (s) {
                case 0: bp_gemm_in(p, l, smem, vb, G); break;
#if IMPL_POST
                case 1: bp_post(p, l, smem, blockIdx.x, G); break;
#endif
#if IMPL_ATTN
                case 2: bp_mixer(p, l, upd, smem); break;
#endif
#if IMPL_MLSTM
                case 3: break;
#endif
#if IMPL_ROUTE
                case 5: bp_route2(p, l, upd, smem, blockIdx.x, G); break;
#endif
                case 4: bp_gemm_out<false>(p, l, upd, smem, vb, G); break;
                case 6: bp_moe1(p, l, smem, vb, G); break;
                case 7: bp_moe2(p, l, smem, vb, G); break;
                case 8: bp_combine<false>(p, l, upd, smem, gwave, nwaves, lane); break;
                default: break;
            }
        }
        if (ph + 1 < ph_end && !(ph >= 2 && (ph - 2) % PPL == 2 && IMPL_ATTN && IMPL_MLSTM)) {
            if (ph_end < 0) grid.sync();
            xcd_barrier(xb);
#ifdef PROBE_DUP
            if (PROBE_DUP & 1024) xcd_barrier(xb);
#endif
        }
    }
#ifdef PROBE_TS
    if (blockIdx.x == 0 && __builtin_amdgcn_mbcnt_hi(~0u, __builtin_amdgcn_mbcnt_lo(~0u, 0u)) == 0u && atomicAdd((unsigned*)(smem + SMEM_BYTES - 8), 1u) == 0u) {
        struct { unsigned long long* TS; float* out; } p;
        { typedef const __attribute__((address_space(4))) unsigned long long* kp_t; kp_t pk = (kp_t)__builtin_amdgcn_kernarg_segment_ptr(); p.TS = (unsigned long long*)pk[offsetof(Params, TS) / 8]; p.out = (float*)pk[offsetof(Params, out) / 8]; }
        p.TS[NPH] = __builtin_amdgcn_s_memrealtime();
        unsigned long long tot = 0;
        if (PROBE_TS == 9) tot = p.TS[2] - p.TS[0];
        else if (PROBE_TS == 10) tot = p.TS[NPH] - p.TS[0];
        else for (int l = 0; l < DEPTH; ++l) tot += p.TS[2 + l * PPL + PROBE_TS + 1] - p.TS[2 + l * PPL + PROBE_TS];
        p.out[0] += (float)tot * 0.01f / PROBE_SCALE;
    }
#endif
}

extern "C" void kernel_launch(void* const* d_in, const int* in_sizes, int n_in, void* d_out, int out_size, void* d_ws, size_t ws_size, hipStream_t stream) {
    Params p;
    memset((void*)&p, 0, sizeof(p));
    fill_inputs(p, d_in, d_out);
    carve(p, d_ws);
    static int grid_blocks = 0;
    if (!grid_blocks) {
        int dev = 0, cus = 0, per_cu = 0;
        (void)hipGetDevice(&dev);
        (void)hipDeviceGetAttribute(&cus, hipDeviceAttributeMultiprocessorCount, dev);
        (void)hipFuncSetAttribute((const void*)k_mega, hipFuncAttributeMaxDynamicSharedMemorySize, SMEM_BYTES);
        (void)hipOccupancyMaxActiveBlocksPerMultiprocessor(&per_cu, k_mega, NTHR, SMEM_BYTES);
        if (per_cu > 2) per_cu = 2;
        if (per_cu < 1) per_cu = 1;
        grid_blocks = cus * per_cu;
    }
    (void)hipMemsetAsync(p.BAR, 0, 4096 * sizeof(unsigned), stream);
    int ph = 0;
    while (ph < NPH) {
        if (phase_in_mega(ph)) {
            int b = ph, e = ph;
            while (e < NPH && phase_in_mega(e)) ++e;
            void* args[] = {&p, &b, &e};
            (void)hipLaunchCooperativeKernel((void*)k_mega, dim3(grid_blocks), dim3(NTHR), args, SMEM_BYTES, stream);
            ph = e;
        } else {
            k_naive<<<2048, NTHR, 0, stream>>>(p, ph);
            ++ph;
        }
    }
}
#endif
```

```cpp
#ifndef HOST_TEST
#include <hip/hip_runtime.h>
#include <hip/hip_cooperative_groups.h>
#include <string.h>
namespace cg = cooperative_groups;
#define HD __host__ __device__ __forceinline__
#else
#include <math.h>
#include <string.h>
#define HD inline
#endif
#include <stdint.h>
#include <stddef.h>

#ifndef CFG_B
#define CFG_B 8
#define CFG_T 2048
#define CFG_C 256
#define CFG_DEPTH 4
#endif
#ifndef MK_LAUNCHES
#define MK_LAUNCHES 1
#endif

constexpr int Bn = CFG_B, Tn = CFG_T, Cn = CFG_C, DEPTH = CFG_DEPTH;
constexpr int Dm = 1024, INW = 2832, MODW = 6144;
constexpr int NL = Bn * Tn, NC = Bn * Cn, NTOK = NL + NC, Sn = Cn + Tn;
constexpr int DQ_OFF = 0, DK_OFF = 384, DV_OFF = 768, GQ_OFF = 1152, GK_OFF = 1536, GV_OFF = 1664, MQK_OFF = 1792, MV_OFF = 2304, MO_OFF = 2560, MG_OFF = 2816;
constexpr int NCH = Sn / 64, NCC = Cn / 64;
constexpr int PMAX = 2 * NTOK + 32 * 256;
constexpr float EPSF = 1e-6f;
constexpr float LOG2E = 1.4426950408889634f;

#ifdef ACT_F32
typedef float act_t;
HD act_t f2a(float f) { return f; }
HD float a2f(act_t a) { return a; }
#else
typedef unsigned short act_t;
HD act_t f2a(float f) { unsigned u; memcpy(&u, &f, 4); u += 0x7fffu + ((u >> 16) & 1u); return (act_t)(u >> 16); }
HD float a2f(act_t a) { unsigned u = ((unsigned)a) << 16; float f; memcpy(&f, &u, 4); return f; }
#endif

HD float silu_f(float x) { return x / (1.0f + expf(-x)); }
HD float sigmoid_f(float x) { return 1.0f / (1.0f + expf(-x)); }
HD float logsigmoid_f(float x) { return fminf(x, 0.0f) - log1pf(expf(-fabsf(x))); }
HD float lam_init_of(int l) { return 0.8f - 0.6f * expf(-0.3f * (float)l); }

struct Params {
    const float *x, *c, *ctx, *c_ctx, *norm1_g, *norm2_g, *w_mod, *b_mod, *w_in, *w_out, *diff_q_norm, *diff_k_norm, *diff_lambda, *diff_subln,
        *gqa_q_norm, *gqa_k_norm, *mlstm_conv_w, *mlstm_conv_b, *mlstm_gate_b, *mlstm_head_norm, *moe_wg, *moe_bg, *moe_we, *moe_be, *moe_w1, *moe_w3, *moe_w2;
    float* out;
    float *mod, *X, *PROJ, *MQK, *MGATE, *DO, *GATE, *HN;
    act_t *XN, *DQL, *DQC, *DK, *DVt, *GQL, *GQC, *GK, *GVt, *MIX, *F;
    int* EID;
    int *CNT, *LIST, *POS;
    act_t *H, *Y;
    float *ROPE, *KV, *NLC, *CHS, *MG4, *NST;
    act_t* XB;
    act_t* MQKB;
    unsigned* BAR;
    act_t *WIN_T, *WOUT_T;
    unsigned long long* TS;
    act_t *FLO, *WRHI, *WRLO, *ZROW;
    act_t *W13T, *W2T;
    act_t* PROJB; float* PG; float* LAMV;
};

HD bool tok_ctx(int tok) { return tok >= NL; }
HD int tok_b(int tok) { return tok < NL ? tok / Tn : (tok - NL) / Cn; }
HD int tok_i(int tok) { return tok < NL ? tok % Tn : (tok - NL) % Cn; }
HD int tok_s(int tok) { return tok < NL ? Cn + tok % Tn : (tok - NL) % Cn; }
HD int tok_modrow(int tok) { return tok < NL ? tok / Tn : Bn; }
HD int tok_of(int b, int s) { return s < Cn ? NL + b * Cn + s : b * Tn + (s - Cn); }
HD const float* mod_row(const Params& p, int l, int tok) { return p.mod + ((size_t)l * (Bn + 1) + tok_modrow(tok)) * MODW; }

HD void ph_mod(const Params& p, long gtid, long gsize) {
    for (long it = gtid; it < (long)DEPTH * MODW; it += gsize) {
        const int l = (int)(it / MODW), j = (int)(it % MODW);
        float acc[Bn + 1];
#pragma unroll
        for (int r = 0; r <= Bn; ++r) acc[r] = 0.f;
        const float* w = p.w_mod + (size_t)l * Dm * MODW + j;
        for (int k = 0; k < Dm; ++k) {
            const float wv = w[(size_t)k * MODW];
#pragma unroll
            for (int r = 0; r < Bn; ++r) acc[r] += silu_f(p.c[r * Dm + k]) * wv;
            acc[Bn] += silu_f(p.c_ctx[k]) * wv;
        }
        const float bb = p.b_mod[l * MODW + j];
#pragma unroll
        for (int r = 0; r <= Bn; ++r) p.mod[((size_t)l * (Bn + 1) + r) * MODW + j] = acc[r] + bb;
    }
    for (long it = gtid; it < (long)NTOK * Dm; it += gsize) p.X[it] = it < (long)NL * Dm ? p.x[it] : p.ctx[it - (long)NL * Dm];
}

HD void ph_norm1(const Params& p, int l, long gtid, long gsize) {
    for (long row = gtid; row < NTOK; row += gsize) {
        const float* xr = p.X + row * Dm;
        float ss = 0.f;
        for (int k = 0; k < Dm; ++k) ss += xr[k] * xr[k];
        const float rstd = 1.0f / sqrtf(ss / Dm + EPSF);
        const float* mr = mod_row(p, l, (int)row);
        const float* g = p.norm1_g + l * Dm;
        for (int k = 0; k < Dm; ++k) p.XN[row * Dm + k] = f2a(xr[k] * rstd * g[k] * (1.0f + mr[Dm + k]) + mr[k]);
    }
}

HD void ph_gemm_in(const Params& p, int l, long gtid, long gsize) {
    const float* W = p.w_in + (size_t)l * Dm * INW;
    for (long it = gtid; it < (long)NTOK * INW; it += gsize) {
        const long m = it / INW; const int n = (int)(it % INW);
        const act_t* a = p.XN + m * Dm;
        float acc = 0.f;
        for (int k = 0; k < Dm; ++k) acc += a2f(a[k]) * W[(size_t)k * INW + n];
        p.PROJ[it] = acc;
    }
}

template <int DHn>
HD void qk_unit(const float* src, const float* g, bool rope, int t, float oscale, float (&y)[DHn]) {
    float ss = 0.f;
#pragma unroll
    for (int i = 0; i < DHn; ++i) { y[i] = src[i]; ss += y[i] * y[i]; }
    const float rstd = 1.0f / sqrtf(ss / DHn + EPSF);
#pragma unroll
    for (int i = 0; i < DHn; ++i) y[i] = y[i] * rstd * g[i];
    if (rope) {
        constexpr int half = DHn / 2, nf = half / 2;
        const float posr = (float)(t / 64), posc = (float)(t % 64);
#pragma unroll
        for (int hsel = 0; hsel < 2; ++hsel) {
            const float pos = hsel ? posc : posr;
#pragma unroll
            for (int i = 0; i < nf; ++i) {
                const float fr = expf(-(float)i / (float)nf * 9.210340371976184f);
                const float ang = pos * fr;
                const float cs = cosf(ang), sn = sinf(ang);
                const float x1 = y[hsel * half + i], x2 = y[hsel * half + nf + i];
                y[hsel * half + i] = x1 * cs - x2 * sn;
                y[hsel * half + nf + i] = x2 * cs + x1 * sn;
            }
        }
    }
#pragma unroll
    for (int i = 0; i < DHn; ++i) y[i] *= oscale;
}

HD void ph_post(const Params& p, int l, long gtid, long gsize) {
    constexpr int NU = 27;
    for (long it = gtid; it < (long)NTOK * NU; it += gsize) {
        const int tok = (int)(it / NU), u = (int)(it % NU);
        const bool isc = tok_ctx(tok);
        const int b = tok_b(tok), ti = tok_i(tok), s = tok_s(tok);
        const float* pr = p.PROJ + (size_t)tok * INW;
        if (u < 16) {
            const bool isk = u >= 8; const int h = (u & 7) >> 1, w = u & 1;
            float y[48];
            qk_unit<48>(pr + (isk ? DK_OFF : DQ_OFF) + h * 96 + w * 48, (isk ? p.diff_k_norm : p.diff_q_norm) + l * 48, !isc, ti,
                        isk ? 1.0f : 0.14433756729740643f * LOG2E, y);
            act_t* dst = isk ? p.DK + (((size_t)(b * 4 + h) * 2 + w) * Sn + s) * 48
                             : (isc ? p.DQC + (((size_t)(b * 4 + h) * 2 + w) * Cn + ti) * 48 : p.DQL + (((size_t)(b * 4 + h) * 2 + w) * Tn + ti) * 48);
#pragma unroll
            for (int i = 0; i < 48; ++i) dst[i] = f2a(y[i]);
        } else if (u < 24) {
            const bool isk = u >= 22; const int h = isk ? u - 22 : u - 16;
            float y[64];
            qk_unit<64>(pr + (isk ? GK_OFF : GQ_OFF) + h * 64, (isk ? p.gqa_k_norm : p.gqa_q_norm) + l * 64, !isc, ti, isk ? 1.0f : 0.125f * LOG2E, y);
            act_t* dst = isk ? p.GK + ((size_t)(b * 2 + h) * Sn + s) * 64
                             : (isc ? p.GQC + ((size_t)(b * 6 + h) * Cn + ti) * 64 : p.GQL + ((size_t)(b * 6 + h) * Tn + ti) * 64);
#pragma unroll
            for (int i = 0; i < 64; ++i) dst[i] = f2a(y[i]);
        } else if (u == 24) {
            for (int j = 0; j < 384; ++j) p.DVt[((size_t)(b * 4 + j / 96) * 96 + j % 96) * Sn + s] = f2a(pr[DV_OFF + j]);
        } else if (u == 25) {
            for (int j = 0; j < 128; ++j) p.GVt[((size_t)(b * 2 + j / 64) * 64 + j % 64) * Sn + s] = f2a(pr[GV_OFF + j]);
        } else {
            const int seglen = isc ? Cn : Tn;
            const float* cw = p.mlstm_conv_w + (size_t)l * 3 * 512; const float* cb = p.mlstm_conv_b + l * 512;
            for (int ch = 0; ch < 512; ++ch) {
                float a = cb[ch] + pr[MQK_OFF + ch] * cw[512 + ch];
                if (ti > 0) a += pr[MQK_OFF + ch - INW] * cw[ch];
                if (ti < seglen - 1) a += pr[MQK_OFF + ch + INW] * cw[1024 + ch];
                a = silu_f(a);
                p.MQK[(size_t)tok * 512 + ch] = ch >= 256 ? a * 0.125f : a;
            }
            const float* gb = p.mlstm_gate_b + l * 16;
            for (int j = 0; j < 16; ++j) {
                const float gv = pr[MG_OFF + j] + gb[j];
                p.MGATE[(size_t)tok * 16 + j] = ((j >> 2) & 1) ? logsigmoid_f(gv) : gv;
            }
        }
    }
}

HD void ph_attn_diff(const Params& p, int l, bool upd, long gtid, long gsize) {
    const int nq = upd ? Tn + Cn : Tn;
    const float lam_init = lam_init_of(l);
    for (long it = gtid; it < (long)Bn * 4 * nq; it += gsize) {
        const int qi = (int)(it % nq), h = (int)((it / nq) % 4), b = (int)(it / ((long)nq * 4));
        const bool isc = qi >= Tn; const int ti = isc ? qi - Tn : qi;
        const int nk = isc ? Cn : Sn;
        const int tok = isc ? NL + b * Cn + ti : b * Tn + ti;
        float* dob = p.DO + ((size_t)(b * 4 + h) * (Tn + Cn) + qi) * 96;
        const act_t* vt = p.DVt + (size_t)(b * 4 + h) * 96 * Sn;
        float l2 = 1.f;
        float o[96];
        for (int w = 0; w < 2; ++w) {
            const act_t* qp = isc ? p.DQC + (((size_t)(b * 4 + h) * 2 + w) * Cn + ti) * 48 : p.DQL + (((size_t)(b * 4 + h) * 2 + w) * Tn + ti) * 48;
            const act_t* kp = p.DK + ((size_t)(b * 4 + h) * 2 + w) * Sn * 48;
            float q[48];
#pragma unroll
            for (int i = 0; i < 48; ++i) q[i] = a2f(qp[i]);
#pragma unroll
            for (int i = 0; i < 96; ++i) o[i] = 0.f;
            float m = -1e30f, lsum = 0.f;
            for (int s = 0; s < nk; ++s) {
                float sc = 0.f;
#pragma unroll
                for (int i = 0; i < 48; ++i) sc += q[i] * a2f(kp[(size_t)s * 48 + i]);
                const float mn = fmaxf(m, sc), alpha = exp2f(m - mn), pe = exp2f(sc - mn);
                lsum = lsum * alpha + pe;
#pragma unroll
                for (int i = 0; i < 96; ++i) o[i] = o[i] * alpha + pe * a2f(vt[(size_t)i * Sn + s]);
                m = mn;
            }
            if (w == 0) {
#pragma unroll
                for (int i = 0; i < 96; ++i) dob[i] = o[i] / lsum;
            } else l2 = lsum;
        }
        const float* dl = p.diff_lambda + l * 4 * 48;
        float s01 = 0.f, s23 = 0.f;
        for (int i = 0; i < 48; ++i) { s01 += dl[i] * dl[48 + i]; s23 += dl[96 + i] * dl[144 + i]; }
        const float lam = expf(s01) - expf(s23) + lam_init;
        float ss = 0.f;
#pragma unroll
        for (int i = 0; i < 96; ++i) { o[i] = dob[i] - lam * o[i] / l2; ss += o[i] * o[i]; }
        const float rstd = 1.0f / sqrtf(ss / 96 + EPSF);
        const float* sg = p.diff_subln + l * 96;
#pragma unroll
        for (int i = 0; i < 96; ++i) p.MIX[(size_t)tok * Dm + h * 96 + i] = f2a(o[i] * rstd * sg[i] * (1.0f - lam_init));
    }
}

HD void ph_attn_gqa(const Params& p, int l, bool upd, long gtid, long gsize) {
    const int nq = upd ? Tn + Cn : Tn;
    for (long it = gtid; it < (long)Bn * 6 * nq; it += gsize) {
        const int qi = (int)(it % nq), hq = (int)((it / nq) % 6), b = (int)(it / ((long)nq * 6));
        const bool isc = qi >= Tn; const int ti = isc ? qi - Tn : qi;
        const int nk = isc ? Cn : Sn, kv = hq / 3;
        const int tok = isc ? NL + b * Cn + ti : b * Tn + ti;
        const act_t* qp = isc ? p.GQC + ((size_t)(b * 6 + hq) * Cn + ti) * 64 : p.GQL + ((size_t)(b * 6 + hq) * Tn + ti) * 64;
        const act_t* kp = p.GK + (size_t)(b * 2 + kv) * Sn * 64;
        const act_t* vt = p.GVt + (size_t)(b * 2 + kv) * 64 * Sn;
        float q[64], o[64];
#pragma unroll
        for (int i = 0; i < 64; ++i) { q[i] = a2f(qp[i]); o[i] = 0.f; }
        float m = -1e30f, lsum = 0.f;
        for (int s = 0; s < nk; ++s) {
            float sc = 0.f;
#pragma unroll
            for (int i = 0; i < 64; ++i) sc += q[i] * a2f(kp[(size_t)s * 64 + i]);
            const float mn = fmaxf(m, sc), alpha = exp2f(m - mn), pe = exp2f(sc - mn);
            lsum = lsum * alpha + pe;
#pragma unroll
            for (int i = 0; i < 64; ++i) o[i] = o[i] * alpha + pe * a2f(vt[(size_t)i * Sn + s]);
            m = mn;
        }
#pragma unroll
        for (int i = 0; i < 64; ++i) p.MIX[(size_t)tok * Dm + 384 + hq * 64 + i] = f2a(o[i] / lsum);
    }
}

HD void mlstm_dir_naive(const Params& p, int b, int h, bool isc, int ti, int dir, const float (&q)[64], float (&hout)[64]) {
    float num[64];
#pragma unroll
    for (int i = 0; i < 64; ++i) num[i] = 0.f;
    float den = 0.f, m = -1e30f, Dg = 0.f;
    for (int seg = 0; seg < (isc ? 1 : 2); ++seg) {
        const bool sc_ = seg == 1 ? true : isc;
        const int len = sc_ ? Cn : Tn;
        int cnt, start, step;
        if (seg == 0) { start = ti; step = dir == 0 ? -1 : 1; cnt = dir == 0 ? ti + 1 : len - ti; }
        else { start = dir == 0 ? len - 1 : 0; step = dir == 0 ? -1 : 1; cnt = len; }
        for (int c = 0, si = start; c < cnt; ++c, si += step) {
            const int tk = sc_ ? NL + b * Cn + si : b * Tn + si;
            const float li = p.MGATE[(size_t)tk * 16 + dir * 8 + h], lf = p.MGATE[(size_t)tk * 16 + dir * 8 + 4 + h];
            const float lw = Dg + li;
            const float* kr = p.MQK + (size_t)tk * 512 + 256 + h * 64;
            const float* vr = p.PROJ + (size_t)tk * INW + MV_OFF + h * 64;
            float qk = 0.f;
#pragma unroll
            for (int i = 0; i < 64; ++i) qk += q[i] * kr[i];
            const float mn = fmaxf(m, lw), alpha = expf(m - mn), w = expf(lw - mn) * qk;
            den = den * alpha + w;
#pragma unroll
            for (int i = 0; i < 64; ++i) num[i] = num[i] * alpha + w * vr[i];
            m = mn;
            Dg += lf;
        }
    }
    const float dn = fmaxf(fabsf(den), expf(-m));
#pragma unroll
    for (int i = 0; i < 64; ++i) hout[i] += num[i] / dn;
}

HD void ph_mlstm(const Params& p, int l, bool upd, long gtid, long gsize) {
    const int nq = upd ? Tn + Cn : Tn;
    for (long it = gtid; it < (long)Bn * 4 * nq; it += gsize) {
        const int qi = (int)(it % nq), h = (int)((it / nq) % 4), b = (int)(it / ((long)nq * 4));
        const bool isc = qi >= Tn; const int ti = isc ? qi - Tn : qi;
        const int tok = isc ? NL + b * Cn + ti : b * Tn + ti;
        float q[64], hh[64];
#pragma unroll
        for (int i = 0; i < 64; ++i) { q[i] = p.MQK[(size_t)tok * 512 + h * 64 + i]; hh[i] = 0.f; }
        mlstm_dir_naive(p, b, h, isc, ti, 0, q, hh);
        mlstm_dir_naive(p, b, h, isc, ti, 1, q, hh);
        float ss = 0.f;
#pragma unroll
        for (int i = 0; i < 64; ++i) ss += hh[i] * hh[i];
        const float rstd = 1.0f / sqrtf(ss / 64 + EPSF);
        const float* hn = p.mlstm_head_norm + l * 256 + h * 64;
        const float* og = p.PROJ + (size_t)tok * INW + MO_OFF + h * 64;
#pragma unroll
        for (int i = 0; i < 64; ++i) p.MIX[(size_t)tok * Dm + 768 + h * 64 + i] = f2a(hh[i] * rstd * hn[i] * sigmoid_f(og[i]));
    }
}

HD void ph_gemm_out(const Params& p, int l, bool upd, long gtid, long gsize) {
    const float* W = p.w_out + (size_t)l * Dm * Dm;
    const long rows = upd ? NTOK : NL;
    for (long it = gtid; it < rows * Dm; it += gsize) {
        const long m = it / Dm; const int n = (int)(it % Dm);
        const act_t* a = p.MIX + m * Dm;
        float acc = 0.f;
        for (int k = 0; k < Dm; ++k) acc += a2f(a[k]) * W[(size_t)k * Dm + n];
        p.X[it] += mod_row(p, l, (int)m)[2 * Dm + n] * acc;
    }
}

HD void ph_norm2_route(const Params& p, int l, bool upd, long gtid, long gsize) {
    const long rows = upd ? NTOK : NL;
    for (long row = gtid; row < rows; row += gsize) {
        const float* xr = p.X + row * Dm;
        float ss = 0.f;
        for (int k = 0; k < Dm; ++k) ss += xr[k] * xr[k];
        const float rstd = 1.0f / sqrtf(ss / Dm + EPSF);
        const float* mr = mod_row(p, l, (int)row);
        const float* g = p.norm2_g + l * Dm;
        const float* wg = p.moe_wg + (size_t)l * Dm * 4; const float* we = p.moe_we + (size_t)l * Dm * 32;
        float ag[4], ae[32];
#pragma unroll
        for (int j = 0; j < 4; ++j) ag[j] = 0.f;
#pragma unroll
        for (int j = 0; j < 32; ++j) ae[j] = 0.f;
        for (int k = 0; k < Dm; ++k) {
            const float f = xr[k] * rstd * g[k] * (1.0f + mr[4 * Dm + k]) + mr[3 * Dm + k];
            p.F[row * Dm + k] = f2a(f);
#pragma unroll
            for (int j = 0; j < 4; ++j) ag[j] += f * wg[k * 4 + j];
#pragma unroll
            for (int j = 0; j < 32; ++j) ae[j] += f * we[k * 32 + j];
        }
        float gmax = -1e30f; int gi = 0;
#pragma unroll
        for (int j = 0; j < 4; ++j) { ag[j] += p.moe_bg[l * 4 + j]; if (ag[j] > gmax) { gmax = ag[j]; gi = j; } }
        float gsum = 0.f;
#pragma unroll
        for (int j = 0; j < 4; ++j) gsum += expf(ag[j] - gmax);
        const float gtop = 1.0f / gsum;
        float e1 = -1e30f, e2 = -1e30f; int i1 = 0, i2 = 0;
#pragma unroll
        for (int grp = 0; grp < 4; ++grp) {
            if (grp == gi) {
#pragma unroll
                for (int j = 0; j < 8; ++j) {
                    const float v = ae[grp * 8 + j] + p.moe_be[l * 32 + grp * 8 + j];
                    if (v > e1) { e2 = e1; i2 = i1; e1 = v; i1 = j; } else if (v > e2) { e2 = v; i2 = j; }
                }
            }
        }
        const float g0 = 1.0f / (1.0f + expf(e2 - e1));
        p.EID[row * 2] = gi * 8 + i1; p.EID[row * 2 + 1] = gi * 8 + i2;
        p.GATE[row * 2] = g0 * gtop; p.GATE[row * 2 + 1] = (1.0f - g0) * gtop;
    }
}

HD void ph_moe1(const Params& p, int l, bool upd, long gtid, long gsize) {
    const long rows = upd ? NTOK : NL;
    for (long it = gtid; it < rows * 2 * 512; it += gsize) {
        const long rk = it / 512; const int j = (int)(it % 512);
        const long row = rk >> 1;
        const int e = p.EID[rk];
        const float* W1 = p.moe_w1 + ((size_t)l * 32 + e) * Dm * 512 + j; const float* W3 = p.moe_w3 + ((size_t)l * 32 + e) * Dm * 512 + j;
        const act_t* f = p.F + row * Dm;
        float a = 0.f, bb = 0.f;
        for (int k = 0; k < Dm; ++k) { const float fv = a2f(f[k]); a += fv * W1[(size_t)k * 512]; bb += fv * W3[(size_t)k * 512]; }
        p.HN[it] = silu_f(a) * bb;
    }
}

HD void ph_moe2(const Params& p, int l, bool upd, long gtid, long gsize) {
    const long rows = upd ? NTOK : NL;
    for (long it = gtid; it < rows * Dm; it += gsize) {
        const long row = it / Dm; const int d = (int)(it % Dm);
        float y = 0.f;
        for (int kk = 0; kk < 2; ++kk) {
            const int e = p.EID[row * 2 + kk];
            const float* W2 = p.moe_w2 + ((size_t)l * 32 + e) * 512 * Dm + d;
            const float* hn = p.HN + (row * 2 + kk) * 512;
            float acc = 0.f;
            for (int j = 0; j < 512; ++j) acc += hn[j] * W2[(size_t)j * Dm];
            y += p.GATE[row * 2 + kk] * acc;
        }
        const float xn = p.X[it] + mod_row(p, l, (int)row)[5 * Dm + d] * y;
        p.X[it] = xn;
        if (l == DEPTH - 1) p.out[it] = xn;
    }
}

constexpr int PH_PER_LAYER = 8;
constexpr int N_PHASES = 1 + DEPTH * PH_PER_LAYER;
HD void run_phase(const Params& p, int ph, long gtid, long gsize) {
    if (ph == 0) { ph_mod(p, gtid, gsize); return; }
    const int l = (ph - 1) / PH_PER_LAYER, s = (ph - 1) % PH_PER_LAYER;
    const bool upd = l < DEPTH - 1;
    switch (s) {
        case 0: ph_norm1(p, l, gtid, gsize); break;
        case 1: ph_gemm_in(p, l, gtid, gsize); break;
        case 2: ph_post(p, l, gtid, gsize); break;
        case 3: ph_attn_diff(p, l, upd, gtid, gsize); ph_attn_gqa(p, l, upd, gtid, gsize); ph_mlstm(p, l, upd, gtid, gsize); break;
        case 4: ph_gemm_out(p, l, upd, gtid, gsize); break;
        case 5: ph_norm2_route(p, l, upd, gtid, gsize); break;
        case 6: ph_moe1(p, l, upd, gtid, gsize); break;
        default: ph_moe2(p, l, upd, gtid, gsize); break;
    }
}

struct Carver { char* base; size_t off; template <class T> T* take(size_t n) { T* r = (T*)(base + off); off += (n * sizeof(T) + 255) & ~(size_t)255; return r; } };
static inline size_t carve(Params& p, void* ws) {
    Carver c{(char*)ws, 0};
    p.mod = c.take<float>((size_t)DEPTH * (Bn + 1) * MODW);
    p.X = c.take<float>((size_t)NTOK * Dm);
#ifdef HOST_TEST
    p.PROJ = c.take<float>((size_t)NTOK * INW);
#endif
#ifdef HOST_TEST
    p.MQK = c.take<float>((size_t)NTOK * 512);
    p.MGATE = c.take<float>((size_t)NTOK * 16);
#endif
    p.DO = c.take<float>((size_t)Bn * 4 * (Tn + Cn) * 96);
    p.GATE = c.take<float>((size_t)NTOK * 2);
#ifdef HOST_TEST
    p.HN = c.take<float>((size_t)NTOK * 2 * 512);
#endif
    p.XN = c.take<act_t>((size_t)NTOK * Dm);
    p.DQL = c.take<act_t>((size_t)Bn * 4 * 2 * Tn * 48);
    p.DQC = c.take<act_t>((size_t)Bn * 4 * 2 * Cn * 48);
    p.DK = c.take<act_t>((size_t)Bn * 4 * 2 * Sn * 48);
    p.DVt = c.take<act_t>((size_t)Bn * 4 * 96 * Sn);
    p.GQL = c.take<act_t>((size_t)Bn * 6 * Tn * 64);
    p.GQC = c.take<act_t>((size_t)Bn * 6 * Cn * 64);
    p.GK = c.take<act_t>((size_t)Bn * 2 * Sn * 64);
    p.GVt = c.take<act_t>((size_t)Bn * 2 * 64 * Sn);
    p.MIX = c.take<act_t>((size_t)NTOK * Dm);
    p.F = c.take<act_t>((size_t)(NTOK + 1) * Dm);
    p.EID = c.take<int>((size_t)NTOK * 2);
    p.CNT = c.take<int>((size_t)DEPTH * 32 * 64);
    p.LIST = c.take<int>((size_t)32 * NTOK);
    p.POS = c.take<int>((size_t)NTOK * 2);
    p.H = c.take<act_t>((size_t)PMAX * 512);
    p.Y = c.take<act_t>((size_t)PMAX * Dm);
    p.ROPE = c.take<float>((size_t)64 * 28 * 2);
    p.KV = c.take<float>((size_t)Bn * 4 * 2 * NCH * 4096);
    p.NLC = c.take<float>((size_t)Bn * 4 * 2 * NCH * 64);
    p.CHS = c.take<float>((size_t)Bn * 4 * 2 * NCH * 2);
    p.MG4 = c.take<float>((size_t)NTOK * 16);
    p.NST = c.take<float>((size_t)Bn * 4 * 2 * NCH * 64);
    p.XB = c.take<act_t>((size_t)NTOK * Dm);
    p.MQKB = c.take<act_t>((size_t)NTOK * 512);
    p.BAR = c.take<unsigned>(4096);
    p.WIN_T = c.take<act_t>((size_t)DEPTH * INW * Dm);
    p.WOUT_T = c.take<act_t>((size_t)DEPTH * Dm * Dm);
    p.TS = c.take<unsigned long long>(256);
    p.FLO = c.take<act_t>((size_t)NTOK * Dm);
    p.WRHI = c.take<act_t>((size_t)DEPTH * 36 * Dm);
    p.WRLO = c.take<act_t>((size_t)DEPTH * 36 * Dm);
    p.ZROW = c.take<act_t>(2048);
    p.W13T = c.take<act_t>((size_t)2 * 32 * 1024 * Dm);
    p.W2T = c.take<act_t>((size_t)2 * 32 * Dm * 512);
    p.PROJB = c.take<act_t>((size_t)NTOK * INW);
    p.PG = c.take<float>((size_t)NTOK * 16);
    p.LAMV = c.take<float>(64);
    return c.off;
}
static inline void fill_inputs(Params& p, void* const* d_in, void* d_out) {
    const float** f = (const float**)&p;
    for (int i = 0; i < 27; ++i) f[i] = (const float*)d_in[i];
    p.out = (float*)d_out;
}


#ifndef HOST_TEST
typedef short bf16x8 __attribute__((ext_vector_type(8)));
typedef float f32x2 __attribute__((ext_vector_type(2)));
typedef float f32x4 __attribute__((ext_vector_type(4)));
typedef float f32x16 __attribute__((ext_vector_type(16)));
typedef unsigned u32x2 __attribute__((ext_vector_type(2)));
typedef unsigned u32x4 __attribute__((ext_vector_type(4)));
typedef __bf16 bf16x2_t __attribute__((ext_vector_type(2)));
#define DI __device__ __forceinline__
DI unsigned pk2(float a, float b) { f32x2 v = {a, b}; return __builtin_bit_cast(unsigned, __builtin_convertvector(v, bf16x2_t)); }
DI float bflo(unsigned u) { return __uint_as_float(u << 16); }
DI float bfhi(unsigned u) { return __uint_as_float(u & 0xffff0000u); }
DI f32x4 ld4bf(const act_t* q) { const u32x2 v = *(const u32x2*)q; return (f32x4){bflo(v[0]), bfhi(v[0]), bflo(v[1]), bfhi(v[1])}; }
DI float shfl_i(float v, int src) { return __int_as_float(__builtin_amdgcn_ds_bpermute(src << 2, __float_as_int(v))); }
DI float shfl_x(float v, int o, int lane) { return shfl_i(v, lane ^ o); }
DI float row16_sum(float v) {
#define ROR_(x, n) __int_as_float(__builtin_amdgcn_update_dpp(0, __float_as_int(x), 0x120 + (n), 0xF, 0xF, false))
    v += ROR_(v, 8); v += ROR_(v, 4); v += ROR_(v, 2); v += ROR_(v, 1);
#undef ROR_
    return v;
}
DI float wave_sum(float v, int lane) {
#pragma unroll
    for (int o = 32; o > 0; o >>= 1) v += shfl_x(v, o, lane);
    return v;
}

constexpr int NTHR = 256, RTHR = 512;
DI void lds_barrier() { asm volatile("s_waitcnt lgkmcnt(0)" ::: "memory"); __builtin_amdgcn_s_barrier(); asm volatile("" ::: "memory"); }
DI int opaque_tid() { int t = threadIdx.x & 255; asm volatile("" : "+v"(t)); return t; }
constexpr int GT_LD = 144;
constexpr int GT_AS = 0, GT_BS = 128 * GT_LD, GT_END = 256 * GT_LD;
constexpr int SM_AUX = 65536;
constexpr int SMEM_BYTES = 66 * 1024;

#ifndef IMPL_POST
#define IMPL_POST 1
#endif
#ifndef IMPL_ATTN
#define IMPL_ATTN 1
#endif
#ifndef IMPL_MLSTM
#define IMPL_MLSTM 1
#endif
#ifndef IMPL_ROUTE
#define IMPL_ROUTE 1
#endif
DI int gt_off(int r, int c) { return r * 128 + ((c ^ ((r >> 1) & 7)) << 4); }
constexpr int GT_STAGE = 32768, GT_B = 16384;
#define GT_COMPUTE(BUF) \
    _Pragma("unroll") for (int kk = 0; kk < 2; ++kk) { \
        bf16x8 af[4], bfr[4]; \
        _Pragma("unroll") for (int mi = 0; mi < 4; ++mi) af[mi] = *(const bf16x8*)(smem + (BUF) * GT_STAGE + gt_off(wm * 64 + mi * 16 + (lane & 15), kk * 4 + (lane >> 4))); \
        _Pragma("unroll") for (int ni = 0; ni < 4; ++ni) bfr[ni] = *(const bf16x8*)(smem + (BUF) * GT_STAGE + GT_B + gt_off(wn * 64 + ni * 16 + (lane & 15), kk * 4 + (lane >> 4))); \
        _Pragma("unroll") for (int mi = 0; mi < 4; ++mi) \
            _Pragma("unroll") for (int ni = 0; ni < 4; ++ni) acc[mi][ni] = __builtin_amdgcn_mfma_f32_16x16x32_bf16(bfr[ni], af[mi], acc[mi][ni], 0, 0, 0); }

DI void gemm_mainloop(unsigned char* smem, const act_t* const (&arow)[4], const float* bptr, const int ldb, const int K, f32x4 (&acc)[4][4]) {
    const int tid = opaque_tid(), lane = tid & 63, w = tid >> 6, wm = w >> 1, wn = w & 1;
    const int a_r = tid >> 3, a_c = tid & 7, kg = lane & 7, c4 = (w * 8 + (lane >> 3)) * 4;
#pragma unroll
    for (int mi = 0; mi < 4; ++mi)
#pragma unroll
        for (int ni = 0; ni < 4; ++ni) acc[mi][ni] = (f32x4){0.f, 0.f, 0.f, 0.f};
    u32x4 ra[4]; f32x4 rb[8];
#define GT_LOAD(KOFF) { \
    _Pragma("unroll") for (int i = 0; i < 4; ++i) ra[i] = *(const u32x4*)(arow[i] + (KOFF) + a_c * 8); \
    _Pragma("unroll") for (int r = 0; r < 8; ++r) rb[r] = *(const f32x4*)(bptr + (size_t)((KOFF) + kg * 8 + r) * ldb); }
#define GT_WRITE(BUF) { \
    _Pragma("unroll") for (int i = 0; i < 4; ++i) *(u32x4*)(smem + (BUF) * GT_STAGE + gt_off(a_r + 32 * i, a_c)) = ra[i]; \
    _Pragma("unroll") for (int i = 0; i < 4; ++i) { \
        const u32x4 q = {pk2(rb[0][i], rb[1][i]), pk2(rb[2][i], rb[3][i]), pk2(rb[4][i], rb[5][i]), pk2(rb[6][i], rb[7][i])}; \
        *(u32x4*)(smem + (BUF) * GT_STAGE + GT_B + gt_off(c4 + i, kg)) = q; } }
    const int nt = K >> 6;
    __syncthreads();
    GT_LOAD(0)
    GT_WRITE(0)
    __syncthreads();
    if (nt > 1) GT_LOAD(64)
    for (int t = 0; t < nt; ++t) {
        const int buf = t & 1;
        GT_COMPUTE(buf)
        if (t + 1 < nt) GT_WRITE(buf ^ 1)
        __syncthreads();
        if (t + 2 < nt) GT_LOAD((t + 2) * 64)
    }
#undef GT_LOAD
#undef GT_WRITE
}

#define LDSP __attribute__((address_space(3)))
template <int MODE = 0>
DI void gemm_mainloop_bb(unsigned char* smem, const act_t* const (&arow)[4], const act_t* const (&brow)[4], const int K, f32x4 (&acc)[4][4]) {
    const int tid = opaque_tid(), lane = tid & 63, w = tid >> 6, wm = w >> 1, wn = w & 1;
    const int wu = __builtin_amdgcn_readfirstlane(w);
#pragma unroll
    for (int mi = 0; mi < 4; ++mi)
#pragma unroll
        for (int ni = 0; ni < 4; ++ni) acc[mi][ni] = (f32x4){0.f, 0.f, 0.f, 0.f};
    const int csrc = ((lane & 7) ^ ((4 * w + (lane >> 4)) & 7)) * 8;
#define GB_DMA(KOFF, BUF) { \
    _Pragma("unroll") for (int i = 0; i < 4; ++i) { \
        __builtin_amdgcn_global_load_lds((const unsigned*)(arow[i] + (KOFF) + csrc), (LDSP unsigned*)(smem + (BUF) * GT_STAGE + (4 * i + wu) * 1024), 16, 0, 0); \
        __builtin_amdgcn_global_load_lds((const unsigned*)(brow[i] + (KOFF) + csrc), (LDSP unsigned*)(smem + (BUF) * GT_STAGE + GT_B + (4 * i + wu) * 1024), 16, 0, 0); } }
    const int nt = K >> 6;
    __syncthreads();
    GB_DMA(0, 0)
    asm volatile("s_waitcnt vmcnt(0)" ::: "memory");
    __syncthreads();
    for (int t = 0; t < nt; ++t) {
        const int buf = t & 1;
        if (t + 1 < nt) GB_DMA((t + 1) * 64, buf ^ 1)
        GT_COMPUTE(buf)
        asm volatile("s_waitcnt vmcnt(0)" ::: "memory");
        __syncthreads();
    }
#undef GB_DMA
}

DI int g32_off(int r, int c) { return r * 64 + ((c ^ (((r >> 2) & 1) * 3)) << 4); }
DI void gemm_mainloop_big(unsigned char* smem, const act_t* const (&arow)[4], const act_t* const (&brow)[2], const int K, f32x4 (&acc)[8][4]) {
    const int tid = opaque_tid(), lane = tid & 63, w = tid >> 6, wm = w >> 1, wn = w & 1;
    const int wu = __builtin_amdgcn_readfirstlane(w);
#pragma unroll
    for (int mi = 0; mi < 8; ++mi)
#pragma unroll
        for (int ni = 0; ni < 4; ++ni) acc[mi][ni] = (f32x4){0.f, 0.f, 0.f, 0.f};
    const int csrc = ((lane & 3) ^ (((lane >> 4) & 1) * 3)) * 8;
    constexpr int STG = 24576, BOFF = 16384;
#define GB_DMA(T, BUF) { const int ko_ = (T) * 32 + csrc; unsigned char* st_ = smem + (BUF) * STG; \
    _Pragma("unroll") for (int j = 0; j < 4; ++j) __builtin_amdgcn_global_load_lds((const unsigned*)(arow[j] + ko_), (LDSP unsigned*)(st_ + (4 * wu + j) * 1024), 16, 0, 0); \
    _Pragma("unroll") for (int j = 0; j < 2; ++j) __builtin_amdgcn_global_load_lds((const unsigned*)(brow[j] + ko_), (LDSP unsigned*)(st_ + BOFF + (2 * wu + j) * 1024), 16, 0, 0); }
    const int nt = K >> 5;
    __syncthreads();
    GB_DMA(0, 0)
    asm volatile("s_waitcnt vmcnt(0)" ::: "memory");
    __syncthreads();
    for (int t = 0; t < nt; ++t) {
        const int buf = t & 1;
        if (t + 1 < nt) GB_DMA(t + 1, buf ^ 1)
        const unsigned char* st = smem + buf * STG;
        bf16x8 bfr[4];
#pragma unroll
        for (int ni = 0; ni < 4; ++ni) bfr[ni] = *(const bf16x8*)(st + BOFF + g32_off(wn * 64 + ni * 16 + (lane & 15), lane >> 4));
#pragma unroll
        for (int mi = 0; mi < 8; ++mi) {
            const bf16x8 af = *(const bf16x8*)(st + g32_off(wm * 128 + mi * 16 + (lane & 15), lane >> 4));
#pragma unroll
            for (int ni = 0; ni < 4; ++ni) acc[mi][ni] = __builtin_amdgcn_mfma_f32_16x16x32_bf16(bfr[ni], af, acc[mi][ni], 0, 0, 0);
        }
        asm volatile("s_waitcnt vmcnt(0)" ::: "memory");
        __syncthreads();
    }
#undef GB_DMA
}

namespace g8 {
constexpr int BM = 256, BK = 64, HALF = 128, HTB = HALF * BK * 2, STAGE_BYTES = 8 * HTB;
DI int lds_byte(int r, int c) { const int st = (r >> 4) * 2 + (c >> 5), rr = r & 15, cc = c & 31, ob = rr * 64 + cc * 2; return st * 1024 + (ob ^ (((ob >> 9) & 1) << 5)); }
DI void stage_rc(int b, int& R, int& C) { const int st = b / 1024, sb = b % 1024, swz = sb ^ (((sb >> 9) & 1) << 5); R = (st >> 1) * 16 + swz / 64; C = (st & 1) * 32 + (swz % 64) / 2; }
DI int perm32(int rho) { const int n = rho >> 4, i = rho & 15; return 8 * (i >> 2) + 4 * n + (i & 3); }
struct Unit { int pm, pn, e, hm; };
static_assert(STAGE_BYTES <= 2 * SMEM_BYTES - 16, "GEMM stage region must leave the barrier words alone");

template <class Epi, class Sched>
DI void gemm(unsigned char* smem_real, const int K, const Sched& S, const Epi& E) {
    LDSP unsigned char* lds = (LDSP unsigned char*)smem_real;
    int tid = threadIdx.x; asm volatile("" : "+v"(tid));
    const int wid = __builtin_amdgcn_readfirstlane(tid >> 6), lane = tid & 63, wr = wid >> 2, wc = wid & 3, fr = lane & 15, fq = lane >> 4;
    const int nt = K / BK;
    unsigned voffB[2];
#pragma unroll
    for (int i = 0; i < 2; ++i) { int R, C; stage_rc(tid * 16 + i * 8192, R, C); const int Rb = Epi::PERM ? ((R & ~31) + perm32(R & 31)) : R;
        voffB[i] = (unsigned)(Rb * K + C) * 2u; }
#define G8_AOFF(U, UI) do { int t2_ = threadIdx.x; asm volatile("" : "+v"(t2_)); int RA[2], CA[2]; \
        _Pragma("unroll") for (int i = 0; i < 2; ++i) { int R, C; stage_rc(t2_ * 16 + i * 8192, R, C); RA[i] = R; CA[i] = C * 2; } S.a_off(U, UI, RA, CA, voffA, lds); } while (0)
    unsigned voffA[2][2];
    const size_t kstep = (size_t)(BK * 2);
    const size_t bh = S.b_hstep();
    const unsigned ldsw = (unsigned)wid * 1024u;
    const int aoff = lds_byte(wr * 64 + fr, fq * 8), boff = lds_byte(wc * 32 + fr, fq * 8);
#define G8_SA(b, h) (((b) * 2 + (h)) * HTB)
#define G8_SB(b, h) ((4 + (b) * 2 + (h)) * HTB)
#define G8_STAGE(bufoff, gbase, voff) do { _Pragma("unroll") for (int _i = 0; _i < 2; ++_i) \
        __builtin_amdgcn_global_load_lds((const unsigned*)((const char*)(gbase) + (voff)[_i]), (LDSP unsigned*)(lds + (bufoff) + ldsw + _i * 8192), 16, 0, 0); } while (0)
#define G8_LDA(dst, b, h) do { _Pragma("unroll") for (int m = 0; m < 4; ++m) _Pragma("unroll") for (int k = 0; k < 2; ++k) dst[m][k] = *(const LDSP bf16x8*)(lds + G8_SA(b, h) + aoff + m * 2048 + k * 1024); } while (0)
#define G8_LDB(dst, b, h) do { _Pragma("unroll") for (int n = 0; n < 2; ++n) _Pragma("unroll") for (int k = 0; k < 2; ++k) dst[n][k] = *(const LDSP bf16x8*)(lds + G8_SB(b, h) + boff + n * 2048 + k * 1024); } while (0)
#define G8_MMA(ai, bj, At, Bt) do { __builtin_amdgcn_s_setprio(1); _Pragma("unroll") for (int m = 0; m < 4; ++m) _Pragma("unroll") for (int n = 0; n < 2; ++n) _Pragma("unroll") for (int k = 0; k < 2; ++k) \
        acc[ai][bj][m][n] = __builtin_amdgcn_mfma_f32_16x16x32_bf16(Bt[n][k], At[m][k], acc[ai][bj][m][n], 0, 0, 0); __builtin_amdgcn_s_setprio(0); } while (0)
#define G8_WAIT_V(n) asm volatile("s_waitcnt vmcnt(" #n ")" ::: "memory")
#define G8_WAIT_L(n) asm volatile("s_waitcnt lgkmcnt(" #n ")" ::: "memory")
#define G8_BAR __builtin_amdgcn_s_barrier()
#define G8_SCHED __builtin_amdgcn_sched_barrier(0)
    Unit cur, nxt; int ui = 0;
    asm volatile("s_waitcnt vmcnt(0) lgkmcnt(0)" ::: "memory"); G8_BAR;
    S.prologue(lds, tid);
    if (!S.next(0, cur)) return;
    f32x4 acc[2][2][4][2];
#pragma unroll
    for (int a = 0; a < 2; ++a)
#pragma unroll
        for (int b = 0; b < 2; ++b)
#pragma unroll
            for (int m = 0; m < 4; ++m)
#pragma unroll
                for (int n = 0; n < 2; ++n) acc[a][b][m][n] = (f32x4){0.f, 0.f, 0.f, 0.f};
    bf16x8 At[4][2], B0[2][2], B1[2][2];
    const char* A0 = S.a_tensor(); const char* cB = S.b_base(cur);
    G8_AOFF(cur, 0);
    G8_STAGE(G8_SB(0, 0), cB, voffB); G8_STAGE(G8_SA(0, 0), A0, voffA[0]); G8_STAGE(G8_SB(0, 1), cB + bh, voffB); G8_STAGE(G8_SA(0, 1), A0, voffA[1]);
    if (wr == 1) G8_BAR;
    G8_WAIT_V(4); G8_BAR;
    G8_STAGE(G8_SB(1, 0), cB + kstep, voffB); G8_STAGE(G8_SA(1, 0), A0 + kstep, voffA[0]); G8_STAGE(G8_SB(1, 1), cB + bh + kstep, voffB);
    G8_WAIT_V(6); G8_BAR;
    for (;;) {
        const bool has_next = S.next(ui + 1, nxt);
        const char* nB = has_next ? S.b_base(nxt) : cB;
        const bool full = cur.hm == 0;
        for (int t = 0; t < nt; t += 2) {
            const bool last = (t == nt - 2);
            const char* a1 = A0 + (size_t)(t + 1) * kstep;
            const char* a2 = A0 + (last ? (size_t)0 : (size_t)(t + 2) * kstep); const char* b2 = last ? nB : cB + (size_t)(t + 2) * kstep;
            const char* a3 = a2 + kstep; const char* b3 = b2 + kstep;
            G8_LDB(B0, 0, 0); G8_SCHED; G8_LDA(At, 0, 0); G8_STAGE(G8_SA(1, 1), a1, voffA[1]);
            if (last && has_next) G8_AOFF(nxt, ui + 1);
            G8_WAIT_L(8); G8_BAR; G8_WAIT_L(0); G8_MMA(0, 0, At, B0); G8_BAR; G8_SCHED;
            G8_LDB(B1, 0, 1); G8_STAGE(G8_SB(0, 0), b2, voffB);
            G8_BAR; G8_WAIT_L(0); G8_MMA(0, 1, At, B1); G8_BAR;
            if (full) G8_LDA(At, 0, 1); G8_STAGE(G8_SA(0, 0), a2, voffA[0]);
            G8_BAR; G8_WAIT_L(0); if (full) G8_MMA(1, 0, At, B0); G8_BAR; G8_SCHED;
            G8_STAGE(G8_SB(0, 1), b2 + bh, voffB);
            G8_WAIT_V(6); G8_BAR; if (full) G8_MMA(1, 1, At, B1); G8_BAR;
            G8_LDB(B0, 1, 0); G8_SCHED; G8_LDA(At, 1, 0); G8_STAGE(G8_SA(0, 1), a2, voffA[1]);
            G8_WAIT_L(8); G8_BAR; G8_WAIT_L(0); G8_MMA(0, 0, At, B0); G8_BAR; G8_SCHED;
            G8_LDB(B1, 1, 1); G8_STAGE(G8_SB(1, 0), b3, voffB);
            G8_BAR; G8_WAIT_L(0); G8_MMA(0, 1, At, B1); G8_BAR;
            if (full) G8_LDA(At, 1, 1); G8_STAGE(G8_SA(1, 0), a3, voffA[0]);
            G8_BAR; G8_WAIT_L(0); if (full) G8_MMA(1, 0, At, B0); G8_BAR; G8_SCHED;
            G8_STAGE(G8_SB(1, 1), b3 + bh, voffB);
            G8_WAIT_V(6); G8_BAR; if (full) G8_MMA(1, 1, At, B1); G8_BAR;
        }
        { int t3_ = threadIdx.x; asm volatile("" : "+v"(t3_)); const int w3_ = __builtin_amdgcn_readfirstlane(t3_ >> 6); E(acc, cur, w3_ >> 2, w3_ & 3, t3_ & 15, (t3_ & 63) >> 4); }
        if (!has_next) break;
#pragma unroll
        for (int a = 0; a < 2; ++a)
#pragma unroll
            for (int b = 0; b < 2; ++b)
#pragma unroll
                for (int m = 0; m < 4; ++m)
#pragma unroll
                    for (int n = 0; n < 2; ++n) acc[a][b][m][n] = (f32x4){0.f, 0.f, 0.f, 0.f};
        cur = nxt; cB = nB; ++ui;
    }
    G8_WAIT_V(0);
    if (wr == 0) G8_BAR;
    G8_BAR;
#undef G8_AOFF
#undef G8_SA
#undef G8_SB
#undef G8_STAGE
#undef G8_LDA
#undef G8_LDB
#undef G8_MMA
#undef G8_WAIT_V
#undef G8_WAIT_L
#undef G8_BAR
#undef G8_SCHED
}
}

DI void bp_wconv(const Params& p, unsigned char* smem, int bid, int G) {
    const int tid = opaque_tid();
    float* T = (float*)smem;
    constexpr int NT_IN = (INW + 63) / 64, NT_OUT = Dm / 64, KT = Dm / 64;
    constexpr int PER_L = (NT_IN + NT_OUT) * KT;
    const int k = tid >> 2, n16 = (tid & 3) * 16;
    const int n = tid >> 2, k16 = (tid & 3) * 16;
    f32x4 v[4];
#define WC_DECODE(ITEM) const int l_ = (ITEM) / PER_L, r_ = (ITEM) % PER_L; const bool isout_ = r_ >= NT_IN * KT; \
        const int rr_ = isout_ ? r_ - NT_IN * KT : r_, nt_ = rr_ / KT, kt_ = rr_ % KT, N_ = isout_ ? Dm : INW; \
        const float* W_ = isout_ ? p.w_out + (size_t)l_ * Dm * Dm : p.w_in + (size_t)l_ * Dm * INW;
#define WC_LOAD(ITEM) { WC_DECODE(ITEM) \
        _Pragma("unroll") for (int i = 0; i < 4; ++i) { const int nn = nt_ * 64 + n16 + i * 4; v[i] = nn < N_ ? *(const f32x4*)(W_ + (size_t)(kt_ * 64 + k) * N_ + nn) : (f32x4){0.f, 0.f, 0.f, 0.f}; } }
    if (bid < DEPTH * PER_L) WC_LOAD(bid)
    for (int item = bid; item < DEPTH * PER_L; item += G) {
        __syncthreads();
#pragma unroll
        for (int i = 0; i < 4; ++i) { T[k * 65 + n16 + i * 4] = v[i][0]; T[k * 65 + n16 + i * 4 + 1] = v[i][1]; T[k * 65 + n16 + i * 4 + 2] = v[i][2]; T[k * 65 + n16 + i * 4 + 3] = v[i][3]; }
        __syncthreads();
        if (item + G < DEPTH * PER_L) WC_LOAD(item + G)
        WC_DECODE(item)
        (void)W_;
        act_t* WT = isout_ ? p.WOUT_T + (size_t)l_ * Dm * Dm : p.WIN_T + (size_t)l_ * INW * Dm;
        if (nt_ * 64 + n < N_) {
            unsigned o[8];
#pragma unroll
            for (int i = 0; i < 8; ++i) o[i] = pk2(T[(k16 + 2 * i) * 65 + n], T[(k16 + 2 * i + 1) * 65 + n]);
            act_t* dst = WT + (size_t)(nt_ * 64 + n) * Dm + kt_ * 64 + k16;
            *(u32x4*)dst = (u32x4){o[0], o[1], o[2], o[3]}; *(u32x4*)(dst + 8) = (u32x4){o[4], o[5], o[6], o[7]};
        }
    }
#undef WC_LOAD
#undef WC_DECODE
}

DI int xcd_remap(int b, int G) { return (G & 7) == 0 ? (b & 7) * (G >> 3) + (b >> 3) : b; }

template <int MODE = 0>
DI void bp_gemm_in(const Params& p, int l, unsigned char* smem, int vb, int G) {
    constexpr int MTB = NTOK / 256, NT = (INW + 127) / 128;
    const int tid = opaque_tid(), lane = tid & 63, w = tid >> 6, wm = w >> 1, wn = w & 1;
    const int nbig_all = MTB * NT, nbig = (nbig_all / G) * G;
    for (int t = vb; t < nbig; t += G) {
        const int mt = t / NT, nt = t % NT, m0 = mt * 256, n0 = nt * 128;
        const act_t* arow[4]; const act_t* brow[2];
#pragma unroll
        for (int j = 0; j < 4; ++j) arow[j] = p.XN + (size_t)(m0 + 64 * w + 16 * j + (lane >> 2)) * Dm;
#pragma unroll
        for (int j = 0; j < 2; ++j) { const int r = 32 * w + 16 * j + (lane >> 2); brow[j] = n0 + r < INW ? p.WIN_T + ((size_t)l * INW + n0 + r) * Dm : p.ZROW; }
        f32x4 acc[8][4];
        gemm_mainloop_big(smem, arow, brow, Dm, acc);
#pragma unroll
        for (int mi = 0; mi < 8; ++mi)
#pragma unroll
            for (int ni = 0; ni < 4; ++ni) {
                const int m = m0 + wm * 128 + mi * 16 + (lane & 15), n = n0 + wn * 64 + ni * 16 + (lane >> 4) * 4;
                if (n < INW) {
                    const f32x4 v = acc[mi][ni];
                    *(u32x2*)(p.PROJB + (size_t)m * INW + n) = (u32x2){pk2(v[0], v[1]), pk2(v[2], v[3])};
                    if (n >= MG_OFF) *(f32x4*)(p.PG + (size_t)m * 16 + n - MG_OFF) = v;
                }
            }
    }
    const int a_r = tid >> 3;
    for (int t = vb; t < 2 * (nbig_all - nbig); t += G) {
        const int tb = nbig + (t >> 1), mt = tb / NT, nt = tb % NT, m0 = mt * 256 + (t & 1) * 128, n0 = nt * 128;
        const act_t* arow[4]; const act_t* brow[4];
#pragma unroll
        for (int i = 0; i < 4; ++i) { arow[i] = p.XN + (size_t)(m0 + a_r + 32 * i) * Dm; brow[i] = n0 + a_r + 32 * i < INW ? p.WIN_T + ((size_t)l * INW + n0 + a_r + 32 * i) * Dm : p.ZROW; }
        f32x4 acc[4][4];
        gemm_mainloop_bb<MODE>(smem, arow, brow, Dm, acc);
#pragma unroll
        for (int mi = 0; mi < 4; ++mi)
#pragma unroll
            for (int ni = 0; ni < 4; ++ni) {
                const int m = m0 + wm * 64 + mi * 16 + (lane & 15), n = n0 + wn * 64 + ni * 16 + (lane >> 4) * 4;
                if (n < INW) {
                    const f32x4 v = acc[mi][ni];
                    *(u32x2*)(p.PROJB + (size_t)m * INW + n) = (u32x2){pk2(v[0], v[1]), pk2(v[2], v[3])};
                    if (n >= MG_OFF) *(f32x4*)(p.PG + (size_t)m * 16 + n - MG_OFF) = v;
                }
            }
    }
}

struct G8SchedDense { const char* A; const char* B; int c, Gr, nfull, npn, nleft;
    DI void prologue(LDSP unsigned char*, int) const {}
    DI bool next(int i, g8::Unit& u) const {
        int L = i * Gr + c; u.hm = 0;
        if (L >= nfull) { if (i * Gr != nfull || c >= 2 * nleft) return false; L = nfull + (c >> 1); u.hm = 1 + (c & 1); }
        u.pm = L / npn; u.pn = L - u.pm * npn; return true; }
    DI const char* a_tensor() const { return A; }
    DI void a_off(const g8::Unit& u, int, const int (&RA)[2], const int (&CA)[2], unsigned (&voffA)[2][2], LDSP unsigned char*) const {
#pragma unroll
        for (int h = 0; h < 2; ++h)
#pragma unroll
            for (int i = 0; i < 2; ++i) voffA[h][i] = (unsigned)(u.pm * 256 + (u.hm == 2 ? 128 : 0) + (u.hm ? 0 : h * 128) + RA[i]) * (unsigned)(Dm * 2) + (unsigned)CA[i]; }
    DI const char* b_base(const g8::Unit& u) const { return B + (size_t)u.pn * (256 * Dm * 2); }
    DI size_t b_hstep() const { return (size_t)128 * Dm * 2; } };
struct G8EpiIn { static constexpr bool PERM = true; act_t* O;
    DI void operator()(const f32x4 (&acc)[2][2][4][2], const g8::Unit& u, int wr, int wc, int fr, int fq) const {
        const int row0 = u.pm * 256 + (u.hm == 2 ? 128 : 0) + wr * 64 + fr, col0 = u.pn * 256 + wc * 32 + 8 * fq;
#pragma unroll
        for (int ai = 0; ai < 2; ++ai)
#pragma unroll
            for (int m = 0; m < 4; ++m) {
                if (ai == 1 && u.hm) continue;
                act_t* rowp = O + (size_t)(row0 + ai * 128 + m * 16) * INW + col0;
#pragma unroll
                for (int bj = 0; bj < 2; ++bj) { const f32x4 v0 = acc[ai][bj][m][0], v1 = acc[ai][bj][m][1];
                    *(u32x4*)(rowp + bj * 128) = (u32x4){pk2(v0[0], v0[1]), pk2(v0[2], v0[3]), pk2(v1[0], v1[1]), pk2(v1[2], v1[3])}; }
            }
    } };
DI int real_block_xcd(int rb, int Gr) { return (Gr & 7) == 0 ? (rb & 7) * (Gr >> 3) + (rb >> 3) : rb; }
DI void bp_gemm_in8(const Params& p, int l, unsigned char* smem_real, unsigned char* smem, int vb, int G, int rb) {
    constexpr int NPN = MG_OFF / 256, NU = (NTOK / 256) * NPN, MT128 = NTOK / 128;
    const int Gr = G >> 1, nfull = (NU / Gr) * Gr, nleft = NU - nfull;
    const bool split = 2 * nleft <= Gr;
    {
        G8SchedDense S; S.nleft = split ? nleft : 0; S.A = (const char*)p.XN; S.B = (const char*)(p.WIN_T + (size_t)l * INW * Dm); S.c = real_block_xcd(rb, Gr); S.Gr = Gr; S.nfull = nfull; S.npn = NPN;
        G8EpiIn E; E.O = p.PROJB;
        g8::gemm(smem_real, Dm, S, E);
    }
    const int tid = opaque_tid(), lane = tid & 63, w = tid >> 6, wm = w >> 1, wn = w & 1, a_r = tid >> 3;
    const int nl4 = split ? 0 : nleft * 4, skip = split ? 4 * nleft : 0;
    for (int t = vb - skip; t >= 0 && t < nl4 + MT128; t += G - skip) {
        int m0, n0;
        if (t < nl4) { const int lu = nfull + (t >> 2), pm = lu / NPN, pn = lu - pm * NPN, sub = t & 3; m0 = pm * 256 + (sub >> 1) * 128; n0 = pn * 256 + (sub & 1) * 128; }
        else { m0 = (t - nl4) * 128; n0 = MG_OFF; }
        const act_t* arow[4]; const act_t* brow[4];
#pragma unroll
        for (int i = 0; i < 4; ++i) { arow[i] = p.XN + (size_t)(m0 + a_r + 32 * i) * Dm; brow[i] = n0 + a_r + 32 * i < INW ? p.WIN_T + ((size_t)l * INW + n0 + a_r + 32 * i) * Dm : p.ZROW; }
        f32x4 acc[4][4];
        gemm_mainloop_bb(smem, arow, brow, Dm, acc);
#pragma unroll
        for (int mi = 0; mi < 4; ++mi)
#pragma unroll
            for (int ni = 0; ni < 4; ++ni) {
                const int m = m0 + wm * 64 + mi * 16 + (lane & 15), n = n0 + wn * 64 + ni * 16 + (lane >> 4) * 4;
                if (n < INW) {
                    const f32x4 v = acc[mi][ni];
                    *(u32x2*)(p.PROJB + (size_t)m * INW + n) = (u32x2){pk2(v[0], v[1]), pk2(v[2], v[3])};
                    if (n >= MG_OFF) *(f32x4*)(p.PG + (size_t)m * 16 + n - MG_OFF) = v;
                }
            }
    }
}

DI void mconv_drain(const Params& p, int l, unsigned char* smem, int max_items);
template <bool DRY>
DI void bp_gemm_out(const Params& p, int l, bool upd, unsigned char* smem, int vb, int G) {
    const int MT = (upd ? NTOK : NL) / 128; constexpr int NT = Dm / 128;
    const float* W = p.w_out + (size_t)l * Dm * Dm;
    const int tid = opaque_tid(), lane = tid & 63, w = tid >> 6, wm = w >> 1, wn = w & 1, a_r = tid >> 3, c4 = (w * 8 + (lane >> 3)) * 4;
    for (int t = vb; t < MT * NT; t += G) {
        const int mt = t / NT, nt = t % NT, m0 = mt * 128, n0 = nt * 128;
        const act_t* arow[4];
#pragma unroll
        for (int i = 0; i < 4; ++i) arow[i] = p.MIX + (size_t)(m0 + a_r + 32 * i) * Dm;
        const act_t* brow[4];
#pragma unroll
        for (int i = 0; i < 4; ++i) brow[i] = p.WOUT_T + ((size_t)l * Dm + n0 + a_r + 32 * i) * Dm;
        f32x4 acc[4][4];
        gemm_mainloop_bb(smem, arow, brow, Dm, acc);
#pragma unroll
        for (int mi = 0; mi < 4; ++mi) {
            const int m = m0 + wm * 64 + mi * 16 + (lane & 15);
            const float* g1 = mod_row(p, l, m) + 2 * Dm;
#pragma unroll
            for (int ni = 0; ni < 4; ++ni) {
                const int n = n0 + wn * 64 + ni * 16 + (lane >> 4) * 4;
                f32x4* xp = (f32x4*)(p.X + (size_t)m * Dm + n);
                const f32x4 xo = l == 0 ? *(const f32x4*)((m < NL ? p.x + (size_t)m * Dm : p.ctx + (size_t)(m - NL) * Dm) + n) : *xp;
                if (DRY) *(f32x4*)((float*)p.PROJB + (size_t)m * Dm + n) = xo + *(const f32x4*)(g1 + n) * acc[mi][ni];
                else *xp = xo + *(const f32x4*)(g1 + n) * acc[mi][ni];
            }
        }
    }
    if (!DRY && vb >= (MT * NT) % G) mconv_drain(p, l, smem, 1);
}

struct G8EpiOut { static constexpr bool PERM = true; const Params* pp; int l;
    DI void operator()(const f32x4 (&acc)[2][2][4][2], const g8::Unit& u, int wr, int wc, int fr, int fq) const {
        const Params& p = *pp;
        const int row0 = u.pm * 256 + (u.hm == 2 ? 128 : 0) + wr * 64 + fr, col0 = u.pn * 256 + wc * 32 + 8 * fq;
        const float* g1 = mod_row(p, l, u.pm * 256) + 2 * Dm + col0;
        f32x4 gv[2][2];
#pragma unroll
        for (int bj = 0; bj < 2; ++bj)
#pragma unroll
            for (int n = 0; n < 2; ++n) gv[bj][n] = *(const f32x4*)(g1 + bj * 128 + n * 4);
        if (l != 0) {
#pragma unroll
            for (int ai = 0; ai < 2; ++ai) {
                if (ai == 1 && u.hm) continue;
                u32x4 rv[4][2];
#pragma unroll
                for (int m = 0; m < 4; ++m) {
                    const act_t* xp = p.XB + (size_t)(row0 + ai * 128 + m * 16) * Dm + col0;
#pragma unroll
                    for (int bj = 0; bj < 2; ++bj) rv[m][bj] = *(const u32x4*)(xp + bj * 128);
                }
#pragma unroll
                for (int m = 0; m < 4; ++m) {
                    act_t* xp = p.XB + (size_t)(row0 + ai * 128 + m * 16) * Dm + col0;
#pragma unroll
                    for (int bj = 0; bj < 2; ++bj) {
                        const u32x4 r = rv[m][bj];
                        const f32x4 r0 = {bflo(r[0]), bfhi(r[0]), bflo(r[1]), bfhi(r[1])}, r1 = {bflo(r[2]), bfhi(r[2]), bflo(r[3]), bfhi(r[3])};
                        const f32x4 o0 = r0 + gv[bj][0] * acc[ai][bj][m][0], o1 = r1 + gv[bj][1] * acc[ai][bj][m][1];
                        *(u32x4*)(xp + bj * 128) = (u32x4){pk2(o0[0], o0[1]), pk2(o0[2], o0[3]), pk2(o1[0], o1[1]), pk2(o1[2], o1[3])};
                    }
                }
                asm volatile("" ::: "memory");
            }
        } else {
#pragma unroll
            for (int ai = 0; ai < 2; ++ai)
#pragma unroll
                for (int m = 0; m < 4; ++m) {
                    if (ai == 1 && u.hm) continue;
                    const int row = row0 + ai * 128 + m * 16;
                    act_t* xp = p.XB + (size_t)row * Dm + col0;
                    const float* rp0 = (row < NL ? p.x + (size_t)row * Dm : p.ctx + (size_t)(row - NL) * Dm) + col0;
                    f32x4 rr[2][2];
#pragma unroll
                    for (int bj = 0; bj < 2; ++bj) { rr[bj][0] = *(const f32x4*)(rp0 + bj * 128); rr[bj][1] = *(const f32x4*)(rp0 + bj * 128 + 4); }
#pragma unroll
                    for (int bj = 0; bj < 2; ++bj) {
                        const f32x4 o0 = rr[bj][0] + gv[bj][0] * acc[ai][bj][m][0], o1 = rr[bj][1] + gv[bj][1] * acc[ai][bj][m][1];
                        *(u32x4*)(xp + bj * 128) = (u32x4){pk2(o0[0], o0[1]), pk2(o0[2], o0[3]), pk2(o1[0], o1[1]), pk2(o1[2], o1[3])};
                    }
                    if (m & 1) asm volatile("" ::: "memory");
                }
        }
    } };
DI void bp_gemm_out8(const Params& p, int l, bool upd, unsigned char* smem_real, unsigned char* smem, int vb, int G, int rb) {
    constexpr int NPN = Dm / 256;
    const int NU = ((upd ? NTOK : NL) / 256) * NPN;
    const int Gr = G >> 1, nfull = (NU / Gr) * Gr, nleft = NU - nfull;
    const bool split = 2 * nleft <= Gr;
    {
        G8SchedDense S; S.nleft = split ? nleft : 0; S.A = (const char*)p.MIX; S.B = (const char*)(p.WOUT_T + (size_t)l * Dm * Dm); S.c = real_block_xcd(rb, Gr); S.Gr = Gr; S.nfull = nfull; S.npn = NPN;
        G8EpiOut E; E.pp = &p; E.l = l;
        g8::gemm(smem_real, Dm, S, E);
    }
    const int tid = opaque_tid(), lane = tid & 63, w = tid >> 6, wm = w >> 1, wn = w & 1, a_r = tid >> 3;
    const int nl4 = split ? 0 : nleft * 4;
    for (int t = vb; t < nl4; t += G) {
        const int lu = nfull + (t >> 2), pm = lu / NPN, pn = lu - pm * NPN, sub = t & 3, m0 = pm * 256 + (sub >> 1) * 128, n0 = pn * 256 + (sub & 1) * 128;
        const act_t* arow[4]; const act_t* brow[4];
#pragma unroll
        for (int i = 0; i < 4; ++i) { arow[i] = p.MIX + (size_t)(m0 + a_r + 32 * i) * Dm; brow[i] = p.WOUT_T + ((size_t)l * Dm + n0 + a_r + 32 * i) * Dm; }
        f32x4 acc[4][4];
        gemm_mainloop_bb(smem, arow, brow, Dm, acc);
#pragma unroll
        for (int mi = 0; mi < 4; ++mi) {
            const int m = m0 + wm * 64 + mi * 16 + (lane & 15);
            const float* g1 = mod_row(p, l, m) + 2 * Dm;
#pragma unroll
            for (int ni = 0; ni < 4; ++ni) {
                const int n = n0 + wn * 64 + ni * 16 + (lane >> 4) * 4;
                act_t* xp = p.XB + (size_t)m * Dm + n;
                const f32x4 xo = l == 0 ? *(const f32x4*)((m < NL ? p.x + (size_t)m * Dm : p.ctx + (size_t)(m - NL) * Dm) + n) : ld4bf(xp);
                const f32x4 o = xo + *(const f32x4*)(g1 + n) * acc[mi][ni];
                *(u32x2*)xp = (u32x2){pk2(o[0], o[1]), pk2(o[2], o[3])};
            }
        }
    }
    if (vb >= (split ? 4 * nleft : nl4 % G)) mconv_drain(p, l, smem, 1);
}

DI int* moe_prep(const Params& p, int l, unsigned char* smem) {
    int* s_moff = (int*)(smem + SM_AUX);
    __syncthreads();
    const int t_ = opaque_tid();
    if (t_ < 32) s_moff[64 + t_] = (p.CNT[(l * 32 + t_) * 64] + 255) >> 8;
    __syncthreads();
    if (t_ <= 32) { int o = 0;
#pragma unroll
        for (int e = 0; e < 32; ++e) { const int v = s_moff[64 + e]; o += e < t_ ? v : 0; }
        s_moff[t_] = o; }
    __syncthreads();
    return s_moff;
}

DI void bp_moe1(const Params& p, int l, unsigned char* smem, int vb, int G) {
    const int* s_moff = moe_prep(p, l, smem);
    const int total = s_moff[32] * 8;
    const int tid = opaque_tid(), lane = tid & 63, w = tid >> 6, wm = w >> 1, wn = w & 1, a_r = tid >> 3, c4 = (w * 8 + (lane >> 3)) * 4;
    for (int t = vb; t < total; t += G) {
        const int mtg = t >> 3, nt = t & 7;
        int e = 0; while (s_moff[e + 1] <= mtg) ++e;
        const int cnt = p.CNT[(l * 32 + e) * 64], lbase = (mtg - s_moff[e]) * 128;
        const act_t* arow[4];
#pragma unroll
        for (int i = 0; i < 4; ++i) { const int li = lbase + a_r + 32 * i; arow[i] = li < cnt ? p.F + (size_t)p.LIST[(size_t)e * NTOK + li] * Dm : p.ZROW; }
        const act_t* brow[4];
#pragma unroll
        for (int i = 0; i < 4; ++i) { const int r = a_r + 32 * i, sel = (r & 63) >> 5, j = nt * 64 + (r >> 6) * 32 + (r & 31); brow[i] = p.W13T + ((size_t)(l & 1) * 32 * 1024 + (size_t)e * 1024 + sel * 512 + j) * Dm; }
        f32x4 acc[4][4];
        gemm_mainloop_bb(smem, arow, brow, Dm, acc);
#pragma unroll
        for (int mi = 0; mi < 4; ++mi)
#pragma unroll
            for (int ni = 0; ni < 2; ++ni) {
                const f32x4 a = acc[mi][ni], b = acc[mi][ni + 2];
                float h[4];
#pragma unroll
                for (int r = 0; r < 4; ++r) h[r] = a[r] / (1.0f + __expf(-a[r])) * b[r];
                const int prow = mtg * 128 + wm * 64 + mi * 16 + (lane & 15), jj = nt * 64 + wn * 32 + ni * 16 + (lane >> 4) * 4;
                *(u32x2*)(p.H + (size_t)prow * 512 + jj) = (u32x2){pk2(h[0], h[1]), pk2(h[2], h[3])};
            }
    }
}

DI void bp_moe2(const Params& p, int l, unsigned char* smem, int vb, int G) {
    const int* s_moff = moe_prep(p, l, smem);
    const int total = s_moff[32] * 8;
    const int tid = opaque_tid(), lane = tid & 63, w = tid >> 6, wm = w >> 1, wn = w & 1, a_r = tid >> 3, c4 = (w * 8 + (lane >> 3)) * 4;
    for (int t = vb; t < total; t += G) {
        const int mtg = t >> 3, nt = t & 7, n0 = nt * 128;
        int e = 0; while (s_moff[e + 1] <= mtg) ++e;
        const act_t* arow[4];
#pragma unroll
        for (int i = 0; i < 4; ++i) arow[i] = p.H + (size_t)(mtg * 128 + a_r + 32 * i) * 512;
        const act_t* brow[4];
#pragma unroll
        for (int i = 0; i < 4; ++i) brow[i] = p.W2T + (((size_t)(l & 1) * 32 + e) * Dm + n0 + a_r + 32 * i) * 512;
        f32x4 acc[4][4];
        gemm_mainloop_bb(smem, arow, brow, 512, acc);
#pragma unroll
        for (int mi = 0; mi < 4; ++mi)
#pragma unroll
            for (int ni = 0; ni < 4; ++ni) {
                const int prow = mtg * 128 + wm * 64 + mi * 16 + (lane & 15), n = n0 + wn * 64 + ni * 16 + (lane >> 4) * 4;
                const f32x4 v = acc[mi][ni];
                *(u32x2*)(p.Y + (size_t)prow * Dm + n) = (u32x2){pk2(v[0], v[1]), pk2(v[2], v[3])};
            }
    }
}

DI void bp_route(const Params& p, int l, bool upd, long gtid, long gsize) {
    ph_norm2_route(p, l, upd, gtid, gsize);
    const long rows = upd ? NTOK : NL;
    for (long row = gtid; row < rows; row += gsize)
#pragma unroll
        for (int kk = 0; kk < 2; ++kk) {
            const int e = p.EID[row * 2 + kk];
            const int pos = atomicAdd(&p.CNT[(l * 32 + e) * 64], 1);
            p.LIST[(size_t)e * NTOK + pos] = (int)row;
            p.POS[row * 2 + kk] = pos;
        }
}

DI void norm1_row(const Params& p, int l, long row, const f32x4 (&x)[4], int lane) {
    float ss = 0.f;
#pragma unroll
    for (int i = 0; i < 4; ++i) ss += x[i][0] * x[i][0] + x[i][1] * x[i][1] + x[i][2] * x[i][2] + x[i][3] * x[i][3];
    ss = wave_sum(ss, lane);
    const float rstd = 1.0f / sqrtf(ss / Dm + EPSF);
    const float* mr = mod_row(p, l, (int)row);
    const float* g = p.norm1_g + l * Dm;
#pragma unroll
    for (int i = 0; i < 4; ++i) {
        const int k = 256 * i + 4 * lane;
        const f32x4 gv = *(const f32x4*)(g + k), sh = *(const f32x4*)(mr + k), sc = *(const f32x4*)(mr + Dm + k);
        const f32x4 y = x[i] * rstd * gv * (1.0f + sc) + sh;
        *(u32x2*)(p.XN + row * Dm + k) = (u32x2){pk2(y[0], y[1]), pk2(y[2], y[3])};
    }
}
DI void bp_norm1(const Params& p, int l, int gwave, int nwaves, int lane) {
    for (long row0 = gwave; row0 < NTOK; row0 += 3 * (long)nwaves) {
        f32x4 x[3][4]; long rw[3];
#pragma unroll
        for (int u = 0; u < 3; ++u) {
            rw[u] = row0 + (long)u * nwaves < NTOK ? row0 + (long)u * nwaves : row0;
            const float* src = rw[u] < NL ? p.x + rw[u] * Dm : p.ctx + (rw[u] - NL) * Dm;
#pragma unroll
            for (int i = 0; i < 4; ++i) x[u][i] = *(const f32x4*)(src + 256 * i + 4 * lane);
        }
#pragma unroll
        for (int u = 0; u < 3; ++u) if (u == 0 || row0 + (long)u * nwaves < NTOK) norm1_row(p, l, rw[u], x[u], lane);
    }
}
constexpr int G8_TAB = g8::STAGE_BYTES, G8_INFO = G8_TAB + 3072, G8_MAXU = 3;
static_assert(G8_INFO + 128 * 4 <= 2 * SMEM_BYTES - 16, "MoE unit tables exceed the LDS budget");
template <bool GATHER>
struct G8SchedMoe { const Params* pp; int l, c, Gr, base;
    DI bool unit_of(int i, int T, int& L, int& hm) const {
        const int Tp = T - base, rounds = Tp / Gr < G8_MAXU ? Tp / Gr : G8_MAXU, nleft = rounds < G8_MAXU ? Tp - rounds * Gr : 0;
        hm = 0;
        if (i < rounds) { L = base + i * Gr + c; return true; }
        if (i > rounds || nleft <= 0) return false;
        if (2 * nleft <= Gr) { if (c >= 2 * nleft) return false; L = base + rounds * Gr + (c >> 1); hm = 1 + (c & 1); return true; }
        if (c >= nleft) return false;
        L = base + rounds * Gr + c; return true;
    }
    DI void prologue(LDSP unsigned char* lds, int tid) const {
        const Params& p = *pp;
        LDSP int* inf = (LDSP int*)(lds + G8_INFO); LDSP unsigned* tab = (LDSP unsigned*)(lds + G8_TAB);
        if (tid < 32) { const int cn = p.CNT[(l * 32 + tid) * 64]; inf[40 + tid] = cn; inf[80 + tid] = (cn + 255) >> 8; }
        asm volatile("s_waitcnt vmcnt(0) lgkmcnt(0)" ::: "memory"); __builtin_amdgcn_s_barrier(); asm volatile("" ::: "memory");
        if (tid <= 32) { int o = 0;
#pragma unroll
            for (int e = 0; e < 32; ++e) { const int v = inf[80 + e]; o += e < tid ? v : 0; }
            inf[tid] = o; }
        asm volatile("s_waitcnt vmcnt(0) lgkmcnt(0)" ::: "memory"); __builtin_amdgcn_s_barrier(); asm volatile("" ::: "memory");
        const int total = inf[32] * 4;
#pragma unroll
        for (int idx = tid; idx < G8_MAXU * 256; idx += RTHR) {
            const int ui = idx >> 8, r = idx & 255; int L, hm;
            if (unit_of(ui, total, L, hm)) {
                const int pm = L >> 2; int e = 0;
#pragma unroll
                for (int q = 1; q < 32; ++q) e += inf[q] <= pm ? 1 : 0;
                if (r == 0) inf[120 + ui] = e;
                if (GATHER) { const int li = (pm - inf[e]) * 256 + (hm ? (hm == 2 ? 128 : 0) + (r & 127) : r); const int tok = li < inf[40 + e] ? p.LIST[(size_t)e * NTOK + li] : NTOK; tab[idx] = (unsigned)tok * (unsigned)(Dm * 2); }
            }
        }
        asm volatile("s_waitcnt vmcnt(0) lgkmcnt(0)" ::: "memory"); __builtin_amdgcn_s_barrier(); asm volatile("" ::: "memory");
    }
    DI bool next(int i, g8::Unit& u) const {
        LDSP int* inf = (LDSP int*)((LDSP unsigned char*)0 + G8_INFO);
        int L, hm;
        if (i >= G8_MAXU || !unit_of(i, inf[32] * 4, L, hm)) return false;
        u.pm = L >> 2; u.pn = L & 3; u.e = inf[120 + i]; u.hm = hm; return true;
    }
    DI const char* a_tensor() const { return GATHER ? (const char*)pp->F : (const char*)pp->H; }
    DI void a_off(const g8::Unit& u, int ui, const int (&RA)[2], const int (&CA)[2], unsigned (&voffA)[2][2], LDSP unsigned char* lds) const {
        LDSP unsigned* tab = (LDSP unsigned*)(lds + G8_TAB);
#pragma unroll
        for (int h = 0; h < 2; ++h)
#pragma unroll
            for (int i = 0; i < 2; ++i)
                voffA[h][i] = GATHER ? tab[ui * 256 + h * 128 + RA[i]] + (unsigned)CA[i] : (unsigned)(u.pm * 256 + (u.hm == 2 ? 128 : 0) + (u.hm ? 0 : h * 128) + RA[i]) * 1024u + (unsigned)CA[i];
    }
    DI const char* b_base(const g8::Unit& u) const {
        return GATHER ? (const char*)(pp->W13T + ((size_t)(l & 1) * 32 * 1024 + (size_t)u.e * 1024 + u.pn * 128) * Dm)
                      : (const char*)(pp->W2T + (((size_t)(l & 1) * 32 + u.e) * Dm + u.pn * 256) * 512);
    }
    DI size_t b_hstep() const { return GATHER ? (size_t)512 * Dm * 2 : (size_t)128 * 512 * 2; }
};
struct G8EpiMoe1 { static constexpr bool PERM = true; act_t* H;
    DI void operator()(const f32x4 (&acc)[2][2][4][2], const g8::Unit& u, int wr, int wc, int fr, int fq) const {
        const int row0 = u.pm * 256 + (u.hm == 2 ? 128 : 0) + wr * 64 + fr, j0 = u.pn * 128 + wc * 32 + 8 * fq;
#pragma unroll
        for (int ai = 0; ai < 2; ++ai)
#pragma unroll
            for (int m = 0; m < 4; ++m) {
                if (ai == 1 && u.hm) continue;
                float h[8];
#pragma unroll
                for (int n = 0; n < 2; ++n)
#pragma unroll
                    for (int r = 0; r < 4; ++r) { const float a = acc[ai][0][m][n][r], b = acc[ai][1][m][n][r]; h[n * 4 + r] = a * __builtin_amdgcn_rcpf(1.0f + __expf(-a)) * b; }
                *(u32x4*)(H + (size_t)(row0 + ai * 128 + m * 16) * 512 + j0) = (u32x4){pk2(h[0], h[1]), pk2(h[2], h[3]), pk2(h[4], h[5]), pk2(h[6], h[7])};
            }
    } };
struct G8EpiMoe2 { static constexpr bool PERM = true; act_t* Y;
    DI void operator()(const f32x4 (&acc)[2][2][4][2], const g8::Unit& u, int wr, int wc, int fr, int fq) const {
        const int row0 = u.pm * 256 + (u.hm == 2 ? 128 : 0) + wr * 64 + fr, col0 = u.pn * 256 + wc * 32 + 8 * fq;
#pragma unroll
        for (int ai = 0; ai < 2; ++ai)
#pragma unroll
            for (int m = 0; m < 4; ++m) {
                if (ai == 1 && u.hm) continue;
                act_t* rowp = Y + (size_t)(row0 + ai * 128 + m * 16) * Dm + col0;
#pragma unroll
                for (int bj = 0; bj < 2; ++bj) { const f32x4 v0 = acc[ai][bj][m][0], v1 = acc[ai][bj][m][1];
                    *(u32x4*)(rowp + bj * 128) = (u32x4){pk2(v0[0], v0[1]), pk2(v0[2], v0[3]), pk2(v1[0], v1[1]), pk2(v1[2], v1[3])}; }
            }
    } };
DI void bp_moe1_8(const Params& p, int l, unsigned char* smem_real, int G, int rb) {
    const int Gr = G >> 1;
#pragma unroll 1
    for (int base = 0; base < (PMAX / 256) * 4; base += G8_MAXU * Gr) {
        G8SchedMoe<true> S; S.pp = &p; S.l = l; S.c = real_block_xcd(rb, Gr); S.Gr = Gr; S.base = base;
        G8EpiMoe1 E; E.H = p.H;
        g8::gemm(smem_real, Dm, S, E);
    }
}
DI void bp_moe2_8(const Params& p, int l, unsigned char* smem_real, int G, int rb) {
    const int Gr = G >> 1;
#pragma unroll 1
    for (int base = 0; base < (PMAX / 256) * 4; base += G8_MAXU * Gr) {
        G8SchedMoe<false> S; S.pp = &p; S.l = l; S.c = real_block_xcd(rb, Gr); S.Gr = Gr; S.base = base;
        G8EpiMoe2 E; E.Y = p.Y;
        g8::gemm(smem_real, 512, S, E);
    }
}

template <bool DRY>
DI void bp_combine(const Params& p, int l, bool upd, unsigned char* smem, int gwave, int nwaves, int lane) {
    const int* s_moff = moe_prep(p, l, smem);
    const long rows = upd ? NTOK : NL;
    const long rpw = (rows + nwaves - 1) / nwaves, rbeg = (long)gwave * rpw, rend = rbeg + rpw < rows ? rbeg + rpw : rows;
    constexpr int CU_ = 3;
    int mb_loaded = -1;
    f32x4 g2v[4], mulv[4], addv[4];
    if (rbeg < rend) {
        const int mb = tok_modrow((int)rbeg);
        mb_loaded = mb;
        const float* mr = p.mod + ((size_t)l * (Bn + 1) + mb) * MODW;
        const float* mrn = p.mod + ((size_t)(l + 1 < DEPTH ? l + 1 : l) * (Bn + 1) + mb) * MODW;
        const float* gn = p.norm1_g + (l + 1 < DEPTH ? l + 1 : l) * Dm;
#pragma unroll
        for (int i = 0; i < 4; ++i) {
            const int k = 256 * i + 4 * lane;
            g2v[i] = *(const f32x4*)(mr + 5 * Dm + k);
            mulv[i] = *(const f32x4*)(gn + k) * (1.0f + *(const f32x4*)(mrn + Dm + k)); addv[i] = *(const f32x4*)(mrn + k);
        }
    }
    for (long row0 = rbeg; row0 < rend; row0 += CU_) {
        long rw[CU_]; bool ok[CU_]; size_t pa[CU_], pb[CU_]; float g0[CU_], g1[CU_];
#pragma unroll
        for (int u = 0; u < CU_; ++u) {
            rw[u] = row0 + u; ok[u] = rw[u] < rend; if (!ok[u]) rw[u] = row0;
            const int e0 = p.EID[rw[u] * 2], e1 = p.EID[rw[u] * 2 + 1];
            pa[u] = (size_t)s_moff[e0] * 256 + p.POS[rw[u] * 2]; pb[u] = (size_t)s_moff[e1] * 256 + p.POS[rw[u] * 2 + 1];
            g0[u] = p.GATE[rw[u] * 2]; g1[u] = p.GATE[rw[u] * 2 + 1];
        }
        f32x4 ya[CU_][4], xo[CU_][4];
#pragma unroll
        for (int u = 0; u < CU_; ++u)
#pragma unroll
            for (int i = 0; i < 4; ++i) {
                const int k = 256 * i + 4 * lane;
                const u32x2 a2 = *(const u32x2*)(p.Y + pa[u] * Dm + k), b2 = *(const u32x2*)(p.Y + pb[u] * Dm + k);
                ya[u][i] = (f32x4){g0[u] * bflo(a2[0]) + g1[u] * bflo(b2[0]), g0[u] * bfhi(a2[0]) + g1[u] * bfhi(b2[0]), g0[u] * bflo(a2[1]) + g1[u] * bflo(b2[1]), g0[u] * bfhi(a2[1]) + g1[u] * bfhi(b2[1])};
                xo[u][i] = ld4bf(p.XB + rw[u] * Dm + k);
            }
#pragma unroll
        for (int u = 0; u < CU_; ++u) {
            if (!ok[u]) continue;
            const int mb = tok_modrow((int)rw[u]);
            if (mb != mb_loaded) {
                mb_loaded = mb;
                const float* mr = p.mod + ((size_t)l * (Bn + 1) + mb) * MODW;
                const float* mrn = p.mod + ((size_t)(l + 1 < DEPTH ? l + 1 : l) * (Bn + 1) + mb) * MODW;
                const float* gn = p.norm1_g + (l + 1 < DEPTH ? l + 1 : l) * Dm;
#pragma unroll
                for (int i = 0; i < 4; ++i) {
                    const int k = 256 * i + 4 * lane;
                    g2v[i] = *(const f32x4*)(mr + 5 * Dm + k);
                    mulv[i] = *(const f32x4*)(gn + k) * (1.0f + *(const f32x4*)(mrn + Dm + k)); addv[i] = *(const f32x4*)(mrn + k);
                }
            }
            f32x4 x[4]; float ss = 0.f;
#pragma unroll
            for (int i = 0; i < 4; ++i) { x[i] = xo[u][i] + g2v[i] * ya[u][i]; ss += x[i][0] * x[i][0] + x[i][1] * x[i][1] + x[i][2] * x[i][2] + x[i][3] * x[i][3]; }
            if (!DRY) {
#pragma unroll
                for (int i = 0; i < 4; ++i) { const int k = 256 * i + 4 * lane; if (l == DEPTH - 1) *(f32x4*)(p.out + rw[u] * Dm + k) = x[i]; else *(u32x2*)(p.XB + rw[u] * Dm + k) = (u32x2){pk2(x[i][0], x[i][1]), pk2(x[i][2], x[i][3])}; }
            }
            if (l < DEPTH - 1) {
                ss = wave_sum(ss, lane);
                const float rstd = 1.0f / sqrtf(ss / Dm + EPSF);
#pragma unroll
                for (int i = 0; i < 4; ++i) {
                    const f32x4 y = x[i] * rstd * mulv[i] + addv[i];
                    *(u32x2*)(p.XN + rw[u] * Dm + 256 * i + 4 * lane) = (u32x2){pk2(y[0], y[1]), pk2(y[2], y[3])};
                }
            }
        }
    }
}

template <int DQK, int DV>
struct AttnCfg {
    static constexpr int KP = DQK * 2 + 16, VP = 144;
    static constexpr int KCH = DQK / 8;
    static constexpr int NK = 64 * KCH, NV = DV * 8, NCH = NK + NV, NLD = (NCH + NTHR - 1) / NTHR;
    static constexpr int LDS_K = 0, LDS_V = 64 * KP, LDS_END = LDS_V + DV * VP;
    static_assert(LDS_END <= GT_END, "attention tile exceeds the LDS budget");
};

template <int DQK, int DV>
DI void attn_block(unsigned char* smem, const act_t* Qb, const act_t* Kb, const act_t* Vt, const int nk, const int q0, f32x16 (&ot)[DV / 32], float& lsum) {
    typedef AttnCfg<DQK, DV> C;
    const int tid = opaque_tid(), lane = tid & 63, w = tid >> 6, h = lane >> 5, qr = lane & 31;
    const int half = __builtin_amdgcn_readfirstlane((int)(threadIdx.x >> 8));
    const int pi = (qr & ~12) | ((qr & 4) << 1) | ((qr & 8) >> 1);
    bf16x8 qf[DQK / 16];
#pragma unroll
    for (int st = 0; st < DQK / 16; ++st) qf[st] = *(const bf16x8*)(Qb + (size_t)(q0 + w * 32 + qr) * DQK + st * 16 + h * 8);
    float m = -1e30f; lsum = 0.f;
#pragma unroll
    for (int db = 0; db < DV / 32; ++db)
#pragma unroll
        for (int r = 0; r < 16; ++r) ot[db][r] = 0.f;
    int goff[C::NLD], ldst[C::NLD];
#pragma unroll
    for (int i = 0; i < C::NLD; ++i) {
        const int c = tid + NTHR * i;
        if (c < C::NK) { const int row = c / C::KCH, part = c % C::KCH; goff[i] = (row * DQK + part * 8) * 2; ldst[i] = C::LDS_K + row * C::KP + part * 16; }
        else { const int cc = (c - C::NK) < C::NV ? c - C::NK : 0, row = cc >> 3, part = cc & 7; goff[i] = (int)((const char*)Vt - (const char*)Kb) + (row * Sn + part * 8) * 2; ldst[i] = C::LDS_V + row * C::VP + part * 16; }
    }
    u32x4 rg[C::NLD];
    const int ntiles = nk >> 6;
#define AT_LOAD(KK, KV) { _Pragma("unroll") for (int i = 0; i < C::NLD; ++i) rg[i] = *(const u32x4*)((const char*)Kb + goff[i] + ((tid + NTHR * i < C::NK) ? (KK) * (128 * DQK) : (KV) * 128)); }
#define AT_WRITE() { _Pragma("unroll") for (int i = 0; i < C::NLD; ++i) if (tid + NTHR * i < C::NCH) *(u32x4*)(smem + ldst[i]) = rg[i]; }
#define AT_QK() { \
    _Pragma("unroll") for (int kb = 0; kb < 2; ++kb) { \
        _Pragma("unroll") for (int r = 0; r < 16; ++r) sc[kb][r] = 0.f; \
        _Pragma("unroll") for (int st = 0; st < DQK / 16; ++st) { \
            const bf16x8 a = *(const bf16x8*)(smem + C::LDS_K + (kb * 32 + pi) * C::KP + st * 32 + h * 16); \
            sc[kb] = __builtin_amdgcn_mfma_f32_32x32x16_bf16(a, qf[st], sc[kb], 0, 0, 0); } } }
#define AT_PV() { \
    _Pragma("unroll") for (int kb = 0; kb < 2; ++kb) _Pragma("unroll") for (int s2 = 0; s2 < 2; ++s2) _Pragma("unroll") for (int db = 0; db < DV / 32; ++db) { \
        const bf16x8 a = *(const bf16x8*)(smem + C::LDS_V + (db * 32 + qr) * C::VP + (kb * 32 + 16 * s2 + 8 * h) * 2); \
        ot[db] = __builtin_amdgcn_mfma_f32_32x32x16_bf16(a, pf[kb][s2], ot[db], 0, 0, 0); } }
#define AT_SOFTMAX() { \
    float mx = sc[0][0]; \
    _Pragma("unroll") for (int kb = 0; kb < 2; ++kb) _Pragma("unroll") for (int r = 0; r < 16; ++r) mx = fmaxf(mx, sc[kb][r]); \
    mx = fmaxf(mx, shfl_x(mx, 32, lane)); \
    const float mn = fmaxf(m, mx), alpha = __builtin_amdgcn_exp2f(m - mn); \
    m = mn; \
    float ps = 0.f; \
    _Pragma("unroll") for (int kb = 0; kb < 2; ++kb) _Pragma("unroll") for (int r = 0; r < 16; ++r) { sc[kb][r] = __builtin_amdgcn_exp2f(sc[kb][r] - mn); ps += sc[kb][r]; } \
    lsum = lsum * alpha + ps; \
    _Pragma("unroll") for (int db = 0; db < DV / 32; ++db) _Pragma("unroll") for (int r = 0; r < 16; ++r) ot[db][r] *= alpha; \
    _Pragma("unroll") for (int kb = 0; kb < 2; ++kb) _Pragma("unroll") for (int s2 = 0; s2 < 2; ++s2) { \
        const u32x4 pw = {pk2(sc[kb][8 * s2], sc[kb][8 * s2 + 1]), pk2(sc[kb][8 * s2 + 2], sc[kb][8 * s2 + 3]), pk2(sc[kb][8 * s2 + 4], sc[kb][8 * s2 + 5]), pk2(sc[kb][8 * s2 + 6], sc[kb][8 * s2 + 7])}; \
        pf[kb][s2] = __builtin_bit_cast(bf16x8, pw); } }
    f32x16 sc[2]; bf16x8 pf[2][2];
    if (half) lds_barrier();
    AT_LOAD(0, 0)
    AT_WRITE()
    AT_LOAD(ntiles > 1 ? 1 : 0, 0)
    lds_barrier();
    AT_QK()
    lds_barrier();
    for (int kt = 0; kt < ntiles; ++kt) {
        AT_SOFTMAX()
        AT_WRITE()
        lds_barrier();
        { const int k2 = kt + 2 < ntiles ? kt + 2 : ntiles - 1, v1 = kt + 1 < ntiles ? kt + 1 : ntiles - 1; AT_LOAD(k2, v1) }
        {
            bf16x8 va[2][2][DV / 32], ka[2][DQK / 16];
#pragma unroll
            for (int kb = 0; kb < 2; ++kb)
#pragma unroll
                for (int s2 = 0; s2 < 2; ++s2)
#pragma unroll
                    for (int db = 0; db < DV / 32; ++db) va[kb][s2][db] = *(const bf16x8*)(smem + C::LDS_V + (db * 32 + qr) * C::VP + (kb * 32 + 16 * s2 + 8 * h) * 2);
#pragma unroll
            for (int kb = 0; kb < 2; ++kb)
#pragma unroll
                for (int st = 0; st < DQK / 16; ++st) ka[kb][st] = *(const bf16x8*)(smem + C::LDS_K + (kb * 32 + pi) * C::KP + st * 32 + h * 16);
            __builtin_amdgcn_sched_barrier(0);
            __builtin_amdgcn_s_setprio(1);
#pragma unroll
            for (int kb = 0; kb < 2; ++kb)
#pragma unroll
                for (int s2 = 0; s2 < 2; ++s2)
#pragma unroll
                    for (int db = 0; db < DV / 32; ++db) ot[db] = __builtin_amdgcn_mfma_f32_32x32x16_bf16(va[kb][s2][db], pf[kb][s2], ot[db], 0, 0, 0);
#pragma unroll
            for (int kb = 0; kb < 2; ++kb) {
#pragma unroll
                for (int r = 0; r < 16; ++r) sc[kb][r] = 0.f;
#pragma unroll
                for (int st = 0; st < DQK / 16; ++st) sc[kb] = __builtin_amdgcn_mfma_f32_32x32x16_bf16(ka[kb][st], qf[st], sc[kb], 0, 0, 0);
            }
            __builtin_amdgcn_s_setprio(0);
        }
        lds_barrier();
    }
    if (!half) lds_barrier();
#undef AT_SOFTMAX
#undef AT_PV
#undef AT_QK
#undef AT_WRITE
#undef AT_LOAD
    lsum += shfl_x(lsum, 32, lane);
}

DI void bp_attn(const Params& p, int l, bool upd, unsigned char* smem, int bid, int G, int vbid) {
    constexpr int QTL = Tn / 128, QTC = Cn / 128;
    const int n_dl = Bn * 4 * QTL, n_gl = Bn * 6 * QTL, n_dc = upd ? Bn * 4 * QTC : 0, n_gc = upd ? Bn * 6 * QTC : 0;
    const int tid = opaque_tid(), lane = tid & 63, w = tid >> 6, hh = lane >> 5, qr = lane & 31;
    const float lam_init = lam_init_of(l);
    for (int it = bid; it < n_dl + n_gl + n_dc + n_gc; it += G) {
        int x = it; bool isdiff, isc;
        if (x < n_dl) { isdiff = true; isc = false; }
        else if ((x -= n_dl) < n_gl) { isdiff = false; isc = false; }
        else if ((x -= n_gl) < n_dc) { isdiff = true; isc = true; }
        else { x -= n_dc; isdiff = false; isc = true; }
        const int qt_n = isc ? QTC : QTL, qlen = isc ? Cn : Tn, nk = isc ? Cn : Sn;
        const int qt = x % qt_n, hb = x / qt_n;
        const int q0 = qt * 128;
        if (isdiff) {
            const int h = hb % 4, b = hb / 4;
            const act_t* Vt = p.DVt + (size_t)(b * 4 + h) * 96 * Sn;
            f32x16 ot[3]; float ls;
            f32x4* stash = (f32x4*)(p.DO + ((size_t)vbid * NTHR + tid) * 48);
            attn_block<48, 96>(smem, (isc ? p.DQC : p.DQL) + ((size_t)(b * 4 + h) * 2) * qlen * 48, p.DK + ((size_t)(b * 4 + h) * 2) * Sn * 48, Vt, nk, q0, ot, ls);
            {
                const float i1 = 1.0f / ls;
#pragma unroll
                for (int db = 0; db < 3; ++db)
#pragma unroll
                    for (int g = 0; g < 4; ++g) stash[db * 4 + g] = (f32x4){ot[db][4 * g] * i1, ot[db][4 * g + 1] * i1, ot[db][4 * g + 2] * i1, ot[db][4 * g + 3] * i1};
            }
            attn_block<48, 96>(smem, (isc ? p.DQC : p.DQL) + ((size_t)(b * 4 + h) * 2 + 1) * qlen * 48, p.DK + ((size_t)(b * 4 + h) * 2 + 1) * Sn * 48, Vt, nk, q0, ot, ls);
            const float lam = p.LAMV[l];
            const float i2 = lam / ls;
            float ss = 0.f;
#pragma unroll
            for (int db = 0; db < 3; ++db)
#pragma unroll
                for (int g = 0; g < 4; ++g) {
                    const f32x4 o1 = stash[db * 4 + g];
#pragma unroll
                    for (int r = 0; r < 4; ++r) { const float v = o1[r] - ot[db][4 * g + r] * i2; ot[db][4 * g + r] = v; ss += v * v; }
                }
            ss += shfl_x(ss, 32, lane);
            const float rstd = 1.0f / sqrtf(ss / 96 + EPSF) * (1.0f - lam_init);
            const float* sg = p.diff_subln + l * 96;
            const size_t tok = isc ? (size_t)NL + b * Cn + q0 + w * 32 + qr : (size_t)b * Tn + q0 + w * 32 + qr;
#pragma unroll
            for (int db = 0; db < 3; ++db)
#pragma unroll
                for (int g = 0; g < 4; ++g) {
                    const int dv = db * 32 + 8 * g + 4 * hh;
                    const f32x4 sv = *(const f32x4*)(sg + dv);
                    *(u32x2*)(p.MIX + tok * Dm + h * 96 + dv) = (u32x2){pk2(ot[db][4 * g] * rstd * sv[0], ot[db][4 * g + 1] * rstd * sv[1]),
                                                                      pk2(ot[db][4 * g + 2] * rstd * sv[2], ot[db][4 * g + 3] * rstd * sv[3])};
                }
        } else {
            const int hq = hb % 6, b = hb / 6, kv = hq / 3;
            f32x16 ot[2]; float ls;
            attn_block<64, 64>(smem, (isc ? p.GQC : p.GQL) + (size_t)(b * 6 + hq) * qlen * 64, p.GK + (size_t)(b * 2 + kv) * Sn * 64, p.GVt + (size_t)(b * 2 + kv) * 64 * Sn, nk, q0, ot, ls);
            const float il = 1.0f / ls;
            const size_t tok = isc ? (size_t)NL + b * Cn + q0 + w * 32 + qr : (size_t)b * Tn + q0 + w * 32 + qr;
#pragma unroll
            for (int db = 0; db < 2; ++db)
#pragma unroll
                for (int g = 0; g < 4; ++g) {
                    const int dv = db * 32 + 8 * g + 4 * hh;
                    *(u32x2*)(p.MIX + tok * Dm + 384 + hq * 64 + dv) = (u32x2){pk2(ot[db][4 * g] * il, ot[db][4 * g + 1] * il), pk2(ot[db][4 * g + 2] * il, ot[db][4 * g + 3] * il)};
                }
        }
    }
}

DI void bp_mod(const Params& p, unsigned char* smem, int bid, int G, long gtid, long gsize) {
    const int tid = opaque_tid(), lane = tid & 63, w = tid >> 6;
    float* sl = (float*)smem;
    float* red = sl + (Bn + 1) * Dm;
    if (bid < DEPTH * (MODW / 64)) {
        f32x4 cv[Bn + 1];
#pragma unroll
        for (int r = 0; r <= Bn; ++r) cv[r] = *(const f32x4*)((r < Bn ? p.c + r * Dm : p.c_ctx) + tid * 4);
#pragma unroll
        for (int r = 0; r <= Bn; ++r) *(f32x4*)(sl + r * Dm + tid * 4) = (f32x4){silu_f(cv[r][0]), silu_f(cv[r][1]), silu_f(cv[r][2]), silu_f(cv[r][3])};
    }
    __syncthreads();
    const int ks = tid >> 4, j4 = tid & 15;
    for (int item = bid; item < DEPTH * (MODW / 64); item += G) {
        const int l = item / (MODW / 64), col = (item % (MODW / 64)) * 64 + j4 * 4;
        const float* wp = p.w_mod + ((size_t)l * Dm + ks * 64) * MODW + col;
        f32x4 acc[Bn + 1];
#pragma unroll
        for (int r = 0; r <= Bn; ++r) acc[r] = (f32x4){0.f, 0.f, 0.f, 0.f};
#pragma unroll 16
        for (int kk = 0; kk < 64; ++kk) {
            const f32x4 wv = *(const f32x4*)(wp + (size_t)kk * MODW);
#pragma unroll
            for (int r = 0; r <= Bn; ++r) acc[r] = acc[r] + sl[r * Dm + ks * 64 + kk] * wv;
        }
#pragma unroll
        for (int r = 0; r <= Bn; ++r)
#pragma unroll
            for (int e = 0; e < 4; ++e) { float v = acc[r][e]; v += shfl_x(v, 16, lane); v += shfl_x(v, 32, lane); acc[r][e] = v; }
        __syncthreads();
        if (lane < 16)
#pragma unroll
            for (int r = 0; r <= Bn; ++r) *(f32x4*)(red + ((w * 16 + lane) * (Bn + 1) + r) * 4) = acc[r];
        __syncthreads();
        if (tid < 16 * (Bn + 1)) {
            const int jj = tid & 15, r = tid >> 4;
            f32x4 t = *(const f32x4*)(p.b_mod + l * MODW + (item % (MODW / 64)) * 64 + jj * 4);
#pragma unroll
            for (int ww = 0; ww < 4; ++ww) t = t + *(const f32x4*)(red + ((ww * 16 + jj) * (Bn + 1) + r) * 4);
            *(f32x4*)(p.mod + ((size_t)l * (Bn + 1) + r) * MODW + (item % (MODW / 64)) * 64 + jj * 4) = t;
        }
    }
    (void)gtid; (void)gsize;
}

DI size_t chunk_slot(int b, int h, int dir, int cid) { return (size_t)((b * 4 + h) * 2 + dir) * NCH + cid; }
DI float wave_incl_scan_add(float v, int lane, bool rev) {
#pragma unroll
    for (int o = 1; o < 64; o <<= 1) { const float t = shfl_i(v, (rev ? lane + o : lane - o) & 63); const bool ok = rev ? (lane + o < 64) : (lane >= o); if (ok) v += t; }
    return v;
}
DI float wave_incl_scan_max(float v, int lane, bool rev) {
#pragma unroll
    for (int o = 1; o < 64; o <<= 1) { const float t = shfl_i(v, (rev ? lane + o : lane - o) & 63); const bool ok = rev ? (lane + o < 64) : (lane >= o); if (ok) v = fmaxf(v, t); }
    return v;
}
DI void bp_post(const Params& p, int l, unsigned char* smem, int bid, int G) {
    const int tid = opaque_tid(), lane = tid & 63, w = tid >> 6;
    constexpr int NGRP = NTOK / 64, N_M = NGRP * 4, N_V = NGRP * 4, N_Q = NTOK / 16;
#ifdef PROBE_POSTDUP
    for (int pass_ = 0; pass_ < 2; ++pass_)
#endif
    for (int item = bid; item < N_M + N_V + N_Q; item += G) {
#ifdef PROBE_POSTDUP
        if (pass_ == 1 && (item >= N_M + N_V ? 2 : item >= N_M ? 1 : 0) != PROBE_POSTDUP) continue;
#endif
        if (item >= N_M + N_V) {
            const int tokb = (item - N_M - N_V) * 16 + w * 4;
            const int j = lane & 15, ug = lane >> 4, third = j / 3;
            f32x4 gvv[6];
#pragma unroll
            for (int st = 0; st < 6; ++st) {
                const int u = st * 4 + ug; const bool d64 = st >= 4;
                const float* gw = !d64 ? ((u >= 8 ? p.diff_k_norm : p.diff_q_norm) + l * 48) : ((u >= 22 ? p.gqa_k_norm : p.gqa_q_norm) + l * 64);
                gvv[st] = (d64 || j < 12) ? *(const f32x4*)(gw + 4 * j) : (f32x4){0.f, 0.f, 0.f, 0.f};
            }
            const bool isc = tokb >= NL;
            const int b = tok_b(tokb), ti0 = tok_i(tokb), sx0 = tok_s(tokb);
            const char* xsrc[6]; char* dbase[6]; float oscv[6];
#pragma unroll
            for (int st = 0; st < 6; ++st) {
                const int u = st * 4 + ug; const bool d64 = st >= 4;
                const int soff = !d64 ? ((u >= 8 ? DK_OFF : DQ_OFF) + ((u & 7) >> 1) * 96 + (u & 1) * 48) : (u >= 22 ? GK_OFF + (u - 22) * 64 : GQ_OFF + (u - 16) * 64);
                xsrc[st] = (const char*)(p.PROJB + (size_t)tokb * INW + soff + 4 * j);
                act_t* dst;
                if (!d64) {
                    const bool isk = u >= 8; const int hh = (u & 7) >> 1, ww = u & 1;
                    oscv[st] = isk ? 1.0f : 0.14433756729740643f * LOG2E;
                    dst = isk ? p.DK + (((size_t)(b * 4 + hh) * 2 + ww) * Sn + sx0) * 48
                              : (isc ? p.DQC + (((size_t)(b * 4 + hh) * 2 + ww) * Cn + ti0) * 48 : p.DQL + (((size_t)(b * 4 + hh) * 2 + ww) * Tn + ti0) * 48);
                } else {
                    const bool isk = u >= 22; const int hh = isk ? u - 22 : u - 16;
                    oscv[st] = isk ? 1.0f : 0.125f * LOG2E;
                    dst = isk ? p.GK + ((size_t)(b * 2 + hh) * Sn + sx0) * 64 : (isc ? p.GQC + ((size_t)(b * 6 + hh) * Cn + ti0) * 64 : p.GQL + ((size_t)(b * 6 + hh) * Tn + ti0) * 64);
                }
                dbase[st] = (char*)(dst + 4 * j);
            }
            const int fi48 = (j - third * 3) * 4, fi64 = 12 + (j & 3) * 4;
            const bool sec48 = j >= 6, sec64 = j >= 8, act48 = j < 12;
            f32x4 xall[4][6];
#pragma unroll
            for (int t4 = 0; t4 < 4; ++t4)
#pragma unroll
                for (int st = 0; st < 6; ++st)
                    { const f32x4 xv_ = ld4bf((const act_t*)(xsrc[st] + (size_t)t4 * INW * 2));
                      xall[t4][st] = (st >= 4 || act48) ? xv_ : (f32x4){0.f, 0.f, 0.f, 0.f}; }
#pragma unroll
            for (int t4 = 0; t4 < 4; ++t4) {
                const int ti = ti0 + t4;
                const float* rt48 = p.ROPE + ((size_t)(sec48 ? (ti & 63) : (ti >> 6)) * 28 + (act48 ? fi48 : 0)) * 2;
                const float* rt64 = p.ROPE + ((size_t)(sec64 ? (ti & 63) : (ti >> 6)) * 28 + fi64) * 2;
                const f32x4 a0 = *(const f32x4*)rt48, a1 = *(const f32x4*)(rt48 + 4), c0 = *(const f32x4*)rt64, c1 = *(const f32x4*)(rt64 + 4);
#pragma unroll
                for (int st = 0; st < 6; ++st) {
                    const bool d64 = st >= 4;
                    const bool act = d64 || act48;
                    const f32x4 x = xall[t4][st];
                    const float ss = row16_sum(x[0] * x[0] + x[1] * x[1] + x[2] * x[2] + x[3] * x[3]);
                    const float rstd = __builtin_amdgcn_rsqf(ss * (d64 ? 1.0f / 64.f : 1.0f / 48.f) + EPSF);
                    f32x4 y = x * rstd * gvv[st];
                    if (!isc) {
                        const int plane = d64 ? (lane ^ 4) : ((third & 1) ? lane - 3 : lane + 3);
                        f32x4 py;
#pragma unroll
                        for (int r = 0; r < 4; ++r) py[r] = shfl_i(y[r], plane);
                        const bool isx2 = d64 ? ((j & 4) != 0) : ((third & 1) != 0);
                        const f32x4 t0 = d64 ? c0 : a0, t1 = d64 ? c1 : a1;
                        const f32x4 cs = {t0[0], t0[2], t1[0], t1[2]}, sn = {t0[1], t0[3], t1[1], t1[3]};
                        y = isx2 ? y * cs + py * sn : y * cs - py * sn;
                    }
                    y = y * oscv[st];
                    if (act) *(u32x2*)(dbase[st] + t4 * (d64 ? 128 : 96)) = (u32x2){pk2(y[0], y[1]), pk2(y[2], y[3])};
                }
            }
        } else if (item >= N_M) {
            const int g = (item - N_M) >> 2, qd = (item - N_M) & 3;
            const int tok0 = g * 64;
            const int b = tok_b(tok0), s0 = tok_s(tok0);
            __syncthreads();
#pragma unroll
            for (int i = 0; i < 8; ++i) {
                const int c = tid + NTHR * i, tt = c >> 5, d4 = c & 31, vd = qd * 128 + d4 * 4;
                *(u32x2*)(smem + tt * 264 + d4 * 8) = *(const u32x2*)(p.PROJB + (size_t)(tok0 + tt) * INW + (vd < 384 ? DV_OFF + vd : GV_OFF + vd - 384));
            }
            __syncthreads();
#pragma unroll
            for (int i = 0; i < 4; ++i) {
                const int o = tid + NTHR * i, dloc = o >> 3, t8 = o & 7, vd = qd * 128 + dloc;
                unsigned e[8];
#pragma unroll
                for (int r = 0; r < 8; ++r) e[r] = *(const unsigned short*)(smem + (t8 * 8 + r) * 264 + dloc * 2);
                act_t* dst = vd < 384 ? p.DVt + ((size_t)(b * 4 + vd / 96) * 96 + vd % 96) * Sn : p.GVt + ((size_t)(b * 2 + (vd - 384) / 64) * 64 + (vd - 384) % 64) * Sn;
                *(u32x4*)(dst + s0 + t8 * 8) = (u32x4){e[0] | (e[1] << 16), e[2] | (e[3] << 16), e[4] | (e[5] << 16), e[6] | (e[7] << 16)};
            }
        } else {
            const int g = item >> 2, h = item & 3;
            const int tok0 = g * 64; const bool isc = tok0 >= NL;
            const int b = tok_b(tok0), ti0 = tok_i(tok0);
        float* kf = (float*)smem; float* vf = kf + 64 * 68; float* gl = vf + 64 * 68;
        const int cid = isc ? ti0 / 64 : NCC + ti0 / 64;
            __syncthreads();
            float gpre[4];
            { const float* prg = p.PG + (size_t)(tok0 + (tid & 63)) * 16;
#pragma unroll
              for (int q = 0; q < 4; ++q) gpre[q] = prg[4 * q + h]; }
            {
                const int tt = tid >> 2, c16 = tid & 3, ti = ti0 + tt, seglen = isc ? Cn : Tn;
                const act_t* pr = p.PROJB + (size_t)(tok0 + tt) * INW;
                const bool hasp = ti > 0, hasn = ti < seglen - 1;
                const float* cw = p.mlstm_conv_w + (size_t)l * 1536; const float* cb = p.mlstm_conv_b + l * 512;
                const act_t* prp = hasp ? pr - INW : pr; const act_t* prn = hasn ? pr + INW : pr;
                const float mp = hasp ? 1.0f : 0.0f, mq = hasn ? 1.0f : 0.0f;
                u32x2 xc[2][4], xp[2][4], xn[2][4];
#pragma unroll
                for (int part = 0; part < 2; ++part)
#pragma unroll
                    for (int i4 = 0; i4 < 4; ++i4) {
                        const int ch = part * 256 + h * 64 + c16 * 16 + i4 * 4;
                        xc[part][i4] = *(const u32x2*)(pr + MQK_OFF + ch); xp[part][i4] = *(const u32x2*)(prp + MQK_OFF + ch); xn[part][i4] = *(const u32x2*)(prn + MQK_OFF + ch);
                    }
#pragma unroll
                for (int part = 0; part < 2; ++part)
#pragma unroll
                    for (int i4 = 0; i4 < 4; ++i4) {
                        const int ch = part * 256 + h * 64 + c16 * 16 + i4 * 4;
                        const u32x2 c_ = xc[part][i4], p_ = xp[part][i4], n_ = xn[part][i4];
                        f32x4 a = *(const f32x4*)(cb + ch) + (f32x4){bflo(c_[0]), bfhi(c_[0]), bflo(c_[1]), bfhi(c_[1])} * *(const f32x4*)(cw + 512 + ch);
                        a = a + (f32x4){bflo(p_[0]), bfhi(p_[0]), bflo(p_[1]), bfhi(p_[1])} * (*(const f32x4*)(cw + ch) * mp);
                        a = a + (f32x4){bflo(n_[0]), bfhi(n_[0]), bflo(n_[1]), bfhi(n_[1])} * (*(const f32x4*)(cw + 1024 + ch) * mq);
#pragma unroll
                        for (int r = 0; r < 4; ++r) a[r] = a[r] * __builtin_amdgcn_rcpf(1.0f + __expf(-a[r]));
                        if (part) { a = a * 0.125f; *(f32x4*)(kf + tt * 68 + c16 * 16 + i4 * 4) = a; }
                        *(u32x2*)(p.MQKB + (size_t)(tok0 + tt) * 512 + ch) = (u32x2){pk2(a[0], a[1]), pk2(a[2], a[3])};
                    }
#pragma unroll
                for (int i4 = 0; i4 < 4; ++i4) *(f32x4*)(vf + tt * 68 + c16 * 16 + i4 * 4) = ld4bf(pr + MV_OFF + h * 64 + c16 * 16 + i4 * 4);
            }
            if (tid < 64) {
                const float* gb = p.mlstm_gate_b + l * 16;
                const float f1 = gpre[1] + gb[4 + h], f3 = gpre[3] + gb[12 + h];
                const f32x4 gt = {gpre[0] + gb[h], fminf(f1, 0.f) - __logf(1.0f + __expf(-fabsf(f1))), gpre[2] + gb[8 + h], fminf(f3, 0.f) - __logf(1.0f + __expf(-fabsf(f3)))};
                gl[tid] = gt[0]; gl[128 + tid] = gt[1]; gl[64 + tid] = gt[2]; gl[192 + tid] = gt[3];
                *(f32x4*)(p.MG4 + ((size_t)(tok0 + tid) * 4 + h) * 4) = gt;
#if !IMPL_MLSTM
                { float* mg = p.MGATE + (size_t)(tok0 + tid) * 16; mg[h] = gt[0]; mg[4 + h] = gt[1]; mg[8 + h] = gt[2]; mg[12 + h] = gt[3]; }
#endif
            }
            __syncthreads();
            if (w < 2) {
                const int dir = w;
                int lane_ = lane; asm volatile("" : "+v"(lane_));
                const int lane = lane_;
                const float lf = gl[128 + dir * 64 + lane], li = gl[dir * 64 + lane];
                const float inc = wave_incl_scan_add(lf, lane, dir == 0);
                const float gg = inc - lf + li;
                float mloc = gg;
#pragma unroll
                for (int o = 32; o > 0; o >>= 1) mloc = fmaxf(mloc, shfl_x(mloc, o, lane));
                gl[256 + dir * 64 + lane] = __expf(gg - mloc);
                const float E = wave_sum(lf, lane);
                if (lane == 0) { float* cs = p.CHS + chunk_slot(b, h, dir, cid) * 2; cs[0] = mloc; cs[1] = E; }
            }
            __syncthreads();
            {
                constexpr int PKT = 36352, PVW0 = PKT + 64 * 144, PVW1 = PVW0 + 65 * 144;
                static_assert(PVW1 + 65 * 144 <= 65536 && PVW1 + 80 * 144 <= SMEM_BYTES, "mLSTM summary operand images exceed the LDS budget");
                {
                    const int r = tid >> 2, s0 = (tid & 3) * 16;
                    unsigned kt[8], v0p[8], v1p[8];
#pragma unroll
                    for (int jj = 0; jj < 8; ++jj) {
                        const int sa = s0 + 2 * jj, sb = sa + 1;
                        const float ka = kf[sa * 68 + r], kb = kf[sb * 68 + r], va = vf[sa * 68 + r], vb = vf[sb * 68 + r];
                        kt[jj] = pk2(ka, kb);
                        v0p[jj] = pk2(gl[256 + sa] * va, gl[256 + sb] * vb); v1p[jj] = pk2(gl[320 + sa] * va, gl[320 + sb] * vb);
                    }
                    unsigned char* dk = smem + PKT + r * 144 + s0 * 2; unsigned char* d0p = smem + PVW0 + r * 144 + s0 * 2; unsigned char* d1p = smem + PVW1 + r * 144 + s0 * 2;
                    *(u32x4*)dk = (u32x4){kt[0], kt[1], kt[2], kt[3]}; *(u32x4*)(dk + 16) = (u32x4){kt[4], kt[5], kt[6], kt[7]};
                    *(u32x4*)d0p = (u32x4){v0p[0], v0p[1], v0p[2], v0p[3]}; *(u32x4*)(d0p + 16) = (u32x4){v0p[4], v0p[5], v0p[6], v0p[7]};
                    *(u32x4*)d1p = (u32x4){v1p[0], v1p[1], v1p[2], v1p[3]}; *(u32x4*)(d1p + 16) = (u32x4){v1p[4], v1p[5], v1p[6], v1p[7]};
                    if (tid < 16) {
                        const int dir = tid >> 3, sq = (tid & 7) * 8; const float* wv = gl + 256 + dir * 64 + sq;
                        *(u32x4*)(smem + (dir ? PVW1 : PVW0) + 64 * 144 + sq * 2) = (u32x4){pk2(wv[0], wv[1]), pk2(wv[2], wv[3]), pk2(wv[4], wv[5]), pk2(wv[6], wv[7])};
                    }
                }
                __syncthreads();
#pragma unroll
                for (int dir = 0; dir < 2; ++dir) {
                    f32x4 acc[5];
#pragma unroll
                    for (int vb = 0; vb < 5; ++vb) acc[vb] = (f32x4){0.f, 0.f, 0.f, 0.f};
#pragma unroll
                    for (int ks = 0; ks < 2; ++ks) {
                        const bf16x8 ak = *(const bf16x8*)(smem + PKT + (16 * w + (lane & 15)) * 144 + ks * 64 + (lane >> 4) * 16);
#pragma unroll
                        for (int vb = 0; vb < 5; ++vb) {
                            const bf16x8 bv = *(const bf16x8*)(smem + (dir ? PVW1 : PVW0) + (vb * 16 + (lane & 15)) * 144 + ks * 64 + (lane >> 4) * 16);
                            acc[vb] = __builtin_amdgcn_mfma_f32_16x16x32_bf16(ak, bv, acc[vb], 0, 0, 0);
                        }
                    }
                    act_t* kvd = (act_t*)p.KV + chunk_slot(b, h, dir, cid) * 4096;
                    const int dcol = 16 * w + (lane >> 4) * 4;
#pragma unroll
                    for (int vb = 0; vb < 4; ++vb) *(u32x2*)(kvd + (vb * 16 + (lane & 15)) * 64 + dcol) = (u32x2){pk2(acc[vb][0], acc[vb][1]), pk2(acc[vb][2], acc[vb][3])};
                    if ((lane & 15) == 0) *(f32x4*)(p.NLC + chunk_slot(b, h, dir, cid) * 64 + dcol) = acc[4];
                }
            }
        }
    }
}

constexpr int ML_Q = 0, ML_K = 9216, ML_VT = 18432, ML_C = 29952, ML_QA = 41472, ML_SC = 50688;
constexpr int SC_LI = 0, SC_LF = 128, SC_BB = 256, SC_MT = 384, SC_AA = 512, SC_UU = 640, SC_WCH = 768, SC_CHS = 848;
static_assert(ML_SC + (SC_CHS + 4 * NCH) * 4 <= 65536, "mLSTM LDS layout exceeds the budget");
DI int ml_scanpos(int dir, int cid) { return dir == 0 ? cid : (cid < NCC ? NCC - 1 - cid : NCC + (NCH - 1 - cid)); }
DI int ml_cid_at(int dir, int i) { return dir == 0 ? i : (i < NCC ? NCC - 1 - i : NCH - 1 - (i - NCC)); }
DI act_t* ml_cst(const Params& p) { return (act_t*)p.KV + (size_t)Bn * 4 * 2 * NCH * 4096; }
DI void bp_mscan(const Params& p, int l, unsigned char* smem, int item) {
    const int tid = opaque_tid();
    const int seq = item >> 2, sl = item & 3, dir = seq & 1;
    float* cs = (float*)smem;
    __syncthreads();
    if (tid < NCH) { const f32x2 v = *(const f32x2*)(p.CHS + ((size_t)seq * NCH + ml_cid_at(dir, tid)) * 2); cs[tid * 2] = v[0]; cs[tid * 2 + 1] = v[1]; }
    __syncthreads();
    const int idx = sl * 1024 + tid * 4;
    const bool don = sl == 0 && tid < 64;
    const act_t* kvb = (const act_t*)p.KV + (size_t)seq * NCH * 4096 + idx;
    act_t* cst = ml_cst(p) + (size_t)seq * NCH * 4096 + idx;
    constexpr int RING = 6;
    u32x2 kr[RING]; float nr[RING];
#pragma unroll
    for (int j = 0; j < RING; ++j) { const int cid = ml_cid_at(dir, j); kr[j] = *(const u32x2*)(kvb + (size_t)cid * 4096); nr[j] = don ? p.NLC[((size_t)seq * NCH + cid) * 64 + tid] : 0.f; }
    f32x4 c = {0.f, 0.f, 0.f, 0.f}; float m = 0.f, nacc = 0.f;
#pragma unroll
    for (int j = 0; j < NCH; ++j) {
        __hip_atomic_store((unsigned long long*)(cst + (size_t)j * 4096), ((unsigned long long)pk2(c[2], c[3]) << 32) | pk2(c[0], c[1]), __ATOMIC_RELAXED, __HIP_MEMORY_SCOPE_AGENT);
        if (don) __hip_atomic_store(&p.NST[((size_t)seq * NCH + j) * 64 + tid], nacc, __ATOMIC_RELAXED, __HIP_MEMORY_SCOPE_AGENT);
        if (j == NCH - 1) break;
        const float mloc = cs[j * 2], E = cs[j * 2 + 1];
        const float mn = fmaxf(E + m, mloc), a = __expf(E + m - mn), bb = __expf(mloc - mn);
        m = mn;
        const u32x2 kv = kr[j % RING]; const float nl = nr[j % RING];
        if (j + RING < NCH - 1) { const int cid = ml_cid_at(dir, j + RING); kr[j % RING] = *(const u32x2*)(kvb + (size_t)cid * 4096); nr[j % RING] = don ? p.NLC[((size_t)seq * NCH + cid) * 64 + tid] : 0.f; }
        c = (f32x4){a * c[0] + bb * bflo(kv[0]), a * c[1] + bb * bfhi(kv[0]), a * c[2] + bb * bflo(kv[1]), a * c[3] + bb * bfhi(kv[1])};
        nacc = a * nacc + bb * nl;
    }
    asm volatile("s_waitcnt vmcnt(0)" ::: "memory");
    __syncthreads();
    if (tid == 0) atomicAdd(p.BAR + 3700 + l, 1u);
}

DI void bp_mlstm(const Params& p, int l, bool upd, unsigned char* smem, int bid, int G) {
    const int tid = opaque_tid(), lane = tid & 63, w = tid >> 6;
    float* sc = (float*)(smem + ML_SC);
    constexpr int CPL = Tn / 64;
    const int nlat = Bn * 4 * CPL, nctx = upd ? Bn * 4 * NCC : 0;
    for (int it = bid; it < nlat + nctx; it += G) {
        int b, h, cid;
        if (it < nlat) { cid = NCC + it % CPL; h = (it / CPL) % 4; b = it / (CPL * 4); }
        else { const int x = it - nlat; cid = x % NCC; h = (x / NCC) % 4; b = x / (NCC * 4); }
        const int tok0 = cid < NCC ? NL + b * Cn + cid * 64 : b * Tn + (cid - NCC) * 64;
        unsigned long long cpre[2][4]; float npre[2];
#pragma unroll
        for (int dir = 0; dir < 2; ++dir) {
            const size_t sp = (size_t)chunk_slot(b, h, dir, 0) + ml_scanpos(dir, cid);
            const act_t* cst = ml_cst(p) + sp * 4096;
#pragma unroll
            for (int q4 = 0; q4 < 4; ++q4) cpre[dir][q4] = __hip_atomic_load((const unsigned long long*)(cst + (tid + NTHR * q4) * 4), __ATOMIC_RELAXED, __HIP_MEMORY_SCOPE_AGENT);
            npre[dir] = tid < 64 ? __hip_atomic_load(&p.NST[sp * 64 + tid], __ATOMIC_RELAXED, __HIP_MEMORY_SCOPE_AGENT) : 0.f;
        }
        u32x2 ogpre[4];
#pragma unroll
        for (int vt = 0; vt < 4; ++vt) ogpre[vt] = *(const u32x2*)(p.PROJB + ((size_t)tok0 + 16 * w + (lane & 15)) * INW + MO_OFF + h * 64 + vt * 16 + (lane >> 4) * 4);
        __syncthreads();
#pragma unroll
        for (int i = 0; i < 4; ++i) {
            const int c = tid + NTHR * i, isk = c >> 9, cc = c & 511, row = cc >> 3, part = cc & 7;
            *(u32x4*)(smem + (isk ? ML_K : ML_Q) + row * 144 + part * 16) = *(const u32x4*)(p.MQKB + (size_t)(tok0 + row) * 512 + isk * 256 + h * 64 + part * 8);
        }
#pragma unroll
        for (int i = 0; i < 2; ++i) {
            const int c = tid + NTHR * i, tt = c >> 3, v8 = c & 7;
            const u32x4 vv = *(const u32x4*)(p.PROJB + (size_t)(tok0 + tt) * INW + MV_OFF + h * 64 + v8 * 8);
            const unsigned pa = vv[0], pb = vv[1], pc = vv[2], pd = vv[3];
            unsigned char* d0 = smem + ML_VT + (v8 * 8) * 144 + tt * 2;
            *(unsigned short*)(d0) = (unsigned short)pa; *(unsigned short*)(d0 + 144) = (unsigned short)(pa >> 16);
            *(unsigned short*)(d0 + 288) = (unsigned short)pb; *(unsigned short*)(d0 + 432) = (unsigned short)(pb >> 16);
            *(unsigned short*)(d0 + 576) = (unsigned short)pc; *(unsigned short*)(d0 + 720) = (unsigned short)(pc >> 16);
            *(unsigned short*)(d0 + 864) = (unsigned short)pd; *(unsigned short*)(d0 + 1008) = (unsigned short)(pd >> 16);
        }
        if (tid < 144) {
            unsigned zz = 0u; asm volatile("" : "+v"(zz));
            const unsigned one2 = tid < 9 ? 0x3F803F80u : zz;
            *(u32x4*)(smem + ML_VT + 64 * 144 + tid * 16) = (u32x4){one2, one2, one2, one2};
            *(u32x4*)(smem + ML_C + 64 * 144 + tid * 16) = (u32x4){zz, zz, zz, zz};
        }
        if (tid < 64) {
            const f32x4 gt = *(const f32x4*)(p.MG4 + ((size_t)(tok0 + tid) * 4 + h) * 4);
            sc[SC_LI + tid] = gt[0]; sc[SC_LF + tid] = gt[1]; sc[SC_LI + 64 + tid] = gt[2]; sc[SC_LF + 64 + tid] = gt[3];
        } else if (tid < 64 + 2 * NCH) {
            const int dir = (tid - 64) / NCH, i = (tid - 64) % NCH;
            const f32x2 cs = *(const f32x2*)(p.CHS + chunk_slot(b, h, dir, ml_cid_at(dir, i)) * 2);
            sc[SC_CHS + (dir * NCH + i) * 2] = cs[0]; sc[SC_CHS + (dir * NCH + i) * 2 + 1] = cs[1];
        }
        __syncthreads();
        if (w < 2) {
            const int dir = w, pj = ml_scanpos(dir, cid);
            const float lf = sc[SC_LF + dir * 64 + lane], li = sc[SC_LI + dir * 64 + lane];
            const float bsum = wave_incl_scan_add(lf, lane, dir == 1);
            const float u = li - bsum;
            const float cm = wave_incl_scan_max(u, lane, dir == 1);
            float m = 0.f;
            for (int i = 0; i < pj; ++i) { const float* cs = sc + SC_CHS + (dir * NCH + i) * 2; m = fmaxf(cs[1] + m, cs[0]); }
            const float mt = bsum + fmaxf(m, cm);
            sc[SC_BB + dir * 64 + lane] = bsum; sc[SC_UU + dir * 64 + lane] = u; sc[SC_MT + dir * 64 + lane] = mt; sc[SC_AA + dir * 64 + lane] = __expf(bsum + m - mt);
        }
        f32x4 sacc[4];
#pragma unroll
        for (int si = 0; si < 4; ++si) sacc[si] = (f32x4){0.f, 0.f, 0.f, 0.f};
#pragma unroll
        for (int ks = 0; ks < 2; ++ks) {
            const bf16x8 bq = *(const bf16x8*)(smem + ML_Q + (16 * w + (lane & 15)) * 144 + ks * 64 + (lane >> 4) * 16);
#pragma unroll
            for (int si = 0; si < 4; ++si) {
                const bf16x8 ak = *(const bf16x8*)(smem + ML_K + (si * 16 + (lane & 15)) * 144 + ks * 64 + (lane >> 4) * 16);
                sacc[si] = __builtin_amdgcn_mfma_f32_16x16x32_bf16(ak, bq, sacc[si], 0, 0, 0);
            }
        }
        __syncthreads();
        f32x4 hs[4];
#pragma unroll
        for (int vt = 0; vt < 4; ++vt) hs[vt] = (f32x4){0.f, 0.f, 0.f, 0.f};
        const int pcol = 16 * w + (lane & 15);
#pragma unroll 1
        for (int dir = 0; dir < 2; ++dir) {
            {
#pragma unroll
                for (int q4 = 0; q4 < 4; ++q4) { const int idx = (tid + NTHR * q4) * 4; const unsigned long long v = dir == 0 ? cpre[0][q4] : cpre[1][q4];
                    *(u32x2*)(smem + ML_C + (idx >> 6) * 144 + (idx & 63) * 2) = (u32x2){(unsigned)v, (unsigned)(v >> 32)}; }
                if (tid < 64) *(unsigned short*)(smem + ML_C + 64 * 144 + tid * 2) = (unsigned short)pk2(dir == 0 ? npre[0] : npre[1], 0.f);
            }
            {
                const float mtp = sc[SC_MT + dir * 64 + pcol], bp = sc[SC_BB + dir * 64 + pcol];
#pragma unroll
                for (int si = 0; si < 4; ++si) {
                    const int sb = si * 16 + (lane >> 4) * 4;
                    const f32x4 uu = *(const f32x4*)(sc + SC_UU + dir * 64 + sb);
                    float wv[4];
#pragma unroll
                    for (int r = 0; r < 4; ++r) { const int sx = sb + r; const bool valid = dir == 0 ? (sx <= pcol) : (sx >= pcol); wv[r] = valid ? __expf(bp + uu[r] - mtp) * sacc[si][r] : 0.f; }
                    *(u32x2*)(smem + ML_K + pcol * 144 + sb * 2) = (u32x2){pk2(wv[0], wv[1]), pk2(wv[2], wv[3])};
                }
                const int row = tid >> 2, c16 = tid & 3;
                const float ar = sc[SC_AA + dir * 64 + row];
#pragma unroll
                for (int i2 = 0; i2 < 2; ++i2) {
                    const u32x4 qv = *(const u32x4*)(smem + ML_Q + row * 144 + c16 * 32 + i2 * 16);
                    u32x4 o;
#pragma unroll
                    for (int r = 0; r < 4; ++r) o[r] = pk2(bflo(qv[r]) * ar, bfhi(qv[r]) * ar);
                    *(u32x4*)(smem + ML_QA + row * 144 + c16 * 32 + i2 * 16) = o;
                }
            }
            __syncthreads();
            f32x4 na5[5];
#pragma unroll
            for (int vt = 0; vt < 5; ++vt) na5[vt] = (f32x4){0.f, 0.f, 0.f, 0.f};
#pragma unroll
            for (int ks = 0; ks < 4; ++ks) {
                const bf16x8 bfrag = *(const bf16x8*)(smem + (ks < 2 ? ML_K : ML_QA) + pcol * 144 + (ks & 1) * 64 + (lane >> 4) * 16);
#pragma unroll
                for (int vt = 0; vt < 5; ++vt) {
                    const bf16x8 afrag = *(const bf16x8*)(smem + (ks < 2 ? ML_VT : ML_C) + (vt * 16 + (lane & 15)) * 144 + (ks & 1) * 64 + (lane >> 4) * 16);
                    na5[vt] = __builtin_amdgcn_mfma_f32_16x16x32_bf16(afrag, bfrag, na5[vt], 0, 0, 0);
                }
            }
            const float den = shfl_i(na5[4][0], lane & 15);
            const float dn = 1.0f / fmaxf(fabsf(den), __expf(-sc[SC_MT + dir * 64 + pcol]));
#pragma unroll
            for (int vt = 0; vt < 4; ++vt) hs[vt] = hs[vt] + na5[vt] * dn;
            __syncthreads();
        }
        float ss = 0.f;
#pragma unroll
        for (int vt = 0; vt < 4; ++vt) ss += hs[vt][0] * hs[vt][0] + hs[vt][1] * hs[vt][1] + hs[vt][2] * hs[vt][2] + hs[vt][3] * hs[vt][3];
        ss += shfl_x(ss, 16, lane); ss += shfl_x(ss, 32, lane);
        const float rstd = 1.0f / sqrtf(ss / 64 + EPSF);
        const size_t tok = (size_t)tok0 + pcol;
#pragma unroll
        for (int vt = 0; vt < 4; ++vt) {
            const int v = vt * 16 + (lane >> 4) * 4;
            const f32x4 hn = *(const f32x4*)(p.mlstm_head_norm + l * 256 + h * 64 + v), og = (f32x4){bflo(ogpre[vt][0]), bfhi(ogpre[vt][0]), bflo(ogpre[vt][1]), bfhi(ogpre[vt][1])};
            float o[4];
#pragma unroll
            for (int r = 0; r < 4; ++r) o[r] = hs[vt][r] * rstd * hn[r] * __builtin_amdgcn_rcpf(1.0f + __expf(-og[r]));
            *(u32x2*)(p.MIX + tok * Dm + 768 + h * 64 + v) = (u32x2){pk2(o[0], o[1]), pk2(o[2], o[3])};
        }
    }
}

template <bool DRY>
DI void bp_route_fast(const Params& p, int l, bool upd, unsigned char* smem, int bid, int G) {
    const int tid = opaque_tid(), lane = tid & 63, w = tid >> 6;
    const int rows = upd ? NTOK : NL;
    float* Wl = (float*)smem;
    const float* g = p.norm2_g + l * Dm;
    const float* wgp = p.moe_wg + (size_t)l * Dm * 4; const float* wep = p.moe_we + (size_t)l * Dm * 32;
    for (int item = bid; item < rows / 4; item += G) {
        const int r0 = item * 4 + w;
        float rstd[1], pacc[1][36];
#pragma unroll
        for (int rr = 0; rr < 1; ++rr) {
            const float* xr = p.X + (size_t)(r0 + rr) * Dm;
            float ss = 0.f;
#pragma unroll
            for (int j = 0; j < 16; ++j) { const float xv = xr[64 * j + lane]; ss += xv * xv; }
            ss = wave_sum(ss, lane);
            rstd[rr] = 1.0f / sqrtf(ss / Dm + EPSF);
#pragma unroll
            for (int c = 0; c < 36; ++c) pacc[rr][c] = 0.f;
        }
#pragma unroll 1
        for (int ch = 0; ch < 4; ++ch) {
            __syncthreads();
            {
                const int k = ch * 256 + tid;
                *(f32x4*)(Wl + tid * 36) = *(const f32x4*)(wgp + (size_t)k * 4);
#pragma unroll
                for (int q = 0; q < 8; ++q) *(f32x4*)(Wl + tid * 36 + 4 + q * 4) = *(const f32x4*)(wep + (size_t)k * 32 + q * 4);
            }
            __syncthreads();
#pragma unroll
            for (int j = 0; j < 4; ++j) {
                const int k = ch * 256 + 64 * j + lane;
                float f[1];
#pragma unroll
                for (int rr = 0; rr < 1; ++rr) {
                    const float* mr = mod_row(p, l, r0 + rr);
                    f[rr] = p.X[(size_t)(r0 + rr) * Dm + k] * rstd[rr] * g[k] * (1.0f + mr[4 * Dm + k]) + mr[3 * Dm + k];
                    p.F[(size_t)(r0 + rr) * Dm + k] = f2a(f[rr]);
                }
                const float* wr = Wl + (64 * j + lane) * 36;
#pragma unroll
                for (int q = 0; q < 9; ++q) {
                    const f32x4 wq = *(const f32x4*)(wr + q * 4);
#pragma unroll
                    for (int rr = 0; rr < 1; ++rr)
#pragma unroll
                        for (int r = 0; r < 4; ++r) pacc[rr][q * 4 + r] += f[rr] * wq[r];
                }
            }
        }
        __syncthreads();
        float* red = (float*)smem + w * (64 * 37);
#pragma unroll 1
        for (int rr = 0; rr < 1; ++rr) {
#pragma unroll
            for (int c = 0; c < 36; ++c) red[lane * 37 + c] = pacc[0][c];
            __syncthreads();
            float tot = 0.f;
            if (lane < 36) for (int q = 0; q < 64; ++q) tot += red[q * 37 + lane];
            __syncthreads();
            if (lane < 36) red[lane] = tot + (lane < 4 ? p.moe_bg[l * 4 + lane] : p.moe_be[l * 32 + lane - 4]);
            __syncthreads();
            float gmax = red[0]; int gi = 0;
#pragma unroll
            for (int j = 1; j < 4; ++j) { const float v = red[j]; if (v > gmax) { gmax = v; gi = j; } }
            float gsum = 0.f;
#pragma unroll
            for (int j = 0; j < 4; ++j) gsum += expf(red[j] - gmax);
            const float gtop = 1.0f / gsum;
            float e1 = -1e30f, e2 = -1e30f; int i1 = 0, i2 = 0;
#pragma unroll
            for (int j = 0; j < 8; ++j) { const float v = red[4 + gi * 8 + j]; if (v > e1) { e2 = e1; i2 = i1; e1 = v; i1 = j; } else if (v > e2) { e2 = v; i2 = j; } }
            const float g0 = 1.0f / (1.0f + expf(e2 - e1));
            if (lane == 0 && (!DRY || g0 == 123.456f)) {
                const int row = r0 + rr, ea = gi * 8 + i1, eb = gi * 8 + i2;
                p.EID[row * 2] = ea; p.EID[row * 2 + 1] = eb;
                p.GATE[row * 2] = g0 * gtop; p.GATE[row * 2 + 1] = (1.0f - g0) * gtop;
                const int pa = atomicAdd(&p.CNT[(l * 32 + ea) * 64], 1), pb = atomicAdd(&p.CNT[(l * 32 + eb) * 64], 1);
                p.LIST[(size_t)ea * NTOK + pa] = row; p.LIST[(size_t)eb * NTOK + pb] = row;
                p.POS[row * 2] = pa; p.POS[row * 2 + 1] = pb;
            }
            __syncthreads();
        }
    }
}

DI void mconv_item(const Params& p, int l, unsigned char* smem, int it) {
    const int tid = opaque_tid();
    float* T = (float*)smem;
    const int e = it / 48, r = it % 48, mat = r >> 4, q = (r >> 1) & 7, kh = r & 1;
    const int K = mat < 2 ? Dm : 512, N = mat < 2 ? 512 : Dm;
    const float *w1p = p.moe_w1, *w3p = p.moe_w3, *w2p = p.moe_w2;
    asm volatile("" : "+s"(w1p), "+s"(w3p), "+s"(w2p));
    const float* W = (mat == 0 ? w1p : mat == 1 ? w3p : w2p) + ((size_t)l * 32 + e) * Dm * 512;
    act_t* WT = mat < 2 ? p.W13T + ((size_t)(l & 1) * 32 * 1024 + (size_t)e * 1024 + mat * 512) * Dm : p.W2T + ((size_t)(l & 1) * 32 + e) * Dm * 512;
    const int ntile0 = mat < 2 ? q : 2 * q, nnt = mat < 2 ? 1 : 2, nkt = K / 128, kt0 = kh * nkt;
    const int k = tid >> 2, n16 = (tid & 3) * 16;
    const int n = tid >> 2, k16 = (tid & 3) * 16;
    f32x4 v[4];
#pragma unroll
    for (int i = 0; i < 4; ++i) v[i] = *(const f32x4*)(W + (size_t)(kt0 * 64 + k) * N + ntile0 * 64 + n16 + i * 4);
    for (int tix = 0; tix < nnt * nkt; ++tix) {
        const int nt = ntile0 + tix / nkt, kt = kt0 + tix % nkt;
        __syncthreads();
#pragma unroll
        for (int i = 0; i < 4; ++i) { T[k * 65 + n16 + i * 4] = v[i][0]; T[k * 65 + n16 + i * 4 + 1] = v[i][1]; T[k * 65 + n16 + i * 4 + 2] = v[i][2]; T[k * 65 + n16 + i * 4 + 3] = v[i][3]; }
        __syncthreads();
        if (tix + 1 < nnt * nkt) {
            const int nt2 = ntile0 + (tix + 1) / nkt, kt2 = kt0 + (tix + 1) % nkt;
#pragma unroll
            for (int i = 0; i < 4; ++i) v[i] = *(const f32x4*)(W + (size_t)(kt2 * 64 + k) * N + nt2 * 64 + n16 + i * 4);
        }
        unsigned o[8];
#pragma unroll
        for (int i = 0; i < 8; ++i) o[i] = pk2(T[(k16 + 2 * i) * 65 + n], T[(k16 + 2 * i + 1) * 65 + n]);
        act_t* dst = WT + (size_t)(nt * 64 + n) * K + kt * 64 + k16;
        *(u32x4*)dst = (u32x4){o[0], o[1], o[2], o[3]}; *(u32x4*)(dst + 8) = (u32x4){o[4], o[5], o[6], o[7]};
    }
}

DI int take_pair_ticket(unsigned* ctr, unsigned char* smem) {
    __syncthreads();
    if (threadIdx.x == 0) { const int t = (int)atomicAdd(ctr, 2u); *(volatile int*)(smem + SM_AUX + 512) = t; *(volatile int*)(smem + SMEM_BYTES + SM_AUX + 512) = t + 1; }
    __syncthreads();
    return *(volatile int*)(smem + SM_AUX + 512);
}
DI void mconv_drain(const Params& p, int l, unsigned char* smem, int max_items) {
    unsigned* ctr = p.BAR + 3600 + l;
    for (int n = 0; n < max_items; ++n) {
        const int it = take_pair_ticket(ctr, smem);
        if (it >= 32 * 48) break;
        mconv_item(p, l, smem, it);
    }
}

DI void bp_mixer(const Params& p, int l, bool upd, unsigned char* smem, int vbid) {
    constexpr int QTL = Tn / 128, QTC = Cn / 128, CPL = Tn / 64, BIG = 1 << 30;
    const int n_al = Bn * 4 * QTL + Bn * 6 * QTL, n_ac = upd ? Bn * 4 * QTC + Bn * 6 * QTC : 0;
    const int n_ml = Bn * 4 * CPL + (upd ? Bn * 4 * NCC : 0);
    const int total = n_al + n_ml + n_ac;
    unsigned* ctr = p.BAR + 3500 + l;
#define NEXT_ITEM() take_pair_ticket(ctr, smem)
    int it = NEXT_ITEM();
#ifdef PROBE_ATT2
    const int dup = n_al;
#else
    const int dup = 0;
#endif
#ifdef PROBE_ML2
    const int dupm = n_ml;
#else
    const int dupm = 0;
#endif
    constexpr int n_sc = Bn * 4 * 2 * 4;
    while (it < n_sc) { bp_mscan(p, l, smem, it); it = NEXT_ITEM(); }
    it -= n_sc;
    while (it < n_al + dup) { bp_attn(p, l, upd, smem, it < n_al ? it : it - n_al, BIG, vbid); it = NEXT_ITEM() - n_sc; }
    if (it < dup + n_al + n_ml + dupm) {
        if (opaque_tid() == 0) { unsigned sp_ = 0; while (__hip_atomic_load(p.BAR + 3700 + l, __ATOMIC_RELAXED, __HIP_MEMORY_SCOPE_AGENT) < (unsigned)n_sc && ++sp_ < (1u << 24)) __builtin_amdgcn_s_sleep(2); }
        __syncthreads();
    }
    while (it < dup + n_al + n_ml + dupm) { const int x = it - dup - n_al; bp_mlstm(p, l, upd, smem, x < n_ml ? x : x - n_ml, BIG); it = NEXT_ITEM() - n_sc; }
    while (it < dup + dupm + n_al + n_ml + n_ac) { bp_attn(p, l, upd, smem, it - dup - dupm - n_ml, BIG, vbid); it = NEXT_ITEM() - n_sc; }
    if (it - (dup + dupm + n_al + n_ml + n_ac) < gridDim.x) mconv_drain(p, l, smem, 1);
    (void)total;
#undef NEXT_ITEM

}

constexpr int RT_LD = 272, RT_AH = 0, RT_AL = 64 * RT_LD, RT_BH = 128 * RT_LD, RT_BL = RT_BH + 48 * RT_LD, RT_END = RT_BL + 48 * RT_LD;
static_assert(RT_END <= 65536, "router tiles exceed the LDS budget");
DI void mconv_drain(const Params& p, int l, unsigned char* smem, int max_items);
DI void bp_route2(const Params& p, int l, bool upd, unsigned char* smem, int bid, int G) {
    const int tid = opaque_tid(), lane = tid & 63, w = tid >> 6;
    const int rows = upd ? NTOK : NL;
    const float* gn = p.norm2_g + l * Dm;
    for (int item = bid; item < rows / 64; item += G) {
        const int r0 = item * 64;
#ifdef PROBE_RTDUP
        for (int rep_ = 0; rep_ < 2; ++rep_) {
#endif
        {
            const float* mr = mod_row(p, l, r0);
            f32x4 mul[4], add[4];
#pragma unroll
            for (int i = 0; i < 4; ++i) {
                const int k = 256 * i + 4 * lane;
                mul[i] = *(const f32x4*)(gn + k) * (1.0f + *(const f32x4*)(mr + 4 * Dm + k)); add[i] = *(const f32x4*)(mr + 3 * Dm + k);
            }
#pragma unroll 1
            for (int i0 = 0; i0 < 16; i0 += 4) {
                f32x4 x[4][4];
#pragma unroll
                for (int rr = 0; rr < 4; ++rr)
#pragma unroll
                    for (int i = 0; i < 4; ++i) x[rr][i] = ld4bf(p.XB + (size_t)(r0 + w * 16 + i0 + rr) * Dm + 256 * i + 4 * lane);
#pragma unroll
                for (int rr = 0; rr < 4; ++rr) {
                    const int row = r0 + w * 16 + i0 + rr;
                    float ss = 0.f;
#pragma unroll
                    for (int i = 0; i < 4; ++i) ss += x[rr][i][0] * x[rr][i][0] + x[rr][i][1] * x[rr][i][1] + x[rr][i][2] * x[rr][i][2] + x[rr][i][3] * x[rr][i][3];
                    ss = wave_sum(ss, lane);
                    const float rstd = 1.0f / sqrtf(ss / Dm + EPSF);
#pragma unroll
                    for (int i = 0; i < 4; ++i) {
                        const int k = 256 * i + 4 * lane;
                        const f32x4 y = x[rr][i] * rstd * mul[i] + add[i];
                        const unsigned h01 = pk2(y[0], y[1]), h23 = pk2(y[2], y[3]);
                        *(u32x2*)(p.F + (size_t)row * Dm + k) = (u32x2){h01, h23};
                        *(u32x2*)(p.FLO + (size_t)row * Dm + k) = (u32x2){pk2(y[0] - bflo(h01), y[1] - bfhi(h01)), pk2(y[2] - bflo(h23), y[3] - bfhi(h23))};
                    }
                }
            }
        }
        __threadfence_block();
        __syncthreads();
        f32x4 acc[3];
#pragma unroll
        for (int ni = 0; ni < 3; ++ni) acc[ni] = (f32x4){0.f, 0.f, 0.f, 0.f};
        const int s_r = tid >> 4, s_c = tid & 15;
        {
            const act_t* Ah = p.F + (size_t)(r0 + s_r) * Dm + s_c * 8;
            const act_t* Al = p.FLO + (size_t)(r0 + s_r) * Dm + s_c * 8;
            const act_t* Bh = p.WRHI + ((size_t)l * 36 + s_r) * Dm + s_c * 8;
            const act_t* Bl = p.WRLO + ((size_t)l * 36 + s_r) * Dm + s_c * 8;
            u32x4 rah[4], ral[4], rbh[3], rbl[3];
#define RT_LOAD(KOFF) { \
    _Pragma("unroll") for (int i = 0; i < 4; ++i) { rah[i] = *(const u32x4*)(Ah + (size_t)16 * i * Dm + (KOFF)); ral[i] = *(const u32x4*)(Al + (size_t)16 * i * Dm + (KOFF)); } \
    _Pragma("unroll") for (int i = 0; i < 3; ++i) { const bool ok = s_r + 16 * i < 36; \
        rbh[i] = ok ? *(const u32x4*)(Bh + (size_t)16 * i * Dm + (KOFF)) : (u32x4){0u, 0u, 0u, 0u}; rbl[i] = ok ? *(const u32x4*)(Bl + (size_t)16 * i * Dm + (KOFF)) : (u32x4){0u, 0u, 0u, 0u}; } }
            RT_LOAD(0)
#pragma unroll 1
            for (int k0 = 0; k0 < Dm; k0 += 128) {
                __syncthreads();
#pragma unroll
                for (int i = 0; i < 4; ++i) { *(u32x4*)(smem + RT_AH + (s_r + 16 * i) * RT_LD + s_c * 16) = rah[i]; *(u32x4*)(smem + RT_AL + (s_r + 16 * i) * RT_LD + s_c * 16) = ral[i]; }
#pragma unroll
                for (int i = 0; i < 3; ++i) { *(u32x4*)(smem + RT_BH + (s_r + 16 * i) * RT_LD + s_c * 16) = rbh[i]; *(u32x4*)(smem + RT_BL + (s_r + 16 * i) * RT_LD + s_c * 16) = rbl[i]; }
                __syncthreads();
                if (k0 + 128 < Dm) RT_LOAD(k0 + 128)
#pragma unroll
                for (int kk = 0; kk < 4; ++kk) {
                    const int fo = (lane & 15) * RT_LD + kk * 64 + (lane >> 4) * 16;
                    const bf16x8 ah = *(const bf16x8*)(smem + RT_AH + w * 16 * RT_LD + fo), al = *(const bf16x8*)(smem + RT_AL + w * 16 * RT_LD + fo);
#pragma unroll
                    for (int ni = 0; ni < 3; ++ni) {
                        const bf16x8 bh = *(const bf16x8*)(smem + RT_BH + ni * 16 * RT_LD + fo), bl = *(const bf16x8*)(smem + RT_BL + ni * 16 * RT_LD + fo);
                        acc[ni] = __builtin_amdgcn_mfma_f32_16x16x32_bf16(bh, ah, acc[ni], 0, 0, 0);
                        acc[ni] = __builtin_amdgcn_mfma_f32_16x16x32_bf16(bh, al, acc[ni], 0, 0, 0);
                        acc[ni] = __builtin_amdgcn_mfma_f32_16x16x32_bf16(bl, ah, acc[ni], 0, 0, 0);
                    }
                }
            }
#undef RT_LOAD
        }
        __syncthreads();
        float* lg = (float*)smem;
#ifdef PROBE_RTDUP
        if (rep_ == 0) continue;
#endif
#pragma unroll
        for (int ni = 0; ni < 3; ++ni)
#pragma unroll
            for (int r = 0; r < 4; ++r) lg[(w * 16 + (lane & 15)) * 49 + ni * 16 + (lane >> 4) * 4 + r] = acc[ni][r];
        __syncthreads();
        int* hist = (int*)(smem + 16384);
        if (tid < 64) hist[tid] = 0;
        __syncthreads();
        int ea = 0, eb = 0, ra = 0, rb = 0;
        if (tid < 64) {
            const float* rl = lg + tid * 49;
            float ag[4];
            float gmax = -1e30f; int gi = 0;
#pragma unroll
            for (int j = 0; j < 4; ++j) { ag[j] = rl[j] + p.moe_bg[l * 4 + j]; if (ag[j] > gmax) { gmax = ag[j]; gi = j; } }
            float gsum = 0.f;
#pragma unroll
            for (int j = 0; j < 4; ++j) gsum += expf(ag[j] - gmax);
            const float gtop = 1.0f / gsum;
            float e1 = -1e30f, e2 = -1e30f; int i1 = 0, i2 = 0;
#pragma unroll
            for (int j = 0; j < 8; ++j) { const float v = rl[4 + gi * 8 + j] + p.moe_be[l * 32 + gi * 8 + j]; if (v > e1) { e2 = e1; i2 = i1; e1 = v; i1 = j; } else if (v > e2) { e2 = v; i2 = j; } }
            const float g0 = 1.0f / (1.0f + expf(e2 - e1));
            const int row = r0 + tid; ea = gi * 8 + i1; eb = gi * 8 + i2;
            p.EID[row * 2] = ea; p.EID[row * 2 + 1] = eb;
            p.GATE[row * 2] = g0 * gtop; p.GATE[row * 2 + 1] = (1.0f - g0) * gtop;
            ra = atomicAdd(&hist[ea], 1); rb = atomicAdd(&hist[eb], 1);
        }
        __syncthreads();
        if (tid < 32 && hist[tid] > 0) hist[32 + tid] = atomicAdd(&p.CNT[(l * 32 + tid) * 64], hist[tid]);
        __syncthreads();
        if (tid < 64) {
            const int row = r0 + tid, pa = hist[32 + ea] + ra, pb = hist[32 + eb] + rb;
            p.LIST[(size_t)ea * NTOK + pa] = row; p.LIST[(size_t)eb * NTOK + pb] = row;
            p.POS[row * 2] = pa; p.POS[row * 2 + 1] = pb;
        }
        __syncthreads();
#ifdef PROBE_RTDUP
        }
#endif
    }
    mconv_drain(p, l, smem, 1 << 30);
}

constexpr int PPL = 9;
constexpr int NPH = 2 + PPL * DEPTH;
static inline bool phase_in_mega(int ph) {
    if (ph < 2) return true;
    const int s = (ph - 2) % PPL;
    return s == 1 ? IMPL_POST : s == 2 ? IMPL_ATTN : s == 3 ? IMPL_MLSTM : s == 5 ? IMPL_ROUTE : true;
}

#define XB_TMO      128
#define XB_XCNT(j)  (256  + 64 * (j))
#define XB_XSUB(j)  (1280 + 64 * (j))
#define XB_XGEN(j)  (2304 + 64 * (j))
#define XB_TOP      3328
#define XB_TOPGEN   3392
#define XCD_BAR_WORDS 3456
#define XB_SPIN_CAP (1u << 22)
#define LAS __attribute__((address_space(3)))
DI unsigned xb_ld(unsigned* p) { return __hip_atomic_load(p, __ATOMIC_RELAXED, __HIP_MEMORY_SCOPE_AGENT); }
DI unsigned xb_add(unsigned* p, unsigned v) { return __hip_atomic_fetch_add(p, v, __ATOMIC_RELAXED, __HIP_MEMORY_SCOPE_AGENT); }
DI unsigned xb_xcc_id() { return (unsigned)__builtin_amdgcn_s_getreg((3 << 11) | 20) & 0xFu; }
#define XB_SPIN(cond, bar) do { unsigned _sp = 0; while (cond) { __builtin_amdgcn_s_sleep(1); \
    if ((++_sp & 255u) == 0u) { if (xb_ld(&(bar)[XB_TMO])) break; if (_sp > XB_SPIN_CAP) { atomicAdd(&(bar)[XB_TMO], 1u); break; } } } } while (0)
struct XcdBarrier { unsigned* bar; unsigned x; volatile LAS unsigned* st; };
DI XcdBarrier xcd_barrier_post(unsigned* bar, volatile LAS unsigned* st) {
    XcdBarrier b; b.bar = bar; b.x = xb_xcc_id(); b.st = st;
    if (threadIdx.x == 0) (void)xb_add(&bar[XB_XCNT(b.x)], 1u);
    return b;
}
DI void xcd_barrier_complete(unsigned* bar, unsigned x, unsigned& nloc, unsigned& nx) {
    const unsigned G = gridDim.x * gridDim.y * gridDim.z;
    unsigned sum, cnt, mine, sp = 0u;
    for (;;) {
        sum = 0u; cnt = 0u; mine = 0u;
#pragma unroll 1
        for (unsigned j = 0; j < 16; ++j) { const unsigned c = xb_ld(&bar[XB_XCNT(j)]); sum += c; cnt += (c > 0u) ? 1u : 0u; }
        mine = xb_ld(&bar[XB_XCNT(x)]);
        if (sum == G) break;
        __builtin_amdgcn_s_sleep(1);
        if ((++sp & 255u) == 0u) { if (xb_ld(&bar[XB_TMO])) break; if (sp > XB_SPIN_CAP) { atomicAdd(&bar[XB_TMO], 1u); break; } }
    }
    nloc = mine > 0u ? mine : 1u; nx = cnt > 0u ? cnt : 1u;
}
DI void xcd_barrier(const XcdBarrier& b) {
    asm volatile("s_waitcnt vmcnt(0)" ::: "memory");
    __syncthreads();
    if (threadIdx.x == 0) {
        unsigned* bar = b.bar;
        __builtin_amdgcn_s_waitcnt(0);
        unsigned nloc = b.st[0], nx = b.st[1];
        if (nloc == 0u) { xcd_barrier_complete(bar, b.x, nloc, nx); b.st[0] = nloc; b.st[1] = nx; }
        const unsigned old = xb_add(&bar[XB_XSUB(b.x)], 1u);
        const unsigned gen = old / nloc;
        if (old + 1u == (gen + 1u) * nloc) {
            __builtin_amdgcn_fence(__ATOMIC_RELEASE, "agent");
            asm volatile("s_waitcnt vmcnt(0)" ::: "memory");
            const unsigned og = xb_add(&bar[XB_TOP], 1u);
            const unsigned tg = og / nx;
            if (og + 1u == (tg + 1u) * nx) xb_add(&bar[XB_TOPGEN], 1u);
            else XB_SPIN(xb_ld(&bar[XB_TOPGEN]) == tg, bar);
            __builtin_amdgcn_fence(__ATOMIC_ACQUIRE, "agent");
            asm volatile("s_waitcnt vmcnt(0)" ::: "memory");
        } else {
            XB_SPIN(xb_ld(&bar[XB_TOPGEN]) == gen, bar);
            __builtin_amdgcn_fence(__ATOMIC_ACQUIRE, "agent");
            asm volatile("s_waitcnt vmcnt(0)" ::: "memory");
        }
    }
    __syncthreads();
}

__global__ void __launch_bounds__(NTHR) k_naive(Params p, int ph) {
    const long gtid = (long)blockIdx.x * NTHR + threadIdx.x, gsize = (long)gridDim.x * NTHR;
    const int l = (ph - 2) / PPL, s = (ph - 2) % PPL;
    const bool upd = l < DEPTH - 1;
    (void)gtid; (void)gsize; (void)l; (void)s; (void)upd;
#if !IMPL_POST
    if (s == 1) ph_post(p, l, gtid, gsize);
#endif
#if !IMPL_ATTN
    if (s == 2) { ph_attn_diff(p, l, upd, gtid, gsize); ph_attn_gqa(p, l, upd, gtid, gsize); }
#endif
#if !IMPL_MLSTM
    if (s == 3) ph_mlstm(p, l, upd, gtid, gsize);
#endif
#if !IMPL_ROUTE
    if (s == 5) bp_route(p, l, upd, gtid, gsize);
#endif
}

__global__ void __launch_bounds__(RTHR, 2) k_mega(Params p_arg, int ph_begin, int ph_end) {
    extern __shared__ __attribute__((aligned(16))) unsigned char smem_real[];
    const Params& p0 = p_arg;
    cg::grid_group grid = cg::this_grid();
    const int half = __builtin_amdgcn_readfirstlane((int)(threadIdx.x >> 8));
    volatile LAS unsigned* xb_st = (volatile LAS unsigned*)(smem_real + 2 * SMEM_BYTES - 16);
    if (threadIdx.x == 0) { xb_st[0] = 0u; xb_st[1] = 0u; xb_st[2] = 0u; }
    __syncthreads();
    const XcdBarrier xb = xcd_barrier_post(p0.BAR, xb_st);
    for (int ph = ph_begin; ph < ph_end; ++ph) {
        Params p;
#if defined(__HIP_DEVICE_COMPILE__)
        {
            typedef const __attribute__((address_space(4))) unsigned long long* kp_t;
            kp_t pk = (kp_t)__builtin_amdgcn_kernarg_segment_ptr();
            asm volatile("" : "+s"(pk));
            static_assert(sizeof(Params) % 8 == 0, "Params is a list of pointers");
#pragma unroll
            for (unsigned i = 0; i < sizeof(Params) / 8; ++i) {
                char* gp = (char*)(__attribute__((address_space(1))) char*)pk[i];
                __builtin_memcpy((char*)&p + 8 * i, &gp, 8);
            }
        }
#else
        p = p0;
#endif
#ifdef PROBE_TS
        if (blockIdx.x == 0 && threadIdx.x == 0) { typedef const __attribute__((address_space(4))) unsigned long long* kp_t; kp_t pk = (kp_t)__builtin_amdgcn_kernarg_segment_ptr(); ((unsigned long long*)pk[offsetof(Params, TS) / 8])[ph] = __builtin_amdgcn_s_memrealtime(); }
#endif
        int half_ = half, rb_ = blockIdx.x, gr_ = gridDim.x; asm volatile("" : "+s"(half_), "+s"(rb_), "+s"(gr_));
        unsigned char* smem = smem_real + half_ * SMEM_BYTES;
        const int G = 2 * gr_, vbid = 2 * rb_ + half_;
        const int vb = (gr_ & 7) == 0 ? (rb_ & 7) * (G >> 3) + 2 * (rb_ >> 3) + half_ : vbid;
        const int tid = opaque_tid(), lane = tid & 63;
        const long gtid = (long)vbid * NTHR + tid, gsize = (long)G * NTHR;
        const int gwave = (int)(gtid >> 6), nwaves = (int)(gsize >> 6);
        if (ph == 0) {
            bp_mod(p, smem, vbid, G, gtid, gsize);
            bp_wconv(p, smem, G - 1 - vbid, G);
            if (gtid < DEPTH * 32 * 64) p.CNT[gtid] = 0;
            for (long it = gtid; it < (long)DEPTH * 36 * Dm; it += gsize) {
                const int k = (int)(it % Dm), n = (int)((it / Dm) % 36), ll = (int)(it / (36 * Dm));
                const float wv = n < 4 ? p.moe_wg[((size_t)ll * Dm + k) * 4 + n] : p.moe_we[((size_t)ll * Dm + k) * 32 + n - 4];
                const act_t hi = f2a(wv);
                p.WRHI[it] = hi; p.WRLO[it] = f2a(wv - a2f(hi));
            }
            { unsigned long long z0 = 0ull; asm volatile("" : "+v"(z0));
              if (gtid < 512) ((unsigned long long*)p.ZROW)[gtid] = z0;
              if (gtid >= 512 && gtid < 768) ((unsigned long long*)(p.F + (size_t)NTOK * Dm))[gtid - 512] = z0; }
            if (gtid < DEPTH) {
                const float* dl = p.diff_lambda + gtid * 4 * 48;
                float s01 = 0.f, s23 = 0.f;
                for (int i = 0; i < 48; ++i) { s01 += dl[i] * dl[48 + i]; s23 += dl[96 + i] * dl[144 + i]; }
                p.LAMV[gtid] = expf(s01) - expf(s23) + lam_init_of((int)gtid);
            }
            if (gtid < 64 * 28) {
                const int pos = (int)gtid / 28, fi = (int)gtid % 28, nf = fi < 12 ? 12 : 16, i = fi < 12 ? fi : fi - 12;
                const float ang = (float)pos * expf(-(float)i / (float)nf * 9.210340371976184f);
                p.ROPE[gtid * 2] = cosf(ang); p.ROPE[gtid * 2 + 1] = sinf(ang);
            }
        } else if (ph == 1) {
            bp_norm1(p, 0, gwave, nwaves, lane);
        } else {
            const int l = (ph - 2) / PPL, s = (ph - 2) % PPL;
            const bool upd = l < DEPTH - 1;
#ifdef PROBE_DUP
            if ((PROBE_DUP >> s) & 1) {
                if (s == 0) bp_gemm_in<PROBE_MODE>(p, l, smem, vb, G);
                if (s == 1) bp_post(p, l, smem, vbid, G);
                if (s == 6) bp_moe1(p, l, smem, vb, G);
                if (s == 7) bp_moe2(p, l, smem, vb, G);
                if (s == 4) bp_gemm_out<true>(p, l, upd, smem, vb, G);
                if (s == 8 && l < DEPTH - 1) bp_combine<true>(p, l, upd, smem, gwave, nwaves, lane);
            }
#endif
            switch (s) {
                case 0: bp_gemm_in8(p, l, smem_real, smem, vb, G, rb_); break;
#if IMPL_POST
                case 1: bp_post(p, l, smem, vbid, G); break;
#endif
#if IMPL_ATTN
                case 2: bp_mixer(p, l, upd, smem, vbid); break;
#endif
#if IMPL_MLSTM
                case 3: break;
#endif
#if IMPL_ROUTE
                case 5: bp_route2(p, l, upd, smem, vbid, G); break;
#endif
                case 4: bp_gemm_out8(p, l, upd, smem_real, smem, vb, G, rb_); break;
                case 6: bp_moe1_8(p, l, smem_real, G, rb_); break;
                case 7: bp_moe2_8(p, l, smem_real, G, rb_); break;
                case 8: bp_combine<false>(p, l, upd, smem, gwave, nwaves, lane); break;
                default: break;
            }
        }
        if (ph + 1 < ph_end && !(ph >= 2 && (ph - 2) % PPL == 2 && IMPL_ATTN && IMPL_MLSTM)) {
            if (ph_end < 0) grid.sync();
            xcd_barrier(xb);
#ifdef PROBE_DUP
            if (PROBE_DUP & 1024) xcd_barrier(xb);
#endif
        }
    }
#ifdef PROBE_TS
    if (blockIdx.x == 0 && __builtin_amdgcn_mbcnt_hi(~0u, __builtin_amdgcn_mbcnt_lo(~0u, 0u)) == 0u && atomicAdd((unsigned*)(smem_real + 2 * SMEM_BYTES - 8), 1u) == 0u) {
        struct { unsigned long long* TS; float* out; } p;
        { typedef const __attribute__((address_space(4))) unsigned long long* kp_t; kp_t pk = (kp_t)__builtin_amdgcn_kernarg_segment_ptr(); p.TS = (unsigned long long*)pk[offsetof(Params, TS) / 8]; p.out = (float*)pk[offsetof(Params, out) / 8]; }
        p.TS[NPH] = __builtin_amdgcn_s_memrealtime();
        unsigned long long tot = 0;
        if (PROBE_TS == 9) tot = p.TS[2] - p.TS[0];
        else if (PROBE_TS == 10) tot = p.TS[NPH] - p.TS[0];
        else for (int l = 0; l < DEPTH; ++l) tot += p.TS[2 + l * PPL + PROBE_TS + 1] - p.TS[2 + l * PPL + PROBE_TS];
        p.out[0] += (float)tot * 0.01f / PROBE_SCALE;
    }
#endif
}

extern "C" void kernel_launch(void* const* d_in, const int* in_sizes, int n_in, void* d_out, int out_size, void* d_ws, size_t ws_size, hipStream_t stream) {
    Params p;
    memset((void*)&p, 0, sizeof(p));
    fill_inputs(p, d_in, d_out);
    carve(p, d_ws);
    static int grid_blocks = 0;
    if (!grid_blocks) {
        int dev = 0, cus = 0, per_cu = 0;
        (void)hipGetDevice(&dev);
        (void)hipDeviceGetAttribute(&cus, hipDeviceAttributeMultiprocessorCount, dev);
        (void)hipFuncSetAttribute((const void*)k_mega, hipFuncAttributeMaxDynamicSharedMemorySize, 2 * SMEM_BYTES);
        (void)hipOccupancyMaxActiveBlocksPerMultiprocessor(&per_cu, k_mega, RTHR, 2 * SMEM_BYTES);
        if (per_cu > 1) per_cu = 1;
        if (per_cu < 1) per_cu = 1;
        grid_blocks = cus * per_cu;
    }
    (void)hipMemsetAsync(p.BAR, 0, 4096 * sizeof(unsigned), stream);
    int ph = 0;
    while (ph < NPH) {
        if (phase_in_mega(ph)) {
            int b = ph, e = ph;
            while (e < NPH && phase_in_mega(e)) ++e;
            void* args[] = {&p, &b, &e};
            (void)hipLaunchCooperativeKernel((void*)k_mega, dim3(grid_blocks), dim3(RTHR), args, 2 * SMEM_BYTES, stream);
            ph = e;
        } else {
            k_naive<<<2048, NTHR, 0, stream>>>(p, ph);
            ++ph;
        }
    }
}
#endif
```
